# Optimizing an MI355X kernel written in HIP

```python
import jax, jax.numpy as jnp
from jax import lax
import numpy as np

D_MODEL = 1024
BATCH = 16
SEQ = 4096
DEPTH = 2

CHUNK = 64
Q_BLOCK = 128
MEM_LEN = 256
MAX_STREAM_OFFSET = 4096
EPS = 1e-6
NEG_INF = -1e30

A_HEADS = 4
A_HEAD_DIM = 64
FORGET_BIAS_INIT = 3.0
B_GROUPS = 4
B_GROUP_DIM = 64
B_WINDOW = 128
C_HEADS = 8
C_NOPE_DIM = 64
C_ROPE_DIM = 32
C_V_DIM = 64
C_Q_RANK = 256
C_KV_RANK = 128
ROPE_THETA = 10000.0
M_HEADS = 4
M_HEAD_DIM = 128
D_FF = 2752
N_EXPERTS = 8
TOP_K = 2
D_FF_EXPERT = 1408

A_W = A_HEADS * A_HEAD_DIM
B_W = B_GROUPS * B_GROUP_DIM
C_W = C_HEADS * C_V_DIM
MIX_W = A_W + B_W + C_W
M_W = M_HEADS * M_HEAD_DIM
IN_SIZES = (A_W, A_W, A_W, A_HEADS, B_W, B_W, C_Q_RANK, C_KV_RANK, C_ROPE_DIM)
IN_W = int(sum(IN_SIZES))
IN_OFFSETS = tuple(int(v) for v in np.cumsum(IN_SIZES)[:-1])
N_DENSE = (DEPTH + 1) // 2
N_MOE = DEPTH // 2

kernel_name = 'hybrid_fox_gmlp_mla_moe_block'


def _rmsnorm(x, g):
    xf = x.astype(jnp.float32)
    y = xf * lax.rsqrt(jnp.mean(xf * xf, axis=-1, keepdims=True) + EPS)
    return (y * g.astype(jnp.float32)).astype(x.dtype)


def _layernorm(x, g):
    xf = x.astype(jnp.float32)
    mu = jnp.mean(xf, axis=-1, keepdims=True)
    var = jnp.mean(jnp.square(xf - mu), axis=-1, keepdims=True)
    return ((xf - mu) * lax.rsqrt(var + EPS) * g.astype(jnp.float32)).astype(x.dtype)


def _rope(x, pos):
    half = x.shape[-1] // 2
    inv = ROPE_THETA ** (-jnp.arange(half, dtype=jnp.float32) / half)
    ang = pos.astype(jnp.float32)[..., None] * inv
    ang = ang.reshape(ang.shape[:2] + (1,) * (x.ndim - 3) + (half,))
    cos, sin = jnp.cos(ang), jnp.sin(ang)
    x1 = x[..., :half].astype(jnp.float32)
    x2 = x[..., half:].astype(jnp.float32)
    return jnp.concatenate([x1 * cos - x2 * sin, x1 * sin + x2 * cos], axis=-1).astype(x.dtype)


def _swiglu(h, w_gate, w_up, w_down):
    return (jax.nn.silu(h @ w_gate) * (h @ w_up)) @ w_down


def _sweep_attention(q, k, v, scale, unit, log_decay):
    bn, nh, s_len, dk = q.shape
    nb = s_len // Q_BLOCK
    k_pos = jnp.arange(s_len)
    q_blocks = q.reshape(bn, nh, nb, Q_BLOCK, dk).transpose(2, 0, 1, 3, 4)
    if log_decay is None:
        xs = (q_blocks, jnp.arange(nb))
    else:
        xs = (q_blocks, jnp.arange(nb), log_decay.reshape(bn, nh, nb, Q_BLOCK).transpose(2, 0, 1, 3))

    def block(blk):
        qi, i = blk[0], blk[1]
        s = jnp.einsum('bhqd,bhkd->bhqk', qi, k, preferred_element_type=jnp.float32) * scale
        if log_decay is not None:
            s = s + blk[2][..., :, None] - log_decay[:, :, None, :]
        q_pos = i * Q_BLOCK + jnp.arange(Q_BLOCK)
        allowed = (k_pos[None, :] // unit) <= (q_pos[:, None] // unit)
        s = jnp.where(allowed, s, NEG_INF)
        p = jax.nn.softmax(s, axis=-1)
        return jnp.einsum('bhqk,bhkd->bhqd', p.astype(v.dtype), v)

    out = lax.map(block, xs)
    return out.transpose(1, 2, 0, 3, 4).reshape(bn, nh, s_len, v.shape[-1])


def _forgetting_attention(qa, ka, va, fa, b_forget, q_gain, k_gain):
    bn, s_len, _ = qa.shape
    q = _rmsnorm(qa.reshape(bn, s_len, A_HEADS, A_HEAD_DIM), q_gain)
    k = _rmsnorm(ka.reshape(bn, s_len, A_HEADS, A_HEAD_DIM), k_gain)
    v = va.reshape(bn, s_len, A_HEADS, A_HEAD_DIM)
    log_f = jax.nn.log_sigmoid((fa + b_forget).astype(jnp.float32))
    cum = jnp.cumsum(log_f, axis=1).transpose(0, 2, 1)
    o = _sweep_attention(q.transpose(0, 2, 1, 3), k.transpose(0, 2, 1, 3), v.transpose(0, 2, 1, 3),
                         A_HEAD_DIM ** -0.5, 1, cum)
    return o.transpose(0, 2, 1, 3).reshape(bn, s_len, A_W)


def _spatial_gating(ub, vb, v_gain, w_s, b_s):
    bn, s_len, _ = ub.shape
    u = jax.nn.gelu(ub, approximate=False)
    v = jax.nn.gelu(vb, approximate=False).reshape(bn, s_len, B_GROUPS, B_GROUP_DIM)
    v = _layernorm(v, v_gain.reshape(B_GROUPS, B_GROUP_DIM))
    v = v.reshape(bn, s_len // B_WINDOW, B_WINDOW, B_GROUPS, B_GROUP_DIM)
    pos = jnp.arange(B_WINDOW)
    mask = (pos[None, :] // CHUNK) <= (pos[:, None] // CHUNK)
    w = jnp.where(mask[None], w_s, 0.0)
    y = jnp.einsum('gts,bnsgd->bntgd', w, v) + b_s.T[None, None, :, :, None]
    return u * y.reshape(bn, s_len, B_W)


def _latent_attention(cq, ckv, kr, positions, cq_gain, w_uq, ckv_gain, w_ukv,
                      qn_g, qr_g, kn_g, kr_g):
    bn, s_len, _ = cq.shape
    q = jnp.einsum('bsr,rhd->bshd', _rmsnorm(cq, cq_gain), w_uq)
    q_nope = _rmsnorm(q[..., :C_NOPE_DIM], qn_g)
    q_rope = _rope(_rmsnorm(q[..., C_NOPE_DIM:], qr_g), positions)
    kv = jnp.einsum('bsr,rhd->bshd', _rmsnorm(ckv, ckv_gain), w_ukv)
    k_nope = _rmsnorm(kv[..., :C_NOPE_DIM], kn_g)
    v = kv[..., C_NOPE_DIM:]
    k_rope = _rope(_rmsnorm(kr, kr_g), positions)
    k = jnp.concatenate([k_nope, jnp.broadcast_to(k_rope[:, :, None, :],
                                                  (bn, s_len, C_HEADS, C_ROPE_DIM))], axis=-1)
    q = jnp.concatenate([q_nope, q_rope], axis=-1)
    o = _sweep_attention(q.transpose(0, 2, 1, 3), k.transpose(0, 2, 1, 3), v.transpose(0, 2, 1, 3),
                         (C_NOPE_DIM + C_ROPE_DIM) ** -0.5, CHUNK, None)
    return o.transpose(0, 2, 1, 3).reshape(bn, s_len, C_W)


def _memory_attention(h, mem_n, w_q, w_kv, q_g, k_g, w_o):
    bn, s_len, _ = h.shape
    m_len = mem_n.shape[1]
    q = _rmsnorm((h @ w_q).reshape(bn, s_len, M_HEADS, M_HEAD_DIM), q_g)
    kv = (mem_n @ w_kv).reshape(bn, m_len, 2, M_HEADS, M_HEAD_DIM)
    k = _rmsnorm(kv[:, :, 0], k_g)
    v = kv[:, :, 1]
    s = jnp.einsum('bshd,bmhd->bhsm', q, k, preferred_element_type=jnp.float32) * M_HEAD_DIM ** -0.5
    p = jax.nn.softmax(s, axis=-1)
    o = jnp.einsum('bhsm,bmhd->bshd', p.astype(v.dtype), v).reshape(bn, s_len, M_W)
    return o @ w_o


def _moe(h, w_router, b_router, w_gate, w_up, w_down):
    logits = (h @ w_router).astype(jnp.float32) + b_router.astype(jnp.float32)
    top_v, top_i = lax.top_k(logits, TOP_K)
    gates = jax.nn.softmax(top_v, axis=-1)
    combine = jnp.sum(jax.nn.one_hot(top_i, N_EXPERTS, dtype=jnp.float32) * gates[..., None],
                      axis=-2).astype(h.dtype)
    y = jnp.zeros_like(h)
    for e in range(N_EXPERTS):
        y = y + combine[..., e:e + 1] * _swiglu(h, w_gate[e], w_up[e], w_down[e])
    return y


def setup_inputs(seed: int = 0) -> dict:
    key = jax.random.key(seed)
    ks = iter(jax.random.split(key, 64))

    def nrm(shape, fan_in, mult=1.0):
        return mult * fan_in ** -0.5 * jax.random.normal(next(ks), shape, jnp.float32)

    def gain(shape):
        return 1.0 + 0.05 * jax.random.normal(next(ks), shape, jnp.float32)

    x = jax.random.normal(next(ks), (BATCH, SEQ, D_MODEL), jnp.float32)
    mem = jax.random.normal(next(ks), (BATCH, MEM_LEN, D_MODEL), jnp.float32)
    offsets = jax.random.randint(next(ks), (BATCH, 1), 0, MAX_STREAM_OFFSET, dtype=jnp.int32)
    positions = offsets + jnp.arange(SEQ, dtype=jnp.int32)[None, :]
    return {
        'x': x,
        'mem': mem,
        'positions': positions,
        'mix_norm': gain((DEPTH, D_MODEL)),
        'w_in': nrm((DEPTH, D_MODEL, IN_W), D_MODEL),
        'b_forget': FORGET_BIAS_INIT + 0.5 * jax.random.normal(next(ks), (DEPTH, A_HEADS), jnp.float32),
        'a_q_norm': gain((DEPTH, A_HEAD_DIM)),
        'a_k_norm': gain((DEPTH, A_HEAD_DIM)),
        'b_v_norm': gain((DEPTH, B_W)),
        'b_spatial_w': nrm((DEPTH, B_GROUPS, B_WINDOW, B_WINDOW), B_WINDOW, 0.5),
        'b_spatial_b': gain((DEPTH, B_GROUPS, B_WINDOW)),
        'c_q_lat_norm': gain((DEPTH, C_Q_RANK)),
        'c_w_uq': nrm((DEPTH, C_Q_RANK, C_HEADS, C_NOPE_DIM + C_ROPE_DIM), C_Q_RANK),
        'c_kv_lat_norm': gain((DEPTH, C_KV_RANK)),
        'c_w_ukv': nrm((DEPTH, C_KV_RANK, C_HEADS, C_NOPE_DIM + C_V_DIM), C_KV_RANK),
        'c_q_nope_norm': gain((DEPTH, C_NOPE_DIM)),
        'c_q_rope_norm': gain((DEPTH, C_ROPE_DIM)),
        'c_k_nope_norm': gain((DEPTH, C_NOPE_DIM)),
        'c_k_rope_norm': gain((DEPTH, C_ROPE_DIM)),
        'out_norm_a': gain((DEPTH, A_W)),
        'out_norm_b': gain((DEPTH, B_W)),
        'out_norm_c': gain((DEPTH, C_W)),
        'w_out': nrm((DEPTH, MIX_W, D_MODEL), MIX_W),
        'xattn_norm': gain((DEPTH, D_MODEL)),
        'mem_norm': gain((DEPTH, D_MODEL)),
        'w_mem_q': nrm((DEPTH, D_MODEL, M_W), D_MODEL),
        'w_mem_kv': nrm((DEPTH, D_MODEL, 2 * M_W), D_MODEL),
        'm_q_norm': gain((DEPTH, M_HEAD_DIM)),
        'm_k_norm': gain((DEPTH, M_HEAD_DIM)),
        'w_mem_out': nrm((DEPTH, M_W, D_MODEL), M_W),
        'ffn_norm': gain((DEPTH, D_MODEL)),
        'ffn_w_gate': nrm((N_DENSE, D_MODEL, D_FF), D_MODEL),
        'ffn_w_up': nrm((N_DENSE, D_MODEL, D_FF), D_MODEL),
        'ffn_w_down': nrm((N_DENSE, D_FF, D_MODEL), D_FF),
        'w_router': nrm((N_MOE, D_MODEL, N_EXPERTS), D_MODEL),
        'b_router': 0.01 * jax.random.normal(next(ks), (N_MOE, N_EXPERTS), jnp.float32),
        'moe_w_gate': nrm((N_MOE, N_EXPERTS, D_MODEL, D_FF_EXPERT), D_MODEL),
        'moe_w_up': nrm((N_MOE, N_EXPERTS, D_MODEL, D_FF_EXPERT), D_MODEL),
        'moe_w_down': nrm((N_MOE, N_EXPERTS, D_FF_EXPERT, D_MODEL), D_FF_EXPERT),
    }


def reference(x, mem, positions, mix_norm, w_in, b_forget, a_q_norm, a_k_norm, b_v_norm,
              b_spatial_w, b_spatial_b, c_q_lat_norm, c_w_uq, c_kv_lat_norm, c_w_ukv,
              c_q_nope_norm, c_q_rope_norm, c_k_nope_norm, c_k_rope_norm,
              out_norm_a, out_norm_b, out_norm_c, w_out, xattn_norm, mem_norm,
              w_mem_q, w_mem_kv, m_q_norm, m_k_norm, w_mem_out, ffn_norm,
              ffn_w_gate, ffn_w_up, ffn_w_down, w_router, b_router,
              moe_w_gate, moe_w_up, moe_w_down):
    for l in range(DEPTH):
        h = _rmsnorm(x, mix_norm[l])
        proj = h @ w_in[l]
        qa, ka, va, fa, ub, vb, cq, ckv, kr = jnp.split(proj, IN_OFFSETS, axis=-1)
        a = _forgetting_attention(qa, ka, va, fa, b_forget[l], a_q_norm[l], a_k_norm[l])
        b = _spatial_gating(ub, vb, b_v_norm[l], b_spatial_w[l], b_spatial_b[l])
        c = _latent_attention(cq, ckv, kr, positions, c_q_lat_norm[l], c_w_uq[l],
                              c_kv_lat_norm[l], c_w_ukv[l], c_q_nope_norm[l], c_q_rope_norm[l],
                              c_k_nope_norm[l], c_k_rope_norm[l])
        o = jnp.concatenate([_rmsnorm(a, out_norm_a[l]), _rmsnorm(b, out_norm_b[l]),
                             _rmsnorm(c, out_norm_c[l])], axis=-1)
        x = x + o @ w_out[l]
        x = x + _memory_attention(_rmsnorm(x, xattn_norm[l]), _rmsnorm(mem, mem_norm[l]),
                                  w_mem_q[l], w_mem_kv[l], m_q_norm[l], m_k_norm[l], w_mem_out[l])
        h = _rmsnorm(x, ffn_norm[l])
        if l % 2 == 0:
            x = x + _swiglu(h, ffn_w_gate[l // 2], ffn_w_up[l // 2], ffn_w_down[l // 2])
        else:
            m = l // 2
            x = x + _moe(h, w_router[m], b_router[m], moe_w_gate[m], moe_w_up[m], moe_w_down[m])
    return x
```

```cpp
#include <hip/hip_runtime.h>
#include <stdint.h>
#include <stdio.h>

typedef unsigned short bf16;
#define LAS __attribute__((address_space(3)))
#define EPSF 1e-6f

constexpr int BATCH = 16, SEQ = 4096, DM = 1024, MTOK = BATCH * SEQ, MEML = 256;
constexpr int PW = 1792;
constexpr int C_QA = 0, C_KA = 256, C_VA = 512, C_UB = 768, C_VB = 1024, C_CQ = 1280, C_CKV = 1536, C_KR = 1664, C_FA = 1696;
constexpr int IN_W = 1700, DFF = 2752, DFFP = 2816, NEXP = 8, DFE = 1408;
constexpr int SLOTS = 2 * MTOK + 16 * 256;
constexpr int MAXTILES = SLOTS / 256;

constexpr size_t MiB = 1u << 20;
constexpr size_t WS_CTL = 0, WS_WB = 1 * MiB, WS_H = 128 * MiB, WS_R1 = 256 * MiB;
constexpr size_t WS_QC = 640 * MiB, WS_KVC = 736 * MiB, WS_OMIX = 864 * MiB, WS_QM = 640 * MiB, WS_OM = 704 * MiB;
constexpr size_t WS_KVM = 992 * MiB, WS_HM = 1000 * MiB, WS_FLOG = 1008 * MiB, WS_CUM = 1009 * MiB, WS_TOP = 1010 * MiB, WS_SLOT = 1012 * MiB, WS_CH = 1014 * MiB;
constexpr size_t WS_HS = 256 * MiB, WS_HIDM = 520 * MiB, WS_END = 1015 * MiB;

__device__ __forceinline__ float bf2f(bf16 v) { return __uint_as_float(((unsigned)v) << 16); }
__device__ __forceinline__ bf16 f2bf(float f) { unsigned u = __float_as_uint(f); u += 0x7fffu + ((u >> 16) & 1u); return (bf16)(u >> 16); }
__device__ __forceinline__ unsigned pack2(float a, float b) { return (unsigned)f2bf(a) | ((unsigned)f2bf(b) << 16); }
__device__ __forceinline__ void unpack2(unsigned u, float& a, float& b) { a = __uint_as_float(u << 16); b = __uint_as_float(u & 0xffff0000u); }
__device__ __forceinline__ void ld4bf(const bf16* p, float (&f)[4]) { const uint2 u = *(const uint2*)p; unpack2(u.x, f[0], f[1]); unpack2(u.y, f[2], f[3]); }
__device__ __forceinline__ void st4bf(bf16* p, const float (&f)[4]) { uint2 u; u.x = pack2(f[0], f[1]); u.y = pack2(f[2], f[3]); *(uint2*)p = u; }
__device__ __forceinline__ void ld8bf(const bf16* p, float (&f)[8]) { const uint4 u = *(const uint4*)p; unpack2(u.x, f[0], f[1]); unpack2(u.y, f[2], f[3]); unpack2(u.z, f[4], f[5]); unpack2(u.w, f[6], f[7]); }
__device__ __forceinline__ void st8bf(bf16* p, const float (&f)[8]) { uint4 u; u.x = pack2(f[0], f[1]); u.y = pack2(f[2], f[3]); u.z = pack2(f[4], f[5]); u.w = pack2(f[6], f[7]); *(uint4*)p = u; }
__device__ __forceinline__ float wsum(float v) {
#pragma unroll
    for (int o = 1; o < 64; o <<= 1) v += __shfl_xor(v, o);
    return v; }
__device__ __forceinline__ float sum16(float v) { v += __shfl_xor(v, 1); v += __shfl_xor(v, 2); v += __shfl_xor(v, 4); v += __shfl_xor(v, 8); return v; }
__device__ __forceinline__ float sum8(float v) { v += __shfl_xor(v, 1); v += __shfl_xor(v, 2); v += __shfl_xor(v, 4); return v; }
__device__ __forceinline__ float gelu_erf(float x) { return 0.5f * x * (1.0f + erff(x * 0.70710678118f)); }
__device__ __forceinline__ float logsigmoid(float z) { return fminf(z, 0.f) - log1pf(expf(-fabsf(z))); }
__device__ __forceinline__ float rope_inv(int i) { return exp2f(-(float)i * (13.287712379549449f / 16.0f)); }

struct Args { const float* in[39]; float* out; unsigned char* ws; int l; int phase; };
struct Ctx {
    const float* x_in; const float* mem; const int* pos;
    const float *mix_norm, *w_in, *b_forget, *aq, *ak, *bv, *bsw, *bsb, *cqg, *wuq, *ckvg, *wukv, *qng, *qrg, *kng, *krg, *ona, *onb, *onc, *wout, *xattn, *memn, *wmq, *wmkv, *mqg, *mkg, *wmo, *ffn_norm;
    const float *fg, *fu, *fd, *wr, *br, *mg, *mu, *md;
    float* X;
    bf16 *H, *PROJ, *QC, *KVC, *OMIX, *QM, *OM, *KVM, *HM, *HID, *HS, *HIDM;
    float *FLOG, *CUM, *TOPG, *SLOT_GATE; int *TOPI, *SLOT_TOK, *CH, *TAB;
};
__device__ __host__ __forceinline__ Ctx make_ctx(const Args& a, int l) {
    Ctx c;
    c.x_in = a.in[0]; c.mem = a.in[1]; c.pos = (const int*)a.in[2];
    c.mix_norm = a.in[3] + l * 1024; c.w_in = a.in[4] + (size_t)l * 1024 * IN_W; c.b_forget = a.in[5] + l * 4; c.aq = a.in[6] + l * 64; c.ak = a.in[7] + l * 64;
    c.bv = a.in[8] + l * 256; c.bsw = a.in[9] + l * 4 * 128 * 128; c.bsb = a.in[10] + l * 4 * 128; c.cqg = a.in[11] + l * 256; c.wuq = a.in[12] + (size_t)l * 256 * 768;
    c.ckvg = a.in[13] + l * 128; c.wukv = a.in[14] + (size_t)l * 128 * 1024; c.qng = a.in[15] + l * 64; c.qrg = a.in[16] + l * 32; c.kng = a.in[17] + l * 64; c.krg = a.in[18] + l * 32;
    c.ona = a.in[19] + l * 256; c.onb = a.in[20] + l * 256; c.onc = a.in[21] + l * 512; c.wout = a.in[22] + (size_t)l * 1024 * 1024; c.xattn = a.in[23] + l * 1024; c.memn = a.in[24] + l * 1024;
    c.wmq = a.in[25] + (size_t)l * 1024 * 512; c.wmkv = a.in[26] + (size_t)l * 1024 * 1024; c.mqg = a.in[27] + l * 128; c.mkg = a.in[28] + l * 128; c.wmo = a.in[29] + (size_t)l * 512 * 1024; c.ffn_norm = a.in[30] + l * 1024;
    c.fg = a.in[31]; c.fu = a.in[32]; c.fd = a.in[33]; c.wr = a.in[34]; c.br = a.in[35]; c.mg = a.in[36]; c.mu = a.in[37]; c.md = a.in[38];
    c.X = a.out;
    unsigned char* ws = a.ws;
    c.H = (bf16*)(ws + WS_H); c.PROJ = (bf16*)(ws + WS_R1); c.QC = (bf16*)(ws + WS_QC); c.KVC = (bf16*)(ws + WS_KVC); c.OMIX = (bf16*)(ws + WS_OMIX); c.QM = (bf16*)(ws + WS_QM); c.OM = (bf16*)(ws + WS_OM);
    c.KVM = (bf16*)(ws + WS_KVM); c.HM = (bf16*)(ws + WS_HM); c.HID = (bf16*)(ws + WS_R1); c.HS = (bf16*)(ws + WS_HS); c.HIDM = (bf16*)(ws + WS_HIDM);
    c.FLOG = (float*)(ws + WS_FLOG); c.CUM = (float*)(ws + WS_CUM); c.TOPI = (int*)(ws + WS_TOP); c.TOPG = (float*)(ws + WS_TOP + MiB); c.SLOT_TOK = (int*)(ws + WS_SLOT); c.SLOT_GATE = (float*)(ws + WS_SLOT + MiB);
    c.CH = (int*)(ws + WS_CH); c.TAB = (int*)(ws + WS_CH + 65536);
    return c;
}

__device__ __forceinline__ void norm_row(const float* xr, const float* g, bf16* hr, int lane) {
    float4 v[4]; float ss = 0.f;
#pragma unroll
    for (int j = 0; j < 4; ++j) { v[j] = ((const float4*)xr)[lane + 64 * j]; ss += v[j].x * v[j].x + v[j].y * v[j].y + v[j].z * v[j].z + v[j].w * v[j].w; }
    ss = wsum(ss); const float r = rsqrtf(ss * (1.f / 1024.f) + EPSF);
#pragma unroll
    for (int j = 0; j < 4; ++j) { const float4 gg = ((const float4*)g)[lane + 64 * j]; float f[4] = {v[j].x * r * gg.x, v[j].y * r * gg.y, v[j].z * r * gg.z, v[j].w * r * gg.w}; st4bf(hr + 4 * (lane + 64 * j), f); }
}
__device__ __forceinline__ void pass_norm(const float* x, const float* g, bf16* H, int nrows, int gw, int ngw, int lane) {
    for (int r = gw; r < nrows; r += ngw) norm_row(x + (size_t)r * 1024, g, H + (size_t)r * 1024, lane);
}
__device__ __forceinline__ void post_proj_row(const Ctx& c, int row, int lane) {
    bf16* p = c.PROJ + (size_t)row * PW; const int c4 = 4 * lane; float f[4];
    { ld4bf(p + C_QA + c4, f); float ss = f[0] * f[0] + f[1] * f[1] + f[2] * f[2] + f[3] * f[3]; ss = sum16(ss); const float r = rsqrtf(ss * (1.f / 64.f) + EPSF);
#pragma unroll
      for (int i = 0; i < 4; ++i) f[i] *= r * c.aq[(c4 + i) & 63];
      st4bf(p + C_QA + c4, f); }
    { ld4bf(p + C_KA + c4, f); float ss = f[0] * f[0] + f[1] * f[1] + f[2] * f[2] + f[3] * f[3]; ss = sum16(ss); const float r = rsqrtf(ss * (1.f / 64.f) + EPSF);
#pragma unroll
      for (int i = 0; i < 4; ++i) f[i] *= r * c.ak[(c4 + i) & 63];
      st4bf(p + C_KA + c4, f); }
    { ld4bf(p + C_UB + c4, f);
#pragma unroll
      for (int i = 0; i < 4; ++i) f[i] = gelu_erf(f[i]);
      st4bf(p + C_UB + c4, f); }
    { ld4bf(p + C_VB + c4, f);
#pragma unroll
      for (int i = 0; i < 4; ++i) f[i] = gelu_erf(f[i]);
      const float mu = sum16(f[0] + f[1] + f[2] + f[3]) * (1.f / 64.f); float q = 0.f;
#pragma unroll
      for (int i = 0; i < 4; ++i) { f[i] -= mu; q += f[i] * f[i]; }
      const float r = rsqrtf(sum16(q) * (1.f / 64.f) + EPSF);
#pragma unroll
      for (int i = 0; i < 4; ++i) f[i] *= r * c.bv[c4 + i];
      st4bf(p + C_VB + c4, f); }
    { ld4bf(p + C_CQ + c4, f); float ss = f[0] * f[0] + f[1] * f[1] + f[2] * f[2] + f[3] * f[3]; ss = wsum(ss); const float r = rsqrtf(ss * (1.f / 256.f) + EPSF);
#pragma unroll
      for (int i = 0; i < 4; ++i) f[i] *= r * c.cqg[c4 + i];
      st4bf(p + C_CQ + c4, f); }
    { float ss = 0.f; if (lane < 32) { ld4bf(p + C_CKV + c4, f); ss = f[0] * f[0] + f[1] * f[1] + f[2] * f[2] + f[3] * f[3]; }
      ss = wsum(ss); const float r = rsqrtf(ss * (1.f / 128.f) + EPSF);
      if (lane < 32) {
#pragma unroll
          for (int i = 0; i < 4; ++i) f[i] *= r * c.ckvg[c4 + i];
          st4bf(p + C_CKV + c4, f); } }
    { float x1 = 0.f, x2 = 0.f; if (lane < 16) { x1 = bf2f(p[C_KR + lane]); x2 = bf2f(p[C_KR + 16 + lane]); }
      const float ss = sum16(x1 * x1 + x2 * x2); const float r = rsqrtf(ss * (1.f / 32.f) + EPSF);
      if (lane < 16) { x1 *= r * c.krg[lane]; x2 *= r * c.krg[16 + lane]; const float ang = (float)c.pos[row] * rope_inv(lane); const float sn = sinf(ang), cs = cosf(ang);
          p[C_KR + lane] = f2bf(x1 * cs - x2 * sn); p[C_KR + 16 + lane] = f2bf(x1 * sn + x2 * cs); } }
    if (lane < 4) c.FLOG[(size_t)row * 4 + lane] = logsigmoid(bf2f(p[C_FA + lane]) + c.b_forget[lane]);
}
__device__ __forceinline__ void post_up_row(const Ctx& c, int row, int lane) {
    const int h = lane >> 3, j = lane & 7;
    bf16* q = c.QC + (size_t)row * 768 + h * 96; bf16* kv = c.KVC + (size_t)row * 1024 + h * 128;
    { float f[8]; ld8bf(q + 8 * j, f); float ss = 0.f;
#pragma unroll
      for (int i = 0; i < 8; ++i) ss += f[i] * f[i];
      const float r = rsqrtf(sum8(ss) * (1.f / 64.f) + EPSF);
#pragma unroll
      for (int i = 0; i < 8; ++i) f[i] *= r * c.qng[8 * j + i];
      st8bf(q + 8 * j, f); }
    { float f[4]; ld4bf(q + 64 + 4 * j, f); float ss = f[0] * f[0] + f[1] * f[1] + f[2] * f[2] + f[3] * f[3]; const float r = rsqrtf(sum8(ss) * (1.f / 32.f) + EPSF);
      const float posf = (float)c.pos[row]; float o[4];
#pragma unroll
      for (int i = 0; i < 4; ++i) { f[i] *= r * c.qrg[4 * j + i]; const float other = __shfl_xor(f[i], 4); const int fi = 4 * (j & 3) + i; const float ang = posf * rope_inv(fi); const float sn = sinf(ang), cs = cosf(ang);
          o[i] = (j < 4) ? (f[i] * cs - other * sn) : (other * sn + f[i] * cs); }
      st4bf(q + 64 + 4 * j, o); }
    { float f[8]; ld8bf(kv + 8 * j, f); float ss = 0.f;
#pragma unroll
      for (int i = 0; i < 8; ++i) ss += f[i] * f[i];
      const float r = rsqrtf(sum8(ss) * (1.f / 64.f) + EPSF);
#pragma unroll
      for (int i = 0; i < 8; ++i) f[i] *= r * c.kng[8 * j + i];
      st8bf(kv + 8 * j, f); }
}
__device__ __forceinline__ void mixnorm_row(const Ctx& c, int row, int lane) {
    bf16* p = c.OMIX + (size_t)row * 1024; float f[4];
    { ld4bf(p + 4 * lane, f); const float r = rsqrtf(wsum(f[0] * f[0] + f[1] * f[1] + f[2] * f[2] + f[3] * f[3]) * (1.f / 256.f) + EPSF);
#pragma unroll
      for (int i = 0; i < 4; ++i) f[i] *= r * c.ona[4 * lane + i];
      st4bf(p + 4 * lane, f); }
    { ld4bf(p + 256 + 4 * lane, f); const float r = rsqrtf(wsum(f[0] * f[0] + f[1] * f[1] + f[2] * f[2] + f[3] * f[3]) * (1.f / 256.f) + EPSF);
#pragma unroll
      for (int i = 0; i < 4; ++i) f[i] *= r * c.onb[4 * lane + i];
      st4bf(p + 256 + 4 * lane, f); }
    { float g[8]; ld8bf(p + 512 + 8 * lane, g); float ss = 0.f;
#pragma unroll
      for (int i = 0; i < 8; ++i) ss += g[i] * g[i];
      const float r = rsqrtf(wsum(ss) * (1.f / 512.f) + EPSF);
#pragma unroll
      for (int i = 0; i < 8; ++i) g[i] *= r * c.onc[8 * lane + i];
      st8bf(p + 512 + 8 * lane, g); }
}
__device__ __forceinline__ void memnorm_row(bf16* p, const float* g, int lane) {
    float f[8]; ld8bf(p + 8 * lane, f); float ss = 0.f;
#pragma unroll
    for (int i = 0; i < 8; ++i) ss += f[i] * f[i];
    const float r = rsqrtf(sum16(ss) * (1.f / 128.f) + EPSF);
#pragma unroll
    for (int i = 0; i < 8; ++i) f[i] *= r * g[(8 * lane + i) & 127];
    st8bf(p + 8 * lane, f);
}
__device__ __forceinline__ void route_row(const Ctx& c, int row, int lane) {
    const float* xr = c.X + (size_t)row * 1024; float4 v[4]; float ss = 0.f;
#pragma unroll
    for (int j = 0; j < 4; ++j) { v[j] = ((const float4*)xr)[lane + 64 * j]; ss += v[j].x * v[j].x + v[j].y * v[j].y + v[j].z * v[j].z + v[j].w * v[j].w; }
    ss = wsum(ss); const float r = rsqrtf(ss * (1.f / 1024.f) + EPSF);
    float lg[8];
#pragma unroll
    for (int e = 0; e < 8; ++e) lg[e] = 0.f;
#pragma unroll
    for (int j = 0; j < 4; ++j) { const float4 gg = ((const float4*)c.ffn_norm)[lane + 64 * j]; float f[4] = {v[j].x * r * gg.x, v[j].y * r * gg.y, v[j].z * r * gg.z, v[j].w * r * gg.w};
        st4bf(c.H + (size_t)row * 1024 + 4 * (lane + 64 * j), f);
#pragma unroll
        for (int i = 0; i < 4; ++i) { const float4* w = (const float4*)(c.wr + (size_t)(4 * (lane + 64 * j) + i) * 8); const float4 w0 = w[0], w1 = w[1];
            lg[0] += f[i] * w0.x; lg[1] += f[i] * w0.y; lg[2] += f[i] * w0.z; lg[3] += f[i] * w0.w; lg[4] += f[i] * w1.x; lg[5] += f[i] * w1.y; lg[6] += f[i] * w1.z; lg[7] += f[i] * w1.w; } }
#pragma unroll
    for (int e = 0; e < 8; ++e) lg[e] = wsum(lg[e]) + c.br[e];
    int i1 = 0; float v1 = lg[0];
#pragma unroll
    for (int e = 1; e < 8; ++e) if (lg[e] > v1) { v1 = lg[e]; i1 = e; }
    int i2 = -1; float v2 = -3.0e38f;
#pragma unroll
    for (int e = 0; e < 8; ++e) if (e != i1 && lg[e] > v2) { v2 = lg[e]; i2 = e; }
    const float e2 = expf(v2 - v1), g1 = 1.f / (1.f + e2), g2 = e2 / (1.f + e2);
    if (lane == 0) { c.TOPI[(size_t)row * 2] = i1; c.TOPI[(size_t)row * 2 + 1] = i2; c.TOPG[(size_t)row * 2] = g1; c.TOPG[(size_t)row * 2 + 1] = g2; }
}

__device__ __forceinline__ void cumsum_batch(const Ctx& c, int b, LAS float* sm  , int tid) {
    const int lane = tid & 63, wave = tid >> 6;
    const float4* src = (const float4*)c.FLOG + (size_t)b * SEQ + tid * 8; float4* dst = (float4*)c.CUM + (size_t)b * SEQ + tid * 8;
    float4 v[8];
#pragma unroll
    for (int i = 0; i < 8; ++i) v[i] = src[i];
#pragma unroll
    for (int i = 1; i < 8; ++i) { v[i].x += v[i - 1].x; v[i].y += v[i - 1].y; v[i].z += v[i - 1].z; v[i].w += v[i - 1].w; }
    const float4 tot = v[7]; float4 inc = tot;
#pragma unroll
    for (int o = 1; o < 64; o <<= 1) { const float tx = __shfl_up(inc.x, o), ty = __shfl_up(inc.y, o), tz = __shfl_up(inc.z, o), tw = __shfl_up(inc.w, o); if (lane >= o) { inc.x += tx; inc.y += ty; inc.z += tz; inc.w += tw; } }
    if (lane == 63) { sm[wave * 4 + 0] = inc.x; sm[wave * 4 + 1] = inc.y; sm[wave * 4 + 2] = inc.z; sm[wave * 4 + 3] = inc.w; }
    __syncthreads();
    float4 base = {0.f, 0.f, 0.f, 0.f};
    for (int w = 0; w < wave; ++w) { base.x += sm[w * 4 + 0]; base.y += sm[w * 4 + 1]; base.z += sm[w * 4 + 2]; base.w += sm[w * 4 + 3]; }
    const float4 ex = {base.x + inc.x - tot.x, base.y + inc.y - tot.y, base.z + inc.z - tot.z, base.w + inc.w - tot.w};
#pragma unroll
    for (int i = 0; i < 8; ++i) dst[i] = make_float4(v[i].x + ex.x, v[i].y + ex.y, v[i].z + ex.z, v[i].w + ex.w);
    __syncthreads();
}
__device__ __forceinline__ void route1_chunk(const Ctx& c, int ch, LAS int* sm  , int tid) {
    const int lane = tid & 63, wave = tid >> 6;
    if (tid < 16) sm[tid] = 0;
    __syncthreads();
    for (int i = 0; i < 32; ++i) route_row(c, ch * 256 + wave * 32 + i, lane);
    __syncthreads();
    if (tid < 256) { const int row = ch * 256 + tid; const int e1 = __hip_atomic_load(c.TOPI + (size_t)row * 2, __ATOMIC_RELAXED, __HIP_MEMORY_SCOPE_AGENT), e2 = __hip_atomic_load(c.TOPI + (size_t)row * 2 + 1, __ATOMIC_RELAXED, __HIP_MEMORY_SCOPE_AGENT);
        atomicAdd((int*)&sm[e1], 1); atomicAdd((int*)&sm[8 + e2], 1); }
    __syncthreads();
    if (tid < 16) c.CH[ch * 16 + tid] = sm[tid];
    __syncthreads();
}
__device__ __forceinline__ void route2_chunk(const Ctx& c, int ch, LAS int* sm  , int tid) {
    const int lane = tid & 63, wave = tid >> 6;
    LAS int* sCH = sm; LAS int* sTot = sm + 4096; LAS int* sPre = sm + 4096 + 16; LAS int* sOff = sm + 4096 + 32; LAS int* sWc = sm + 4096 + 64; LAS int* sSlot = sm + 4096 + 128;
    for (int i = tid; i < 4096; i += 512) sCH[i] = c.CH[i];
    __syncthreads();
    if (tid < 16) { int tot = 0, pre = 0; for (int k = 0; k < 256; ++k) { const int v = sCH[k * 16 + tid]; tot += v; if (k < ch) pre += v; } sTot[tid] = tot; sPre[tid] = pre; }
    __syncthreads();
    if (tid == 0) { int o = 0; for (int g = 0; g < 16; ++g) { sOff[g] = o; o += (sTot[g] + 255) & ~255; } sOff[16] = o; }
    __syncthreads();
    int e1 = -1, e2 = -1, r1 = 0, r2 = 0; const int row = ch * 256 + tid;
    if (tid < 256) { e1 = c.TOPI[(size_t)row * 2]; e2 = c.TOPI[(size_t)row * 2 + 1]; }
    for (int g = 0; g < 16; ++g) { const bool pred = (tid < 256) && (g < 8 ? (e1 == g) : (e2 == g - 8)); const unsigned long long m = __ballot(pred);
        const int rk = __popcll(m & ((1ull << lane) - 1ull)); if (pred) { if (g < 8) r1 = rk; else r2 = rk; }
        if (lane == 0 && wave < 4) sWc[wave * 16 + g] = __popcll(m); }
    __syncthreads();
    if (tid < 256) { int b1 = sOff[e1] + sPre[e1], b2 = sOff[8 + e2] + sPre[8 + e2]; for (int w = 0; w < wave; ++w) { b1 += sWc[w * 16 + e1]; b2 += sWc[w * 16 + 8 + e2]; }
        const int s1 = b1 + r1, s2 = b2 + r2; sSlot[tid * 2] = s1; sSlot[tid * 2 + 1] = s2;
        c.SLOT_TOK[s1] = row; c.SLOT_TOK[s2] = row; c.SLOT_GATE[s1] = c.TOPG[(size_t)row * 2]; c.SLOT_GATE[s2] = c.TOPG[(size_t)row * 2 + 1]; }
    __syncthreads();
    for (int i = 0; i < 32; ++i) { const int t = wave * 32 + i; const uint4* src = (const uint4*)(c.H + (size_t)(ch * 256 + t) * 1024); const uint4 a = src[lane], b = src[lane + 64];
#pragma unroll
        for (int k = 0; k < 2; ++k) { uint4* d = (uint4*)(c.HS + (size_t)sSlot[t * 2 + k] * 1024); d[lane] = a; d[lane + 64] = b; } }
    for (int g = 0; g < 16; ++g) { const int rem = sTot[g] & 255; if (rem && ch >= rem) { const int r = sOff[g] + (sTot[g] & ~255) + ch; ((unsigned*)(c.HS + (size_t)r * 1024))[tid] = 0u; if (tid == 0) { c.SLOT_TOK[r] = -1; c.SLOT_GATE[r] = 0.f; } } }
    if (ch == 0) { const int nt = sOff[16] >> 8; for (int t = tid; t < MAXTILES + 16; t += 512) { int g = -1; if (t < nt) { for (int q = 0; q < 16; ++q) if ((t << 8) >= sOff[q] && (t << 8) < sOff[q + 1]) g = q; } c.TAB[t] = g; } if (tid == 0) { c.TAB[1000] = nt; c.TAB[1001] = sOff[8] >> 8; } }
    __syncthreads();
}

enum { PH_NORM1 = 0, PH_POSTPROJ, PH_CUMSUM, PH_POSTUP, PH_MIXNORM, PH_NORM2, PH_MEMNORM_Q, PH_MEMKV_NORM, PH_MEMNORM_K, PH_NORM3, PH_ROUTE1, PH_ROUTE2, PH_ZEROPAD };
__global__ void __launch_bounds__(512) k_elem(Args a) {
    __shared__ int smem[4096 + 128 + 512 + 64];
    const Ctx c = make_ctx(a, a.l);
    const int tid = threadIdx.x, lane = tid & 63, wave = tid >> 6, gw = blockIdx.x * 8 + wave, ngw = gridDim.x * 8;
    switch (a.phase) {
    case PH_NORM1: pass_norm(a.l == 0 ? c.x_in : c.X, c.mix_norm, c.H, MTOK, gw, ngw, lane); break;
    case PH_POSTPROJ: for (int r = gw; r < MTOK; r += ngw) post_proj_row(c, r, lane); break;
    case PH_CUMSUM: for (int b = blockIdx.x; b < BATCH; b += gridDim.x) cumsum_batch(c, b, (LAS float*)smem, tid); break;
    case PH_POSTUP: for (int r = gw; r < MTOK; r += ngw) post_up_row(c, r, lane); break;
    case PH_MIXNORM: for (int r = gw; r < MTOK; r += ngw) mixnorm_row(c, r, lane); break;
    case PH_NORM2: pass_norm(c.X, c.xattn, c.H, MTOK, gw, ngw, lane); break;
    case PH_MEMNORM_Q: for (int r = gw; r < MTOK; r += ngw) memnorm_row(c.QM + (size_t)r * 512, c.mqg, lane); break;
    case PH_MEMKV_NORM: pass_norm(c.mem, c.memn, c.HM, BATCH * MEML, gw, ngw, lane); break;
    case PH_MEMNORM_K: for (int r = gw; r < BATCH * MEML; r += ngw) memnorm_row(c.KVM + (size_t)r * 1024, c.mkg, lane); break;
    case PH_NORM3: pass_norm(c.X, c.ffn_norm, c.H, MTOK, gw, ngw, lane); break;
    case PH_ROUTE1: for (int ch = blockIdx.x; ch < 256; ch += gridDim.x) route1_chunk(c, ch, (LAS int*)smem, tid); break;
    case PH_ROUTE2: for (int ch = blockIdx.x; ch < 256; ch += gridDim.x) route2_chunk(c, ch, (LAS int*)smem, tid); break;
    case PH_ZEROPAD: for (int r = gw; r < MTOK; r += ngw) { bf16* p = c.PROJ + (size_t)r * PW + IN_W; if (lane < 23) *(uint2*)(p + 4 * lane) = make_uint2(0u, 0u); } break;
    }
}

template <int EPI> __global__ void __launch_bounds__(256) nv_gemm(const bf16* A, int lda, const float* W, const float* W2, int ldw, size_t wstride, int N, int K, void* out, int ldo, const float* res,
                                                               const int* tile_grp, int kphase, const int* slot_tok, const float* slot_gate) {
    __shared__ float As[16][68]; __shared__ float Ws[16][68]; __shared__ float W2s[EPI == 2 ? 16 : 1][68];
    const int tid = threadIdx.x, tx = tid & 15, ty = tid >> 4, n0 = blockIdx.x * 64, m0 = blockIdx.y * 64;
    if (tile_grp) { const int g = tile_grp[m0 >> 8]; if (g < 0) return; if (EPI == 3 && (g >> 3) != kphase) return; W += (size_t)(g & 7) * wstride; if (EPI == 2) W2 += (size_t)(g & 7) * wstride; }
    float acc[4][4], acc2[4][4];
#pragma unroll
    for (int i = 0; i < 4; ++i)
#pragma unroll
        for (int j = 0; j < 4; ++j) { acc[i][j] = 0.f; acc2[i][j] = 0.f; }
    const int ar = tid >> 2, ak = (tid & 3) * 4, wk = tid >> 4, wn = (tid & 15) * 4;
    for (int k0 = 0; k0 < K; k0 += 16) {
        { float f[4]; ld4bf(A + (size_t)(m0 + ar) * lda + k0 + ak, f); As[ak + 0][ar] = f[0]; As[ak + 1][ar] = f[1]; As[ak + 2][ar] = f[2]; As[ak + 3][ar] = f[3]; }
        { float4 w = make_float4(0.f, 0.f, 0.f, 0.f); if (n0 + wn < N) w = *(const float4*)(W + (size_t)(k0 + wk) * ldw + n0 + wn); *(float4*)&Ws[wk][wn] = w;
          if (EPI == 2) { float4 w2 = make_float4(0.f, 0.f, 0.f, 0.f); if (n0 + wn < N) w2 = *(const float4*)(W2 + (size_t)(k0 + wk) * ldw + n0 + wn); *(float4*)&W2s[wk][wn] = w2; } }
        __syncthreads();
#pragma unroll
        for (int kk = 0; kk < 16; ++kk) { const float4 a = *(const float4*)&As[kk][ty * 4]; const float4 w = *(const float4*)&Ws[kk][tx * 4]; const float av[4] = {a.x, a.y, a.z, a.w}, wv[4] = {w.x, w.y, w.z, w.w};
#pragma unroll
            for (int i = 0; i < 4; ++i)
#pragma unroll
                for (int j = 0; j < 4; ++j) acc[i][j] += av[i] * wv[j];
            if (EPI == 2) { const float4 w2 = *(const float4*)&W2s[kk][tx * 4]; const float w2v[4] = {w2.x, w2.y, w2.z, w2.w};
#pragma unroll
                for (int i = 0; i < 4; ++i)
#pragma unroll
                    for (int j = 0; j < 4; ++j) acc2[i][j] += av[i] * w2v[j]; } }
        __syncthreads();
    }
    const int n = n0 + tx * 4; if (n >= N) return;
#pragma unroll
    for (int i = 0; i < 4; ++i) { const int row = m0 + ty * 4 + i;
        if (EPI == 0) { float f[4] = {acc[i][0], acc[i][1], acc[i][2], acc[i][3]}; st4bf((bf16*)out + (size_t)row * ldo + n, f); }
        if (EPI == 1) { const float4 r = *(const float4*)(res + (size_t)row * ldo + n); *(float4*)((float*)out + (size_t)row * ldo + n) = make_float4(r.x + acc[i][0], r.y + acc[i][1], r.z + acc[i][2], r.w + acc[i][3]); }
        if (EPI == 2) { float f[4];
#pragma unroll
            for (int j = 0; j < 4; ++j) { const float g = acc[i][j]; f[j] = g / (1.f + expf(-g)) * acc2[i][j]; }
            st4bf((bf16*)out + (size_t)row * ldo + n, f); }
        if (EPI == 3) { const int tok = slot_tok[row]; if (tok >= 0) { const float gt = slot_gate[row]; float4* o = (float4*)((float*)out + (size_t)tok * ldo + n); float4 r = *o; r.x += gt * acc[i][0]; r.y += gt * acc[i][1]; r.z += gt * acc[i][2]; r.w += gt * acc[i][3]; *o = r; } }
    }
}

template <int DK, int DK1, int MODE> __global__ void __launch_bounds__(64) nv_attn(const bf16* Q, int ldq, int hq, const bf16* K, int ldk, int hk, const bf16* K2, int ldk2, const bf16* V, int ldv, int hv,
                                                                                    bf16* O, int ldo, int ho, const float* cum, float scale) {
    __shared__ float Ks[64][DK + 4]; __shared__ float Vs[64][68]; __shared__ float Cs[64];
    const int tid = threadIdx.x, h = blockIdx.y, z = blockIdx.z, row = blockIdx.x * 64 + tid, b = row / SEQ, qt = (blockIdx.x * 64 % SEQ) / 64;
    float q[DK];
    { const bf16* qp = Q + (size_t)row * ldq + h * hq;
#pragma unroll
      for (int d = 0; d < DK; d += 8) { float f[8]; ld8bf(qp + d, f);
#pragma unroll
          for (int i = 0; i < 8; ++i) q[d + i] = f[i] * scale; } }
    float o[64];
#pragma unroll
    for (int d = 0; d < 64; ++d) o[d] = 0.f;
    float m = -3.0e38f, l = 0.f; const float cq = (MODE == 0) ? cum[(size_t)row * 4 + h] : 0.f;
    const int ntile = (MODE == 2) ? 4 : qt + 1; const size_t kbase = (MODE == 2) ? (size_t)b * MEML : (size_t)b * SEQ;
    for (int kt = 0; kt < ntile; ++kt) {
        const size_t krow = kbase + kt * 64 + tid;
        { const bf16* kp = K + krow * ldk + h * hk;
#pragma unroll
          for (int d = 0; d < DK1; d += 8) { float f[8]; ld8bf(kp + d, f);
#pragma unroll
              for (int i = 0; i < 8; ++i) Ks[tid][d + i] = f[i]; }
          if (DK > DK1) { const bf16* kp2 = K2 + krow * ldk2;
#pragma unroll
              for (int d = 0; d < DK - DK1; d += 8) { float f[8]; ld8bf(kp2 + d, f);
#pragma unroll
                  for (int i = 0; i < 8; ++i) Ks[tid][DK1 + d + i] = f[i]; } }
          const bf16* vp = V + krow * ldv + h * hv + z * 64;
#pragma unroll
          for (int d = 0; d < 64; d += 8) { float f[8]; ld8bf(vp + d, f);
#pragma unroll
              for (int i = 0; i < 8; ++i) Vs[tid][d + i] = f[i]; }
          if (MODE == 0) Cs[tid] = cum[krow * 4 + h]; }
        __syncthreads();
        const int jmax = (MODE == 0 && kt == ntile - 1) ? tid : 63;
        for (int j = 0; j <= jmax; ++j) {
            float s = 0.f;
#pragma unroll
            for (int d = 0; d < DK; d += 4) { const float4 kv = *(const float4*)&Ks[j][d]; s += q[d] * kv.x + q[d + 1] * kv.y + q[d + 2] * kv.z + q[d + 3] * kv.w; }
            if (MODE == 0) s += cq - Cs[j];
            if (s > m) { const float sc = expf(m - s); l *= sc;
#pragma unroll
                for (int d = 0; d < 64; ++d) o[d] *= sc;
                m = s; }
            const float p = expf(s - m); l += p;
#pragma unroll
            for (int d = 0; d < 64; d += 4) { const float4 vv = *(const float4*)&Vs[j][d]; o[d] += p * vv.x; o[d + 1] += p * vv.y; o[d + 2] += p * vv.z; o[d + 3] += p * vv.w; }
        }
        __syncthreads();
    }
    const float il = 1.f / l; bf16* op = O + (size_t)row * ldo + h * ho + z * 64;
#pragma unroll
    for (int d = 0; d < 64; d += 8) { float f[8];
#pragma unroll
        for (int i = 0; i < 8; ++i) f[i] = o[d + i] * il;
        st8bf(op + d, f); }
}
__global__ void __launch_bounds__(256) nv_sgu(const bf16* PROJ, const float* wS, const float* bS, bf16* OMIX) {
    __shared__ float Vs[128][68];
    const int tid = threadIdx.x, win = blockIdx.x, g = blockIdx.y; const size_t row0 = (size_t)win * 128;
    for (int i = tid; i < 128 * 8; i += 256) { const int s = i >> 3, d = (i & 7) * 8; float f[8]; ld8bf(PROJ + (row0 + s) * PW + C_VB + g * 64 + d, f);
#pragma unroll
        for (int k = 0; k < 8; ++k) Vs[s][d + k] = f[k]; }
    __syncthreads();
    const int t = tid >> 1, dh = (tid & 1) * 32; float acc[32];
#pragma unroll
    for (int d = 0; d < 32; ++d) acc[d] = 0.f;
    const int smax = ((t >> 6) + 1) * 64; const float* wr = wS + (size_t)g * 16384 + t * 128;
    for (int s = 0; s < smax; ++s) { const float w = wr[s];
#pragma unroll
        for (int d = 0; d < 32; d += 4) { const float4 v = *(const float4*)&Vs[s][dh + d]; acc[d] += w * v.x; acc[d + 1] += w * v.y; acc[d + 2] += w * v.z; acc[d + 3] += w * v.w; } }
    const float bb = bS[g * 128 + t];
#pragma unroll
    for (int d = 0; d < 32; d += 8) { float u[8]; ld8bf(PROJ + (row0 + t) * PW + C_UB + g * 64 + dh + d, u);
#pragma unroll
        for (int k = 0; k < 8; ++k) u[k] *= (acc[d + k] + bb);
        st8bf(OMIX + (row0 + t) * 1024 + 256 + g * 64 + dh + d, u); }
}


#ifndef BUILD_STEP
#define BUILD_STEP 2
#endif
namespace pg8 {
typedef unsigned short bf16_t;
typedef short bf16x8 __attribute__((ext_vector_type(8)));
typedef float f32x4 __attribute__((ext_vector_type(4)));
typedef float f32x2 __attribute__((ext_vector_type(2)));
typedef unsigned u32x4 __attribute__((ext_vector_type(4)));
constexpr int BM = 256, BK = 64, HALF = 128, HTB = HALF * BK * 2, STAGE_BYTES = 8 * HTB, NXCD = 8, WGM = 8;
__host__ __device__ __forceinline__ int lds_byte(int r, int c) { const int st = (r >> 4) * 2 + (c >> 5), rr = r & 15, cc = c & 31, ob = rr * 64 + cc * 2; return st * 1024 + (ob ^ (((ob >> 9) & 1) << 5)); }
__host__ __device__ __forceinline__ void stage_rc(int b, int& R, int& C) { const int st = b / 1024, sb = b % 1024, swz = sb ^ (((sb >> 9) & 1) << 5); R = (st >> 1) * 16 + swz / 64; C = (st & 1) * 32 + (swz % 64) / 2; }
__host__ __device__ __forceinline__ int perm32(int rho) { const int n = rho >> 4, i = rho & 15; return 8 * (i >> 2) + 4 * n + (i & 3); }
struct Unit { int pm, pn; const char* a; const char* b; };
__device__ __forceinline__ unsigned cvt_pk_bf16(float lo, float hi) { unsigned r; asm volatile("v_cvt_pk_bf16_f32 %0, %1, %2" : "=v"(r) : "v"(lo), "v"(hi)); return r; }

struct DenseOrder {
    int nM, nN, nwg, G, c, pm0; const char* A; const char* B; size_t tA, tB;
    __device__ __forceinline__ void init(int nM_, int nN_, int G_, int c_, const void* A_, int lda, const void* B_, int K) { nM = nM_; nN = nN_; nwg = nM * nN; G = G_; c = c_; pm0 = 0; A = (const char*)A_; B = (const char*)B_; tA = (size_t)BM * lda * 2; tB = (size_t)BM * K * 2; }
    __device__ __forceinline__ bool map(int i, int& pm, int& pn) const {
        const long L = (long)i * G + c; if (L >= nwg) return false;
        int wgid = (int)L; { const int q = nwg / NXCD, r = nwg % NXCD, xcd = wgid % NXCD, off = wgid / NXCD; wgid = (xcd < r ? xcd * (q + 1) : r * (q + 1) + (xcd - r) * q) + off; }
        const int nig = WGM * nN, gid = wgid / nig, fm = gid * WGM, gsz = (nM - fm) < WGM ? (nM - fm) : WGM;
        pm = fm + ((wgid % nig) % gsz); pn = (wgid % nig) / gsz; return true; }
    __device__ __forceinline__ bool next(int i, Unit& u) const { int pm, pn; if (!map(i, pm, pn)) return false; u.pm = pm; u.pn = pn; u.a = A + (size_t)pm * tA; u.b = B + (size_t)pn * tB; return true; }
};
struct GroupOrder : DenseOrder {
    const int* tab; size_t estride;
    __device__ __forceinline__ bool next(int i, Unit& u) const { int pm, pn; if (!map(i, pm, pn)) return false; pm += pm0; u.pm = pm; u.pn = pn; const int e = tab[pm] & 7; u.a = A + (size_t)pm * tA; u.b = B + (size_t)e * estride + (size_t)pn * tB; return true; }
};
struct KvmOrder {
    int c; const char* A; const char* B; size_t bstride;
    __device__ __forceinline__ bool next(int i, Unit& u) const { if (i > 0 || c >= 128) return false; const int l2 = c >> 6, r = c & 63; u.pm = l2 * 16 + (r & 15); u.pn = r >> 4; u.a = A + (size_t)u.pm * (256 * 1024 * 2); u.b = B + (size_t)l2 * bstride + (size_t)u.pn * (256 * 1024 * 2); return true; }
};

struct EpiStore { static constexpr bool PERM = true; bf16_t* O; int ldc;
    __device__ __forceinline__ void operator()(const f32x4 (&acc)[2][2][4][2], const Unit& u, int wr, int wc, int fr, int fq) const {
        const int row0 = u.pm * BM + wr * 64 + fr, col0 = u.pn * BM + wc * 32 + 8 * fq;
#pragma unroll
        for (int ai = 0; ai < 2; ++ai)
#pragma unroll
            for (int m = 0; m < 4; ++m) { bf16_t* rowp = O + (size_t)(row0 + ai * HALF + m * 16) * ldc + col0;
#pragma unroll
                for (int bj = 0; bj < 2; ++bj) { const f32x4 v0 = acc[ai][bj][m][0], v1 = acc[ai][bj][m][1]; u32x4 w; w.x = cvt_pk_bf16(v0[0], v0[1]); w.y = cvt_pk_bf16(v0[2], v0[3]); w.z = cvt_pk_bf16(v1[0], v1[1]); w.w = cvt_pk_bf16(v1[2], v1[3]);
                    *(u32x4*)(rowp + bj * HALF) = w; } } } };
struct EpiRes { static constexpr bool PERM = false; const float* res; float* out;
    __device__ __forceinline__ void operator()(const f32x4 (&acc)[2][2][4][2], const Unit& u, int wr, int wc, int fr, int fq) const {
        const int row0 = u.pm * BM + wr * 64 + fr, col0 = u.pn * BM + wc * 32 + 4 * fq;
#pragma unroll
        for (int ai = 0; ai < 2; ++ai)
#pragma unroll
            for (int m = 0; m < 4; ++m) { const size_t off = (size_t)(row0 + ai * HALF + m * 16) * 1024 + col0;
#pragma unroll
                for (int bj = 0; bj < 2; ++bj)
#pragma unroll
                    for (int n = 0; n < 2; ++n) { const f32x4 r = *(const f32x4*)(res + off + bj * HALF + n * 16); *(f32x4*)(out + off + bj * HALF + n * 16) = r + acc[ai][bj][m][n]; }
                asm volatile("" ::: "memory"); } } };
__device__ __forceinline__ float silu_mul(float g, float u) { return g * __builtin_amdgcn_rcpf(1.0f + __builtin_amdgcn_exp2f(-1.4426950408889634f * g)) * u; }
struct EpiSwiglu { static constexpr bool PERM = true; bf16_t* O; int ldc;
    __device__ __forceinline__ void operator()(const f32x4 (&acc)[2][2][4][2], const Unit& u, int wr, int wc, int fr, int fq) const {
        const int row0 = u.pm * BM + wr * 64 + fr, col0 = u.pn * HALF + wc * 32 + 8 * fq;
#pragma unroll
        for (int ai = 0; ai < 2; ++ai)
#pragma unroll
            for (int m = 0; m < 4; ++m) { const f32x4 g0 = acc[ai][0][m][0], g1 = acc[ai][0][m][1], u0 = acc[ai][1][m][0], u1 = acc[ai][1][m][1]; u32x4 w;
                w.x = cvt_pk_bf16(silu_mul(g0[0], u0[0]), silu_mul(g0[1], u0[1])); w.y = cvt_pk_bf16(silu_mul(g0[2], u0[2]), silu_mul(g0[3], u0[3]));
                w.z = cvt_pk_bf16(silu_mul(g1[0], u1[0]), silu_mul(g1[1], u1[1])); w.w = cvt_pk_bf16(silu_mul(g1[2], u1[2]), silu_mul(g1[3], u1[3]));
                *(u32x4*)(O + (size_t)(row0 + ai * HALF + m * 16) * ldc + col0) = w; } } };
struct EpiScatter { static constexpr bool PERM = false; float* X; const int* tok; const float* gate;
    __device__ __forceinline__ void operator()(const f32x4 (&acc)[2][2][4][2], const Unit& u, int wr, int wc, int fr, int fq) const {
        const int row0 = u.pm * BM + wr * 64 + fr, col0 = u.pn * BM + wc * 32 + 4 * fq;
#pragma unroll
        for (int ai = 0; ai < 2; ++ai)
#pragma unroll
            for (int m = 0; m < 4; ++m) { const int row = row0 + ai * HALF + m * 16; const int t = tok[row]; const float g = gate[row];
                if (t >= 0) { float* p = X + (size_t)t * 1024 + col0;
#pragma unroll
                    for (int bj = 0; bj < 2; ++bj)
#pragma unroll
                        for (int n = 0; n < 2; ++n) { const f32x4 r = *(const f32x4*)(p + bj * HALF + n * 16); *(f32x4*)(p + bj * HALF + n * 16) = r + g * acc[ai][bj][m][n]; } }
                asm volatile("" ::: "memory"); } } };

template <class Epi, class Sched, bool ALIGN_EPI, bool SP2>
__device__ __forceinline__ void gemm_phase(LAS unsigned char* lds, const int K, const int lda, const Sched& S, const Epi& E) {
    int tid_o = threadIdx.x; asm volatile("" : "+v"(tid_o));
    const int tid = tid_o, wid = __builtin_amdgcn_readfirstlane(tid >> 6), lane = tid & 63, wr = wid >> 2, wc = wid & 3, fr = lane & 15, fq = lane >> 4;
    const int nt = K / BK;
    unsigned voffA[2], voffB[2];
#pragma unroll
    for (int i = 0; i < 2; ++i) { int R, C; stage_rc(tid * 16 + i * 8192, R, C); const int Rb = Epi::PERM ? ((R & ~31) + perm32(R & 31)) : R;
        voffA[i] = (unsigned)(R * lda + C) * 2u; voffB[i] = (unsigned)(Rb * K + C) * 2u; }
    const size_t kstep = (size_t)(BK * 2);
    const size_t hA = (size_t)HALF * lda * 2, hB = (size_t)HALF * K * 2;
    const unsigned ldsw = (unsigned)wid * 1024u;
    const int aoff = lds_byte(wr * 64 + fr, fq * 8), boff = lds_byte(wc * 32 + fr, fq * 8);
#define PG8_SA(b, h) (((b) * 2 + (h)) * HTB)
#define PG8_SB(b, h) ((4 + (b) * 2 + (h)) * HTB)
#define PG8_STAGE(bufoff, gbase, voff) do { _Pragma("unroll") for (int _i = 0; _i < 2; ++_i) \
        __builtin_amdgcn_global_load_lds((const unsigned*)((const char*)(gbase) + (voff)[_i]), (LAS unsigned*)(lds + (bufoff) + ldsw + _i * 8192), 16, 0, 0); } while (0)
#define PG8_LDA(dst, b, h) do { _Pragma("unroll") for (int m = 0; m < 4; ++m) _Pragma("unroll") for (int k = 0; k < 2; ++k) dst[m][k] = *(const LAS bf16x8*)(lds + PG8_SA(b, h) + aoff + m * 2048 + k * 1024); } while (0)
#define PG8_LDB(dst, b, h) do { _Pragma("unroll") for (int n = 0; n < 2; ++n) _Pragma("unroll") for (int k = 0; k < 2; ++k) dst[n][k] = *(const LAS bf16x8*)(lds + PG8_SB(b, h) + boff + n * 2048 + k * 1024); } while (0)
#define PG8_MMA(ai, bj, At, Bt) do { __builtin_amdgcn_s_setprio(1); _Pragma("unroll") for (int m = 0; m < 4; ++m) _Pragma("unroll") for (int n = 0; n < 2; ++n) _Pragma("unroll") for (int k = 0; k < 2; ++k) \
        acc[ai][bj][m][n] = __builtin_amdgcn_mfma_f32_16x16x32_bf16(Bt[n][k], At[m][k], acc[ai][bj][m][n], 0, 0, 0); __builtin_amdgcn_s_setprio(0); } while (0)
#define PG8_WAIT_V(n) asm volatile("s_waitcnt vmcnt(" #n ")" ::: "memory")
#define PG8_WAIT_L(n) asm volatile("s_waitcnt lgkmcnt(" #n ")" ::: "memory")
#define PG8_BAR __builtin_amdgcn_s_barrier()
#define PG8_SCHED __builtin_amdgcn_sched_barrier(0)
    Unit cur, nxt; int ui = 0;
    if (!S.next(0, cur)) return;
    f32x4 acc[2][2][4][2];
#pragma unroll
    for (int a = 0; a < 2; ++a)
#pragma unroll
        for (int b = 0; b < 2; ++b)
#pragma unroll
            for (int m = 0; m < 4; ++m)
#pragma unroll
                for (int n = 0; n < 2; ++n) acc[a][b][m][n] = (f32x4){0.f, 0.f, 0.f, 0.f};
    bf16x8 At[4][2], B0[2][2], B1[2][2];
    const char* cA = cur.a; const char* cB = cur.b;
    if constexpr (SP2) {
        PG8_STAGE(PG8_SB(0, 0), cB, voffB); PG8_STAGE(PG8_SB(0, 1), cB + hB, voffB); PG8_STAGE(PG8_SA(0, 0), cA, voffA); PG8_STAGE(PG8_SA(0, 1), cA + hA, voffA);
        if (wr == 1) PG8_BAR;
        PG8_WAIT_V(2); PG8_BAR;
        PG8_STAGE(PG8_SB(1, 0), cB + kstep, voffB); PG8_STAGE(PG8_SA(1, 0), cA + kstep, voffA); PG8_STAGE(PG8_SB(1, 1), cB + hB + kstep, voffB);
        PG8_WAIT_V(6); PG8_BAR;
    } else {
        PG8_STAGE(PG8_SB(0, 0), cB, voffB); PG8_STAGE(PG8_SA(0, 0), cA, voffA); PG8_STAGE(PG8_SB(0, 1), cB + hB, voffB); PG8_STAGE(PG8_SA(0, 1), cA + hA, voffA);
        if (wr == 1) PG8_BAR;
        PG8_WAIT_V(4); PG8_BAR;
        PG8_STAGE(PG8_SB(1, 0), cB + kstep, voffB); PG8_STAGE(PG8_SA(1, 0), cA + kstep, voffA); PG8_STAGE(PG8_SB(1, 1), cB + hB + kstep, voffB);
        PG8_WAIT_V(6); PG8_BAR;
    }
    for (;;) {
        const bool has_next = S.next(ui + 1, nxt);
        const char* nA = has_next ? nxt.a : cA; const char* nB = has_next ? nxt.b : cB;
        for (int t = 0; t < nt; t += 2) {
            const bool last = (t == nt - 2);
            const char* a1 = cA + (size_t)(t + 1) * kstep;
            const char* a2 = last ? nA : cA + (size_t)(t + 2) * kstep; const char* b2 = last ? nB : cB + (size_t)(t + 2) * kstep;
            const char* a3 = a2 + kstep; const char* b3 = b2 + kstep;
            if constexpr (SP2) {
            PG8_LDB(B0, 0, 0); PG8_LDB(B1, 0, 1); PG8_SCHED; PG8_LDA(At, 0, 0); PG8_STAGE(PG8_SA(1, 1), a1 + hA, voffA);
            PG8_WAIT_V(8); PG8_WAIT_L(0); PG8_BAR; PG8_MMA(0, 0, At, B0); PG8_MMA(0, 1, At, B1); PG8_BAR; PG8_SCHED;
            PG8_LDA(At, 0, 1); PG8_STAGE(PG8_SB(0, 0), b2, voffB); PG8_STAGE(PG8_SB(0, 1), b2 + hB, voffB); PG8_STAGE(PG8_SA(0, 0), a2, voffA);
            PG8_WAIT_V(8); PG8_WAIT_L(0); PG8_BAR; PG8_MMA(1, 0, At, B0); PG8_MMA(1, 1, At, B1); PG8_BAR; PG8_SCHED;
            PG8_LDB(B0, 1, 0); PG8_LDB(B1, 1, 1); PG8_SCHED; PG8_LDA(At, 1, 0); PG8_STAGE(PG8_SA(0, 1), a2 + hA, voffA);
            PG8_WAIT_V(8); PG8_WAIT_L(0); PG8_BAR; PG8_MMA(0, 0, At, B0); PG8_MMA(0, 1, At, B1); PG8_BAR; PG8_SCHED;
            PG8_LDA(At, 1, 1); PG8_STAGE(PG8_SB(1, 0), b3, voffB); PG8_STAGE(PG8_SB(1, 1), b3 + hB, voffB); PG8_STAGE(PG8_SA(1, 0), a3, voffA);
            PG8_WAIT_V(8); PG8_WAIT_L(0); PG8_BAR; PG8_MMA(1, 0, At, B0); PG8_MMA(1, 1, At, B1); PG8_BAR; PG8_SCHED;
            } else {
            PG8_LDB(B0, 0, 0); PG8_SCHED; PG8_LDA(At, 0, 0); PG8_STAGE(PG8_SA(1, 1), a1 + hA, voffA);
            PG8_WAIT_L(8); PG8_BAR; PG8_WAIT_L(0); PG8_MMA(0, 0, At, B0); PG8_BAR; PG8_SCHED;
            PG8_LDB(B1, 0, 1); PG8_STAGE(PG8_SB(0, 0), b2, voffB);
            PG8_BAR; PG8_WAIT_L(0); PG8_MMA(0, 1, At, B1); PG8_BAR;
            PG8_LDA(At, 0, 1); PG8_STAGE(PG8_SA(0, 0), a2, voffA);
            PG8_BAR; PG8_WAIT_L(0); PG8_MMA(1, 0, At, B0); PG8_BAR; PG8_SCHED;
            PG8_STAGE(PG8_SB(0, 1), b2 + hB, voffB);
            PG8_WAIT_V(6); PG8_BAR; PG8_MMA(1, 1, At, B1); PG8_BAR;
            PG8_LDB(B0, 1, 0); PG8_SCHED; PG8_LDA(At, 1, 0); PG8_STAGE(PG8_SA(0, 1), a2 + hA, voffA);
            PG8_WAIT_L(8); PG8_BAR; PG8_WAIT_L(0); PG8_MMA(0, 0, At, B0); PG8_BAR; PG8_SCHED;
            PG8_LDB(B1, 1, 1); PG8_STAGE(PG8_SB(1, 0), b3, voffB);
            PG8_BAR; PG8_WAIT_L(0); PG8_MMA(0, 1, At, B1); PG8_BAR;
            PG8_LDA(At, 1, 1); PG8_STAGE(PG8_SA(1, 0), a3, voffA);
            PG8_BAR; PG8_WAIT_L(0); PG8_MMA(1, 0, At, B0); PG8_BAR; PG8_SCHED;
            PG8_STAGE(PG8_SB(1, 1), b3 + hB, voffB);
            PG8_WAIT_V(6); PG8_BAR; PG8_MMA(1, 1, At, B1); PG8_BAR;
            }
        }
        if constexpr (ALIGN_EPI) { if (wr == 0) PG8_BAR; }
        E(acc, cur, wr, wc, fr, fq);
        if (!has_next) break;
#pragma unroll
        for (int a = 0; a < 2; ++a)
#pragma unroll
            for (int b = 0; b < 2; ++b)
#pragma unroll
                for (int m = 0; m < 4; ++m)
#pragma unroll
                    for (int n = 0; n < 2; ++n) acc[a][b][m][n] = (f32x4){0.f, 0.f, 0.f, 0.f};
        cur = nxt; cA = nA; cB = nB; ++ui;
        if constexpr (ALIGN_EPI) { if (wr == 1) PG8_BAR; }
    }
    PG8_WAIT_V(0);
    if constexpr (!ALIGN_EPI) { if (wr == 0) PG8_BAR; }
    PG8_BAR;
#undef PG8_SA
#undef PG8_SB
#undef PG8_STAGE
#undef PG8_LDA
#undef PG8_LDB
#undef PG8_MMA
#undef PG8_WAIT_V
#undef PG8_WAIT_L
#undef PG8_BAR
#undef PG8_SCHED
}
}

namespace att {
typedef short bf16x8 __attribute__((ext_vector_type(8)));
typedef short s16x4 __attribute__((ext_vector_type(4)));
typedef short v4i16_t __attribute__((ext_vector_type(4)));
typedef float f32x16 __attribute__((ext_vector_type(16)));
typedef float f32x4 __attribute__((ext_vector_type(4)));
typedef unsigned u32x4 __attribute__((ext_vector_type(4)));
typedef float f32x2_t __attribute__((ext_vector_type(2))); typedef __bf16 bf16x2_t __attribute__((ext_vector_type(2)));
__device__ __forceinline__ int crow(int r, int hi) { return (r & 3) + 8 * (r >> 2) + 4 * hi; }
__device__ __forceinline__ void glds16(const void* gsrc, unsigned lds_dst) { unsigned keep;
    asm volatile("s_mov_b32 %0, m0\n\ts_mov_b32 m0, %2\n\ts_nop 0\n\tglobal_load_lds_dwordx4 %1, off\n\ts_mov_b32 m0, %0" : "=&s"(keep) : "v"(gsrc), "s"(lds_dst) : "memory"); }
__device__ __forceinline__ unsigned cvtpk(float lo, float hi) { f32x2_t v = {lo, hi}; bf16x2_t b = __builtin_convertvector(v, bf16x2_t); return __builtin_bit_cast(unsigned, b); }
__device__ __forceinline__ s16x4 vtr(const LAS unsigned char* p) { return __builtin_bit_cast(s16x4, __builtin_amdgcn_ds_read_tr16_b64_v4i16((LAS v4i16_t*)p)); }
__device__ __forceinline__ float half_max(float m) { auto rr = __builtin_amdgcn_permlane32_swap(__float_as_uint(m), __float_as_uint(m), false, false); return fmaxf(__uint_as_float(rr[0]), __uint_as_float(rr[1])); }
__device__ __forceinline__ float half_sum(float m) { auto rr = __builtin_amdgcn_permlane32_swap(__float_as_uint(m), __float_as_uint(m), false, false); return __uint_as_float(rr[0]) + __uint_as_float(rr[1]); }
__device__ __forceinline__ bf16x8 scale8(bf16x8 v, float s) { u32x4 u = __builtin_bit_cast(u32x4, v); u32x4 o;
#pragma unroll
    for (int i = 0; i < 4; ++i) { const float a = __uint_as_float(u[i] << 16) * s, b = __uint_as_float(u[i] & 0xffff0000u) * s; o[i] = cvtpk(a, b); }
    return __builtin_bit_cast(bf16x8, o); }
#define ATT_WAITBAR(N) asm volatile("s_waitcnt vmcnt(%0) lgkmcnt(0)\n\ts_barrier" :: "n"(N) : "memory")

template <int DK, int DV, int MODE>
__device__ __forceinline__ void attn_unit(LAS unsigned char* shm, const bf16* Qw, int ldq, float qscale, const bf16* Kh, int ldk, const bf16* K2, int ldk2, const bf16* Vh, int ldv,
                                          bf16* Ow, int ldo, const float* cumh, int q0, int NT, int tid) {
    constexpr int KSLOT = DK * 128, VSLOT = DV * 128, NS = 3, ND = DK / 16, NO = DV / 32;
    constexpr int LDS_K = 0, LDS_V = NS * KSLOT, LDS_WS = LDS_V + NS * VSLOT, LDS_FB = LDS_WS + 2048;
    constexpr int NPT = (DK > 64 ? 2 : 1) + (DV > 64 ? 2 : 1);
    constexpr float LOG2E = 1.4426950408889634f;
    const int lane = tid & 63, r32 = lane & 31, hi = lane >> 5, wid = __builtin_amdgcn_readfirstlane(tid >> 6);
    const unsigned lds0 = (unsigned)(uintptr_t)shm;
    LAS float* wsf = (LAS float*)(shm + LDS_WS) + wid * 64;
    LAS float* Fb = (LAS float*)(shm + LDS_FB);
    if (MODE == 0) { for (int i = tid; i < q0 + 256; i += 512) Fb[i] = -cumh[(size_t)i * 4] * LOG2E; }
    bf16x8 qr[ND];
#pragma unroll
    for (int d0 = 0; d0 < ND; ++d0) qr[d0] = scale8(*(const bf16x8*)(Qw + (size_t)r32 * ldq + d0 * 16 + hi * 8), qscale);
    asm volatile("" ::: "memory");
    const bf16* ksrc = Kh + (size_t)lane * ldk + wid * 8;
    const bf16* k2src = (DK == 96) ? (K2 + (size_t)lane * ldk2 + (wid & 3) * 8) : (Kh + (size_t)lane * ldk + (8 + wid) * 8);
    const size_t k2step = (DK == 96) ? (size_t)64 * ldk2 : (size_t)64 * ldk;
    const int k2chunk = (DK == 96) ? 8 + (wid & 3) : 8 + wid;
    const bf16* vsrc = Vh + (size_t)(16 * (wid & 3) + (lane >> 2)) * ldv + (wid >> 2) * 32 + (lane & 3) * 8;
#define ATT_DMA(t, slot) do { glds16(ksrc + (size_t)(t) * 64 * ldk, (unsigned)__builtin_amdgcn_readfirstlane(lds0 + LDS_K + (slot) * KSLOT + wid * 1024)); \
        if (DK > 64) glds16(k2src + (size_t)(t) * k2step, (unsigned)__builtin_amdgcn_readfirstlane(lds0 + LDS_K + (slot) * KSLOT + k2chunk * 1024)); \
        glds16(vsrc + (size_t)(t) * 64 * ldv, (unsigned)__builtin_amdgcn_readfirstlane(lds0 + LDS_V + (slot) * VSLOT + wid * 1024)); \
        if (DV > 64) glds16(vsrc + 64 + (size_t)(t) * 64 * ldv, (unsigned)__builtin_amdgcn_readfirstlane(lds0 + LDS_V + (slot) * VSLOT + (wid + 8) * 1024)); } while (0)
    ATT_DMA(0, 0); if (NT > 1) ATT_DMA(1, 1);
    float mhat = 0.f, l_reg = 0.f; f32x16 o[NO];
#pragma unroll
    for (int d = 0; d < NO; ++d) o[d] = f32x16{};
    const int qmin = q0 + 32 * wid;
    int sl = 0, sl2 = 2;
    for (int t = 0; t < NT; ++t) {
        if (t + 1 < NT) ATT_WAITBAR(NPT); else ATT_WAITBAR(0);
        if (t + 2 < NT) ATT_DMA(t + 2, sl2);
        const bool vis = (MODE == 2) ? true : (MODE == 1 ? (t <= (qmin >> 6)) : (64 * t <= qmin + 31));
        if (vis) {
            const LAS unsigned char* kb = shm + LDS_K + sl * KSLOT + hi * 1024 + r32 * 16;
            f32x16 p0 = f32x16{}, p1 = f32x16{};
#pragma unroll
            for (int d0 = 0; d0 < ND; ++d0) { const bf16x8 b0 = *(const LAS bf16x8*)(kb + d0 * 2048), b1 = *(const LAS bf16x8*)(kb + d0 * 2048 + 512);
                p0 = __builtin_amdgcn_mfma_f32_32x32x16_bf16(b0, qr[d0], p0, 0, 0, 0); p1 = __builtin_amdgcn_mfma_f32_32x32x16_bf16(b1, qr[d0], p1, 0, 0, 0); }
            if (MODE == 0) {
#pragma unroll
                for (int g = 0; g < 4; ++g) { const f32x4 f0 = *(const LAS f32x4*)(Fb + 64 * t + 8 * g + 4 * hi), f1 = *(const LAS f32x4*)(Fb + 64 * t + 32 + 8 * g + 4 * hi);
#pragma unroll
                    for (int j = 0; j < 4; ++j) { p0[4 * g + j] += f0[j]; p1[4 * g + j] += f1[j]; } }
                if (64 * t + 63 > qmin) { const int q = qmin + r32;
#pragma unroll
                    for (int r = 0; r < 16; ++r) { const int kv = 64 * t + crow(r, hi); if (kv > q) p0[r] = -INFINITY; if (kv + 32 > q) p1[r] = -INFINITY; } }
            }
            float rm = fmaxf(p0[0], p1[0]);
#pragma unroll
            for (int r = 1; r < 16; ++r) rm = fmaxf(rm, fmaxf(p0[r], p1[r]));
            rm = half_max(rm);
            if (t == 0) mhat = rm;
            else if (__any(rm > mhat + 8.0f)) { const float dl = fmaxf(rm - mhat, 0.f); mhat += dl; const float f = __builtin_amdgcn_exp2f(-dl); l_reg *= f;
                if (hi == 0) wsf[r32] = f;
                asm volatile("s_waitcnt lgkmcnt(0)" ::: "memory");
#pragma unroll
                for (int r = 0; r < 16; ++r) { const float fr_ = wsf[crow(r, hi)];
#pragma unroll
                    for (int d = 0; d < NO; ++d) o[d][r] *= fr_; }
                asm volatile("s_waitcnt lgkmcnt(0)" ::: "memory"); }
            float sacc = 0.f;
#pragma unroll
            for (int r = 0; r < 16; ++r) { p0[r] = __builtin_amdgcn_exp2f(p0[r] - mhat); p1[r] = __builtin_amdgcn_exp2f(p1[r] - mhat); sacc += p0[r] + p1[r]; }
            l_reg += sacc;
            u32x4 pw[4];
#pragma unroll
            for (int i = 0; i < 4; ++i) { pw[0][i] = cvtpk(p0[2 * i], p0[2 * i + 1]); pw[1][i] = cvtpk(p0[8 + 2 * i], p0[9 + 2 * i]); pw[2][i] = cvtpk(p1[2 * i], p1[2 * i + 1]); pw[3][i] = cvtpk(p1[8 + 2 * i], p1[9 + 2 * i]); }
            const LAS unsigned char* vp = shm + LDS_V + sl * VSLOT + ((lane >> 4) & 1) * 32 + (lane & 3) * 8 + (4 * hi + ((lane & 15) >> 2)) * 64;
#pragma unroll
            for (int d0 = 0; d0 < NO; ++d0)
#pragma unroll
                for (int ks = 0; ks < 4; ++ks) { const s16x4 lo = vtr(vp + d0 * 4096 + ks * 1024), hh = vtr(vp + d0 * 4096 + ks * 1024 + 512);
                    const bf16x8 vf = (bf16x8){lo[0], lo[1], lo[2], lo[3], hh[0], hh[1], hh[2], hh[3]};
                    o[d0] = __builtin_amdgcn_mfma_f32_32x32x16_bf16(__builtin_bit_cast(bf16x8, pw[ks]), vf, o[d0], 0, 0, 0); }
        }
        sl = (sl == NS - 1) ? 0 : sl + 1; sl2 = (sl2 == NS - 1) ? 0 : sl2 + 1;
    }
#undef ATT_DMA
    l_reg = half_sum(l_reg);
    ATT_WAITBAR(0);
    if (hi == 0) wsf[32 + r32] = l_reg;
    asm volatile("s_waitcnt lgkmcnt(0)" ::: "memory");
    float rli[16];
#pragma unroll
    for (int r = 0; r < 16; ++r) rli[r] = __builtin_amdgcn_rcpf(wsf[32 + crow(r, hi)]);
    LAS bf16* stg = (LAS bf16*)shm + wid * (32 * DV);
#pragma unroll
    for (int r = 0; r < 16; ++r) { const int orow = crow(r, hi);
#pragma unroll
        for (int d0 = 0; d0 < NO; ++d0) stg[orow * DV + d0 * 32 + r32] = f2bf(o[d0][r] * rli[r]); }
    asm volatile("s_waitcnt lgkmcnt(0)" ::: "memory");
    constexpr int CPR = DV / 8;
#pragma unroll
    for (int i = 0; i < (32 * CPR) / 64; ++i) { const int idx = i * 64 + lane, row = idx / CPR, ch = idx % CPR; const u32x4 v = *(const LAS u32x4*)(stg + row * DV + ch * 8); *(u32x4*)(Ow + (size_t)row * ldo + ch * 8) = v; }
    ATT_WAITBAR(0);
}

__device__ __forceinline__ void sgu_unit(LAS unsigned char* shm, const bf16* PROJ, const bf16* Wb  , const float* bS, bf16* OMIX, int win, int g, int tid) {
    const int lane = tid & 63, r32 = lane & 31, hi = lane >> 5, wid = __builtin_amdgcn_readfirstlane(tid >> 6);
    const unsigned lds0 = (unsigned)(uintptr_t)shm; const size_t row0 = (size_t)win * 128;
    const bf16* Vh = PROJ + row0 * PW + C_VB + g * 64;
    const bf16* vsrc = Vh + (size_t)(16 * (wid & 3) + (lane >> 2)) * PW + (wid >> 2) * 32 + (lane & 3) * 8;
    glds16(vsrc, (unsigned)__builtin_amdgcn_readfirstlane(lds0 + wid * 1024)); glds16(vsrc + (size_t)64 * PW, (unsigned)__builtin_amdgcn_readfirstlane(lds0 + 8192 + wid * 1024));
    const int tb = wid >> 1, db = wid & 1, t = 32 * tb + r32;
    const bf16* wrow = Wb + (size_t)g * 16384 + (size_t)t * 128;
    const int ntile = (tb < 2) ? 1 : 2;
    uint2 wa[2][4][2];
#pragma unroll
    for (int tl = 0; tl < 2; ++tl)
#pragma unroll
        for (int ks = 0; ks < 4; ++ks) { if (tl < ntile) { wa[tl][ks][0] = *(const uint2*)(wrow + 64 * tl + 16 * ks + 4 * hi); wa[tl][ks][1] = *(const uint2*)(wrow + 64 * tl + 16 * ks + 8 + 4 * hi); } else { wa[tl][ks][0] = make_uint2(0u, 0u); wa[tl][ks][1] = make_uint2(0u, 0u); } }
    ATT_WAITBAR(0);
    f32x16 o = f32x16{};
    const LAS unsigned char* vp = shm + ((lane >> 4) & 1) * 32 + (lane & 3) * 8 + (4 * hi + ((lane & 15) >> 2)) * 64 + db * 4096;
#pragma unroll
    for (int tl = 0; tl < 2; ++tl) { if (tl < ntile) {
#pragma unroll
        for (int ks = 0; ks < 4; ++ks) { const s16x4 lo = vtr(vp + tl * 8192 + ks * 1024), hh = vtr(vp + tl * 8192 + ks * 1024 + 512);
            const bf16x8 vf = (bf16x8){lo[0], lo[1], lo[2], lo[3], hh[0], hh[1], hh[2], hh[3]};
            const u32x4 au = {wa[tl][ks][0].x, wa[tl][ks][0].y, wa[tl][ks][1].x, wa[tl][ks][1].y};
            o = __builtin_amdgcn_mfma_f32_32x32x16_bf16(__builtin_bit_cast(bf16x8, au), vf, o, 0, 0, 0); } } }
    const int d = 32 * db + r32;
#pragma unroll
    for (int r = 0; r < 16; ++r) { const int tt = 32 * tb + crow(r, hi); const size_t row = row0 + tt;
        const float u = bf2f(PROJ[row * PW + C_UB + g * 64 + d]); OMIX[row * 1024 + 256 + g * 64 + d] = f2bf(u * (o[r] + bS[g * 128 + tt])); }
    ATT_WAITBAR(0);
}
#undef ATT_WAITBAR
}

#define XB_TMO      128
#define XB_XCNT(j)  (256  + 64 * (j))
#define XB_XSUB(j)  (1280 + 64 * (j))
#define XB_XGEN(j)  (2304 + 64 * (j))
#define XB_TOP      3328
#define XB_TOPGEN   3392
#define XCD_BAR_WORDS 3456
#define XB_SPIN_CAP (1u << 18)
__device__ __forceinline__ unsigned xb_ld(unsigned* p)              { return __hip_atomic_load(p, __ATOMIC_RELAXED, __HIP_MEMORY_SCOPE_AGENT); }
__device__ __forceinline__ unsigned xb_add(unsigned* p, unsigned v) { return __hip_atomic_fetch_add(p, v, __ATOMIC_RELAXED, __HIP_MEMORY_SCOPE_AGENT); }
__device__ __forceinline__ unsigned xb_xcc_id() { return (unsigned)__builtin_amdgcn_s_getreg((3 << 11) | 20) & 0xFu; }
#define XB_SPIN(cond, bar) do { unsigned _sp = 0; while (cond) { __builtin_amdgcn_s_sleep(1); \
    if ((++_sp & 255u) == 0u) { if (xb_ld(&(bar)[XB_TMO])) break; if (_sp > XB_SPIN_CAP) { atomicAdd(&(bar)[XB_TMO], 1u); break; } } } } while (0)
struct XcdBarrier { unsigned* bar; unsigned x; volatile LAS unsigned* st; };
__device__ __forceinline__ XcdBarrier xcd_barrier_post(unsigned* bar, volatile LAS unsigned* st) {
    XcdBarrier b; b.bar = bar; b.x = xb_xcc_id(); b.st = st;
    if (threadIdx.x == 0) (void)xb_add(&bar[XB_XCNT(b.x)], 1u);
    return b;
}
__device__ __forceinline__ void xcd_barrier_complete(unsigned* bar, unsigned x, unsigned& nloc, unsigned& nx) {
    const unsigned G = gridDim.x * gridDim.y * gridDim.z;
    unsigned sum, cnt, mine, sp = 0u;
    for (;;) {
        sum = 0u; cnt = 0u; mine = 0u;
#pragma unroll
        for (unsigned j = 0; j < 16; ++j) { const unsigned c = xb_ld(&bar[XB_XCNT(j)]); sum += c; cnt += (c > 0u) ? 1u : 0u; mine = (j == x) ? c : mine; }
        if (sum == G) break;
        __builtin_amdgcn_s_sleep(1);
        if ((++sp & 255u) == 0u) { if (xb_ld(&bar[XB_TMO])) break; if (sp > XB_SPIN_CAP) { atomicAdd(&bar[XB_TMO], 1u); break; } }
    }
    nloc = mine > 0u ? mine : 1u; nx = cnt > 0u ? cnt : 1u;
}
__device__ __forceinline__ void xcd_barrier(const XcdBarrier& b) {
    asm volatile("s_waitcnt vmcnt(0)" ::: "memory");
    __syncthreads();
    if (threadIdx.x == 0) {
        unsigned* bar = b.bar;
        __builtin_amdgcn_s_waitcnt(0);
        unsigned nloc = b.st[0], nx = b.st[1];
        if (nloc == 0u) { xcd_barrier_complete(bar, b.x, nloc, nx); b.st[0] = nloc; b.st[1] = nx; }
        const unsigned old = xb_add(&bar[XB_XSUB(b.x)], 1u);
        const unsigned gen = old / nloc;
        if (old + 1u == (gen + 1u) * nloc) {
            __builtin_amdgcn_fence(__ATOMIC_RELEASE, "agent");
            asm volatile("s_waitcnt vmcnt(0)" ::: "memory");
            const unsigned og = xb_add(&bar[XB_TOP], 1u);
            const unsigned tg = og / nx;
            if (og + 1u == (tg + 1u) * nx) xb_add(&bar[XB_TOPGEN], 1u);
            else XB_SPIN(xb_ld(&bar[XB_TOPGEN]) == tg, bar);
            __builtin_amdgcn_fence(__ATOMIC_ACQUIRE, "agent");
            xb_add(&bar[XB_XGEN(b.x)], 1u);
            asm volatile("s_waitcnt vmcnt(0)" ::: "memory");
        } else {
            XB_SPIN(xb_ld(&bar[XB_XGEN(b.x)]) == gen, bar);
            __builtin_amdgcn_fence(__ATOMIC_ACQUIRE, "agent");
            asm volatile("s_waitcnt vmcnt(0)" ::: "memory");
        }
    }
    __syncthreads();
}

constexpr int NWAVES = 8;
constexpr int RING_BYTES = 131072, LDSCTL_OFF = RING_BYTES, MISC_OFF = LDSCTL_OFF + 320, LDS_BYTES = 147456;
constexpr int CW_BAR = 4096;
constexpr size_t L_WIN = 0, L_WUQ = 3670016, L_WUKV = 4063232, L_WOUT = 4587520, L_WMQ = 6684672, L_WMKV = 7733248, L_WMO = 9830400, LW_STRIDE = 11 * MiB;
constexpr size_t W_FGU = 22 * MiB, W_FD = 33 * MiB, W_MGU = 39 * MiB, W_MD = 83 * MiB, MGU_STRIDE = (size_t)DFE * 2 * 1024 * 2, MD_STRIDE = (size_t)1024 * DFE * 2;
constexpr size_t W_SGU = 106 * MiB;
constexpr size_t WS_HMP = WS_QC;

struct Job { const float* src; const float* src2; int ldw, Ksrc, Kpad, Nphys, map, nlog; bf16* dst; };
__device__ __forceinline__ Job get_job(const Args& a, int j) {
    Job J; J.src2 = nullptr; J.map = 0; unsigned char* wb = a.ws + WS_WB;
    if (j < 14) { const int l = j / 7, t = j % 7; unsigned char* lb = wb + (size_t)l * LW_STRIDE;
        switch (t) {
        case 0: J.src = a.in[4] + (size_t)l * 1024 * IN_W; J.ldw = IN_W; J.Ksrc = 1024; J.Kpad = 1024; J.Nphys = 1792; J.map = 1; J.nlog = IN_W; J.dst = (bf16*)(lb + L_WIN); break;
        case 1: J.src = a.in[12] + (size_t)l * 256 * 768; J.ldw = 768; J.Ksrc = 256; J.Kpad = 256; J.Nphys = 768; J.nlog = 768; J.dst = (bf16*)(lb + L_WUQ); break;
        case 2: J.src = a.in[14] + (size_t)l * 128 * 1024; J.ldw = 1024; J.Ksrc = 128; J.Kpad = 256; J.Nphys = 1024; J.nlog = 1024; J.dst = (bf16*)(lb + L_WUKV); break;
        case 3: J.src = a.in[22] + (size_t)l * 1024 * 1024; J.ldw = 1024; J.Ksrc = 1024; J.Kpad = 1024; J.Nphys = 1024; J.nlog = 1024; J.dst = (bf16*)(lb + L_WOUT); break;
        case 4: J.src = a.in[25] + (size_t)l * 1024 * 512; J.ldw = 512; J.Ksrc = 1024; J.Kpad = 1024; J.Nphys = 512; J.nlog = 512; J.dst = (bf16*)(lb + L_WMQ); break;
        case 5: J.src = a.in[26] + (size_t)l * 1024 * 1024; J.ldw = 1024; J.Ksrc = 1024; J.Kpad = 1024; J.Nphys = 1024; J.nlog = 1024; J.dst = (bf16*)(lb + L_WMKV); break;
        default: J.src = a.in[29] + (size_t)l * 512 * 1024; J.ldw = 1024; J.Ksrc = 512; J.Kpad = 512; J.Nphys = 1024; J.nlog = 1024; J.dst = (bf16*)(lb + L_WMO); break;
        }
    } else if (j == 14) { J.src = a.in[31]; J.src2 = a.in[32]; J.ldw = DFF; J.Ksrc = 1024; J.Kpad = 1024; J.Nphys = 2 * DFFP; J.map = 2; J.nlog = DFF; J.dst = (bf16*)(wb + W_FGU); }
    else if (j == 15) { J.src = a.in[33]; J.ldw = 1024; J.Ksrc = DFF; J.Kpad = DFFP; J.Nphys = 1024; J.nlog = 1024; J.dst = (bf16*)(wb + W_FD); }
    else if (j < 24) { const int e = j - 16; J.src = a.in[36] + (size_t)e * 1024 * DFE; J.src2 = a.in[37] + (size_t)e * 1024 * DFE; J.ldw = DFE; J.Ksrc = 1024; J.Kpad = 1024; J.Nphys = 2 * DFE; J.map = 2; J.nlog = DFE; J.dst = (bf16*)(wb + W_MGU + (size_t)e * MGU_STRIDE); }
    else { const int e = j - 24; J.src = a.in[38] + (size_t)e * DFE * 1024; J.ldw = 1024; J.Ksrc = DFE; J.Kpad = DFE; J.Nphys = 1024; J.nlog = 1024; J.dst = (bf16*)(wb + W_MD + (size_t)e * MD_STRIDE); }
    return J;
}
__device__ __forceinline__ int job_items(const Job& J) { return (J.Kpad / 64) * (J.Nphys / 32); }
__device__ __forceinline__ void transpose_item(const Job& J, int item, LAS float* scr, int lane) {
    const int nblk = J.Nphys / 32, kb = item / nblk, nb = item % nblk, k0 = 64 * kb, n0 = 32 * nb;
    const int p = n0 + (lane & 31); int col = -1; const float* src = J.src;
    if (J.map == 0) col = p < J.nlog ? p : -1;
    else if (J.map == 1) col = p < 768 ? p : (p < 1696 ? p + 4 : (p < 1700 ? 768 + (p - 1696) : -1));
    else { const int jt = p >> 8, w = p & 255; col = 128 * jt + (w & 127); if (w >> 7) src = J.src2; if (col >= J.nlog) col = -1; }
#pragma unroll 8
    for (int i = 0; i < 32; ++i) { const int kk = 2 * i + (lane >> 5); float v = 0.f; if (col >= 0 && k0 + kk < J.Ksrc) v = src[(size_t)(k0 + kk) * J.ldw + col]; scr[kk * 33 + (lane & 31)] = v; }
    asm volatile("s_waitcnt lgkmcnt(0)" ::: "memory");
    const int c = lane & 7;
#pragma unroll
    for (int j = 0; j < 4; ++j) { const int n = (lane >> 3) + 8 * j; const LAS float* s = scr + (8 * c) * 33 + n;
        uint4 o; o.x = pack2(s[0 * 33], s[1 * 33]); o.y = pack2(s[2 * 33], s[3 * 33]); o.z = pack2(s[4 * 33], s[5 * 33]); o.w = pack2(s[6 * 33], s[7 * 33]);
        *(uint4*)(J.dst + (size_t)(n0 + n) * J.Kpad + k0 + 8 * c) = o; }
    asm volatile("s_waitcnt lgkmcnt(0)" ::: "memory");
}

enum { GP_PRO = 0, GP_KVM = 1, GP_L0 = 2, GP_LSTRIDE = 20, GP_END = 42 };
enum { LP_N1 = 0, LP_G1, LP_POSTPROJ, LP_UP, LP_POSTUP, LP_ATTN, LP_MIXNORM, LP_G4, LP_N2, LP_G5, LP_MEMNQ, LP_ATTM, LP_G7, LP_N3, LP_F1, LP_F2, LP_F3, LP_F4 };

struct MArgs { const float* in[39]; float* out; unsigned char* ws; int ph_lo, ph_hi, li, pad; };
typedef const __attribute__((address_space(4))) MArgs* KArgP;
#define PHASE_ENV() KArgP kp_ = kp; asm volatile("" : "+s"(kp_)); int tid = threadIdx.x; asm volatile("" : "+v"(tid)); int l_ = l; asm volatile("" : "+s"(l_)); \
    const int lane = tid & 63, wave = __builtin_amdgcn_readfirstlane(tid >> 6), gw = bx * NWAVES + wave, ngw = G * NWAVES; (void)lane; (void)gw; (void)ngw; \
    Args a; _Pragma("unroll") for (int i_ = 0; i_ < 39; ++i_) a.in[i_] = kp_->in[i_]; a.out = kp_->out; a.ws = kp_->ws; a.l = 0; a.phase = 0; \
    const Ctx c = make_ctx(a, l_); unsigned char* wb = a.ws + WS_WB; unsigned char* lb = wb + (size_t)l_ * LW_STRIDE; (void)lb; (void)c; \
    bf16* HMP = (bf16*)(a.ws + WS_HMP); bf16* KVM2 = (bf16*)(a.ws + WS_KVM); bf16* KVMl = KVM2 + (size_t)l_ * 4096 * 1024; (void)HMP; (void)KVMl;
__global__ void __launch_bounds__(NWAVES * 64, 2) mega(MArgs margs) {
    extern __shared__ __attribute__((aligned(16))) unsigned char lds_raw[];
    LAS unsigned char* lds = (LAS unsigned char*)lds_raw;
    volatile LAS unsigned* MISC = (volatile LAS unsigned*)(lds + MISC_OFF);
    const int G = gridDim.x, bx = blockIdx.x;
    for (int u = threadIdx.x; u < (LDS_BYTES - LDSCTL_OFF) / 4; u += NWAVES * 64) ((LAS unsigned*)(lds + LDSCTL_OFF))[u] = 0u;
    __syncthreads();
    const KArgP kp = (KArgP)__builtin_amdgcn_kernarg_segment_ptr();
    const XcdBarrier bar = xcd_barrier_post((unsigned*)(margs.ws + WS_CTL) + CW_BAR + margs.li * XCD_BAR_WORDS, MISC + 8);
    const int lo = margs.ph_lo, hi = margs.ph_hi;
#define IN(k) (lo <= (k) && (k) < hi)
#define SEAM(k) do { if (IN(k) && IN((k) + 1)) xcd_barrier(bar); } while (0)
    { const int l = 0;
    if (IN(GP_PRO)) { PHASE_ENV();
        LAS float* scr = (LAS float*)(lds + wave * 16384);
        int base = 0;
        for (int j = 0; j < 32; ++j) { const Job J = get_job(a, j); const int n = job_items(J);
            int first = gw - (base % ngw); if (first < 0) first += ngw;
            for (int it = first; it < n; it += ngw) transpose_item(J, it, scr, lane);
            base += n; }
        { bf16* wsg = (bf16*)(wb + W_SGU); for (int i = gw * 64 + lane; i < 2 * 65536; i += ngw * 64) wsg[i] = f2bf(a.in[9][i]); }
        pass_norm(a.in[0], a.in[3], (bf16*)(a.ws + WS_H), MTOK, gw, ngw, lane);
        for (int l2 = 0; l2 < 2; ++l2) pass_norm(a.in[1], a.in[24] + l2 * 1024, HMP + (size_t)l2 * 4096 * 1024, BATCH * MEML, gw, ngw, lane);
    }
    SEAM(GP_PRO);
    if (IN(GP_KVM)) { PHASE_ENV();
        pg8::KvmOrder S; S.c = bx; S.A = (const char*)HMP; S.B = (const char*)(wb + L_WMKV); S.bstride = LW_STRIDE;
        pg8::EpiStore E{KVM2, 1024};
        pg8::gemm_phase<pg8::EpiStore, pg8::KvmOrder, false, true>(lds, 1024, 1024, S, E);
    }
    SEAM(GP_KVM);
    }
    for (int l = 0; l < 2; ++l) {
        const int B = GP_L0 + GP_LSTRIDE * l;
        if (l > 0) { if (IN(B + LP_N1)) { PHASE_ENV(); pass_norm(c.X, c.mix_norm, c.H, MTOK, gw, ngw, lane); } SEAM(B + LP_N1); }
        if (IN(B + LP_G1)) { PHASE_ENV(); pg8::DenseOrder S; S.init(MTOK / 256, PW / 256, G, bx, c.H, 1024, lb + L_WIN, 1024); pg8::EpiStore E{c.PROJ, PW};
            pg8::gemm_phase<pg8::EpiStore, pg8::DenseOrder, true, true>(lds, 1024, 1024, S, E); }
        SEAM(B + LP_G1);
        if (IN(B + LP_POSTPROJ)) { PHASE_ENV(); for (int r = gw; r < MTOK; r += ngw) post_proj_row(c, r, lane);
            for (int r = gw; r < BATCH * MEML; r += ngw) memnorm_row(KVMl + (size_t)r * 1024, c.mkg, lane); }
        SEAM(B + LP_POSTPROJ);
        if (IN(B + LP_UP)) {
            { PHASE_ENV(); for (int b = bx; b < BATCH; b += G) cumsum_batch(c, b, (LAS float*)lds, tid); }
            { PHASE_ENV(); pg8::DenseOrder S; S.init(MTOK / 256, 3, G, bx, c.PROJ + C_CQ, PW, lb + L_WUQ, 256); pg8::EpiStore E{c.QC, 768};
              pg8::gemm_phase<pg8::EpiStore, pg8::DenseOrder, true, true>(lds, 256, PW, S, E); }
            { PHASE_ENV(); pg8::DenseOrder S; S.init(MTOK / 256, 4, G, bx, c.PROJ + C_CKV, PW, lb + L_WUKV, 256); pg8::EpiStore E{c.KVC, 1024};
              pg8::gemm_phase<pg8::EpiStore, pg8::DenseOrder, true, true>(lds, 256, PW, S, E); }
        }
        SEAM(B + LP_UP);
        if (IN(B + LP_POSTUP)) { PHASE_ENV(); for (int r = gw; r < MTOK; r += ngw) post_up_row(c, r, lane); }
        SEAM(B + LP_POSTUP);
        if (IN(B + LP_ATTN) && BUILD_STEP >= 2) { PHASE_ENV(); const int vcu = (G % 8 == 0) ? (bx % 8) * (G / 8) + bx / 8 : bx;
            for (int U = vcu; U < 1024; U += G) { const int i = U >> 8, v = U & 255, bh = v >> 2, s = v & 3, qb = (i == 0) ? s : (i == 1) ? 7 - s : (i == 2) ? 8 + s : 15 - s, b = bh >> 2, h = bh & 3;
                const size_t rb = (size_t)b * SEQ, rw = rb + qb * 256 + 32 * wave;
                att::attn_unit<64, 64, 0>(lds, c.PROJ + rw * PW + C_QA + h * 64, PW, 0.125f * 1.4426950408889634f, c.PROJ + rb * PW + C_KA + h * 64, PW, nullptr, 0, c.PROJ + rb * PW + C_VA + h * 64, PW,
                                          c.OMIX + rw * 1024 + h * 64, 1024, c.CUM + rb * 4 + h, qb * 256, 4 * qb + 4, tid); }
            for (int U = vcu; U < 2048; U += G) { const int i = U >> 8, v = U & 255, bh = v >> 1, s = v & 1, qb = (i & 1) ? (4 * (i >> 1) + 3 - s) : (4 * (i >> 1) + s), b = bh >> 3, h = bh & 7;
                const size_t rb = (size_t)b * SEQ, rw = rb + qb * 256 + 32 * wave;
                att::attn_unit<96, 64, 1>(lds, c.QC + rw * 768 + h * 96, 768, 0.10206207261596575f * 1.4426950408889634f, c.KVC + rb * 1024 + h * 128, 1024, c.PROJ + rb * PW + C_KR, PW, c.KVC + rb * 1024 + h * 128 + 64, 1024,
                                          c.OMIX + rw * 1024 + 512 + h * 64, 1024, nullptr, qb * 256, 4 * qb + 4, tid); }
            for (int U = vcu; U < 2048; U += G) att::sgu_unit(lds, c.PROJ, (const bf16*)(wb + W_SGU) + (size_t)l_ * 65536, c.bsb, c.OMIX, U >> 2, U & 3, tid);
        }
        SEAM(B + LP_ATTN);
        if (IN(B + LP_MIXNORM)) { PHASE_ENV(); for (int r = gw; r < MTOK; r += ngw) mixnorm_row(c, r, lane); }
        SEAM(B + LP_MIXNORM);
        if (IN(B + LP_G4)) { PHASE_ENV(); pg8::DenseOrder S; S.init(MTOK / 256, 4, G, bx, c.OMIX, 1024, lb + L_WOUT, 1024); pg8::EpiRes E{l_ == 0 ? c.x_in : c.X, c.X};
            pg8::gemm_phase<pg8::EpiRes, pg8::DenseOrder, true, true>(lds, 1024, 1024, S, E); }
        SEAM(B + LP_G4);
        if (IN(B + LP_N2)) { PHASE_ENV(); pass_norm(c.X, c.xattn, c.H, MTOK, gw, ngw, lane); }
        SEAM(B + LP_N2);
        if (IN(B + LP_G5)) { PHASE_ENV(); pg8::DenseOrder S; S.init(MTOK / 256, 2, G, bx, c.H, 1024, lb + L_WMQ, 1024); pg8::EpiStore E{c.QM, 512};
            pg8::gemm_phase<pg8::EpiStore, pg8::DenseOrder, true, true>(lds, 1024, 1024, S, E); }
        SEAM(B + LP_G5);
        if (IN(B + LP_MEMNQ)) { PHASE_ENV(); for (int r = gw; r < MTOK; r += ngw) memnorm_row(c.QM + (size_t)r * 512, c.mqg, lane); }
        SEAM(B + LP_MEMNQ);
        if (IN(B + LP_ATTM) && BUILD_STEP >= 2) { PHASE_ENV(); const int vcu = (G % 8 == 0) ? (bx % 8) * (G / 8) + bx / 8 : bx;
            for (int U = vcu; U < 1024; U += G) { const int qblk = U >> 2, h = U & 3; const size_t rw = (size_t)qblk * 256 + 32 * wave; const int b = (qblk * 256) / SEQ; const bf16* kvb = KVMl + (size_t)b * MEML * 1024 + h * 128;
                att::attn_unit<128, 128, 2>(lds, c.QM + rw * 512 + h * 128, 512, 0.08838834764831845f * 1.4426950408889634f, kvb, 1024, nullptr, 0, kvb + 512, 1024, c.OM + rw * 512 + h * 128, 512, nullptr, 0, 4, tid); }
        }
        SEAM(B + LP_ATTM);
        if (IN(B + LP_G7)) { PHASE_ENV(); pg8::DenseOrder S; S.init(MTOK / 256, 4, G, bx, c.OM, 512, lb + L_WMO, 512); pg8::EpiRes E{c.X, c.X};
            pg8::gemm_phase<pg8::EpiRes, pg8::DenseOrder, true, true>(lds, 512, 512, S, E); }
        SEAM(B + LP_G7);
        if (l == 0) {
            if (IN(B + LP_N3)) { PHASE_ENV(); pass_norm(c.X, c.ffn_norm, c.H, MTOK, gw, ngw, lane); }
            SEAM(B + LP_N3);
            if (IN(B + LP_F1)) { PHASE_ENV(); pg8::DenseOrder S; S.init(MTOK / 256, 22, G, bx, c.H, 1024, wb + W_FGU, 1024); pg8::EpiSwiglu E{c.HID, DFFP};
                pg8::gemm_phase<pg8::EpiSwiglu, pg8::DenseOrder, true, true>(lds, 1024, 1024, S, E); }
            SEAM(B + LP_F1);
            if (IN(B + LP_F2)) { PHASE_ENV(); pg8::DenseOrder S; S.init(MTOK / 256, 4, G, bx, c.HID, DFFP, wb + W_FD, DFFP); pg8::EpiRes E{c.X, c.X};
                pg8::gemm_phase<pg8::EpiRes, pg8::DenseOrder, true, true>(lds, DFFP, DFFP, S, E); }
            if (IN(B + LP_F2) && IN(B + GP_LSTRIDE)) xcd_barrier(bar);
        } else {
            if (IN(B + LP_N3)) { PHASE_ENV(); for (int ch = bx; ch < 256; ch += G) route1_chunk(c, ch, (LAS int*)lds, tid); }
            SEAM(B + LP_N3);
            if (IN(B + LP_F1)) { PHASE_ENV(); for (int ch = bx; ch < 256; ch += G) route2_chunk(c, ch, (LAS int*)lds, tid); }
            SEAM(B + LP_F1);
            if (IN(B + LP_F2)) { PHASE_ENV(); const int nt = c.TAB[1000]; pg8::GroupOrder S; S.init(nt, 11, G, bx, c.HS, 1024, wb + W_MGU, 1024); S.tab = c.TAB; S.estride = MGU_STRIDE; pg8::EpiSwiglu E{c.HIDM, DFE};
                pg8::gemm_phase<pg8::EpiSwiglu, pg8::GroupOrder, true, true>(lds, 1024, 1024, S, E); }
            SEAM(B + LP_F2);
            if (IN(B + LP_F3)) { PHASE_ENV(); const int t0 = c.TAB[1001]; pg8::GroupOrder S; S.init(t0, 4, G, bx, c.HIDM, DFE, wb + W_MD, DFE); S.tab = c.TAB; S.estride = MD_STRIDE; pg8::EpiScatter E{c.X, c.SLOT_TOK, c.SLOT_GATE};
                pg8::gemm_phase<pg8::EpiScatter, pg8::GroupOrder, true, true>(lds, DFE, DFE, S, E); }
            SEAM(B + LP_F3);
            if (IN(B + LP_F4)) { PHASE_ENV(); const int nt = c.TAB[1000], t0 = c.TAB[1001]; pg8::GroupOrder S; S.init(nt - t0, 4, G, bx, c.HIDM, DFE, wb + W_MD, DFE); S.pm0 = t0; S.tab = c.TAB; S.estride = MD_STRIDE; pg8::EpiScatter E{c.X, c.SLOT_TOK, c.SLOT_GATE};
                pg8::gemm_phase<pg8::EpiScatter, pg8::GroupOrder, true, true>(lds, DFE, DFE, S, E); }
        }
    }
#undef IN
#undef SEAM
}

extern "C" void kernel_launch(void* const* d_in, const int* in_sizes, int n_in, void* d_out, int out_size, void* d_ws, size_t ws_size, hipStream_t stream) {
    static int grid = 0;
    if (grid == 0) {
        if (n_in != 39 || out_size != MTOK * DM || ws_size < WS_END) { fprintf(stderr, "kernel_launch: unexpected problem (n_in %d out %d ws %zu)\n", n_in, out_size, ws_size); grid = -1; return; }
        int dev = 0, cus = 0, per_cu = 0;
        if (hipGetDevice(&dev) != hipSuccess || hipDeviceGetAttribute(&cus, hipDeviceAttributeMultiprocessorCount, dev) != hipSuccess) { grid = -1; return; }
        if (hipFuncSetAttribute((const void*)mega, hipFuncAttributeMaxDynamicSharedMemorySize, LDS_BYTES) != hipSuccess) { fprintf(stderr, "kernel_launch: hipFuncSetAttribute failed\n"); grid = -1; return; }
        if (hipOccupancyMaxActiveBlocksPerMultiprocessor(&per_cu, (const void*)mega, NWAVES * 64, LDS_BYTES) != hipSuccess || per_cu < 1) fprintf(stderr, "kernel_launch: occupancy query says %d\n", per_cu);
        (void)hipGetLastError();
        grid = cus;
    }
    if (grid < 0) return;
    hipMemsetAsync((char*)d_ws + WS_CTL, 0, 1 * MiB, stream);
    Args a{}; for (int i = 0; i < 39; ++i) a.in[i] = (const float*)d_in[i]; a.out = (float*)d_out; a.ws = (unsigned char*)d_ws;
    MArgs m{}; for (int i = 0; i < 39; ++i) m.in[i] = (const float*)d_in[i]; m.out = (float*)d_out; m.ws = (unsigned char*)d_ws;
    int li = 0;
#define MEGA(lo_, hi_) do { m.ph_lo = (lo_); m.ph_hi = (hi_); m.li = li++; hipLaunchKernelGGL(mega, dim3(grid), dim3(NWAVES * 64), LDS_BYTES, stream, m); } while (0)
#if BUILD_STEP >= 2
    MEGA(GP_PRO, GP_END);
}
#else
    const int B0 = GP_L0, B1 = GP_L0 + GP_LSTRIDE;
    int cur = GP_PRO;
    for (int l = 0; l < 2; ++l) {
        a.l = l; const Ctx c = make_ctx(a, l); const int B = l ? B1 : B0;
        MEGA(cur, B + LP_ATTN);
        hipLaunchKernelGGL((nv_attn<64, 64, 0>), dim3(MTOK / 64, 4, 1), dim3(64), 0, stream, c.PROJ + C_QA, PW, 64, c.PROJ + C_KA, PW, 64, nullptr, 0, c.PROJ + C_VA, PW, 64, c.OMIX, 1024, 64, c.CUM, 0.125f);
        hipLaunchKernelGGL(nv_sgu, dim3(MTOK / 128, 4), dim3(256), 0, stream, c.PROJ, c.bsw, c.bsb, c.OMIX);
        hipLaunchKernelGGL((nv_attn<96, 64, 1>), dim3(MTOK / 64, 8, 1), dim3(64), 0, stream, c.QC, 768, 96, c.KVC, 1024, 128, c.PROJ + C_KR, PW, c.KVC + 64, 1024, 128, c.OMIX + 512, 1024, 64, nullptr, 0.10206207261596575f);
        MEGA(B + LP_MIXNORM, B + LP_ATTM);
        hipLaunchKernelGGL((nv_attn<128, 128, 2>), dim3(MTOK / 64, 4, 2), dim3(64), 0, stream, c.QM, 512, 128, c.KVM + (size_t)l * 4096 * 1024, 1024, 128, nullptr, 0, c.KVM + (size_t)l * 4096 * 1024 + 512, 1024, 128, c.OM, 512, 128, nullptr, 0.08838834764831845f);
        cur = B + LP_G7;
    }
    MEGA(cur, GP_END);
}
#endif
```

```cpp
#include <hip/hip_runtime.h>
#include <stdint.h>
#include <stdio.h>

typedef unsigned short bf16;
#define LAS __attribute__((address_space(3)))
#define EPSF 1e-6f

constexpr int BATCH = 16, SEQ = 4096, DM = 1024, MTOK = BATCH * SEQ, MEML = 256;
constexpr int PW = 1792;
constexpr int C_QA = 0, C_KA = 256, C_VA = 512, C_UB = 768, C_VB = 1024, C_CQ = 1280, C_CKV = 1536, C_KR = 1664, C_FA = 1696;
constexpr int IN_W = 1700, DFF = 2752, DFFP = 2816, NEXP = 8, DFE = 1408;
constexpr int SLOTS = 2 * MTOK + 16 * 256;
constexpr int MAXTILES = SLOTS / 256;

constexpr size_t MiB = 1u << 20;
constexpr size_t WS_CTL = 0, WS_WB = 1 * MiB, WS_H = 128 * MiB, WS_R1 = 256 * MiB;
constexpr size_t WS_QC = 640 * MiB, WS_KVC = 736 * MiB, WS_OMIX = 864 * MiB, WS_QM = 640 * MiB, WS_OM = 704 * MiB;
constexpr size_t WS_KVM = 992 * MiB, WS_HM = 1000 * MiB, WS_FLOG = 1008 * MiB, WS_CUM = 1009 * MiB, WS_TOP = 1010 * MiB, WS_SLOT = 1012 * MiB, WS_CH = 1014 * MiB;
constexpr size_t WS_PART = 1019 * MiB;
constexpr size_t WS_CUMX = 1015 * MiB;
constexpr size_t WS_HS = 256 * MiB, WS_HIDM = 520 * MiB, WS_END = 1023 * MiB;

__device__ __forceinline__ float bf2f(bf16 v) { return __uint_as_float(((unsigned)v) << 16); }
__device__ __forceinline__ bf16 f2bf(float f) { unsigned u = __float_as_uint(f); u += 0x7fffu + ((u >> 16) & 1u); return (bf16)(u >> 16); }
__device__ __forceinline__ unsigned pack2(float a, float b) { return (unsigned)f2bf(a) | ((unsigned)f2bf(b) << 16); }
__device__ __forceinline__ void unpack2(unsigned u, float& a, float& b) { a = __uint_as_float(u << 16); b = __uint_as_float(u & 0xffff0000u); }
__device__ __forceinline__ void ld4bf(const bf16* p, float (&f)[4]) { const uint2 u = *(const uint2*)p; unpack2(u.x, f[0], f[1]); unpack2(u.y, f[2], f[3]); }
__device__ __forceinline__ void st4bf(bf16* p, const float (&f)[4]) { uint2 u; u.x = pack2(f[0], f[1]); u.y = pack2(f[2], f[3]); *(uint2*)p = u; }
__device__ __forceinline__ void ld8bf(const bf16* p, float (&f)[8]) { const uint4 u = *(const uint4*)p; unpack2(u.x, f[0], f[1]); unpack2(u.y, f[2], f[3]); unpack2(u.z, f[4], f[5]); unpack2(u.w, f[6], f[7]); }
__device__ __forceinline__ void st8bf(bf16* p, const float (&f)[8]) { uint4 u; u.x = pack2(f[0], f[1]); u.y = pack2(f[2], f[3]); u.z = pack2(f[4], f[5]); u.w = pack2(f[6], f[7]); *(uint4*)p = u; }
__device__ __forceinline__ float shx(float v, int lane, int o) { return __int_as_float(__builtin_amdgcn_ds_bpermute((lane ^ o) << 2, __float_as_int(v))); }
__device__ __forceinline__ float wsum(float v, int lane) {
#pragma unroll
    for (int o = 1; o < 64; o <<= 1) v += shx(v, lane, o);
    return v; }
__device__ __forceinline__ float sum16(float v, int lane) { v += shx(v, lane, 1); v += shx(v, lane, 2); v += shx(v, lane, 4); v += shx(v, lane, 8); return v; }
__device__ __forceinline__ float sum8(float v, int lane) { v += shx(v, lane, 1); v += shx(v, lane, 2); v += shx(v, lane, 4); return v; }
__device__ __forceinline__ float gelu_erf(float v) {
    const float av = fabsf(v), t = __builtin_amdgcn_rcpf(av * 0.2316418882f + 1.0f);
    float q = t * 0.5307027145f + (-0.7265760135f); q = q * t + 0.7107068705f; q = q * t + (-0.142248368f); q = q * t + 0.127414796f; q = q * t;
    const float e = __builtin_amdgcn_exp2f((v * v) * (-0.72134752044f)), m = v * (q * e);
    return v < 0.f ? m : v - m; }
__device__ __forceinline__ float logsigmoid(float z) { return fminf(z, 0.f) - 0.6931471805599453f * __builtin_amdgcn_logf(1.0f + __builtin_amdgcn_exp2f(-1.4426950408889634f * fabsf(z))); }
__device__ __forceinline__ float rope_inv(int i) { return exp2f(-(float)i * (13.287712379549449f / 16.0f)); }

struct Args { const float* in[39]; float* out; unsigned char* ws; int l; int phase; };
struct Ctx {
    const float* x_in; const float* mem; const int* pos;
    const float *mix_norm, *w_in, *b_forget, *aq, *ak, *bv, *bsw, *bsb, *cqg, *wuq, *ckvg, *wukv, *qng, *qrg, *kng, *krg, *ona, *onb, *onc, *wout, *xattn, *memn, *wmq, *wmkv, *mqg, *mkg, *wmo, *ffn_norm;
    const float *fg, *fu, *fd, *wr, *br, *mg, *mu, *md;
    float* X;
    bf16 *H, *PROJ, *QC, *KVC, *OMIX, *QM, *OM, *KVM, *HM, *HID, *HS, *HIDM;
    float *FLOG, *CUM, *TOPG, *SLOT_GATE, *PART, *RTOK, *SLOT_R; int *TOPI, *SLOT_TOK, *CH, *TAB; bf16* CUMX;
};
__device__ __host__ __forceinline__ Ctx make_ctx(const Args& a, int l) {
    Ctx c;
    c.x_in = a.in[0]; c.mem = a.in[1]; c.pos = (const int*)a.in[2];
    c.mix_norm = a.in[3] + l * 1024; c.w_in = a.in[4] + (size_t)l * 1024 * IN_W; c.b_forget = a.in[5] + l * 4; c.aq = a.in[6] + l * 64; c.ak = a.in[7] + l * 64;
    c.bv = a.in[8] + l * 256; c.bsw = a.in[9] + l * 4 * 128 * 128; c.bsb = a.in[10] + l * 4 * 128; c.cqg = a.in[11] + l * 256; c.wuq = a.in[12] + (size_t)l * 256 * 768;
    c.ckvg = a.in[13] + l * 128; c.wukv = a.in[14] + (size_t)l * 128 * 1024; c.qng = a.in[15] + l * 64; c.qrg = a.in[16] + l * 32; c.kng = a.in[17] + l * 64; c.krg = a.in[18] + l * 32;
    c.ona = a.in[19] + l * 256; c.onb = a.in[20] + l * 256; c.onc = a.in[21] + l * 512; c.wout = a.in[22] + (size_t)l * 1024 * 1024; c.xattn = a.in[23] + l * 1024; c.memn = a.in[24] + l * 1024;
    c.wmq = a.in[25] + (size_t)l * 1024 * 512; c.wmkv = a.in[26] + (size_t)l * 1024 * 1024; c.mqg = a.in[27] + l * 128; c.mkg = a.in[28] + l * 128; c.wmo = a.in[29] + (size_t)l * 512 * 1024; c.ffn_norm = a.in[30] + l * 1024;
    c.fg = a.in[31]; c.fu = a.in[32]; c.fd = a.in[33]; c.wr = a.in[34]; c.br = a.in[35]; c.mg = a.in[36]; c.mu = a.in[37]; c.md = a.in[38];
    c.X = a.out;
    unsigned char* ws = a.ws;
    c.H = (bf16*)(ws + WS_H); c.PROJ = (bf16*)(ws + WS_R1); c.QC = (bf16*)(ws + WS_QC); c.KVC = (bf16*)(ws + WS_KVC); c.OMIX = (bf16*)(ws + WS_OMIX); c.QM = (bf16*)(ws + WS_QM); c.OM = (bf16*)(ws + WS_OM);
    c.KVM = (bf16*)(ws + WS_KVM); c.HM = (bf16*)(ws + WS_HM); c.HID = (bf16*)(ws + WS_R1); c.HS = (bf16*)(ws + WS_HS); c.HIDM = (bf16*)(ws + WS_HIDM);
    c.FLOG = (float*)(ws + WS_FLOG); c.CUM = (float*)(ws + WS_CUM); c.TOPI = (int*)(ws + WS_TOP); c.TOPG = (float*)(ws + WS_TOP + MiB); c.SLOT_TOK = (int*)(ws + WS_SLOT); c.SLOT_GATE = (float*)(ws + WS_SLOT + MiB);
    c.CH = (int*)(ws + WS_CH); c.TAB = (int*)(ws + WS_CH + 65536); c.CUMX = (bf16*)(ws + WS_CUMX); c.PART = (float*)(ws + WS_PART); c.RTOK = c.TOPG + 2 * MTOK; c.SLOT_R = (float*)(ws + WS_CH + 131072);
    return c;
}

constexpr int RB = 4;
__device__ __forceinline__ void pass_norm(const float* x, const float* g, bf16* H, int nrows, int gw, int ngw, int lane) {
    float4 gg[4];
#pragma unroll
    for (int j = 0; j < 4; ++j) gg[j] = ((const float4*)g)[lane + 64 * j];
    for (int r0 = gw; r0 < nrows; r0 += ngw * RB) {
        float4 v[RB][4];
#pragma unroll
        for (int k = 0; k < RB; ++k) { const int r = r0 + k * ngw; if (r < nrows) {
#pragma unroll
            for (int j = 0; j < 4; ++j) v[k][j] = ((const float4*)(x + (size_t)r * 1024))[lane + 64 * j]; } }
#pragma unroll
        for (int k = 0; k < RB; ++k) { const int r = r0 + k * ngw; if (r < nrows) { float ss = 0.f;
#pragma unroll
            for (int j = 0; j < 4; ++j) ss += v[k][j].x * v[k][j].x + v[k][j].y * v[k][j].y + v[k][j].z * v[k][j].z + v[k][j].w * v[k][j].w;
            ss = wsum(ss, lane); const float rr = rsqrtf(ss * (1.f / 1024.f) + EPSF);
#pragma unroll
            for (int j = 0; j < 4; ++j) { float f[4] = {v[k][j].x * rr * gg[j].x, v[k][j].y * rr * gg[j].y, v[k][j].z * rr * gg[j].z, v[k][j].w * rr * gg[j].w}; st4bf(H + (size_t)r * 1024 + 4 * (lane + 64 * j), f); } } }
    }
}
__device__ __forceinline__ void pass_xb(const float* x, bf16* Xb, float* part, int nrows, int gw, int ngw, int lane) {
    for (int r0 = gw; r0 < nrows; r0 += ngw * RB) {
        float4 v[RB][4];
#pragma unroll
        for (int k = 0; k < RB; ++k) { const int r = r0 + k * ngw;
#pragma unroll
            for (int j = 0; j < 4; ++j) v[k][j] = ((const float4*)(x + (size_t)r * 1024))[lane + 64 * j]; }
#pragma unroll
        for (int k = 0; k < RB; ++k) { const int r = r0 + k * ngw; float ss = 0.f;
#pragma unroll
            for (int j = 0; j < 4; ++j) { ss += v[k][j].x * v[k][j].x + v[k][j].y * v[k][j].y + v[k][j].z * v[k][j].z + v[k][j].w * v[k][j].w; float f[4] = {v[k][j].x, v[k][j].y, v[k][j].z, v[k][j].w}; st4bf(Xb + (size_t)r * 1024 + 4 * (lane + 64 * j), f); }
            ss = wsum(ss, lane); if (lane < 16) part[(size_t)r * 16 + lane] = (lane == 0) ? ss : 0.f; }
    }
}
__device__ __forceinline__ void pass_post_proj(const Ctx& c, int nrows, int gw, int ngw, int lane) {
    const int c4 = 4 * lane;
    float gq[4], gk[4], gv[4], gc[4], gkv[4];
#pragma unroll
    for (int i = 0; i < 4; ++i) { gq[i] = c.aq[(c4 + i) & 63]; gk[i] = c.ak[(c4 + i) & 63]; gv[i] = c.bv[c4 + i]; gc[i] = c.cqg[c4 + i]; gkv[i] = c.ckvg[(c4 + i) & 127]; }
    const float gr1 = c.krg[lane & 15], gr2 = c.krg[16 + (lane & 15)], inv = rope_inv(lane & 15), bf = c.b_forget[lane & 3];
    for (int r0 = gw; r0 < nrows; r0 += ngw * RB) {
        uint2 uq[RB], uk[RB], uu[RB], uv[RB], uc[RB], ukv[RB]; bf16 x1[RB], x2[RB], fa[RB]; int ps[RB];
#pragma unroll
        for (int k = 0; k < RB; ++k) { const int r = r0 + k * ngw; const bf16* p = c.PROJ + (size_t)r * PW;
            uq[k] = *(const uint2*)(p + C_QA + c4); uk[k] = *(const uint2*)(p + C_KA + c4); uu[k] = *(const uint2*)(p + C_UB + c4); uv[k] = *(const uint2*)(p + C_VB + c4); uc[k] = *(const uint2*)(p + C_CQ + c4);
            ukv[k] = *(const uint2*)(p + C_CKV + (c4 & 127)); x1[k] = p[C_KR + (lane & 15)]; x2[k] = p[C_KR + 16 + (lane & 15)]; fa[k] = p[C_FA + (lane & 3)]; ps[k] = c.pos[r]; }
#pragma unroll
        for (int k = 0; k < RB; ++k) { const int r = r0 + k * ngw; bf16* p = c.PROJ + (size_t)r * PW; float f[4];
            { unpack2(uq[k].x, f[0], f[1]); unpack2(uq[k].y, f[2], f[3]); const float rr = rsqrtf(sum16(f[0] * f[0] + f[1] * f[1] + f[2] * f[2] + f[3] * f[3], lane) * (1.f / 64.f) + EPSF);
#pragma unroll
              for (int i = 0; i < 4; ++i) f[i] *= rr * gq[i];
              st4bf(p + C_QA + c4, f); }
            { unpack2(uk[k].x, f[0], f[1]); unpack2(uk[k].y, f[2], f[3]); const float rr = rsqrtf(sum16(f[0] * f[0] + f[1] * f[1] + f[2] * f[2] + f[3] * f[3], lane) * (1.f / 64.f) + EPSF);
#pragma unroll
              for (int i = 0; i < 4; ++i) f[i] *= rr * gk[i];
              st4bf(p + C_KA + c4, f); }
            { unpack2(uu[k].x, f[0], f[1]); unpack2(uu[k].y, f[2], f[3]);
#pragma unroll
              for (int i = 0; i < 4; ++i) f[i] = gelu_erf(f[i]);
              st4bf(p + C_UB + c4, f); }
            { unpack2(uv[k].x, f[0], f[1]); unpack2(uv[k].y, f[2], f[3]);
#pragma unroll
              for (int i = 0; i < 4; ++i) f[i] = gelu_erf(f[i]);
              const float mu = sum16(f[0] + f[1] + f[2] + f[3], lane) * (1.f / 64.f); float q = 0.f;
#pragma unroll
              for (int i = 0; i < 4; ++i) { f[i] -= mu; q += f[i] * f[i]; }
              const float rr = rsqrtf(sum16(q, lane) * (1.f / 64.f) + EPSF);
#pragma unroll
              for (int i = 0; i < 4; ++i) f[i] *= rr * gv[i];
              st4bf(p + C_VB + c4, f); }
            { unpack2(uc[k].x, f[0], f[1]); unpack2(uc[k].y, f[2], f[3]); const float rr = rsqrtf(wsum(f[0] * f[0] + f[1] * f[1] + f[2] * f[2] + f[3] * f[3], lane) * (1.f / 256.f) + EPSF);
#pragma unroll
              for (int i = 0; i < 4; ++i) f[i] *= rr * gc[i];
              st4bf(p + C_CQ + c4, f); }
            { unpack2(ukv[k].x, f[0], f[1]); unpack2(ukv[k].y, f[2], f[3]); float ss = (lane < 32) ? (f[0] * f[0] + f[1] * f[1] + f[2] * f[2] + f[3] * f[3]) : 0.f; const float rr = rsqrtf(wsum(ss, lane) * (1.f / 128.f) + EPSF);
              if (lane < 32) {
#pragma unroll
                  for (int i = 0; i < 4; ++i) f[i] *= rr * gkv[i];
                  st4bf(p + C_CKV + c4, f); } }
            { float a1 = bf2f(x1[k]), a2 = bf2f(x2[k]); const float rr = rsqrtf(sum16(a1 * a1 + a2 * a2, lane) * (1.f / 32.f) + EPSF); a1 *= rr * gr1; a2 *= rr * gr2;
              const float ang = (float)ps[k] * inv; const float sn = sinf(ang), cs = cosf(ang);
              if (lane < 16) { p[C_KR + lane] = f2bf(a1 * cs - a2 * sn); p[C_KR + 16 + lane] = f2bf(a1 * sn + a2 * cs); } }
            if (lane < 4) c.FLOG[(size_t)r * 4 + lane] = logsigmoid(bf2f(fa[k]) + bf);
        }
    }
}
__device__ __forceinline__ void pass_post_up(const Ctx& c, int nrows, int gw, int ngw, int lane) {
    const int h = lane >> 3, j = lane & 7;
    float gn[8], gkn[8], gr[4], iv[4];
#pragma unroll
    for (int i = 0; i < 8; ++i) { gn[i] = c.qng[8 * j + i]; gkn[i] = c.kng[8 * j + i]; }
#pragma unroll
    for (int i = 0; i < 4; ++i) { gr[i] = c.qrg[4 * j + i]; iv[i] = rope_inv(4 * (j & 3) + i); }
    for (int r0 = gw; r0 < nrows; r0 += ngw * RB) {
        uint4 un[RB], ukn[RB]; uint2 ur[RB]; int ps[RB];
#pragma unroll
        for (int k = 0; k < RB; ++k) { const int r = r0 + k * ngw; const bf16* q = c.QC + (size_t)r * 768 + h * 96; const bf16* kv = c.KVC + (size_t)r * 1024 + h * 128;
            un[k] = *(const uint4*)(q + 8 * j); ur[k] = *(const uint2*)(q + 64 + 4 * j); ukn[k] = *(const uint4*)(kv + 8 * j); ps[k] = c.pos[r]; }
#pragma unroll
        for (int k = 0; k < RB; ++k) { const int r = r0 + k * ngw; bf16* q = c.QC + (size_t)r * 768 + h * 96; bf16* kv = c.KVC + (size_t)r * 1024 + h * 128;
            { float f[8]; unpack2(un[k].x, f[0], f[1]); unpack2(un[k].y, f[2], f[3]); unpack2(un[k].z, f[4], f[5]); unpack2(un[k].w, f[6], f[7]); float ss = 0.f;
#pragma unroll
              for (int i = 0; i < 8; ++i) ss += f[i] * f[i];
              const float rr = rsqrtf(sum8(ss, lane) * (1.f / 64.f) + EPSF);
#pragma unroll
              for (int i = 0; i < 8; ++i) f[i] *= rr * gn[i];
              st8bf(q + 8 * j, f); }
            { float f[4], o[4]; unpack2(ur[k].x, f[0], f[1]); unpack2(ur[k].y, f[2], f[3]); const float rr = rsqrtf(sum8(f[0] * f[0] + f[1] * f[1] + f[2] * f[2] + f[3] * f[3], lane) * (1.f / 32.f) + EPSF); const float posf = (float)ps[k];
#pragma unroll
              for (int i = 0; i < 4; ++i) { f[i] *= rr * gr[i]; const float other = shx(f[i], lane, 4); const float ang = posf * iv[i]; const float sn = sinf(ang), cs = cosf(ang); o[i] = (j < 4) ? (f[i] * cs - other * sn) : (other * sn + f[i] * cs); }
              st4bf(q + 64 + 4 * j, o); }
            { float f[8]; unpack2(ukn[k].x, f[0], f[1]); unpack2(ukn[k].y, f[2], f[3]); unpack2(ukn[k].z, f[4], f[5]); unpack2(ukn[k].w, f[6], f[7]); float ss = 0.f;
#pragma unroll
              for (int i = 0; i < 8; ++i) ss += f[i] * f[i];
              const float rr = rsqrtf(sum8(ss, lane) * (1.f / 64.f) + EPSF);
#pragma unroll
              for (int i = 0; i < 8; ++i) f[i] *= rr * gkn[i];
              st8bf(kv + 8 * j, f); }
        }
    }
}
__device__ __forceinline__ void pass_mixnorm(const Ctx& c, int nrows, int gw, int ngw, int lane) {
    float ga[4], gb[4], gc[8];
#pragma unroll
    for (int i = 0; i < 4; ++i) { ga[i] = c.ona[4 * lane + i]; gb[i] = c.onb[4 * lane + i]; }
#pragma unroll
    for (int i = 0; i < 8; ++i) gc[i] = c.onc[8 * lane + i];
    for (int r0 = gw; r0 < nrows; r0 += ngw * RB) {
        uint2 ua[RB], ub[RB]; uint4 uc[RB];
#pragma unroll
        for (int k = 0; k < RB; ++k) { const bf16* p = c.OMIX + (size_t)(r0 + k * ngw) * 1024; ua[k] = *(const uint2*)(p + 4 * lane); ub[k] = *(const uint2*)(p + 256 + 4 * lane); uc[k] = *(const uint4*)(p + 512 + 8 * lane); }
#pragma unroll
        for (int k = 0; k < RB; ++k) { bf16* p = c.OMIX + (size_t)(r0 + k * ngw) * 1024; float f[4];
            { unpack2(ua[k].x, f[0], f[1]); unpack2(ua[k].y, f[2], f[3]); const float rr = rsqrtf(wsum(f[0] * f[0] + f[1] * f[1] + f[2] * f[2] + f[3] * f[3], lane) * (1.f / 256.f) + EPSF);
#pragma unroll
              for (int i = 0; i < 4; ++i) f[i] *= rr * ga[i];
              st4bf(p + 4 * lane, f); }
            { unpack2(ub[k].x, f[0], f[1]); unpack2(ub[k].y, f[2], f[3]); const float rr = rsqrtf(wsum(f[0] * f[0] + f[1] * f[1] + f[2] * f[2] + f[3] * f[3], lane) * (1.f / 256.f) + EPSF);
#pragma unroll
              for (int i = 0; i < 4; ++i) f[i] *= rr * gb[i];
              st4bf(p + 256 + 4 * lane, f); }
            { float g[8]; unpack2(uc[k].x, g[0], g[1]); unpack2(uc[k].y, g[2], g[3]); unpack2(uc[k].z, g[4], g[5]); unpack2(uc[k].w, g[6], g[7]); float ss = 0.f;
#pragma unroll
              for (int i = 0; i < 8; ++i) ss += g[i] * g[i];
              const float rr = rsqrtf(wsum(ss, lane) * (1.f / 512.f) + EPSF);
#pragma unroll
              for (int i = 0; i < 8; ++i) g[i] *= rr * gc[i];
              st8bf(p + 512 + 8 * lane, g); }
        }
    }
}
__device__ __forceinline__ void pass_memnorm(bf16* buf, int ld, const float* g, int nrows, int gw, int ngw, int lane) {
    float gg[8];
#pragma unroll
    for (int i = 0; i < 8; ++i) gg[i] = g[(8 * lane + i) & 127];
    for (int r0 = gw; r0 < nrows; r0 += ngw * RB) {
        uint4 u[RB];
#pragma unroll
        for (int k = 0; k < RB; ++k) { const int r = r0 + k * ngw; if (r < nrows) u[k] = *(const uint4*)(buf + (size_t)r * ld + 8 * lane); }
#pragma unroll
        for (int k = 0; k < RB; ++k) { const int r = r0 + k * ngw; if (r < nrows) { float f[8]; unpack2(u[k].x, f[0], f[1]); unpack2(u[k].y, f[2], f[3]); unpack2(u[k].z, f[4], f[5]); unpack2(u[k].w, f[6], f[7]); float ss = 0.f;
#pragma unroll
            for (int i = 0; i < 8; ++i) ss += f[i] * f[i];
            const float rr = rsqrtf(sum16(ss, lane) * (1.f / 128.f) + EPSF);
#pragma unroll
            for (int i = 0; i < 8; ++i) f[i] *= rr * gg[i];
            st8bf(buf + (size_t)r * ld + 8 * lane, f); } }
    }
}
__device__ __forceinline__ void route_rows32(const Ctx& c, int row0, int lane) {
    float wr[16][8];
#pragma unroll
    for (int j = 0; j < 4; ++j) { const float4 gg = ((const float4*)c.ffn_norm)[lane + 64 * j]; const float g4[4] = {gg.x, gg.y, gg.z, gg.w};
#pragma unroll
        for (int i = 0; i < 4; ++i) { const float4* w = (const float4*)(c.wr + (size_t)(4 * (lane + 64 * j) + i) * 8); const float4 w0 = w[0], w1 = w[1]; const float g = g4[i];
            wr[4 * j + i][0] = w0.x * g; wr[4 * j + i][1] = w0.y * g; wr[4 * j + i][2] = w0.z * g; wr[4 * j + i][3] = w0.w * g; wr[4 * j + i][4] = w1.x * g; wr[4 * j + i][5] = w1.y * g; wr[4 * j + i][6] = w1.z * g; wr[4 * j + i][7] = w1.w * g; } }
    float br[8];
#pragma unroll
    for (int e = 0; e < 8; ++e) br[e] = c.br[e];
    for (int rb = 0; rb < 32; rb += 2) {
        float4 v[2][4];
#pragma unroll
        for (int k = 0; k < 2; ++k)
#pragma unroll
            for (int j = 0; j < 4; ++j) v[k][j] = ((const float4*)(c.X + (size_t)(row0 + rb + k) * 1024))[lane + 64 * j];
#pragma unroll
        for (int k = 0; k < 2; ++k) { const int row = row0 + rb + k; float ss = 0.f, lg[8];
#pragma unroll
            for (int e = 0; e < 8; ++e) lg[e] = 0.f;
#pragma unroll
            for (int j = 0; j < 4; ++j) { const float f[4] = {v[k][j].x, v[k][j].y, v[k][j].z, v[k][j].w};
#pragma unroll
                for (int i = 0; i < 4; ++i) { ss += f[i] * f[i];
#pragma unroll
                    for (int e = 0; e < 8; ++e) lg[e] += f[i] * wr[4 * j + i][e]; } }
            ss = wsum(ss, lane); const float r = rsqrtf(ss * (1.f / 1024.f) + EPSF);
#pragma unroll
            for (int e = 0; e < 8; ++e) lg[e] = wsum(lg[e], lane) * r + br[e];
            int i1 = 0; float v1 = lg[0];
#pragma unroll
            for (int e = 1; e < 8; ++e) if (lg[e] > v1) { v1 = lg[e]; i1 = e; }
            int i2 = -1; float v2 = -3.0e38f;
#pragma unroll
            for (int e = 0; e < 8; ++e) if (e != i1 && lg[e] > v2) { v2 = lg[e]; i2 = e; }
            const float e2 = expf(v2 - v1), g1 = 1.f / (1.f + e2), g2 = e2 / (1.f + e2);
            if (lane == 0) { c.TOPI[(size_t)row * 2] = i1; c.TOPI[(size_t)row * 2 + 1] = i2; c.TOPG[(size_t)row * 2] = g1; c.TOPG[(size_t)row * 2 + 1] = g2; c.RTOK[row] = r; } }
    }
}

__device__ __forceinline__ void cumsum_batch(const Ctx& c, int b, LAS float* sm  , int tid) {
    const int lane = tid & 63, wave = tid >> 6;
    const float4* src = (const float4*)c.FLOG + (size_t)b * SEQ + tid * 8; float4* dst = (float4*)c.CUM + (size_t)b * SEQ + tid * 8;
    float4 v[8];
#pragma unroll
    for (int i = 0; i < 8; ++i) v[i] = src[i];
#pragma unroll
    for (int i = 1; i < 8; ++i) { v[i].x += v[i - 1].x; v[i].y += v[i - 1].y; v[i].z += v[i - 1].z; v[i].w += v[i - 1].w; }
    const float4 tot = v[7]; float4 inc = tot;
#pragma unroll
    for (int o = 1; o < 64; o <<= 1) { const int si = ((lane - o) & 63) << 2; const float tx = __int_as_float(__builtin_amdgcn_ds_bpermute(si, __float_as_int(inc.x))), ty = __int_as_float(__builtin_amdgcn_ds_bpermute(si, __float_as_int(inc.y))), tz = __int_as_float(__builtin_amdgcn_ds_bpermute(si, __float_as_int(inc.z))), tw = __int_as_float(__builtin_amdgcn_ds_bpermute(si, __float_as_int(inc.w))); if (lane >= o) { inc.x += tx; inc.y += ty; inc.z += tz; inc.w += tw; } }
    if (lane == 63) { sm[wave * 4 + 0] = inc.x; sm[wave * 4 + 1] = inc.y; sm[wave * 4 + 2] = inc.z; sm[wave * 4 + 3] = inc.w; }
    __syncthreads();
    float4 base = {0.f, 0.f, 0.f, 0.f};
    for (int w = 0; w < wave; ++w) { base.x += sm[w * 4 + 0]; base.y += sm[w * 4 + 1]; base.z += sm[w * 4 + 2]; base.w += sm[w * 4 + 3]; }
    const float4 ex = {base.x + inc.x - tot.x, base.y + inc.y - tot.y, base.z + inc.z - tot.z, base.w + inc.w - tot.w};
#pragma unroll
    for (int i = 0; i < 8; ++i) { const float4 cv = make_float4(v[i].x + ex.x, v[i].y + ex.y, v[i].z + ex.z, v[i].w + ex.w); dst[i] = cv;
        const float cc[4] = {cv.x, cv.y, cv.z, cv.w};
#pragma unroll
        for (int h = 0; h < 4; ++h) { const float fb = -cc[h] * 1.4426950408889634f; const bf16 b0 = f2bf(fb); const float r1 = fb - bf2f(b0); const bf16 b1 = f2bf(r1); const bf16 b2 = f2bf(r1 - bf2f(b1));
            uint4 rec; rec.x = (unsigned)b0 | ((unsigned)b1 << 16); rec.y = (unsigned)b2; rec.z = 0u; rec.w = 0u;
            *(uint4*)(c.CUMX + ((size_t)(b * 4 + h) * SEQ + tid * 8 + i) * 8) = rec; } }
    __syncthreads();
}
__device__ __forceinline__ void route1_chunk(const Ctx& c, int ch, LAS int* sm  , int tid) {
    const int lane = tid & 63, wave = tid >> 6;
    if (tid < 16) sm[tid] = 0;
    __syncthreads();
    route_rows32(c, ch * 256 + wave * 32, lane);
    __syncthreads();
    if (tid < 256) { const int row = ch * 256 + tid; const int e1 = __hip_atomic_load(c.TOPI + (size_t)row * 2, __ATOMIC_RELAXED, __HIP_MEMORY_SCOPE_AGENT), e2 = __hip_atomic_load(c.TOPI + (size_t)row * 2 + 1, __ATOMIC_RELAXED, __HIP_MEMORY_SCOPE_AGENT);
        atomicAdd((int*)&sm[e1], 1); atomicAdd((int*)&sm[8 + e2], 1); }
    __syncthreads();
    if (tid < 16) c.CH[ch * 16 + tid] = sm[tid];
    __syncthreads();
}
__device__ __forceinline__ void route2_chunk(const Ctx& c, int ch, LAS int* sm  , int tid) {
    const int lane = tid & 63, wave = tid >> 6;
    LAS int* sCH = sm; LAS int* sTot = sm + 4096; LAS int* sPre = sm + 4096 + 16; LAS int* sOff = sm + 4096 + 32; LAS int* sWc = sm + 4096 + 64; LAS int* sSlot = sm + 4096 + 128;
    for (int i = tid; i < 4096; i += 512) sCH[i] = c.CH[i];
    __syncthreads();
    if (tid < 16) { int tot = 0, pre = 0; for (int k = 0; k < 256; ++k) { const int v = sCH[k * 16 + tid]; tot += v; if (k < ch) pre += v; } sTot[tid] = tot; sPre[tid] = pre; }
    __syncthreads();
    if (tid == 0) { int o = 0; for (int g = 0; g < 16; ++g) { sOff[g] = o; o += (sTot[g] + 255) & ~255; } sOff[16] = o; }
    __syncthreads();
    int e1 = -1, e2 = -1, r1 = 0, r2 = 0; const int row = ch * 256 + tid;
    if (tid < 256) { e1 = c.TOPI[(size_t)row * 2]; e2 = c.TOPI[(size_t)row * 2 + 1]; }
    for (int g = 0; g < 16; ++g) { const bool pred = (tid < 256) && (g < 8 ? (e1 == g) : (e2 == g - 8)); const unsigned long long m = __ballot(pred);
        const int rk = __popcll(m & ((1ull << lane) - 1ull)); if (pred) { if (g < 8) r1 = rk; else r2 = rk; }
        if (lane == 0 && wave < 4) sWc[wave * 16 + g] = __popcll(m); }
    __syncthreads();
    if (tid < 256) { int b1 = sOff[e1] + sPre[e1], b2 = sOff[8 + e2] + sPre[8 + e2]; for (int w = 0; w < wave; ++w) { b1 += sWc[w * 16 + e1]; b2 += sWc[w * 16 + 8 + e2]; }
        const int s1 = b1 + r1, s2 = b2 + r2; sSlot[tid * 2] = s1; sSlot[tid * 2 + 1] = s2;
        c.SLOT_TOK[s1] = row; c.SLOT_TOK[s2] = row; c.SLOT_GATE[s1] = c.TOPG[(size_t)row * 2]; c.SLOT_GATE[s2] = c.TOPG[(size_t)row * 2 + 1]; const float rr = c.RTOK[row]; c.SLOT_R[s1] = rr; c.SLOT_R[s2] = rr; }
    __syncthreads();
    for (int i = 0; i < 32; i += 2) { const int t0 = wave * 32 + i, t1 = t0 + 1;
        const uint4* s0 = (const uint4*)(c.H + (size_t)(ch * 256 + t0) * 1024); const uint4* s1 = (const uint4*)(c.H + (size_t)(ch * 256 + t1) * 1024);
        const uint4 a0 = s0[lane], b0 = s0[lane + 64], a1 = s1[lane], b1 = s1[lane + 64];
        uint4* d00 = (uint4*)(c.HS + (size_t)sSlot[t0 * 2] * 1024); uint4* d01 = (uint4*)(c.HS + (size_t)sSlot[t0 * 2 + 1] * 1024); uint4* d10 = (uint4*)(c.HS + (size_t)sSlot[t1 * 2] * 1024); uint4* d11 = (uint4*)(c.HS + (size_t)sSlot[t1 * 2 + 1] * 1024);
        d00[lane] = a0; d00[lane + 64] = b0; d01[lane] = a0; d01[lane + 64] = b0; d10[lane] = a1; d10[lane + 64] = b1; d11[lane] = a1; d11[lane + 64] = b1; }
    for (int g = 0; g < 16; ++g) { const int rem = sTot[g] & 255; if (rem && ch >= rem) { const int r = sOff[g] + (sTot[g] & ~255) + ch; ((unsigned*)(c.HS + (size_t)r * 1024))[tid] = 0u; if (tid == 0) { c.SLOT_TOK[r] = -1; c.SLOT_GATE[r] = 0.f; c.SLOT_R[r] = 0.f; } } }
    if (ch == 0) { const int nt = sOff[16] >> 8; for (int t = tid; t < MAXTILES + 16; t += 512) { int g = -1; if (t < nt) { for (int q = 0; q < 16; ++q) if ((t << 8) >= sOff[q] && (t << 8) < sOff[q + 1]) g = q; } c.TAB[t] = g; } if (tid == 0) { c.TAB[1000] = nt; c.TAB[1001] = sOff[8] >> 8; } }
    __syncthreads();
}

enum { PH_NORM1 = 0, PH_POSTPROJ, PH_CUMSUM, PH_POSTUP, PH_MIXNORM, PH_NORM2, PH_MEMNORM_Q, PH_MEMKV_NORM, PH_MEMNORM_K, PH_NORM3, PH_ROUTE1, PH_ROUTE2, PH_ZEROPAD };
__global__ void __launch_bounds__(512) k_elem(Args a) {
    __shared__ int smem[4096 + 128 + 512 + 64];
    const Ctx c = make_ctx(a, a.l);
    const int tid = threadIdx.x, lane = tid & 63, wave = tid >> 6, gw = blockIdx.x * 8 + wave, ngw = gridDim.x * 8;
    switch (a.phase) {
    case PH_NORM1: pass_norm(a.l == 0 ? c.x_in : c.X, c.mix_norm, c.H, MTOK, gw, ngw, lane); break;
    case PH_POSTPROJ: pass_post_proj(c, MTOK, gw, ngw, lane); break;
    case PH_CUMSUM: for (int b = blockIdx.x; b < BATCH; b += gridDim.x) cumsum_batch(c, b, (LAS float*)smem, tid); break;
    case PH_POSTUP: pass_post_up(c, MTOK, gw, ngw, lane); break;
    case PH_MIXNORM: pass_mixnorm(c, MTOK, gw, ngw, lane); break;
    case PH_NORM2: pass_norm(c.X, c.xattn, c.H, MTOK, gw, ngw, lane); break;
    case PH_MEMNORM_Q: pass_memnorm(c.QM, 512, c.mqg, MTOK, gw, ngw, lane); break;
    case PH_MEMKV_NORM: pass_norm(c.mem, c.memn, c.HM, BATCH * MEML, gw, ngw, lane); break;
    case PH_MEMNORM_K: pass_memnorm(c.KVM, 1024, c.mkg, BATCH * MEML, gw, ngw, lane); break;
    case PH_NORM3: pass_norm(c.X, c.ffn_norm, c.H, MTOK, gw, ngw, lane); break;
    case PH_ROUTE1: for (int ch = blockIdx.x; ch < 256; ch += gridDim.x) route1_chunk(c, ch, (LAS int*)smem, tid); break;
    case PH_ROUTE2: for (int ch = blockIdx.x; ch < 256; ch += gridDim.x) route2_chunk(c, ch, (LAS int*)smem, tid); break;
    case PH_ZEROPAD: for (int r = gw; r < MTOK; r += ngw) { bf16* p = c.PROJ + (size_t)r * PW + IN_W; if (lane < 23) *(uint2*)(p + 4 * lane) = make_uint2(0u, 0u); } break;
    }
}

template <int EPI> __global__ void __launch_bounds__(256) nv_gemm(const bf16* A, int lda, const float* W, const float* W2, int ldw, size_t wstride, int N, int K, void* out, int ldo, const float* res,
                                                               const int* tile_grp, int kphase, const int* slot_tok, const float* slot_gate) {
    __shared__ float As[16][68]; __shared__ float Ws[16][68]; __shared__ float W2s[EPI == 2 ? 16 : 1][68];
    const int tid = threadIdx.x, tx = tid & 15, ty = tid >> 4, n0 = blockIdx.x * 64, m0 = blockIdx.y * 64;
    if (tile_grp) { const int g = tile_grp[m0 >> 8]; if (g < 0) return; if (EPI == 3 && (g >> 3) != kphase) return; W += (size_t)(g & 7) * wstride; if (EPI == 2) W2 += (size_t)(g & 7) * wstride; }
    float acc[4][4], acc2[4][4];
#pragma unroll
    for (int i = 0; i < 4; ++i)
#pragma unroll
        for (int j = 0; j < 4; ++j) { acc[i][j] = 0.f; acc2[i][j] = 0.f; }
    const int ar = tid >> 2, ak = (tid & 3) * 4, wk = tid >> 4, wn = (tid & 15) * 4;
    for (int k0 = 0; k0 < K; k0 += 16) {
        { float f[4]; ld4bf(A + (size_t)(m0 + ar) * lda + k0 + ak, f); As[ak + 0][ar] = f[0]; As[ak + 1][ar] = f[1]; As[ak + 2][ar] = f[2]; As[ak + 3][ar] = f[3]; }
        { float4 w = make_float4(0.f, 0.f, 0.f, 0.f); if (n0 + wn < N) w = *(const float4*)(W + (size_t)(k0 + wk) * ldw + n0 + wn); *(float4*)&Ws[wk][wn] = w;
          if (EPI == 2) { float4 w2 = make_float4(0.f, 0.f, 0.f, 0.f); if (n0 + wn < N) w2 = *(const float4*)(W2 + (size_t)(k0 + wk) * ldw + n0 + wn); *(float4*)&W2s[wk][wn] = w2; } }
        __syncthreads();
#pragma unroll
        for (int kk = 0; kk < 16; ++kk) { const float4 a = *(const float4*)&As[kk][ty * 4]; const float4 w = *(const float4*)&Ws[kk][tx * 4]; const float av[4] = {a.x, a.y, a.z, a.w}, wv[4] = {w.x, w.y, w.z, w.w};
#pragma unroll
            for (int i = 0; i < 4; ++i)
#pragma unroll
                for (int j = 0; j < 4; ++j) acc[i][j] += av[i] * wv[j];
            if (EPI == 2) { const float4 w2 = *(const float4*)&W2s[kk][tx * 4]; const float w2v[4] = {w2.x, w2.y, w2.z, w2.w};
#pragma unroll
                for (int i = 0; i < 4; ++i)
#pragma unroll
                    for (int j = 0; j < 4; ++j) acc2[i][j] += av[i] * w2v[j]; } }
        __syncthreads();
    }
    const int n = n0 + tx * 4; if (n >= N) return;
#pragma unroll
    for (int i = 0; i < 4; ++i) { const int row = m0 + ty * 4 + i;
        if (EPI == 0) { float f[4] = {acc[i][0], acc[i][1], acc[i][2], acc[i][3]}; st4bf((bf16*)out + (size_t)row * ldo + n, f); }
        if (EPI == 1) { const float4 r = *(const float4*)(res + (size_t)row * ldo + n); *(float4*)((float*)out + (size_t)row * ldo + n) = make_float4(r.x + acc[i][0], r.y + acc[i][1], r.z + acc[i][2], r.w + acc[i][3]); }
        if (EPI == 2) { float f[4];
#pragma unroll
            for (int j = 0; j < 4; ++j) { const float g = acc[i][j]; f[j] = g / (1.f + expf(-g)) * acc2[i][j]; }
            st4bf((bf16*)out + (size_t)row * ldo + n, f); }
        if (EPI == 3) { const int tok = slot_tok[row]; if (tok >= 0) { const float gt = slot_gate[row]; float4* o = (float4*)((float*)out + (size_t)tok * ldo + n); float4 r = *o; r.x += gt * acc[i][0]; r.y += gt * acc[i][1]; r.z += gt * acc[i][2]; r.w += gt * acc[i][3]; *o = r; } }
    }
}

template <int DK, int DK1, int MODE> __global__ void __launch_bounds__(64) nv_attn(const bf16* Q, int ldq, int hq, const bf16* K, int ldk, int hk, const bf16* K2, int ldk2, const bf16* V, int ldv, int hv,
                                                                                    bf16* O, int ldo, int ho, const float* cum, float scale) {
    __shared__ float Ks[64][DK + 4]; __shared__ float Vs[64][68]; __shared__ float Cs[64];
    const int tid = threadIdx.x, h = blockIdx.y, z = blockIdx.z, row = blockIdx.x * 64 + tid, b = row / SEQ, qt = (blockIdx.x * 64 % SEQ) / 64;
    float q[DK];
    { const bf16* qp = Q + (size_t)row * ldq + h * hq;
#pragma unroll
      for (int d = 0; d < DK; d += 8) { float f[8]; ld8bf(qp + d, f);
#pragma unroll
          for (int i = 0; i < 8; ++i) q[d + i] = f[i] * scale; } }
    float o[64];
#pragma unroll
    for (int d = 0; d < 64; ++d) o[d] = 0.f;
    float m = -3.0e38f, l = 0.f; const float cq = (MODE == 0) ? cum[(size_t)row * 4 + h] : 0.f;
    const int ntile = (MODE == 2) ? 4 : qt + 1; const size_t kbase = (MODE == 2) ? (size_t)b * MEML : (size_t)b * SEQ;
    for (int kt = 0; kt < ntile; ++kt) {
        const size_t krow = kbase + kt * 64 + tid;
        { const bf16* kp = K + krow * ldk + h * hk;
#pragma unroll
          for (int d = 0; d < DK1; d += 8) { float f[8]; ld8bf(kp + d, f);
#pragma unroll
              for (int i = 0; i < 8; ++i) Ks[tid][d + i] = f[i]; }
          if (DK > DK1) { const bf16* kp2 = K2 + krow * ldk2;
#pragma unroll
              for (int d = 0; d < DK - DK1; d += 8) { float f[8]; ld8bf(kp2 + d, f);
#pragma unroll
                  for (int i = 0; i < 8; ++i) Ks[tid][DK1 + d + i] = f[i]; } }
          const bf16* vp = V + krow * ldv + h * hv + z * 64;
#pragma unroll
          for (int d = 0; d < 64; d += 8) { float f[8]; ld8bf(vp + d, f);
#pragma unroll
              for (int i = 0; i < 8; ++i) Vs[tid][d + i] = f[i]; }
          if (MODE == 0) Cs[tid] = cum[krow * 4 + h]; }
        __syncthreads();
        const int jmax = (MODE == 0 && kt == ntile - 1) ? tid : 63;
        for (int j = 0; j <= jmax; ++j) {
            float s = 0.f;
#pragma unroll
            for (int d = 0; d < DK; d += 4) { const float4 kv = *(const float4*)&Ks[j][d]; s += q[d] * kv.x + q[d + 1] * kv.y + q[d + 2] * kv.z + q[d + 3] * kv.w; }
            if (MODE == 0) s += cq - Cs[j];
            if (s > m) { const float sc = expf(m - s); l *= sc;
#pragma unroll
                for (int d = 0; d < 64; ++d) o[d] *= sc;
                m = s; }
            const float p = expf(s - m); l += p;
#pragma unroll
            for (int d = 0; d < 64; d += 4) { const float4 vv = *(const float4*)&Vs[j][d]; o[d] += p * vv.x; o[d + 1] += p * vv.y; o[d + 2] += p * vv.z; o[d + 3] += p * vv.w; }
        }
        __syncthreads();
    }
    const float il = 1.f / l; bf16* op = O + (size_t)row * ldo + h * ho + z * 64;
#pragma unroll
    for (int d = 0; d < 64; d += 8) { float f[8];
#pragma unroll
        for (int i = 0; i < 8; ++i) f[i] = o[d + i] * il;
        st8bf(op + d, f); }
}
__global__ void __launch_bounds__(256) nv_sgu(const bf16* PROJ, const float* wS, const float* bS, bf16* OMIX) {
    __shared__ float Vs[128][68];
    const int tid = threadIdx.x, win = blockIdx.x, g = blockIdx.y; const size_t row0 = (size_t)win * 128;
    for (int i = tid; i < 128 * 8; i += 256) { const int s = i >> 3, d = (i & 7) * 8; float f[8]; ld8bf(PROJ + (row0 + s) * PW + C_VB + g * 64 + d, f);
#pragma unroll
        for (int k = 0; k < 8; ++k) Vs[s][d + k] = f[k]; }
    __syncthreads();
    const int t = tid >> 1, dh = (tid & 1) * 32; float acc[32];
#pragma unroll
    for (int d = 0; d < 32; ++d) acc[d] = 0.f;
    const int smax = ((t >> 6) + 1) * 64; const float* wr = wS + (size_t)g * 16384 + t * 128;
    for (int s = 0; s < smax; ++s) { const float w = wr[s];
#pragma unroll
        for (int d = 0; d < 32; d += 4) { const float4 v = *(const float4*)&Vs[s][dh + d]; acc[d] += w * v.x; acc[d + 1] += w * v.y; acc[d + 2] += w * v.z; acc[d + 3] += w * v.w; } }
    const float bb = bS[g * 128 + t];
#pragma unroll
    for (int d = 0; d < 32; d += 8) { float u[8]; ld8bf(PROJ + (row0 + t) * PW + C_UB + g * 64 + dh + d, u);
#pragma unroll
        for (int k = 0; k < 8; ++k) u[k] *= (acc[d + k] + bb);
        st8bf(OMIX + (row0 + t) * 1024 + 256 + g * 64 + dh + d, u); }
}


#ifndef REP_ATTN
#define REP_ATTN 1
#endif
#ifndef REP_FOX
#define REP_FOX 1
#endif
#ifndef PROBE_MODE
#define PROBE_MODE 0
#endif
#ifndef REP_MLA
#define REP_MLA 1
#endif
#ifndef REP_SGU
#define REP_SGU 1
#endif
#ifndef REP_ATTM
#define REP_ATTM 1
#endif
#ifndef REP_G1
#define REP_G1 1
#endif
#ifndef REP_F1
#define REP_F1 1
#endif
#ifndef PRB
#define PRB 0
#endif
#ifndef BUILD_STEP
#define BUILD_STEP 2
#endif
namespace pg8 {
typedef unsigned short bf16_t;
typedef short bf16x8 __attribute__((ext_vector_type(8)));
typedef float f32x4 __attribute__((ext_vector_type(4)));
typedef float f32x2 __attribute__((ext_vector_type(2)));
typedef unsigned u32x4 __attribute__((ext_vector_type(4)));
constexpr int BM = 256, BK = 64, HALF = 128, HTB = HALF * BK * 2, STAGE_BYTES = 8 * HTB, NXCD = 8, WGM = 8;
__host__ __device__ __forceinline__ int lds_byte(int r, int c) { const int st = (r >> 4) * 2 + (c >> 5), rr = r & 15, cc = c & 31, ob = rr * 64 + cc * 2; return st * 1024 + (ob ^ (((ob >> 9) & 1) << 5)); }
__host__ __device__ __forceinline__ void stage_rc(int b, int& R, int& C) { const int st = b / 1024, sb = b % 1024, swz = sb ^ (((sb >> 9) & 1) << 5); R = (st >> 1) * 16 + swz / 64; C = (st & 1) * 32 + (swz % 64) / 2; }
__host__ __device__ __forceinline__ int perm32(int rho) { const int n = rho >> 4, i = rho & 15; return 8 * (i >> 2) + 4 * n + (i & 3); }
struct Unit { int pm, pn; const char* a; const char* b; };
__device__ __forceinline__ unsigned cvt_pk_bf16(float lo, float hi) { unsigned r; asm volatile("v_cvt_pk_bf16_f32 %0, %1, %2" : "=v"(r) : "v"(lo), "v"(hi)); return r; }

struct DenseOrder {
    int nM, nN, nwg, G, c, pm0; const char* A; const char* B; size_t tA, tB;
    __device__ __forceinline__ void init(int nM_, int nN_, int G_, int c_, const void* A_, int lda, const void* B_, int K) { nM = nM_; nN = nN_; nwg = nM * nN; G = G_; c = c_; pm0 = 0; A = (const char*)A_; B = (const char*)B_; tA = (size_t)BM * lda * 2; tB = (size_t)BM * K * 2; }
    __device__ __forceinline__ bool map(int i, int& pm, int& pn) const {
        const long L = (long)i * G + c; if (L >= nwg) return false;
        int wgid = (int)L; { const int q = nwg / NXCD, r = nwg % NXCD, xcd = wgid % NXCD, off = wgid / NXCD; wgid = (xcd < r ? xcd * (q + 1) : r * (q + 1) + (xcd - r) * q) + off; }
        const int nig = WGM * nN, gid = wgid / nig, fm = gid * WGM, gsz = (nM - fm) < WGM ? (nM - fm) : WGM;
        pm = fm + ((wgid % nig) % gsz); pn = (wgid % nig) / gsz; return true; }
    __device__ __forceinline__ bool next(int i, Unit& u) const { int pm, pn; if (!map(i, pm, pn)) return false; u.pm = pm; u.pn = pn; u.a = A + (size_t)pm * tA; u.b = B + (size_t)pn * tB; return true; }
};
struct GroupOrder : DenseOrder {
    const int* tab; size_t estride;
    __device__ __forceinline__ bool next(int i, Unit& u) const { int pm, pn; if (!map(i, pm, pn)) return false; pm += pm0; u.pm = pm; u.pn = pn; const int e = tab[pm] & 7; u.a = A + (size_t)pm * tA; u.b = B + (size_t)e * estride + (size_t)pn * tB; return true; }
};
struct KvmOrder {
    int c; const char* A; const char* B; size_t bstride;
    __device__ __forceinline__ bool next(int i, Unit& u) const { if (i > 0 || c >= 128) return false; const int l2 = c >> 6, r = c & 63; u.pm = l2 * 16 + (r & 15); u.pn = r >> 4; u.a = A + (size_t)u.pm * (256 * 1024 * 2); u.b = B + (size_t)l2 * bstride + (size_t)u.pn * (256 * 1024 * 2); return true; }
};

struct EpiStore { static constexpr bool PERM = true; bf16_t* O; int ldc;
    __device__ __forceinline__ void operator()(const f32x4 (&acc)[2][2][4][2], const Unit& u, int wr, int wc, int fr, int fq) const {
        const int row0 = u.pm * BM + wr * 64 + fr, col0 = u.pn * BM + wc * 32 + 8 * fq;
#pragma unroll
        for (int ai = 0; ai < 2; ++ai)
#pragma unroll
            for (int m = 0; m < 4; ++m) { bf16_t* rowp = O + (size_t)(row0 + ai * HALF + m * 16) * ldc + col0;
#pragma unroll
                for (int bj = 0; bj < 2; ++bj) { const f32x4 v0 = acc[ai][bj][m][0], v1 = acc[ai][bj][m][1]; u32x4 w; w.x = cvt_pk_bf16(v0[0], v0[1]); w.y = cvt_pk_bf16(v0[2], v0[3]); w.z = cvt_pk_bf16(v1[0], v1[1]); w.w = cvt_pk_bf16(v1[2], v1[3]);
                    *(u32x4*)(rowp + bj * HALF) = w; } } } };
__device__ __forceinline__ void row_rs(const float* part, int row0, int fr, int fq, float (&rs)[2][4]) {
    const int lane = fr + 16 * fq;
#pragma unroll
    for (int ai = 0; ai < 2; ++ai)
#pragma unroll
        for (int m = 0; m < 4; ++m) { const f32x4 p = *(const f32x4*)(part + (size_t)(row0 + ai * HALF + m * 16) * 16 + 4 * fq); float s = (p[0] + p[1]) + (p[2] + p[3]);
            s += shx(s, lane, 16); s += shx(s, lane, 32); rs[ai][m] = rsqrtf(s * (1.f / 1024.f) + EPSF); }
}
struct EpiStoreN { static constexpr bool PERM = true; bf16_t* O; int ldc; const float* part;
    __device__ __forceinline__ void operator()(const f32x4 (&acc)[2][2][4][2], const Unit& u, int wr, int wc, int fr, int fq) const {
        const int row0 = u.pm * BM + wr * 64 + fr, col0 = u.pn * BM + wc * 32 + 8 * fq; float rs[2][4]; row_rs(part, row0, fr, fq, rs);
#pragma unroll
        for (int ai = 0; ai < 2; ++ai)
#pragma unroll
            for (int m = 0; m < 4; ++m) { bf16_t* rowp = O + (size_t)(row0 + ai * HALF + m * 16) * ldc + col0; const float r = rs[ai][m];
#pragma unroll
                for (int bj = 0; bj < 2; ++bj) { const f32x4 v0 = acc[ai][bj][m][0] * r, v1 = acc[ai][bj][m][1] * r; u32x4 w; w.x = cvt_pk_bf16(v0[0], v0[1]); w.y = cvt_pk_bf16(v0[2], v0[3]); w.z = cvt_pk_bf16(v1[0], v1[1]); w.w = cvt_pk_bf16(v1[2], v1[3]);
                    *(u32x4*)(rowp + bj * HALF) = w; } } } };
struct EpiRes { static constexpr bool PERM = true; const float* res; float* out; bf16_t* xb; float* part;
    __device__ __forceinline__ void operator()(const f32x4 (&acc)[2][2][4][2], const Unit& u, int wr, int wc, int fr, int fq) const {
        const int row0 = u.pm * BM + wr * 64 + fr, col0 = u.pn * BM + wc * 32 + 8 * fq, lane = fr + 16 * fq;
#pragma unroll
        for (int ai = 0; ai < 2; ++ai)
#pragma unroll
            for (int m = 0; m < 4; ++m) { const int row = row0 + ai * HALF + m * 16; const size_t off = (size_t)row * 1024 + col0; float ss = 0.f;
#pragma unroll
                for (int bj = 0; bj < 2; ++bj) { const f32x4 r0 = *(const f32x4*)(res + off + bj * HALF), r1 = *(const f32x4*)(res + off + bj * HALF + 4);
                    const f32x4 v0 = r0 + acc[ai][bj][m][0], v1 = r1 + acc[ai][bj][m][1];
                    *(f32x4*)(out + off + bj * HALF) = v0; *(f32x4*)(out + off + bj * HALF + 4) = v1;
                    if (xb) { u32x4 w; w.x = cvt_pk_bf16(v0[0], v0[1]); w.y = cvt_pk_bf16(v0[2], v0[3]); w.z = cvt_pk_bf16(v1[0], v1[1]); w.w = cvt_pk_bf16(v1[2], v1[3]); *(u32x4*)(xb + off + bj * HALF) = w;
                        ss += (v0[0] * v0[0] + v0[1] * v0[1]) + (v0[2] * v0[2] + v0[3] * v0[3]) + (v1[0] * v1[0] + v1[1] * v1[1]) + (v1[2] * v1[2] + v1[3] * v1[3]); } }
                if (xb) { ss += shx(ss, lane, 16); ss += shx(ss, lane, 32); if (fq == 0) part[(size_t)row * 16 + 4 * u.pn + wc] = ss; }
                asm volatile("" ::: "memory"); } } };
__device__ __forceinline__ float silu_mul(float g, float u) { return g * __builtin_amdgcn_rcpf(1.0f + __builtin_amdgcn_exp2f(-1.4426950408889634f * g)) * u; }
struct EpiSwiglu { static constexpr bool PERM = true; bf16_t* O; int ldc; const float* part; const float* rsrow;
    __device__ __forceinline__ void operator()(const f32x4 (&acc)[2][2][4][2], const Unit& u, int wr, int wc, int fr, int fq) const {
        const int row0 = u.pm * BM + wr * 64 + fr, col0 = u.pn * HALF + wc * 32 + 8 * fq; float rs[2][4];
        if (part) row_rs(part, row0, fr, fq, rs);
        else {
#pragma unroll
            for (int ai = 0; ai < 2; ++ai)
#pragma unroll
                for (int m = 0; m < 4; ++m) rs[ai][m] = rsrow[row0 + ai * HALF + m * 16]; }
#pragma unroll
        for (int ai = 0; ai < 2; ++ai)
#pragma unroll
            for (int m = 0; m < 4; ++m) { const float r = rs[ai][m]; const f32x4 g0 = acc[ai][0][m][0] * r, g1 = acc[ai][0][m][1] * r, u0 = acc[ai][1][m][0] * r, u1 = acc[ai][1][m][1] * r; u32x4 w;
                w.x = cvt_pk_bf16(silu_mul(g0[0], u0[0]), silu_mul(g0[1], u0[1])); w.y = cvt_pk_bf16(silu_mul(g0[2], u0[2]), silu_mul(g0[3], u0[3]));
                w.z = cvt_pk_bf16(silu_mul(g1[0], u1[0]), silu_mul(g1[1], u1[1])); w.w = cvt_pk_bf16(silu_mul(g1[2], u1[2]), silu_mul(g1[3], u1[3]));
                *(u32x4*)(O + (size_t)(row0 + ai * HALF + m * 16) * ldc + col0) = w; } } };
struct EpiScatter { static constexpr bool PERM = false; float* X; const int* tok; const float* gate;
    __device__ __forceinline__ void operator()(const f32x4 (&acc)[2][2][4][2], const Unit& u, int wr, int wc, int fr, int fq) const {
        const int row0 = u.pm * BM + wr * 64 + fr, col0 = u.pn * BM + wc * 32 + 4 * fq;
#pragma unroll
        for (int ai = 0; ai < 2; ++ai)
#pragma unroll
            for (int m = 0; m < 4; ++m) { const int row = row0 + ai * HALF + m * 16; const int t = tok[row]; const float g = gate[row];
                if (t >= 0) { float* p = X + (size_t)t * 1024 + col0;
#pragma unroll
                    for (int bj = 0; bj < 2; ++bj)
#pragma unroll
                        for (int n = 0; n < 2; ++n) { const f32x4 r = *(const f32x4*)(p + bj * HALF + n * 16); *(f32x4*)(p + bj * HALF + n * 16) = r + g * acc[ai][bj][m][n]; } }
                asm volatile("" ::: "memory"); } } };

template <class Epi, class Sched, bool ALIGN_EPI, bool SP2>
__device__ __forceinline__ void gemm_phase(LAS unsigned char* lds, const int K, const int lda, const Sched& S, const Epi& E, const int tid_in) {
    const int tid = tid_in, wid = __builtin_amdgcn_readfirstlane(tid >> 6), lane = tid & 63, wr = wid >> 2, wc = wid & 3, fr = lane & 15, fq = lane >> 4;
    int nt = K / BK; asm volatile("" : "+s"(nt));
    unsigned voffA[2], voffB[2];
#pragma unroll
    for (int i = 0; i < 2; ++i) { int R, C; stage_rc(tid * 16 + i * 8192, R, C); const int Rb = Epi::PERM ? ((R & ~31) + perm32(R & 31)) : R;
        voffA[i] = (unsigned)(R * lda + C) * 2u; voffB[i] = (unsigned)(Rb * K + C) * 2u; }
    const size_t kstep = (size_t)(BK * 2);
    const size_t hA = (size_t)HALF * lda * 2, hB = (size_t)HALF * K * 2;
    const unsigned ldsw = (unsigned)wid * 1024u;
    const int aoff = lds_byte(wr * 64 + fr, fq * 8), boff = lds_byte(wc * 32 + fr, fq * 8);
#define PG8_SA(b, h) (((b) * 2 + (h)) * HTB)
#define PG8_SB(b, h) ((4 + (b) * 2 + (h)) * HTB)
#define PG8_STAGE(bufoff, gbase, voff) do { _Pragma("unroll") for (int _i = 0; _i < 2; ++_i) \
        __builtin_amdgcn_global_load_lds((const unsigned*)((const char*)(gbase) + (voff)[_i]), (LAS unsigned*)(lds + (bufoff) + ldsw + _i * 8192), 16, 0, 0); } while (0)
#define PG8_LDA(dst, b, h) do { _Pragma("unroll") for (int m = 0; m < 4; ++m) _Pragma("unroll") for (int k = 0; k < 2; ++k) dst[m][k] = *(const LAS bf16x8*)(lds + PG8_SA(b, h) + aoff + m * 2048 + k * 1024); } while (0)
#define PG8_LDB(dst, b, h) do { _Pragma("unroll") for (int n = 0; n < 2; ++n) _Pragma("unroll") for (int k = 0; k < 2; ++k) dst[n][k] = *(const LAS bf16x8*)(lds + PG8_SB(b, h) + boff + n * 2048 + k * 1024); } while (0)
#define PG8_MMA(ai, bj, At, Bt) do { __builtin_amdgcn_s_setprio(1); _Pragma("unroll") for (int m = 0; m < 4; ++m) _Pragma("unroll") for (int n = 0; n < 2; ++n) _Pragma("unroll") for (int k = 0; k < 2; ++k) \
        acc[ai][bj][m][n] = __builtin_amdgcn_mfma_f32_16x16x32_bf16(Bt[n][k], At[m][k], acc[ai][bj][m][n], 0, 0, 0); __builtin_amdgcn_s_setprio(0); } while (0)
#define PG8_WAIT_V(n) asm volatile("s_waitcnt vmcnt(" #n ")" ::: "memory")
#define PG8_WAIT_L(n) asm volatile("s_waitcnt lgkmcnt(" #n ")" ::: "memory")
#define PG8_BAR __builtin_amdgcn_s_barrier()
#define PG8_SCHED __builtin_amdgcn_sched_barrier(0)
    Unit cur, nxt; int ui = 0;
    if (!S.next(0, cur)) return;
    f32x4 acc[2][2][4][2];
#pragma unroll
    for (int a = 0; a < 2; ++a)
#pragma unroll
        for (int b = 0; b < 2; ++b)
#pragma unroll
            for (int m = 0; m < 4; ++m)
#pragma unroll
                for (int n = 0; n < 2; ++n) acc[a][b][m][n] = (f32x4){0.f, 0.f, 0.f, 0.f};
    bf16x8 At[4][2], B0[2][2], B1[2][2];
    const char* cA = cur.a; const char* cB = cur.b;
    if constexpr (SP2) {
        PG8_STAGE(PG8_SB(0, 0), cB, voffB); PG8_STAGE(PG8_SB(0, 1), cB + hB, voffB); PG8_STAGE(PG8_SA(0, 0), cA, voffA); PG8_STAGE(PG8_SA(0, 1), cA + hA, voffA);
        if (wr == 1) PG8_BAR;
        PG8_WAIT_V(2); PG8_BAR;
        PG8_STAGE(PG8_SB(1, 0), cB + kstep, voffB); PG8_STAGE(PG8_SA(1, 0), cA + kstep, voffA); PG8_STAGE(PG8_SB(1, 1), cB + hB + kstep, voffB);
        PG8_WAIT_V(6); PG8_BAR;
    } else {
        PG8_STAGE(PG8_SB(0, 0), cB, voffB); PG8_STAGE(PG8_SA(0, 0), cA, voffA); PG8_STAGE(PG8_SB(0, 1), cB + hB, voffB); PG8_STAGE(PG8_SA(0, 1), cA + hA, voffA);
        if (wr == 1) PG8_BAR;
        PG8_WAIT_V(4); PG8_BAR;
        PG8_STAGE(PG8_SB(1, 0), cB + kstep, voffB); PG8_STAGE(PG8_SA(1, 0), cA + kstep, voffA); PG8_STAGE(PG8_SB(1, 1), cB + hB + kstep, voffB);
        PG8_WAIT_V(6); PG8_BAR;
    }
    for (;;) {
        const bool has_next = S.next(ui + 1, nxt);
        const char* nA = has_next ? nxt.a : cA; const char* nB = has_next ? nxt.b : cB;
        for (int t = 0; t < nt; t += 2) {
            const bool last = (t == nt - 2);
            const char* a1 = cA + (size_t)(t + 1) * kstep;
            const char* a2 = last ? nA : cA + (size_t)(t + 2) * kstep; const char* b2 = last ? nB : cB + (size_t)(t + 2) * kstep;
            const char* a3 = a2 + kstep; const char* b3 = b2 + kstep;
            if constexpr (SP2) {
            PG8_LDB(B0, 0, 0); PG8_LDB(B1, 0, 1); PG8_SCHED; PG8_LDA(At, 0, 0); PG8_STAGE(PG8_SA(1, 1), a1 + hA, voffA);
            PG8_WAIT_V(8); PG8_WAIT_L(0); PG8_BAR; PG8_MMA(0, 0, At, B0); PG8_MMA(0, 1, At, B1); PG8_BAR; PG8_SCHED;
            PG8_LDA(At, 0, 1); PG8_STAGE(PG8_SB(0, 0), b2, voffB); PG8_STAGE(PG8_SB(0, 1), b2 + hB, voffB); PG8_STAGE(PG8_SA(0, 0), a2, voffA);
            PG8_WAIT_V(8); PG8_WAIT_L(0); PG8_BAR; PG8_MMA(1, 0, At, B0); PG8_MMA(1, 1, At, B1); PG8_BAR; PG8_SCHED;
            PG8_LDB(B0, 1, 0); PG8_LDB(B1, 1, 1); PG8_SCHED; PG8_LDA(At, 1, 0); PG8_STAGE(PG8_SA(0, 1), a2 + hA, voffA);
            PG8_WAIT_V(8); PG8_WAIT_L(0); PG8_BAR; PG8_MMA(0, 0, At, B0); PG8_MMA(0, 1, At, B1); PG8_BAR; PG8_SCHED;
            PG8_LDA(At, 1, 1); PG8_STAGE(PG8_SB(1, 0), b3, voffB); PG8_STAGE(PG8_SB(1, 1), b3 + hB, voffB); PG8_STAGE(PG8_SA(1, 0), a3, voffA);
            PG8_WAIT_V(8); PG8_WAIT_L(0); PG8_BAR; PG8_MMA(1, 0, At, B0); PG8_MMA(1, 1, At, B1); PG8_BAR; PG8_SCHED;
            } else {
            PG8_LDB(B0, 0, 0); PG8_SCHED; PG8_LDA(At, 0, 0); PG8_STAGE(PG8_SA(1, 1), a1 + hA, voffA);
            PG8_WAIT_L(8); PG8_BAR; PG8_WAIT_L(0); PG8_MMA(0, 0, At, B0); PG8_BAR; PG8_SCHED;
            PG8_LDB(B1, 0, 1); PG8_STAGE(PG8_SB(0, 0), b2, voffB);
            PG8_BAR; PG8_WAIT_L(0); PG8_MMA(0, 1, At, B1); PG8_BAR;
            PG8_LDA(At, 0, 1); PG8_STAGE(PG8_SA(0, 0), a2, voffA);
            PG8_BAR; PG8_WAIT_L(0); PG8_MMA(1, 0, At, B0); PG8_BAR; PG8_SCHED;
            PG8_STAGE(PG8_SB(0, 1), b2 + hB, voffB);
            PG8_WAIT_V(6); PG8_BAR; PG8_MMA(1, 1, At, B1); PG8_BAR;
            PG8_LDB(B0, 1, 0); PG8_SCHED; PG8_LDA(At, 1, 0); PG8_STAGE(PG8_SA(0, 1), a2 + hA, voffA);
            PG8_WAIT_L(8); PG8_BAR; PG8_WAIT_L(0); PG8_MMA(0, 0, At, B0); PG8_BAR; PG8_SCHED;
            PG8_LDB(B1, 1, 1); PG8_STAGE(PG8_SB(1, 0), b3, voffB);
            PG8_BAR; PG8_WAIT_L(0); PG8_MMA(0, 1, At, B1); PG8_BAR;
            PG8_LDA(At, 1, 1); PG8_STAGE(PG8_SA(1, 0), a3, voffA);
            PG8_BAR; PG8_WAIT_L(0); PG8_MMA(1, 0, At, B0); PG8_BAR; PG8_SCHED;
            PG8_STAGE(PG8_SB(1, 1), b3 + hB, voffB);
            PG8_WAIT_V(6); PG8_BAR; PG8_MMA(1, 1, At, B1); PG8_BAR;
            }
        }
        if constexpr (ALIGN_EPI) { if (wr == 0) PG8_BAR; }
        { int fr_e = fr, fq_e = fq; asm volatile("" : "+v"(fr_e), "+v"(fq_e));
          E(acc, cur, wr, wc, fr_e, fq_e); }
        if (!has_next) break;
#pragma unroll
        for (int a = 0; a < 2; ++a)
#pragma unroll
            for (int b = 0; b < 2; ++b)
#pragma unroll
                for (int m = 0; m < 4; ++m)
#pragma unroll
                    for (int n = 0; n < 2; ++n) acc[a][b][m][n] = (f32x4){0.f, 0.f, 0.f, 0.f};
        cur = nxt; cA = nA; cB = nB; ++ui;
        if constexpr (ALIGN_EPI) { if (wr == 1) PG8_BAR; }
    }
    PG8_WAIT_V(0);
    if constexpr (!ALIGN_EPI) { if (wr == 0) PG8_BAR; }
    PG8_BAR;
#undef PG8_SA
#undef PG8_SB
#undef PG8_STAGE
#undef PG8_LDA
#undef PG8_LDB
#undef PG8_MMA
#undef PG8_WAIT_V
#undef PG8_WAIT_L
#undef PG8_BAR
#undef PG8_SCHED
}
}

namespace att {
typedef short bf16x8 __attribute__((ext_vector_type(8)));
typedef short s16x4 __attribute__((ext_vector_type(4)));
typedef short v4i16_t __attribute__((ext_vector_type(4)));
typedef float f32x16 __attribute__((ext_vector_type(16)));
typedef float f32x4 __attribute__((ext_vector_type(4)));
typedef unsigned u32x4 __attribute__((ext_vector_type(4)));
typedef float f32x2_t __attribute__((ext_vector_type(2))); typedef __bf16 bf16x2_t __attribute__((ext_vector_type(2)));
__device__ __forceinline__ int crow(int r, int hi) { return (r & 3) + 8 * (r >> 2) + 4 * hi; }
__device__ __forceinline__ void glds16(const void* gsrc, unsigned lds_dst) { unsigned keep;
    asm volatile("s_mov_b32 %0, m0\n\ts_mov_b32 m0, %2\n\ts_nop 0\n\tglobal_load_lds_dwordx4 %1, off\n\ts_mov_b32 m0, %0" : "=&s"(keep) : "v"(gsrc), "s"(lds_dst) : "memory"); }
__device__ __forceinline__ unsigned cvtpk(float lo, float hi) { f32x2_t v = {lo, hi}; bf16x2_t b = __builtin_convertvector(v, bf16x2_t); return __builtin_bit_cast(unsigned, b); }
__device__ __forceinline__ s16x4 vtr(const LAS unsigned char* p) { return __builtin_bit_cast(s16x4, __builtin_amdgcn_ds_read_tr16_b64_v4i16((LAS v4i16_t*)p)); }
__device__ __forceinline__ float half_max(float m) { auto rr = __builtin_amdgcn_permlane32_swap(__float_as_uint(m), __float_as_uint(m), false, false); return fmaxf(__uint_as_float(rr[0]), __uint_as_float(rr[1])); }
__device__ __forceinline__ float half_sum(float m) { auto rr = __builtin_amdgcn_permlane32_swap(__float_as_uint(m), __float_as_uint(m), false, false); return __uint_as_float(rr[0]) + __uint_as_float(rr[1]); }
__device__ __forceinline__ bf16x8 scale8(bf16x8 v, float s) { u32x4 u = __builtin_bit_cast(u32x4, v); u32x4 o;
#pragma unroll
    for (int i = 0; i < 4; ++i) { const float a = __uint_as_float(u[i] << 16) * s, b = __uint_as_float(u[i] & 0xffff0000u) * s; o[i] = cvtpk(a, b); }
    return __builtin_bit_cast(bf16x8, o); }
#define ATT_WAITBAR(N) asm volatile("s_waitcnt vmcnt(%0) lgkmcnt(0)\n\ts_barrier" :: "n"(N) : "memory")

__device__ __forceinline__ float max3f(float a, float b, float c) { return __builtin_fmaxf(__builtin_fmaxf(a, b), c); }
template <int DK, int DV, int MODE, int PROBE = 0>
__device__ __forceinline__ void attn_unit(LAS unsigned char* shm, const bf16* Qw, int ldq, float qscale, const bf16* Kh, int ldk, const bf16* K2, int ldk2, const bf16* Vh, int ldv,
                                          bf16* Ow, int ldo, int q0, int NT, int tid) {
    constexpr int ND = DK / 16 + (MODE == 0 ? 1 : 0), NO = DV / 32, PD = (MODE == 2) ? 2 : 4, NSK = PD + 1, NSV = PD + 2;
    constexpr int KSLOT = (MODE == 0 ? 10 : DK / 8) * 1024, VSLOT = DV * 128;
    constexpr int LDS_K = 0, LDS_V = NSK * KSLOT, LDS_WS = LDS_V + NSV * VSLOT;
    constexpr int NPT = (DK > 64 ? 2 : 1) + (DV > 64 ? 2 : 1);
    const int lane = tid & 63, r32 = lane & 31, hi = lane >> 5, wid = __builtin_amdgcn_readfirstlane(tid >> 6), half = wid >> 2;
    const unsigned lds0 = (unsigned)(uintptr_t)shm;
    LAS float* wsf = (LAS float*)(shm + LDS_WS) + wid * 64;
    bf16x8 qr[ND];
#pragma unroll
    for (int d0 = 0; d0 < DK / 16; ++d0) qr[d0] = scale8(*(const bf16x8*)(Qw + (size_t)r32 * ldq + d0 * 16 + hi * 8), qscale);
    if (MODE == 0) { const short one = (short)0x3f80; qr[ND - 1] = hi ? (bf16x8){0, 0, 0, 0, 0, 0, 0, 0} : (bf16x8){one, one, one, 0, 0, 0, 0, 0}; }
    asm volatile("" ::: "memory");
    const bf16* ksrc = Kh + (size_t)lane * ldk + wid * 8;
    const bf16* k2src = (MODE == 0) ? (K2 + (size_t)lane * 8) : (DK == 96) ? (K2 + (size_t)lane * ldk2 + (wid & 3) * 8) : (Kh + (size_t)lane * ldk + (8 + wid) * 8);
    const size_t k2step = (MODE == 0) ? (size_t)64 * 8 : (DK == 96) ? (size_t)64 * ldk2 : (size_t)64 * ldk;
    const int k2chunk = (MODE == 0) ? 8 : (DK == 96) ? 8 + (wid & 3) : 8 + wid;
    const bool k2do = (MODE == 0) ? (wid == 0) : (DK > 64);
    const bf16* vsrc = Vh + (size_t)(16 * (wid & 3) + (lane >> 2)) * ldv + (wid >> 2) * 32 + (lane & 3) * 8;
#define ATT_DMA(t, ks_, vs_) do { glds16(ksrc + (size_t)(t) * 64 * ldk, (unsigned)__builtin_amdgcn_readfirstlane(lds0 + LDS_K + (ks_) * KSLOT + wid * 1024)); \
        if (k2do) glds16(k2src + (size_t)(t) * k2step, (unsigned)__builtin_amdgcn_readfirstlane(lds0 + LDS_K + (ks_) * KSLOT + k2chunk * 1024)); \
        glds16(vsrc + (size_t)(t) * 64 * ldv, (unsigned)__builtin_amdgcn_readfirstlane(lds0 + LDS_V + (vs_) * VSLOT + wid * 1024)); \
        if (DV > 64) glds16(vsrc + 64 + (size_t)(t) * 64 * ldv, (unsigned)__builtin_amdgcn_readfirstlane(lds0 + LDS_V + (vs_) * VSLOT + (wid + 8) * 1024)); } while (0)
#define ATT_WAITGRP(keep) do { const int k_ = (keep); if (MODE == 0 && wid == 0) { if (k_ <= 0) ATT_WAITBAR(0); else if (k_ == 1) ATT_WAITBAR(NPT + 1); else if (k_ == 2) ATT_WAITBAR(2 * (NPT + 1)); else ATT_WAITBAR(3 * (NPT + 1)); } \
        else { if (k_ <= 0) ATT_WAITBAR(0); else if (k_ == 1) ATT_WAITBAR(NPT); else if (k_ == 2) ATT_WAITBAR(2 * NPT); else ATT_WAITBAR(3 * NPT); } } while (0)
#pragma unroll
    for (int i = 0; i < PD; ++i) if (i < NT) ATT_DMA(i, i, i);
    if (half == 1) ATT_WAITGRP((NT < PD ? NT : PD) - 1);
    float mhat = 0.f, l_reg = 0.f; f32x16 o[NO]; f32x16 negm = f32x16{};
#pragma unroll
    for (int d = 0; d < NO; ++d) o[d] = f32x16{};
    u32x4 pw[4] = {};
    const int qmin = q0 + 32 * wid;
    int ks = 0, ks2 = PD % NSK, vs1 = NSV - 1, vs2 = PD % NSV;
    bool pvis = false;
#define ATT_SCHED() __builtin_amdgcn_sched_barrier(0)
#define ATT_VLOAD(vfr, vslot) do { const LAS unsigned char* vp = shm + LDS_V + (vslot) * VSLOT + ((lane >> 4) & 1) * 32 + (lane & 3) * 8 + (4 * hi + ((lane & 15) >> 2)) * 64; \
        _Pragma("unroll") for (int k4 = 0; k4 < 4; ++k4) _Pragma("unroll") for (int d0 = 0; d0 < NO; ++d0) { const s16x4 lo = vtr(vp + d0 * 4096 + k4 * 1024), hh = vtr(vp + d0 * 4096 + k4 * 1024 + 512); \
            vfr[k4][d0] = (bf16x8){lo[0], lo[1], lo[2], lo[3], hh[0], hh[1], hh[2], hh[3]}; } } while (0)
#define ATT_PVMMA(vfr) do { _Pragma("unroll") for (int k4 = 0; k4 < 4; ++k4) _Pragma("unroll") for (int d0 = 0; d0 < NO; ++d0) \
            o[d0] = __builtin_amdgcn_mfma_f32_32x32x16_bf16(__builtin_bit_cast(bf16x8, pw[k4]), vfr[k4][d0], o[d0], 0, 0, 0); } while (0)
    for (int t = 0; t < NT; ++t) {
        { const int rem = NT - t; ATT_WAITGRP((rem < PD ? rem : PD) - 1); }
        if (t + PD < NT) ATT_DMA(t + PD, ks2, vs2);
        const bool vis0 = (MODE == 2) ? true : (MODE == 1 ? (t <= (qmin >> 6)) : (64 * t <= qmin + 31));
        const bool vis = (PROBE == 1) ? false : vis0;
        f32x16 p0 = f32x16{}, p1 = f32x16{};
        {
            bf16x8 vfr[4][NO]; bf16x8 kf[ND][2];
            ATT_SCHED();
            if (pvis) ATT_VLOAD(vfr, vs1);
            if (DV > 64) { ATT_SCHED(); if (pvis) ATT_PVMMA(vfr); ATT_SCHED(); }
            if (vis) {
                const LAS unsigned char* kb = shm + LDS_K + ks * KSLOT + hi * 1024 + r32 * 16;
#pragma unroll
                for (int d0 = 0; d0 < ND; ++d0) { const LAS unsigned char* kp = (MODE == 0 && d0 == ND - 1) ? (shm + LDS_K + ks * KSLOT + 8 * 1024 + r32 * 16) : (kb + d0 * 2048);
                    kf[d0][0] = *(const LAS bf16x8*)(kp); kf[d0][1] = *(const LAS bf16x8*)(kp + 512); }
            }
            ATT_SCHED();
            if (DV <= 64) { if (pvis) ATT_PVMMA(vfr); }
            if (vis) {
#pragma unroll
                for (int d0 = 0; d0 < ND; ++d0) {
                    if (d0 == 0) { p0 = __builtin_amdgcn_mfma_f32_32x32x16_bf16(kf[0][0], qr[0], negm, 0, 0, 0); p1 = __builtin_amdgcn_mfma_f32_32x32x16_bf16(kf[0][1], qr[0], negm, 0, 0, 0); }
                    else { p0 = __builtin_amdgcn_mfma_f32_32x32x16_bf16(kf[d0][0], qr[d0], p0, 0, 0, 0); p1 = __builtin_amdgcn_mfma_f32_32x32x16_bf16(kf[d0][1], qr[d0], p1, 0, 0, 0); } }
            }
            ATT_SCHED();
        }
        { const int rem = NT - t - 1; ATT_WAITGRP((rem < PD ? rem : PD) - 1); }
        if (vis && PROBE != 2) {
            if (MODE == 0) { if (64 * t + 63 > qmin) { const int q = qmin + r32;
#pragma unroll
                    for (int r = 0; r < 16; ++r) { const int kv = 64 * t + crow(r, hi); if (kv > q) p0[r] = -INFINITY; if (kv + 32 > q) p1[r] = -INFINITY; } } }
            float ma = max3f(p0[0], p0[1], p1[0]), mb = max3f(p0[2], p0[3], p1[1]); ma = max3f(ma, p1[2], p1[3]);
#pragma unroll
            for (int r = 4; r < 16; r += 4) { ma = max3f(ma, p0[r], p0[r + 1]); mb = max3f(mb, p0[r + 2], p0[r + 3]); ma = max3f(ma, p1[r], p1[r + 1]); mb = max3f(mb, p1[r + 2], p1[r + 3]); }
            const float rm = half_max(fmaxf(ma, mb));
            if (t == 0 || __any(rm > 8.0f)) { const float dl = (t == 0) ? rm : fmaxf(rm, 0.f); mhat += dl;
#pragma unroll
                for (int r = 0; r < 16; ++r) { p0[r] -= dl; p1[r] -= dl; negm[r] = -mhat; }
                if (t > 0) { const float f = __builtin_amdgcn_exp2f(-dl); l_reg *= f;
                    if (hi == 0) wsf[r32] = f;
                    asm volatile("s_waitcnt lgkmcnt(0)" ::: "memory");
#pragma unroll
                    for (int r = 0; r < 16; ++r) { const float fr_ = wsf[crow(r, hi)];
#pragma unroll
                        for (int d = 0; d < NO; ++d) o[d][r] *= fr_; }
                    asm volatile("s_waitcnt lgkmcnt(0)" ::: "memory"); } }
            float sa = 0.f, sb = 0.f;
#pragma unroll
            for (int r = 0; r < 16; ++r) { p0[r] = __builtin_amdgcn_exp2f(p0[r]); p1[r] = __builtin_amdgcn_exp2f(p1[r]); sa += p0[r]; sb += p1[r]; }
            l_reg += sa + sb;
#pragma unroll
            for (int i = 0; i < 4; ++i) { pw[0][i] = cvtpk(p0[2 * i], p0[2 * i + 1]); pw[1][i] = cvtpk(p0[8 + 2 * i], p0[9 + 2 * i]); pw[2][i] = cvtpk(p1[2 * i], p1[2 * i + 1]); pw[3][i] = cvtpk(p1[8 + 2 * i], p1[9 + 2 * i]); }
        }
        pvis = vis;
        ks = (ks == NSK - 1) ? 0 : ks + 1; ks2 = (ks2 == NSK - 1) ? 0 : ks2 + 1; vs1 = (vs1 == NSV - 1) ? 0 : vs1 + 1; vs2 = (vs2 == NSV - 1) ? 0 : vs2 + 1;
    }
    if (pvis) { bf16x8 vfr[4][NO]; ATT_SCHED(); ATT_VLOAD(vfr, vs1); ATT_SCHED(); ATT_PVMMA(vfr); ATT_SCHED(); }
#undef ATT_VLOAD
#undef ATT_PVMMA
#undef ATT_SCHED
#undef ATT_DMA
#undef ATT_WAITGRP
    l_reg = half_sum(l_reg);
    if (half == 0) asm volatile("s_waitcnt lgkmcnt(0)\n\ts_barrier" ::: "memory");
    ATT_WAITBAR(0);
    if (hi == 0) wsf[32 + r32] = l_reg;
    asm volatile("s_waitcnt lgkmcnt(0)" ::: "memory");
    float rli[16];
#pragma unroll
    for (int r = 0; r < 16; ++r) rli[r] = __builtin_amdgcn_rcpf(wsf[32 + crow(r, hi)]);
    LAS bf16* stg = (LAS bf16*)shm + wid * (32 * DV);
#pragma unroll
    for (int r = 0; r < 16; ++r) { const int orow = crow(r, hi);
#pragma unroll
        for (int d0 = 0; d0 < NO; ++d0) stg[orow * DV + d0 * 32 + r32] = f2bf(o[d0][r] * rli[r]); }
    asm volatile("s_waitcnt lgkmcnt(0)" ::: "memory");
    constexpr int CPR = DV / 8;
#pragma unroll
    for (int i = 0; i < (32 * CPR) / 64; ++i) { const int idx = i * 64 + lane, row = idx / CPR, ch = idx % CPR; const u32x4 v = *(const LAS u32x4*)(stg + row * DV + ch * 8); *(u32x4*)(Ow + (size_t)row * ldo + ch * 8) = v; }
    ATT_WAITBAR(0);
}

__device__ __forceinline__ void sgu_unit(LAS unsigned char* shm, const bf16* PROJ, const bf16* Wb  , const float* bS, bf16* OMIX, int win, int g, int tid) {
    const int lane = tid & 63, r32 = lane & 31, hi = lane >> 5, wid = __builtin_amdgcn_readfirstlane(tid >> 6);
    const unsigned lds0 = (unsigned)(uintptr_t)shm; const size_t row0 = (size_t)win * 128;
    const bf16* Vh = PROJ + row0 * PW + C_VB + g * 64;
    const bf16* vsrc = Vh + (size_t)(16 * (wid & 3) + (lane >> 2)) * PW + (wid >> 2) * 32 + (lane & 3) * 8;
    glds16(vsrc, (unsigned)__builtin_amdgcn_readfirstlane(lds0 + wid * 1024)); glds16(vsrc + (size_t)64 * PW, (unsigned)__builtin_amdgcn_readfirstlane(lds0 + 8192 + wid * 1024));
    const int tb = wid >> 1, db = wid & 1, t = 32 * tb + r32;
    const bf16* wrow = Wb + (size_t)g * 16384 + (size_t)t * 128;
    const int ntile = (tb < 2) ? 1 : 2;
    uint2 wa[2][4][2];
#pragma unroll
    for (int tl = 0; tl < 2; ++tl)
#pragma unroll
        for (int ks = 0; ks < 4; ++ks) { if (tl < ntile) { wa[tl][ks][0] = *(const uint2*)(wrow + 64 * tl + 16 * ks + 4 * hi); wa[tl][ks][1] = *(const uint2*)(wrow + 64 * tl + 16 * ks + 8 + 4 * hi); } else { wa[tl][ks][0] = make_uint2(0u, 0u); wa[tl][ks][1] = make_uint2(0u, 0u); } }
    ATT_WAITBAR(0);
    f32x16 o = f32x16{};
    const LAS unsigned char* vp = shm + ((lane >> 4) & 1) * 32 + (lane & 3) * 8 + (4 * hi + ((lane & 15) >> 2)) * 64 + db * 4096;
#pragma unroll
    for (int tl = 0; tl < 2; ++tl) { if (tl < ntile) {
#pragma unroll
        for (int ks = 0; ks < 4; ++ks) { const s16x4 lo = vtr(vp + tl * 8192 + ks * 1024), hh = vtr(vp + tl * 8192 + ks * 1024 + 512);
            const bf16x8 vf = (bf16x8){lo[0], lo[1], lo[2], lo[3], hh[0], hh[1], hh[2], hh[3]};
            const u32x4 au = {wa[tl][ks][0].x, wa[tl][ks][0].y, wa[tl][ks][1].x, wa[tl][ks][1].y};
            o = __builtin_amdgcn_mfma_f32_32x32x16_bf16(__builtin_bit_cast(bf16x8, au), vf, o, 0, 0, 0); } } }
    const int d = 32 * db + r32;
#pragma unroll
    for (int r = 0; r < 16; ++r) { const int tt = 32 * tb + crow(r, hi); const size_t row = row0 + tt;
        const float u = bf2f(PROJ[row * PW + C_UB + g * 64 + d]); OMIX[row * 1024 + 256 + g * 64 + d] = f2bf(u * (o[r] + bS[g * 128 + tt])); }
    ATT_WAITBAR(0);
}
#undef ATT_WAITBAR
}

#define XB_TMO      128
#define XB_XCNT(j)  (256  + 64 * (j))
#define XB_XSUB(j)  (1280 + 64 * (j))
#define XB_XGEN(j)  (2304 + 64 * (j))
#define XB_TOP      3328
#define XB_TOPGEN   3392
#define XCD_BAR_WORDS 3456
#define XB_SPIN_CAP (1u << 18)
__device__ __forceinline__ unsigned xb_ld(unsigned* p)              { return __hip_atomic_load(p, __ATOMIC_RELAXED, __HIP_MEMORY_SCOPE_AGENT); }
__device__ __forceinline__ unsigned xb_add(unsigned* p, unsigned v) { return __hip_atomic_fetch_add(p, v, __ATOMIC_RELAXED, __HIP_MEMORY_SCOPE_AGENT); }
__device__ __forceinline__ unsigned xb_xcc_id() { return (unsigned)__builtin_amdgcn_s_getreg((3 << 11) | 20) & 0xFu; }
#define XB_SPIN(cond, bar) do { unsigned _sp = 0; while (cond) { __builtin_amdgcn_s_sleep(1); \
    if ((++_sp & 255u) == 0u) { if (xb_ld(&(bar)[XB_TMO])) break; if (_sp > XB_SPIN_CAP) { atomicAdd(&(bar)[XB_TMO], 1u); break; } } } } while (0)
struct XcdBarrier { unsigned* bar; unsigned x; volatile LAS unsigned* st; };
__device__ __forceinline__ XcdBarrier xcd_barrier_post(unsigned* bar, volatile LAS unsigned* st) {
    XcdBarrier b; b.bar = bar; b.x = xb_xcc_id(); b.st = st;
    if (threadIdx.x == 0) (void)xb_add(&bar[XB_XCNT(b.x)], 1u);
    return b;
}
__device__ __forceinline__ void xcd_barrier_complete(unsigned* bar, unsigned x, unsigned& nloc, unsigned& nx) {
    const unsigned G = gridDim.x * gridDim.y * gridDim.z;
    unsigned sum, cnt, mine, sp = 0u;
    for (;;) {
        sum = 0u; cnt = 0u; mine = 0u;
#pragma unroll
        for (unsigned j = 0; j < 16; ++j) { const unsigned c = xb_ld(&bar[XB_XCNT(j)]); sum += c; cnt += (c > 0u) ? 1u : 0u; mine = (j == x) ? c : mine; }
        if (sum == G) break;
        __builtin_amdgcn_s_sleep(1);
        if ((++sp & 255u) == 0u) { if (xb_ld(&bar[XB_TMO])) break; if (sp > XB_SPIN_CAP) { atomicAdd(&bar[XB_TMO], 1u); break; } }
    }
    nloc = mine > 0u ? mine : 1u; nx = cnt > 0u ? cnt : 1u;
}
__device__ __forceinline__ void xcd_barrier(const XcdBarrier& b, int tid_) {
    asm volatile("s_waitcnt vmcnt(0)" ::: "memory");
    __syncthreads();
    if (tid_ == 0) {
        unsigned* bar = b.bar;
        __builtin_amdgcn_s_waitcnt(0);
        unsigned nloc = b.st[0], nx = b.st[1];
        unsigned bx_ = b.x; asm volatile("" : "+s"(bx_));
        if (nloc == 0u) { xcd_barrier_complete(bar, bx_, nloc, nx); b.st[0] = nloc; b.st[1] = nx; }
        const unsigned old = xb_add(&bar[XB_XSUB(bx_)], 1u);
        const unsigned gen = old / nloc;
        if (old + 1u == (gen + 1u) * nloc) {
            __builtin_amdgcn_fence(__ATOMIC_RELEASE, "agent");
            asm volatile("s_waitcnt vmcnt(0)" ::: "memory");
            const unsigned og = xb_add(&bar[XB_TOP], 1u);
            const unsigned tg = og / nx;
            if (og + 1u == (tg + 1u) * nx) xb_add(&bar[XB_TOPGEN], 1u);
            else XB_SPIN(xb_ld(&bar[XB_TOPGEN]) == tg, bar);
            __builtin_amdgcn_fence(__ATOMIC_ACQUIRE, "agent");
            xb_add(&bar[XB_XGEN(bx_)], 1u);
            asm volatile("s_waitcnt vmcnt(0)" ::: "memory");
        } else {
            XB_SPIN(xb_ld(&bar[XB_XGEN(bx_)]) == gen, bar);
            __builtin_amdgcn_fence(__ATOMIC_ACQUIRE, "agent");
            asm volatile("s_waitcnt vmcnt(0)" ::: "memory");
        }
    }
    __syncthreads();
}

constexpr int NWAVES = 8;
constexpr int RING_BYTES = 131072, LDSCTL_OFF = RING_BYTES, MISC_OFF = LDSCTL_OFF + 320, LDS_BYTES = 147456;
constexpr int CW_BAR = 4096;
constexpr size_t L_WIN = 0, L_WUQ = 3670016, L_WUKV = 4063232, L_WOUT = 4587520, L_WMQ = 6684672, L_WMKV = 7733248, L_WMO = 9830400, LW_STRIDE = 11 * MiB;
constexpr size_t W_FGU = 22 * MiB, W_FD = 33 * MiB, W_MGU = 39 * MiB, W_MD = 83 * MiB, MGU_STRIDE = (size_t)DFE * 2 * 1024 * 2, MD_STRIDE = (size_t)1024 * DFE * 2;
constexpr size_t W_SGU = 106 * MiB;
constexpr size_t WS_HMP = WS_QC;

struct Job { const float* src; const float* src2; const float* ksc; int ldw, Ksrc, Kpad, Nphys, map, nlog; bf16* dst; };
__device__ __forceinline__ Job get_job(const Args& a, int j) {
    Job J; J.src2 = nullptr; J.ksc = nullptr; J.map = 0; unsigned char* wb = a.ws + WS_WB;
    if (j < 14) { const int l = j / 7, t = j % 7; unsigned char* lb = wb + (size_t)l * LW_STRIDE;
        switch (t) {
        case 0: J.src = a.in[4] + (size_t)l * 1024 * IN_W; J.ldw = IN_W; J.Ksrc = 1024; J.Kpad = 1024; J.Nphys = 1792; J.map = 1; J.nlog = IN_W; J.dst = (bf16*)(lb + L_WIN); J.ksc = a.in[3] + l * 1024; break;
        case 1: J.src = a.in[12] + (size_t)l * 256 * 768; J.ldw = 768; J.Ksrc = 256; J.Kpad = 256; J.Nphys = 768; J.nlog = 768; J.dst = (bf16*)(lb + L_WUQ); break;
        case 2: J.src = a.in[14] + (size_t)l * 128 * 1024; J.ldw = 1024; J.Ksrc = 128; J.Kpad = 256; J.Nphys = 1024; J.nlog = 1024; J.dst = (bf16*)(lb + L_WUKV); break;
        case 3: J.src = a.in[22] + (size_t)l * 1024 * 1024; J.ldw = 1024; J.Ksrc = 1024; J.Kpad = 1024; J.Nphys = 1024; J.nlog = 1024; J.dst = (bf16*)(lb + L_WOUT); break;
        case 4: J.src = a.in[25] + (size_t)l * 1024 * 512; J.ldw = 512; J.Ksrc = 1024; J.Kpad = 1024; J.Nphys = 512; J.nlog = 512; J.dst = (bf16*)(lb + L_WMQ); J.ksc = a.in[23] + l * 1024; break;
        case 5: J.src = a.in[26] + (size_t)l * 1024 * 1024; J.ldw = 1024; J.Ksrc = 1024; J.Kpad = 1024; J.Nphys = 1024; J.nlog = 1024; J.dst = (bf16*)(lb + L_WMKV); break;
        default: J.src = a.in[29] + (size_t)l * 512 * 1024; J.ldw = 1024; J.Ksrc = 512; J.Kpad = 512; J.Nphys = 1024; J.nlog = 1024; J.dst = (bf16*)(lb + L_WMO); break;
        }
    } else if (j == 14) { J.src = a.in[31]; J.src2 = a.in[32]; J.ldw = DFF; J.Ksrc = 1024; J.Kpad = 1024; J.Nphys = 2 * DFFP; J.map = 2; J.nlog = DFF; J.dst = (bf16*)(wb + W_FGU); J.ksc = a.in[30]; }
    else if (j == 15) { J.src = a.in[33]; J.ldw = 1024; J.Ksrc = DFF; J.Kpad = DFFP; J.Nphys = 1024; J.nlog = 1024; J.dst = (bf16*)(wb + W_FD); }
    else if (j < 24) { const int e = j - 16; J.src = a.in[36] + (size_t)e * 1024 * DFE; J.src2 = a.in[37] + (size_t)e * 1024 * DFE; J.ldw = DFE; J.Ksrc = 1024; J.Kpad = 1024; J.Nphys = 2 * DFE; J.map = 2; J.nlog = DFE; J.dst = (bf16*)(wb + W_MGU + (size_t)e * MGU_STRIDE); J.ksc = a.in[30] + 1024; }
    else { const int e = j - 24; J.src = a.in[38] + (size_t)e * DFE * 1024; J.ldw = 1024; J.Ksrc = DFE; J.Kpad = DFE; J.Nphys = 1024; J.nlog = 1024; J.dst = (bf16*)(wb + W_MD + (size_t)e * MD_STRIDE); }
    return J;
}
__device__ __forceinline__ int job_items(const Job& J) { return (J.Kpad / 32) * (J.Nphys / 64); }
__device__ __forceinline__ void transpose_item(const Job& J, int item, LAS float* scr, int lane) {
    const int nblk = J.Nphys / 64, kb = item / nblk, nb = item % nblk, k0 = 32 * kb, n0 = 64 * nb;
    const int p = n0 + 4 * (lane & 15); int col = -1; const float* src = J.src;
    if (J.map == 0) col = p < J.nlog ? p : -1;
    else if (J.map == 1) col = p < 768 ? p : (p < 1696 ? p + 4 : (p < 1700 ? 768 + (p - 1696) : -1));
    else { const int jt = p >> 8, w = p & 255; col = 128 * jt + (w & 127); if (w >> 7) src = J.src2; if (col >= J.nlog) col = -1; }
    float4 v[8];
#pragma unroll
    for (int i = 0; i < 8; ++i) { const int kk = 4 * i + (lane >> 4); v[i] = make_float4(0.f, 0.f, 0.f, 0.f);
        if (col >= 0 && k0 + kk < J.Ksrc) { v[i] = *(const float4*)(src + (size_t)(k0 + kk) * J.ldw + col); if (J.ksc) { const float s = J.ksc[k0 + kk]; v[i].x *= s; v[i].y *= s; v[i].z *= s; v[i].w *= s; } } }
#pragma unroll
    for (int i = 0; i < 8; ++i) { const int kk = 4 * i + (lane >> 4); LAS float* d = scr + kk * 65 + 4 * (lane & 15); d[0] = v[i].x; d[1] = v[i].y; d[2] = v[i].z; d[3] = v[i].w; }
    asm volatile("s_waitcnt lgkmcnt(0)" ::: "memory");
    const int c = lane & 3;
#pragma unroll
    for (int j = 0; j < 4; ++j) { const int n = (lane >> 2) + 16 * j; const LAS float* s = scr + (8 * c) * 65 + n;
        uint4 o; o.x = pack2(s[0 * 65], s[1 * 65]); o.y = pack2(s[2 * 65], s[3 * 65]); o.z = pack2(s[4 * 65], s[5 * 65]); o.w = pack2(s[6 * 65], s[7 * 65]);
        *(uint4*)(J.dst + (size_t)(n0 + n) * J.Kpad + k0 + 8 * c) = o; }
    asm volatile("s_waitcnt lgkmcnt(0)" ::: "memory");
}

enum { GP_PRO = 0, GP_KVM = 1, GP_L0 = 2, GP_LSTRIDE = 20, GP_END = 42 };
enum { LP_N1 = 0, LP_G1, LP_POSTPROJ, LP_UP, LP_POSTUP, LP_ATTN, LP_MIXNORM, LP_G4, LP_N2, LP_G5, LP_MEMNQ, LP_ATTM, LP_G7, LP_N3, LP_F1, LP_F2, LP_F3, LP_F4 };

__device__ __forceinline__ int hw_lane() { int l; asm volatile("v_mbcnt_lo_u32_b32 %0, -1, 0\n\tv_mbcnt_hi_u32_b32 %0, -1, %0" : "=v"(l)); return l; }
struct MArgs { const float* in[39]; float* out; unsigned char* ws; int ph_lo, ph_hi, li, pad; };
typedef const __attribute__((address_space(4))) MArgs* KArgP;
#define PHASE_ENV() KArgP kp_ = kp; asm volatile("" : "+s"(kp_)); const int lane = hw_lane(), wave = wave_s, tid = wave_s * 64 + lane; int l_ = l; asm volatile("" : "+s"(l_)); \
    const int gw = bx * NWAVES + wave, ngw = G * NWAVES; (void)lane; (void)gw; (void)ngw; (void)tid; \
    Args a; _Pragma("unroll") for (int i_ = 0; i_ < 39; ++i_) a.in[i_] = kp_->in[i_]; a.out = kp_->out; a.ws = kp_->ws; a.l = 0; a.phase = 0; \
    const Ctx c = make_ctx(a, l_); unsigned char* wb = a.ws + WS_WB; unsigned char* lb = wb + (size_t)l_ * LW_STRIDE; (void)lb; (void)c; \
    bf16* HMP = (bf16*)(a.ws + WS_HMP); bf16* KVM2 = (bf16*)(a.ws + WS_KVM); bf16* KVMl = KVM2 + (size_t)l_ * 4096 * 1024; (void)HMP; (void)KVMl;
__global__ void __launch_bounds__(NWAVES * 64, 2) mega(MArgs margs) {
    extern __shared__ __attribute__((aligned(16))) unsigned char lds_raw[];
    LAS unsigned char* lds = (LAS unsigned char*)lds_raw;
    volatile LAS unsigned* MISC = (volatile LAS unsigned*)(lds + MISC_OFF);
    const int G = gridDim.x, bx = blockIdx.x;
    for (int u = threadIdx.x; u < (LDS_BYTES - LDSCTL_OFF) / 4; u += NWAVES * 64) ((LAS unsigned*)(lds + LDSCTL_OFF))[u] = 0u;
    __syncthreads();
    const KArgP kp = (KArgP)__builtin_amdgcn_kernarg_segment_ptr();
    const int wave_s = __builtin_amdgcn_readfirstlane(threadIdx.x >> 6);
    const XcdBarrier bar = xcd_barrier_post((unsigned*)(margs.ws + WS_CTL) + CW_BAR + margs.li * XCD_BAR_WORDS, MISC + 8);
    const int lo = margs.ph_lo, hi = margs.ph_hi;
#define IN(k) (lo <= (k) && (k) < hi)
#define SEAM(k) do { if (IN(k) && IN((k) + 1)) xcd_barrier(bar, wave_s * 64 + hw_lane()); } while (0)
    { const int l = 0;
    for (int pr_ = 0; pr_ < (PRB == 5 ? 2 : 1); ++pr_) {
    if (IN(GP_PRO)) { PHASE_ENV();
        LAS float* scr = (LAS float*)(lds + wave * 16384);
        int base = 0;
        for (int j = 0; j < 32; ++j) { const Job J = get_job(a, j); const int n = job_items(J);
            int first = gw - (base % ngw); if (first < 0) first += ngw;
            for (int it = first; it < n; it += ngw) transpose_item(J, it, scr, lane);
            base += n; }
        { bf16* wsg = (bf16*)(wb + W_SGU); for (int i = gw * 64 + lane; i < 2 * 65536; i += ngw * 64) wsg[i] = f2bf(a.in[9][i]); }
        pass_xb(a.in[0], (bf16*)(a.ws + WS_H), c.PART, MTOK, gw, ngw, lane);
        for (int l2 = 0; l2 < 2; ++l2) pass_norm(a.in[1], a.in[24] + l2 * 1024, HMP + (size_t)l2 * 4096 * 1024, BATCH * MEML, gw, ngw, lane);
    }
    SEAM(GP_PRO);
    if (IN(GP_KVM)) { PHASE_ENV();
        pg8::KvmOrder S; S.c = bx; S.A = (const char*)HMP; S.B = (const char*)(wb + L_WMKV); S.bstride = LW_STRIDE;
        pg8::EpiStore E{KVM2, 1024};
        pg8::gemm_phase<pg8::EpiStore, pg8::KvmOrder, false, true>(lds, 1024, 1024, S, E, tid);
    }
    SEAM(GP_KVM);
    }
    if (PRB == 5) for (int i_ = 0; i_ < 20; ++i_) xcd_barrier(bar, wave_s * 64 + hw_lane());
    }
    for (int l = 0; l < 2; ++l) {
        const int B = GP_L0 + GP_LSTRIDE * l;
        for (int pr_ = 0; pr_ < (PRB == 1 ? 2 : 1); ++pr_) {
        for (int rep_ = 0; rep_ < REP_G1; ++rep_) if (IN(B + LP_G1)) { PHASE_ENV(); pg8::DenseOrder S; S.init(MTOK / 256, PW / 256, G, bx, c.H, 1024, lb + L_WIN, 1024); pg8::EpiStoreN E{c.PROJ, PW, c.PART};
            pg8::gemm_phase<pg8::EpiStoreN, pg8::DenseOrder, true, true>(lds, 1024, 1024, S, E, tid); }
        SEAM(B + LP_G1);
        if (IN(B + LP_POSTPROJ)) { PHASE_ENV(); pass_post_proj(c, MTOK, gw, ngw, lane);
            pass_memnorm(KVMl, 1024, c.mkg, BATCH * MEML, gw, ngw, lane); }
        SEAM(B + LP_POSTPROJ);
        }
        for (int pr_ = 0; pr_ < ((PRB == 1 || PRB == 2) ? 2 : 1); ++pr_) {
        if (IN(B + LP_UP)) {
            { PHASE_ENV(); for (int b = bx; b < BATCH; b += G) cumsum_batch(c, b, (LAS float*)lds, tid); }
            { PHASE_ENV(); pg8::DenseOrder S; S.init(MTOK / 256, 3, G, bx, c.PROJ + C_CQ, PW, lb + L_WUQ, 256); pg8::EpiStore E{c.QC, 768};
              pg8::gemm_phase<pg8::EpiStore, pg8::DenseOrder, true, true>(lds, 256, PW, S, E, tid); }
            { PHASE_ENV(); pg8::DenseOrder S; S.init(MTOK / 256, 4, G, bx, c.PROJ + C_CKV, PW, lb + L_WUKV, 256); pg8::EpiStore E{c.KVC, 1024};
              pg8::gemm_phase<pg8::EpiStore, pg8::DenseOrder, true, true>(lds, 256, PW, S, E, tid); }
        }
        SEAM(B + LP_UP);
        if (PRB == 2 && pr_ == 0) continue;
        if (IN(B + LP_POSTUP)) { PHASE_ENV(); pass_post_up(c, MTOK, gw, ngw, lane); }
        SEAM(B + LP_POSTUP);
        }
        for (int pr_ = 0; pr_ < (PRB == 1 ? 2 : 1); ++pr_) {
        for (int rep_ = 0; rep_ < REP_ATTN; ++rep_) {
          for (int r2_ = 0; r2_ < REP_FOX; ++r2_) if (IN(B + LP_ATTN) && BUILD_STEP >= 2) { PHASE_ENV(); const int vcu = (G % 8 == 0) ? (bx % 8) * (G / 8) + bx / 8 : bx;
            for (int U = vcu; U < 1024; U += G) { const int i = U >> 8, v = U & 255, xq = v >> 5, j = v & 31, bh = 8 * xq + 2 * i + (j >> 4), qb = (i & 1) ? 15 - (j & 15) : (j & 15), b = bh >> 2, h = bh & 3;
                const size_t rb = (size_t)b * SEQ, rw = rb + qb * 256 + 32 * wave;
                if (REP_FOX > 1 && r2_ == 0) att::attn_unit<64, 64, 0, PROBE_MODE>(lds, c.PROJ + rw * PW + C_QA + h * 64, PW, 0.125f * 1.4426950408889634f, c.PROJ + rb * PW + C_KA + h * 64, PW, c.CUMX + ((size_t)(b * 4 + h) * SEQ) * 8, 0, c.PROJ + rb * PW + C_VA + h * 64, PW,
                                          c.OMIX + rw * 1024 + h * 64, 1024, qb * 256, 4 * qb + 4, tid);
                else att::attn_unit<64, 64, 0>(lds, c.PROJ + rw * PW + C_QA + h * 64, PW, 0.125f * 1.4426950408889634f, c.PROJ + rb * PW + C_KA + h * 64, PW, c.CUMX + ((size_t)(b * 4 + h) * SEQ) * 8, 0, c.PROJ + rb * PW + C_VA + h * 64, PW,
                                          c.OMIX + rw * 1024 + h * 64, 1024, qb * 256, 4 * qb + 4, tid); }
          }
          for (int r2_ = 0; r2_ < REP_MLA; ++r2_) if (IN(B + LP_ATTN) && BUILD_STEP >= 2) { PHASE_ENV(); const int vcu = (G % 8 == 0) ? (bx % 8) * (G / 8) + bx / 8 : bx;
            for (int U = vcu; U < 2048; U += G) { const int i = U >> 8, v = U & 255, xq = v >> 5, j = v & 31, bh = 16 * xq + 2 * i + (j >> 4), qb = (i & 1) ? 15 - (j & 15) : (j & 15), b = bh >> 3, h = bh & 7;
                const size_t rb = (size_t)b * SEQ, rw = rb + qb * 256 + 32 * wave;
                att::attn_unit<96, 64, 1>(lds, c.QC + rw * 768 + h * 96, 768, 0.10206207261596575f * 1.4426950408889634f, c.KVC + rb * 1024 + h * 128, 1024, c.PROJ + rb * PW + C_KR, PW, c.KVC + rb * 1024 + h * 128 + 64, 1024,
                                          c.OMIX + rw * 1024 + 512 + h * 64, 1024, qb * 256, 4 * qb + 4, tid); }
          }
          for (int r2_ = 0; r2_ < REP_SGU; ++r2_) if (IN(B + LP_ATTN) && BUILD_STEP >= 2) { PHASE_ENV(); const int vcu = (G % 8 == 0) ? (bx % 8) * (G / 8) + bx / 8 : bx;
            for (int U = vcu; U < 2048; U += G) att::sgu_unit(lds, c.PROJ, (const bf16*)(wb + W_SGU) + (size_t)l_ * 65536, c.bsb, c.OMIX, U >> 2, U & 3, tid);
          }
        }
        SEAM(B + LP_ATTN);
        if (IN(B + LP_MIXNORM)) { PHASE_ENV(); pass_mixnorm(c, MTOK, gw, ngw, lane); }
        SEAM(B + LP_MIXNORM);
        }
        if (PRB == 3 && IN(B + LP_G4)) { PHASE_ENV(); pg8::DenseOrder S; S.init(MTOK / 256, 4, G, bx, c.OMIX, 1024, lb + L_WOUT, 1024); pg8::EpiStore E{c.KVC, 1024};
            pg8::gemm_phase<pg8::EpiStore, pg8::DenseOrder, true, true>(lds, 1024, 1024, S, E, tid); xcd_barrier(bar, wave_s * 64 + hw_lane()); }
        if (IN(B + LP_G4)) { PHASE_ENV(); pg8::DenseOrder S; S.init(MTOK / 256, 4, G, bx, c.OMIX, 1024, lb + L_WOUT, 1024); pg8::EpiRes E{l_ == 0 ? c.x_in : c.X, c.X, c.H, c.PART};
            pg8::gemm_phase<pg8::EpiRes, pg8::DenseOrder, true, true>(lds, 1024, 1024, S, E, tid); }
        SEAM(B + LP_G4);
        for (int pr_ = 0; pr_ < ((PRB == 1 || PRB == 2) ? 2 : 1); ++pr_) {
        if (IN(B + LP_G5)) { PHASE_ENV(); pg8::DenseOrder S; S.init(MTOK / 256, 2, G, bx, c.H, 1024, lb + L_WMQ, 1024); pg8::EpiStoreN E{c.QM, 512, c.PART};
            pg8::gemm_phase<pg8::EpiStoreN, pg8::DenseOrder, true, true>(lds, 1024, 1024, S, E, tid); }
        SEAM(B + LP_G5);
        if (PRB == 2 && pr_ == 0) continue;
        if (IN(B + LP_MEMNQ)) { PHASE_ENV(); pass_memnorm(c.QM, 512, c.mqg, MTOK, gw, ngw, lane); }
        SEAM(B + LP_MEMNQ);
        }
        for (int rep_ = 0; rep_ < REP_ATTM; ++rep_) if (IN(B + LP_ATTM) && BUILD_STEP >= 2) { PHASE_ENV(); const int vcu = (G % 8 == 0) ? (bx % 8) * (G / 8) + bx / 8 : bx;
            for (int U = vcu; U < 1024; U += G) { const int qblk = U >> 2, h = U & 3; const size_t rw = (size_t)qblk * 256 + 32 * wave; const int b = (qblk * 256) / SEQ; const bf16* kvb = KVMl + (size_t)b * MEML * 1024 + h * 128;
                att::attn_unit<128, 128, 2>(lds, c.QM + rw * 512 + h * 128, 512, 0.08838834764831845f * 1.4426950408889634f, kvb, 1024, nullptr, 0, kvb + 512, 1024, c.OM + rw * 512 + h * 128, 512, 0, 4, tid); }
        }
        SEAM(B + LP_ATTM);
        if (PRB == 3 && IN(B + LP_G7)) { PHASE_ENV(); pg8::DenseOrder S; S.init(MTOK / 256, 4, G, bx, c.OM, 512, lb + L_WMO, 512); pg8::EpiStore E{c.KVC, 1024};
            pg8::gemm_phase<pg8::EpiStore, pg8::DenseOrder, true, true>(lds, 512, 512, S, E, tid); xcd_barrier(bar, wave_s * 64 + hw_lane()); }
        if (IN(B + LP_G7)) { PHASE_ENV(); pg8::DenseOrder S; S.init(MTOK / 256, 4, G, bx, c.OM, 512, lb + L_WMO, 512); pg8::EpiRes E{c.X, c.X, c.H, c.PART};
            pg8::gemm_phase<pg8::EpiRes, pg8::DenseOrder, true, true>(lds, 512, 512, S, E, tid); }
        SEAM(B + LP_G7);
        if (l == 0) {
            for (int rep_ = 0; rep_ < REP_F1; ++rep_) if (IN(B + LP_F1)) { PHASE_ENV(); pg8::DenseOrder S; S.init(MTOK / 256, 22, G, bx, c.H, 1024, wb + W_FGU, 1024); pg8::EpiSwiglu E{c.HID, DFFP, c.PART, nullptr};
                pg8::gemm_phase<pg8::EpiSwiglu, pg8::DenseOrder, true, true>(lds, 1024, 1024, S, E, tid); }
            SEAM(B + LP_F1);
            if (PRB == 3 && IN(B + LP_F2)) { PHASE_ENV(); pg8::DenseOrder S; S.init(MTOK / 256, 4, G, bx, c.HID, DFFP, wb + W_FD, DFFP); pg8::EpiStore E{c.KVC, 1024};
                pg8::gemm_phase<pg8::EpiStore, pg8::DenseOrder, true, true>(lds, DFFP, DFFP, S, E, tid); xcd_barrier(bar, wave_s * 64 + hw_lane()); }
            if (IN(B + LP_F2)) { PHASE_ENV(); pg8::DenseOrder S; S.init(MTOK / 256, 4, G, bx, c.HID, DFFP, wb + W_FD, DFFP); pg8::EpiRes E{c.X, c.X, c.H, c.PART};
                pg8::gemm_phase<pg8::EpiRes, pg8::DenseOrder, true, true>(lds, DFFP, DFFP, S, E, tid); }
            if (IN(B + LP_F2) && IN(B + GP_LSTRIDE)) xcd_barrier(bar, wave_s * 64 + hw_lane());
        } else {
            for (int pr_ = 0; pr_ < (PRB == 4 ? 2 : 1); ++pr_) {
            if (IN(B + LP_N3)) { PHASE_ENV(); for (int ch = bx; ch < 256; ch += G) route1_chunk(c, ch, (LAS int*)lds, tid); }
            SEAM(B + LP_N3);
            if (IN(B + LP_F1)) { PHASE_ENV(); for (int ch = bx; ch < 256; ch += G) route2_chunk(c, ch, (LAS int*)lds, tid); }
            SEAM(B + LP_F1);
            if (IN(B + LP_F2)) { PHASE_ENV(); const int nt = c.TAB[1000]; pg8::GroupOrder S; S.init(nt, 11, G, bx, c.HS, 1024, wb + W_MGU, 1024); S.tab = c.TAB; S.estride = MGU_STRIDE; pg8::EpiSwiglu E{c.HIDM, DFE, nullptr, c.SLOT_R};
                pg8::gemm_phase<pg8::EpiSwiglu, pg8::GroupOrder, true, true>(lds, 1024, 1024, S, E, tid); }
            SEAM(B + LP_F2);
            }
            if (PRB == 3 && IN(B + LP_F3)) { PHASE_ENV(); const int nt = c.TAB[1000]; pg8::GroupOrder S; S.init(nt, 4, G, bx, c.HIDM, DFE, wb + W_MD, DFE); S.tab = c.TAB; S.estride = MD_STRIDE; pg8::EpiStore E{c.HS, 1024};
                pg8::gemm_phase<pg8::EpiStore, pg8::GroupOrder, true, true>(lds, DFE, DFE, S, E, tid); xcd_barrier(bar, wave_s * 64 + hw_lane()); }
            if (IN(B + LP_F3)) { PHASE_ENV(); const int t0 = c.TAB[1001]; pg8::GroupOrder S; S.init(t0, 4, G, bx, c.HIDM, DFE, wb + W_MD, DFE); S.tab = c.TAB; S.estride = MD_STRIDE; pg8::EpiScatter E{c.X, c.SLOT_TOK, c.SLOT_GATE};
                pg8::gemm_phase<pg8::EpiScatter, pg8::GroupOrder, true, true>(lds, DFE, DFE, S, E, tid); }
            SEAM(B + LP_F3);
            if (IN(B + LP_F4)) { PHASE_ENV(); const int nt = c.TAB[1000], t0 = c.TAB[1001]; pg8::GroupOrder S; S.init(nt - t0, 4, G, bx, c.HIDM, DFE, wb + W_MD, DFE); S.pm0 = t0; S.tab = c.TAB; S.estride = MD_STRIDE; pg8::EpiScatter E{c.X, c.SLOT_TOK, c.SLOT_GATE};
                pg8::gemm_phase<pg8::EpiScatter, pg8::GroupOrder, true, true>(lds, DFE, DFE, S, E, tid); }
        }
    }
#undef IN
#undef SEAM
}

extern "C" void kernel_launch(void* const* d_in, const int* in_sizes, int n_in, void* d_out, int out_size, void* d_ws, size_t ws_size, hipStream_t stream) {
    static int grid = 0;
    if (grid == 0) {
        if (n_in != 39 || out_size != MTOK * DM || ws_size < WS_END) { fprintf(stderr, "kernel_launch: unexpected problem (n_in %d out %d ws %zu)\n", n_in, out_size, ws_size); grid = -1; return; }
        int dev = 0, cus = 0, per_cu = 0;
        if (hipGetDevice(&dev) != hipSuccess || hipDeviceGetAttribute(&cus, hipDeviceAttributeMultiprocessorCount, dev) != hipSuccess) { grid = -1; return; }
        if (hipFuncSetAttribute((const void*)mega, hipFuncAttributeMaxDynamicSharedMemorySize, LDS_BYTES) != hipSuccess) { fprintf(stderr, "kernel_launch: hipFuncSetAttribute failed\n"); grid = -1; return; }
        if (hipOccupancyMaxActiveBlocksPerMultiprocessor(&per_cu, (const void*)mega, NWAVES * 64, LDS_BYTES) != hipSuccess || per_cu < 1) fprintf(stderr, "kernel_launch: occupancy query says %d\n", per_cu);
        (void)hipGetLastError();
        grid = cus;
    }
    if (grid < 0) return;
    hipMemsetAsync((char*)d_ws + WS_CTL, 0, 1 * MiB, stream);
    Args a{}; for (int i = 0; i < 39; ++i) a.in[i] = (const float*)d_in[i]; a.out = (float*)d_out; a.ws = (unsigned char*)d_ws;
    MArgs m{}; for (int i = 0; i < 39; ++i) m.in[i] = (const float*)d_in[i]; m.out = (float*)d_out; m.ws = (unsigned char*)d_ws;
    int li = 0;
#define MEGA(lo_, hi_) do { m.ph_lo = (lo_); m.ph_hi = (hi_); m.li = li++; hipLaunchKernelGGL(mega, dim3(grid), dim3(NWAVES * 64), LDS_BYTES, stream, m); } while (0)
#if BUILD_STEP >= 2
    MEGA(GP_PRO, GP_END);
}
#else
    const int B0 = GP_L0, B1 = GP_L0 + GP_LSTRIDE;
    int cur = GP_PRO;
    for (int l = 0; l < 2; ++l) {
        a.l = l; const Ctx c = make_ctx(a, l); const int B = l ? B1 : B0;
        MEGA(cur, B + LP_ATTN);
        hipLaunchKernelGGL((nv_attn<64, 64, 0>), dim3(MTOK / 64, 4, 1), dim3(64), 0, stream, c.PROJ + C_QA, PW, 64, c.PROJ + C_KA, PW, 64, nullptr, 0, c.PROJ + C_VA, PW, 64, c.OMIX, 1024, 64, c.CUM, 0.125f);
        hipLaunchKernelGGL(nv_sgu, dim3(MTOK / 128, 4), dim3(256), 0, stream, c.PROJ, c.bsw, c.bsb, c.OMIX);
        hipLaunchKernelGGL((nv_attn<96, 64, 1>), dim3(MTOK / 64, 8, 1), dim3(64), 0, stream, c.QC, 768, 96, c.KVC, 1024, 128, c.PROJ + C_KR, PW, c.KVC + 64, 1024, 128, c.OMIX + 512, 1024, 64, nullptr, 0.10206207261596575f);
        MEGA(B + LP_MIXNORM, B + LP_ATTM);
        hipLaunchKernelGGL((nv_attn<128, 128, 2>), dim3(MTOK / 64, 4, 2), dim3(64), 0, stream, c.QM, 512, 128, c.KVM + (size_t)l * 4096 * 1024, 1024, 128, nullptr, 0, c.KVM + (size_t)l * 4096 * 1024 + 512, 1024, 128, c.OM, 512, 128, nullptr, 0.08838834764831845f);
        cur = B + LP_G7;
    }
    MEGA(cur, GP_END);
}
#endif
```

```cpp
#include <hip/hip_runtime.h>
#include <stdint.h>
#include <stdio.h>

#ifndef BUILD_STEP
#define BUILD_STEP 2
#endif
typedef unsigned short bf16;
#define LAS __attribute__((address_space(3)))
#define EPSF 1e-6f

constexpr int BATCH = 16, SEQ = 4096, DM = 1024, MTOK = BATCH * SEQ, MEML = 256;
constexpr int PW = 1792;
constexpr int C_QA = 0, C_KA = 256, C_VA = 512, C_UB = 768, C_VB = 1024, C_CQ = 1280, C_CKV = 1536, C_KR = 1664, C_FA = 1696;
constexpr int IN_W = 1700, DFF = 2752, DFFP = 2816, NEXP = 8, DFE = 1408;
constexpr int SLOTS = 2 * MTOK + 16 * 256;
constexpr int MAXTILES = SLOTS / 256;

constexpr size_t MiB = 1u << 20;
constexpr size_t WS_CTL = 0, WS_WB = 1 * MiB, WS_H = 128 * MiB, WS_R1 = 256 * MiB;
constexpr size_t WS_QC = 640 * MiB, WS_KVC = 736 * MiB, WS_OMIX = 864 * MiB, WS_QM = 640 * MiB, WS_OM = 704 * MiB;
constexpr size_t WS_KVM = 992 * MiB, WS_HM = 1000 * MiB, WS_FLOG = 1008 * MiB, WS_CUM = 1009 * MiB, WS_TOP = 1010 * MiB, WS_SLOT = 1012 * MiB, WS_CH = 1014 * MiB;
constexpr size_t WS_PART = 1019 * MiB;
constexpr size_t WS_CUMX = 1015 * MiB;
constexpr size_t WS_HS = 256 * MiB, WS_HIDM = 520 * MiB, WS_END = 1023 * MiB;

__device__ __forceinline__ float bf2f(bf16 v) { return __uint_as_float(((unsigned)v) << 16); }
__device__ __forceinline__ bf16 f2bf(float f) { unsigned u = __float_as_uint(f); u += 0x7fffu + ((u >> 16) & 1u); return (bf16)(u >> 16); }
__device__ __forceinline__ unsigned pack2(float a, float b) { return (unsigned)f2bf(a) | ((unsigned)f2bf(b) << 16); }
__device__ __forceinline__ void unpack2(unsigned u, float& a, float& b) { a = __uint_as_float(u << 16); b = __uint_as_float(u & 0xffff0000u); }
__device__ __forceinline__ void ld4bf(const bf16* p, float (&f)[4]) { const uint2 u = *(const uint2*)p; unpack2(u.x, f[0], f[1]); unpack2(u.y, f[2], f[3]); }
__device__ __forceinline__ void st4bf(bf16* p, const float (&f)[4]) { uint2 u; u.x = pack2(f[0], f[1]); u.y = pack2(f[2], f[3]); *(uint2*)p = u; }
__device__ __forceinline__ void ld8bf(const bf16* p, float (&f)[8]) { const uint4 u = *(const uint4*)p; unpack2(u.x, f[0], f[1]); unpack2(u.y, f[2], f[3]); unpack2(u.z, f[4], f[5]); unpack2(u.w, f[6], f[7]); }
__device__ __forceinline__ void st8bf(bf16* p, const float (&f)[8]) { uint4 u; u.x = pack2(f[0], f[1]); u.y = pack2(f[2], f[3]); u.z = pack2(f[4], f[5]); u.w = pack2(f[6], f[7]); *(uint4*)p = u; }
__device__ __forceinline__ float shx(float v, int lane, int o) { return __int_as_float(__builtin_amdgcn_ds_bpermute((lane ^ o) << 2, __float_as_int(v))); }
__device__ __forceinline__ float wsum(float v, int lane) {
#pragma unroll
    for (int o = 1; o < 64; o <<= 1) v += shx(v, lane, o);
    return v; }
__device__ __forceinline__ float sum16(float v, int lane) { v += shx(v, lane, 1); v += shx(v, lane, 2); v += shx(v, lane, 4); v += shx(v, lane, 8); return v; }
__device__ __forceinline__ float sum8(float v, int lane) { v += shx(v, lane, 1); v += shx(v, lane, 2); v += shx(v, lane, 4); return v; }
__device__ __forceinline__ float gelu_erf(float v) {
    const float av = fabsf(v), t = __builtin_amdgcn_rcpf(av * 0.2316418882f + 1.0f);
    float q = t * 0.5307027145f + (-0.7265760135f); q = q * t + 0.7107068705f; q = q * t + (-0.142248368f); q = q * t + 0.127414796f; q = q * t;
    const float e = __builtin_amdgcn_exp2f((v * v) * (-0.72134752044f)), m = v * (q * e);
    return v < 0.f ? m : v - m; }
__device__ __forceinline__ float logsigmoid(float z) { return fminf(z, 0.f) - 0.6931471805599453f * __builtin_amdgcn_logf(1.0f + __builtin_amdgcn_exp2f(-1.4426950408889634f * fabsf(z))); }
__device__ __forceinline__ float rope_inv(int i) { return exp2f(-(float)i * (13.287712379549449f / 16.0f)); }

struct Args { const float* in[39]; float* out; unsigned char* ws; int l; int phase; };
struct Ctx {
    const float* x_in; const float* mem; const int* pos;
    const float *mix_norm, *w_in, *b_forget, *aq, *ak, *bv, *bsw, *bsb, *cqg, *wuq, *ckvg, *wukv, *qng, *qrg, *kng, *krg, *ona, *onb, *onc, *wout, *xattn, *memn, *wmq, *wmkv, *mqg, *mkg, *wmo, *ffn_norm;
    const float *fg, *fu, *fd, *wr, *br, *mg, *mu, *md;
    float* X;
    bf16 *H, *PROJ, *QC, *KVC, *OMIX, *QM, *OM, *KVM, *HM, *HID, *HS, *HIDM;
    float *FLOG, *CUM, *TOPG, *SLOT_GATE, *PART, *RTOK, *SLOT_R; int *TOPI, *SLOT_TOK, *CH, *TAB; bf16* CUMX;
};
__device__ __host__ __forceinline__ Ctx make_ctx(const Args& a, int l) {
    Ctx c;
    c.x_in = a.in[0]; c.mem = a.in[1]; c.pos = (const int*)a.in[2];
    c.mix_norm = a.in[3] + l * 1024; c.w_in = a.in[4] + (size_t)l * 1024 * IN_W; c.b_forget = a.in[5] + l * 4; c.aq = a.in[6] + l * 64; c.ak = a.in[7] + l * 64;
    c.bv = a.in[8] + l * 256; c.bsw = a.in[9] + l * 4 * 128 * 128; c.bsb = a.in[10] + l * 4 * 128; c.cqg = a.in[11] + l * 256; c.wuq = a.in[12] + (size_t)l * 256 * 768;
    c.ckvg = a.in[13] + l * 128; c.wukv = a.in[14] + (size_t)l * 128 * 1024; c.qng = a.in[15] + l * 64; c.qrg = a.in[16] + l * 32; c.kng = a.in[17] + l * 64; c.krg = a.in[18] + l * 32;
    c.ona = a.in[19] + l * 256; c.onb = a.in[20] + l * 256; c.onc = a.in[21] + l * 512; c.wout = a.in[22] + (size_t)l * 1024 * 1024; c.xattn = a.in[23] + l * 1024; c.memn = a.in[24] + l * 1024;
    c.wmq = a.in[25] + (size_t)l * 1024 * 512; c.wmkv = a.in[26] + (size_t)l * 1024 * 1024; c.mqg = a.in[27] + l * 128; c.mkg = a.in[28] + l * 128; c.wmo = a.in[29] + (size_t)l * 512 * 1024; c.ffn_norm = a.in[30] + l * 1024;
    c.fg = a.in[31]; c.fu = a.in[32]; c.fd = a.in[33]; c.wr = a.in[34]; c.br = a.in[35]; c.mg = a.in[36]; c.mu = a.in[37]; c.md = a.in[38];
    c.X = a.out;
    unsigned char* ws = a.ws;
    c.H = (bf16*)(ws + WS_H); c.PROJ = (bf16*)(ws + WS_R1); c.QC = (bf16*)(ws + WS_QC); c.KVC = (bf16*)(ws + WS_KVC); c.OMIX = (bf16*)(ws + WS_OMIX); c.QM = (bf16*)(ws + WS_QM); c.OM = (bf16*)(ws + WS_OM);
    c.KVM = (bf16*)(ws + WS_KVM); c.HM = (bf16*)(ws + WS_HM); c.HID = (bf16*)(ws + WS_R1); c.HS = (bf16*)(ws + WS_HS); c.HIDM = (bf16*)(ws + WS_HIDM);
    c.FLOG = (float*)(ws + WS_FLOG); c.CUM = (float*)(ws + WS_CUM); c.TOPI = (int*)(ws + WS_TOP); c.TOPG = (float*)(ws + WS_TOP + MiB); c.SLOT_TOK = (int*)(ws + WS_SLOT); c.SLOT_GATE = (float*)(ws + WS_SLOT + MiB);
    c.CH = (int*)(ws + WS_CH); c.TAB = (int*)(ws + WS_CH + 65536); c.CUMX = (bf16*)(ws + WS_CUMX); c.PART = (float*)(ws + WS_PART); c.RTOK = c.TOPG + 2 * MTOK; c.SLOT_R = (float*)(ws + WS_CH + 131072);
    return c;
}

constexpr int RB = 4;
__device__ __forceinline__ void pass_norm(const float* x, const float* g, bf16* H, int nrows, int gw, int ngw, int lane) {
    float4 gg[4];
#pragma unroll
    for (int j = 0; j < 4; ++j) gg[j] = ((const float4*)g)[lane + 64 * j];
    for (int r0 = gw; r0 < nrows; r0 += ngw * RB) {
        float4 v[RB][4];
#pragma unroll
        for (int k = 0; k < RB; ++k) { const int r = r0 + k * ngw; if (r < nrows) {
#pragma unroll
            for (int j = 0; j < 4; ++j) v[k][j] = ((const float4*)(x + (size_t)r * 1024))[lane + 64 * j]; } }
#pragma unroll
        for (int k = 0; k < RB; ++k) { const int r = r0 + k * ngw; if (r < nrows) { float ss = 0.f;
#pragma unroll
            for (int j = 0; j < 4; ++j) ss += v[k][j].x * v[k][j].x + v[k][j].y * v[k][j].y + v[k][j].z * v[k][j].z + v[k][j].w * v[k][j].w;
            ss = wsum(ss, lane); const float rr = rsqrtf(ss * (1.f / 1024.f) + EPSF);
#pragma unroll
            for (int j = 0; j < 4; ++j) { float f[4] = {v[k][j].x * rr * gg[j].x, v[k][j].y * rr * gg[j].y, v[k][j].z * rr * gg[j].z, v[k][j].w * rr * gg[j].w}; st4bf(H + (size_t)r * 1024 + 4 * (lane + 64 * j), f); } } }
    }
}
__device__ __forceinline__ void pass_xb(const float* x, bf16* Xb, float* part, int nrows, int gw, int ngw, int lane) {
    for (int r0 = gw; r0 < nrows; r0 += ngw * RB) {
        float4 v[RB][4];
#pragma unroll
        for (int k = 0; k < RB; ++k) { const int r = r0 + k * ngw;
#pragma unroll
            for (int j = 0; j < 4; ++j) v[k][j] = ((const float4*)(x + (size_t)r * 1024))[lane + 64 * j]; }
#pragma unroll
        for (int k = 0; k < RB; ++k) { const int r = r0 + k * ngw; float ss = 0.f;
#pragma unroll
            for (int j = 0; j < 4; ++j) { ss += v[k][j].x * v[k][j].x + v[k][j].y * v[k][j].y + v[k][j].z * v[k][j].z + v[k][j].w * v[k][j].w; float f[4] = {v[k][j].x, v[k][j].y, v[k][j].z, v[k][j].w}; st4bf(Xb + (size_t)r * 1024 + 4 * (lane + 64 * j), f); }
            ss = wsum(ss, lane); if (lane < 16) part[(size_t)r * 16 + lane] = (lane == 0) ? ss : 0.f; }
    }
}
__device__ __forceinline__ void pass_post_proj(const Ctx& c, int nrows, int gw, int ngw, int lane) {
    const int c4 = 4 * lane;
    float gq[4], gk[4], gv[4], gc[4], gkv[4];
#pragma unroll
    for (int i = 0; i < 4; ++i) { gq[i] = c.aq[(c4 + i) & 63]; gk[i] = c.ak[(c4 + i) & 63]; gv[i] = c.bv[c4 + i]; gc[i] = c.cqg[c4 + i]; gkv[i] = c.ckvg[(c4 + i) & 127]; }
    const float gr1 = c.krg[lane & 15], gr2 = c.krg[16 + (lane & 15)], inv = rope_inv(lane & 15), bf = c.b_forget[lane & 3];
    for (int r0 = gw; r0 < nrows; r0 += ngw * RB) {
        uint2 uq[RB], uk[RB], uu[RB], uv[RB], uc[RB], ukv[RB]; bf16 x1[RB], x2[RB], fa[RB]; int ps[RB];
#pragma unroll
        for (int k = 0; k < RB; ++k) { const int r = r0 + k * ngw; const bf16* p = c.PROJ + (size_t)r * PW;
            uq[k] = *(const uint2*)(p + C_QA + c4); uk[k] = *(const uint2*)(p + C_KA + c4); uu[k] = *(const uint2*)(p + C_UB + c4); uv[k] = *(const uint2*)(p + C_VB + c4); uc[k] = *(const uint2*)(p + C_CQ + c4);
            ukv[k] = *(const uint2*)(p + C_CKV + (c4 & 127)); x1[k] = p[C_KR + (lane & 15)]; x2[k] = p[C_KR + 16 + (lane & 15)]; fa[k] = p[C_FA + (lane & 3)]; ps[k] = c.pos[r]; }
#pragma unroll
        for (int k = 0; k < RB; ++k) { const int r = r0 + k * ngw; bf16* p = c.PROJ + (size_t)r * PW; float f[4];
            { unpack2(uq[k].x, f[0], f[1]); unpack2(uq[k].y, f[2], f[3]); const float rr = rsqrtf(sum16(f[0] * f[0] + f[1] * f[1] + f[2] * f[2] + f[3] * f[3], lane) * (1.f / 64.f) + EPSF);
#pragma unroll
              for (int i = 0; i < 4; ++i) f[i] *= rr * gq[i];
              st4bf(p + C_QA + c4, f); }
            { unpack2(uk[k].x, f[0], f[1]); unpack2(uk[k].y, f[2], f[3]); const float rr = rsqrtf(sum16(f[0] * f[0] + f[1] * f[1] + f[2] * f[2] + f[3] * f[3], lane) * (1.f / 64.f) + EPSF);
#pragma unroll
              for (int i = 0; i < 4; ++i) f[i] *= rr * gk[i];
              st4bf(p + C_KA + c4, f); }
            { unpack2(uu[k].x, f[0], f[1]); unpack2(uu[k].y, f[2], f[3]);
#pragma unroll
              for (int i = 0; i < 4; ++i) f[i] = gelu_erf(f[i]);
              st4bf(p + C_UB + c4, f); }
            { unpack2(uv[k].x, f[0], f[1]); unpack2(uv[k].y, f[2], f[3]);
#pragma unroll
              for (int i = 0; i < 4; ++i) f[i] = gelu_erf(f[i]);
              const float mu = sum16(f[0] + f[1] + f[2] + f[3], lane) * (1.f / 64.f); float q = 0.f;
#pragma unroll
              for (int i = 0; i < 4; ++i) { f[i] -= mu; q += f[i] * f[i]; }
              const float rr = rsqrtf(sum16(q, lane) * (1.f / 64.f) + EPSF);
#pragma unroll
              for (int i = 0; i < 4; ++i) f[i] *= rr * gv[i];
              st4bf(p + C_VB + c4, f); }
            { unpack2(uc[k].x, f[0], f[1]); unpack2(uc[k].y, f[2], f[3]); const float rr = rsqrtf(wsum(f[0] * f[0] + f[1] * f[1] + f[2] * f[2] + f[3] * f[3], lane) * (1.f / 256.f) + EPSF);
#pragma unroll
              for (int i = 0; i < 4; ++i) f[i] *= rr * gc[i];
              st4bf(p + C_CQ + c4, f); }
            { unpack2(ukv[k].x, f[0], f[1]); unpack2(ukv[k].y, f[2], f[3]); float ss = (lane < 32) ? (f[0] * f[0] + f[1] * f[1] + f[2] * f[2] + f[3] * f[3]) : 0.f; const float rr = rsqrtf(wsum(ss, lane) * (1.f / 128.f) + EPSF);
              if (lane < 32) {
#pragma unroll
                  for (int i = 0; i < 4; ++i) f[i] *= rr * gkv[i];
                  st4bf(p + C_CKV + c4, f); } }
            { float a1 = bf2f(x1[k]), a2 = bf2f(x2[k]); const float rr = rsqrtf(sum16(a1 * a1 + a2 * a2, lane) * (1.f / 32.f) + EPSF); a1 *= rr * gr1; a2 *= rr * gr2;
              const float ang = (float)ps[k] * inv; const float sn = sinf(ang), cs = cosf(ang);
              if (lane < 16) { p[C_KR + lane] = f2bf(a1 * cs - a2 * sn); p[C_KR + 16 + lane] = f2bf(a1 * sn + a2 * cs); } }
            if (lane < 4) c.FLOG[(size_t)r * 4 + lane] = logsigmoid(bf2f(fa[k]) + bf);
        }
    }
}
__device__ __forceinline__ void pass_post_up(const Ctx& c, int nrows, int gw, int ngw, int lane) {
    const int h = lane >> 3, j = lane & 7;
    float gn[8], gkn[8], gr[4], iv[4];
#pragma unroll
    for (int i = 0; i < 8; ++i) { gn[i] = c.qng[8 * j + i]; gkn[i] = c.kng[8 * j + i]; }
#pragma unroll
    for (int i = 0; i < 4; ++i) { gr[i] = c.qrg[4 * j + i]; iv[i] = rope_inv(4 * (j & 3) + i); }
    for (int r0 = gw; r0 < nrows; r0 += ngw * RB) {
        uint4 un[RB], ukn[RB]; uint2 ur[RB]; int ps[RB];
#pragma unroll
        for (int k = 0; k < RB; ++k) { const int r = r0 + k * ngw; const bf16* q = c.QC + (size_t)r * 768 + h * 96; const bf16* kv = c.KVC + (size_t)r * 1024 + h * 128;
            un[k] = *(const uint4*)(q + 8 * j); ur[k] = *(const uint2*)(q + 64 + 4 * j); ukn[k] = *(const uint4*)(kv + 8 * j); ps[k] = c.pos[r]; }
#pragma unroll
        for (int k = 0; k < RB; ++k) { const int r = r0 + k * ngw; bf16* q = c.QC + (size_t)r * 768 + h * 96; bf16* kv = c.KVC + (size_t)r * 1024 + h * 128;
            { float f[8]; unpack2(un[k].x, f[0], f[1]); unpack2(un[k].y, f[2], f[3]); unpack2(un[k].z, f[4], f[5]); unpack2(un[k].w, f[6], f[7]); float ss = 0.f;
#pragma unroll
              for (int i = 0; i < 8; ++i) ss += f[i] * f[i];
              const float rr = rsqrtf(sum8(ss, lane) * (1.f / 64.f) + EPSF);
#pragma unroll
              for (int i = 0; i < 8; ++i) f[i] *= rr * gn[i];
              st8bf(q + 8 * j, f); }
            { float f[4], o[4]; unpack2(ur[k].x, f[0], f[1]); unpack2(ur[k].y, f[2], f[3]); const float rr = rsqrtf(sum8(f[0] * f[0] + f[1] * f[1] + f[2] * f[2] + f[3] * f[3], lane) * (1.f / 32.f) + EPSF); const float posf = (float)ps[k];
#pragma unroll
              for (int i = 0; i < 4; ++i) { f[i] *= rr * gr[i]; const float other = shx(f[i], lane, 4); const float ang = posf * iv[i]; const float sn = sinf(ang), cs = cosf(ang); o[i] = (j < 4) ? (f[i] * cs - other * sn) : (other * sn + f[i] * cs); }
              st4bf(q + 64 + 4 * j, o); }
            { float f[8]; unpack2(ukn[k].x, f[0], f[1]); unpack2(ukn[k].y, f[2], f[3]); unpack2(ukn[k].z, f[4], f[5]); unpack2(ukn[k].w, f[6], f[7]); float ss = 0.f;
#pragma unroll
              for (int i = 0; i < 8; ++i) ss += f[i] * f[i];
              const float rr = rsqrtf(sum8(ss, lane) * (1.f / 64.f) + EPSF);
#pragma unroll
              for (int i = 0; i < 8; ++i) f[i] *= rr * gkn[i];
              st8bf(kv + 8 * j, f); }
        }
    }
}
__device__ __forceinline__ void pass_mixnorm(const Ctx& c, int nrows, int gw, int ngw, int lane) {
    float ga[4], gb[4], gc[8];
#pragma unroll
    for (int i = 0; i < 4; ++i) { ga[i] = c.ona[4 * lane + i]; gb[i] = c.onb[4 * lane + i]; }
#pragma unroll
    for (int i = 0; i < 8; ++i) gc[i] = c.onc[8 * lane + i];
    for (int r0 = gw; r0 < nrows; r0 += ngw * RB) {
        uint2 ua[RB], ub[RB]; uint4 uc[RB];
#pragma unroll
        for (int k = 0; k < RB; ++k) { const bf16* p = c.OMIX + (size_t)(r0 + k * ngw) * 1024; ua[k] = *(const uint2*)(p + 4 * lane); ub[k] = *(const uint2*)(p + 256 + 4 * lane); uc[k] = *(const uint4*)(p + 512 + 8 * lane); }
#pragma unroll
        for (int k = 0; k < RB; ++k) { bf16* p = c.OMIX + (size_t)(r0 + k * ngw) * 1024; float f[4];
            { unpack2(ua[k].x, f[0], f[1]); unpack2(ua[k].y, f[2], f[3]); const float rr = rsqrtf(wsum(f[0] * f[0] + f[1] * f[1] + f[2] * f[2] + f[3] * f[3], lane) * (1.f / 256.f) + EPSF);
#pragma unroll
              for (int i = 0; i < 4; ++i) f[i] *= rr * ga[i];
              st4bf(p + 4 * lane, f); }
            { unpack2(ub[k].x, f[0], f[1]); unpack2(ub[k].y, f[2], f[3]); const float rr = rsqrtf(wsum(f[0] * f[0] + f[1] * f[1] + f[2] * f[2] + f[3] * f[3], lane) * (1.f / 256.f) + EPSF);
#pragma unroll
              for (int i = 0; i < 4; ++i) f[i] *= rr * gb[i];
              st4bf(p + 256 + 4 * lane, f); }
            { float g[8]; unpack2(uc[k].x, g[0], g[1]); unpack2(uc[k].y, g[2], g[3]); unpack2(uc[k].z, g[4], g[5]); unpack2(uc[k].w, g[6], g[7]); float ss = 0.f;
#pragma unroll
              for (int i = 0; i < 8; ++i) ss += g[i] * g[i];
              const float rr = rsqrtf(wsum(ss, lane) * (1.f / 512.f) + EPSF);
#pragma unroll
              for (int i = 0; i < 8; ++i) g[i] *= rr * gc[i];
              st8bf(p + 512 + 8 * lane, g); }
        }
    }
}
__device__ __forceinline__ void pass_memnorm(bf16* buf, int ld, const float* g, const float* g2, int nrows, int gw, int ngw, int lane) {
    float gg[8];
#pragma unroll
    for (int i = 0; i < 8; ++i) gg[i] = g[(8 * lane + i) & 127] * (g2 ? g2[(8 * lane + i) & 127] : 1.f);
    for (int r0 = gw; r0 < nrows; r0 += ngw * RB) {
        uint4 u[RB];
#pragma unroll
        for (int k = 0; k < RB; ++k) { const int r = r0 + k * ngw; if (r < nrows) u[k] = *(const uint4*)(buf + (size_t)r * ld + 8 * lane); }
#pragma unroll
        for (int k = 0; k < RB; ++k) { const int r = r0 + k * ngw; if (r < nrows) { float f[8]; unpack2(u[k].x, f[0], f[1]); unpack2(u[k].y, f[2], f[3]); unpack2(u[k].z, f[4], f[5]); unpack2(u[k].w, f[6], f[7]); float ss = 0.f;
#pragma unroll
            for (int i = 0; i < 8; ++i) ss += f[i] * f[i];
            const float rr = rsqrtf(sum16(ss, lane) * (1.f / 128.f) + EPSF);
#pragma unroll
            for (int i = 0; i < 8; ++i) f[i] *= rr * gg[i];
            st8bf(buf + (size_t)r * ld + 8 * lane, f); } }
    }
}
__device__ __forceinline__ void route_rows32(const Ctx& c, int row0, int lane) {
    float wr[16][8];
#pragma unroll
    for (int h = 0; h < 2; ++h)
#pragma unroll
        for (int i = 0; i < 8; ++i) { const int k = 512 * h + 8 * lane + i; const float g = c.ffn_norm[k]; const float4* w = (const float4*)(c.wr + (size_t)k * 8); const float4 w0 = w[0], w1 = w[1];
            wr[8 * h + i][0] = w0.x * g; wr[8 * h + i][1] = w0.y * g; wr[8 * h + i][2] = w0.z * g; wr[8 * h + i][3] = w0.w * g; wr[8 * h + i][4] = w1.x * g; wr[8 * h + i][5] = w1.y * g; wr[8 * h + i][6] = w1.z * g; wr[8 * h + i][7] = w1.w * g; }
    float br[8];
#pragma unroll
    for (int e = 0; e < 8; ++e) br[e] = c.br[e];
    for (int rb = 0; rb < 32; rb += 4) {
        uint4 v[4][2];
#pragma unroll
        for (int k = 0; k < 4; ++k) { const uint4* xr = (const uint4*)(c.H + (size_t)(row0 + rb + k) * 1024); v[k][0] = xr[lane]; v[k][1] = xr[64 + lane]; }
#pragma unroll
        for (int k = 0; k < 4; ++k) { const int row = row0 + rb + k; float ss = 0.f, lg[8];
#pragma unroll
            for (int e = 0; e < 8; ++e) lg[e] = 0.f;
#pragma unroll
            for (int h = 0; h < 2; ++h) { float f[8]; unpack2(v[k][h].x, f[0], f[1]); unpack2(v[k][h].y, f[2], f[3]); unpack2(v[k][h].z, f[4], f[5]); unpack2(v[k][h].w, f[6], f[7]);
#pragma unroll
                for (int i = 0; i < 8; ++i) { ss += f[i] * f[i];
#pragma unroll
                    for (int e = 0; e < 8; ++e) lg[e] += f[i] * wr[8 * h + i][e]; } }
            ss = wsum(ss, lane); const float r = rsqrtf(ss * (1.f / 1024.f) + EPSF);
#pragma unroll
            for (int e = 0; e < 8; ++e) lg[e] = wsum(lg[e], lane) * r + br[e];
            int i1 = 0; float v1 = lg[0];
#pragma unroll
            for (int e = 1; e < 8; ++e) if (lg[e] > v1) { v1 = lg[e]; i1 = e; }
            int i2 = -1; float v2 = -3.0e38f;
#pragma unroll
            for (int e = 0; e < 8; ++e) if (e != i1 && lg[e] > v2) { v2 = lg[e]; i2 = e; }
            const float e2 = expf(v2 - v1), g1 = 1.f / (1.f + e2), g2 = e2 / (1.f + e2);
            if (lane == 0) { c.TOPI[(size_t)row * 2] = i1; c.TOPI[(size_t)row * 2 + 1] = i2; c.TOPG[(size_t)row * 2] = g1; c.TOPG[(size_t)row * 2 + 1] = g2; c.RTOK[row] = r; } }
    }
}

__device__ __forceinline__ void cumsum_batch(const Ctx& c, int b, LAS float* sm  , int tid) {
    const int lane = tid & 63, wave = tid >> 6;
    const float4* src = (const float4*)c.FLOG + (size_t)b * SEQ + tid * 8; float4* dst = (float4*)c.CUM + (size_t)b * SEQ + tid * 8;
    float4 v[8];
#pragma unroll
    for (int i = 0; i < 8; ++i) v[i] = src[i];
#pragma unroll
    for (int i = 1; i < 8; ++i) { v[i].x += v[i - 1].x; v[i].y += v[i - 1].y; v[i].z += v[i - 1].z; v[i].w += v[i - 1].w; }
    const float4 tot = v[7]; float4 inc = tot;
#pragma unroll
    for (int o = 1; o < 64; o <<= 1) { const int si = ((lane - o) & 63) << 2; const float tx = __int_as_float(__builtin_amdgcn_ds_bpermute(si, __float_as_int(inc.x))), ty = __int_as_float(__builtin_amdgcn_ds_bpermute(si, __float_as_int(inc.y))), tz = __int_as_float(__builtin_amdgcn_ds_bpermute(si, __float_as_int(inc.z))), tw = __int_as_float(__builtin_amdgcn_ds_bpermute(si, __float_as_int(inc.w))); if (lane >= o) { inc.x += tx; inc.y += ty; inc.z += tz; inc.w += tw; } }
    if (lane == 63) { sm[wave * 4 + 0] = inc.x; sm[wave * 4 + 1] = inc.y; sm[wave * 4 + 2] = inc.z; sm[wave * 4 + 3] = inc.w; }
    __syncthreads();
    float4 base = {0.f, 0.f, 0.f, 0.f};
    for (int w = 0; w < wave; ++w) { base.x += sm[w * 4 + 0]; base.y += sm[w * 4 + 1]; base.z += sm[w * 4 + 2]; base.w += sm[w * 4 + 3]; }
    const float4 ex = {base.x + inc.x - tot.x, base.y + inc.y - tot.y, base.z + inc.z - tot.z, base.w + inc.w - tot.w};
#pragma unroll
    for (int i = 0; i < 8; ++i) { const float4 cv = make_float4(v[i].x + ex.x, v[i].y + ex.y, v[i].z + ex.z, v[i].w + ex.w); dst[i] = cv;
        const float cc[4] = {cv.x, cv.y, cv.z, cv.w};
#pragma unroll
        for (int h = 0; h < 4; ++h) { const float fb = -cc[h] * 1.4426950408889634f; const bf16 b0 = f2bf(fb); const float r1 = fb - bf2f(b0); const bf16 b1 = f2bf(r1); const bf16 b2 = f2bf(r1 - bf2f(b1));
            uint4 rec; rec.x = (unsigned)b0 | ((unsigned)b1 << 16); rec.y = (unsigned)b2; rec.z = 0u; rec.w = 0u;
            *(uint4*)(c.CUMX + ((size_t)(b * 4 + h) * SEQ + tid * 8 + i) * 8) = rec; } }
    __syncthreads();
}
__device__ __forceinline__ void route1_chunk(const Ctx& c, int ch, LAS int* sm  , int tid) {
    const int lane = tid & 63, wave = tid >> 6;
    if (tid < 16) sm[tid] = 0;
    __syncthreads();
    route_rows32(c, ch * 256 + wave * 32, lane);
    __syncthreads();
    if (tid < 256) { const int row = ch * 256 + tid; const int e1 = __hip_atomic_load(c.TOPI + (size_t)row * 2, __ATOMIC_RELAXED, __HIP_MEMORY_SCOPE_AGENT), e2 = __hip_atomic_load(c.TOPI + (size_t)row * 2 + 1, __ATOMIC_RELAXED, __HIP_MEMORY_SCOPE_AGENT);
        atomicAdd((int*)&sm[e1], 1); atomicAdd((int*)&sm[8 + e2], 1); }
    __syncthreads();
    if (tid < 16) c.CH[ch * 16 + tid] = sm[tid];
    __syncthreads();
}
__device__ __forceinline__ void route2_chunk(const Ctx& c, int ch, LAS int* sm  , int tid) {
    const int lane = tid & 63, wave = tid >> 6;
    LAS int* sCH = sm; LAS int* sTot = sm + 4096; LAS int* sPre = sm + 4096 + 16; LAS int* sOff = sm + 4096 + 32; LAS int* sWc = sm + 4096 + 64; LAS int* sSlot = sm + 4096 + 128;
    for (int i = tid; i < 4096; i += 512) sCH[i] = c.CH[i];
    __syncthreads();
    if (tid < 16) { int tot = 0, pre = 0; for (int k = 0; k < 256; ++k) { const int v = sCH[k * 16 + tid]; tot += v; if (k < ch) pre += v; } sTot[tid] = tot; sPre[tid] = pre; }
    __syncthreads();
    if (tid == 0) { int o = 0; for (int g = 0; g < 16; ++g) { sOff[g] = o; o += (sTot[g] + 255) & ~255; } sOff[16] = o; }
    __syncthreads();
    int e1 = -1, e2 = -1, r1 = 0, r2 = 0; const int row = ch * 256 + tid;
    if (tid < 256) { e1 = c.TOPI[(size_t)row * 2]; e2 = c.TOPI[(size_t)row * 2 + 1]; }
    for (int g = 0; g < 16; ++g) { const bool pred = (tid < 256) && (g < 8 ? (e1 == g) : (e2 == g - 8)); const unsigned long long m = __ballot(pred);
        const int rk = __popcll(m & ((1ull << lane) - 1ull)); if (pred) { if (g < 8) r1 = rk; else r2 = rk; }
        if (lane == 0 && wave < 4) sWc[wave * 16 + g] = __popcll(m); }
    __syncthreads();
    if (tid < 256) { int b1 = sOff[e1] + sPre[e1], b2 = sOff[8 + e2] + sPre[8 + e2]; for (int w = 0; w < wave; ++w) { b1 += sWc[w * 16 + e1]; b2 += sWc[w * 16 + 8 + e2]; }
        const int s1 = b1 + r1, s2 = b2 + r2; sSlot[tid * 2] = s1; sSlot[tid * 2 + 1] = s2;
        c.SLOT_TOK[s1] = row; c.SLOT_TOK[s2] = row; c.SLOT_GATE[s1] = c.TOPG[(size_t)row * 2]; c.SLOT_GATE[s2] = c.TOPG[(size_t)row * 2 + 1]; const float rr = c.RTOK[row]; c.SLOT_R[s1] = rr; c.SLOT_R[s2] = rr; }
    __syncthreads();
    for (int i = 0; i < 32; i += 2) { const int t0 = wave * 32 + i, t1 = t0 + 1;
        const uint4* s0 = (const uint4*)(c.H + (size_t)(ch * 256 + t0) * 1024); const uint4* s1 = (const uint4*)(c.H + (size_t)(ch * 256 + t1) * 1024);
        const uint4 a0 = s0[lane], b0 = s0[lane + 64], a1 = s1[lane], b1 = s1[lane + 64];
        uint4* d00 = (uint4*)(c.HS + (size_t)sSlot[t0 * 2] * 1024); uint4* d01 = (uint4*)(c.HS + (size_t)sSlot[t0 * 2 + 1] * 1024); uint4* d10 = (uint4*)(c.HS + (size_t)sSlot[t1 * 2] * 1024); uint4* d11 = (uint4*)(c.HS + (size_t)sSlot[t1 * 2 + 1] * 1024);
        d00[lane] = a0; d00[lane + 64] = b0; d01[lane] = a0; d01[lane + 64] = b0; d10[lane] = a1; d10[lane + 64] = b1; d11[lane] = a1; d11[lane + 64] = b1; }
    for (int g = 0; g < 16; ++g) { const int rem = sTot[g] & 255; if (rem && ch >= rem) { const int r = sOff[g] + (sTot[g] & ~255) + ch; ((unsigned*)(c.HS + (size_t)r * 1024))[tid] = 0u; if (tid == 0) { c.SLOT_TOK[r] = -1; c.SLOT_GATE[r] = 0.f; c.SLOT_R[r] = 0.f; } } }
    if (ch == 0) { const int nt = sOff[16] >> 8; for (int t = tid; t < MAXTILES + 16; t += 512) { int g = -1; if (t < nt) { for (int q = 0; q < 16; ++q) if ((t << 8) >= sOff[q] && (t << 8) < sOff[q + 1]) g = q; } c.TAB[t] = g; } if (tid == 0) { c.TAB[1000] = nt; c.TAB[1001] = sOff[8] >> 8; } }
    __syncthreads();
}

#if BUILD_STEP < 2
enum { PH_NORM1 = 0, PH_POSTPROJ, PH_CUMSUM, PH_POSTUP, PH_MIXNORM, PH_NORM2, PH_MEMNORM_Q, PH_MEMKV_NORM, PH_MEMNORM_K, PH_NORM3, PH_ROUTE1, PH_ROUTE2, PH_ZEROPAD };
__global__ void __launch_bounds__(512) k_elem(Args a) {
    __shared__ int smem[4096 + 128 + 512 + 64];
    const Ctx c = make_ctx(a, a.l);
    const int tid = threadIdx.x, lane = tid & 63, wave = tid >> 6, gw = blockIdx.x * 8 + wave, ngw = gridDim.x * 8;
    switch (a.phase) {
    case PH_NORM1: pass_norm(a.l == 0 ? c.x_in : c.X, c.mix_norm, c.H, MTOK, gw, ngw, lane); break;
    case PH_POSTPROJ: pass_post_proj(c, MTOK, gw, ngw, lane); break;
    case PH_CUMSUM: for (int b = blockIdx.x; b < BATCH; b += gridDim.x) cumsum_batch(c, b, (LAS float*)smem, tid); break;
    case PH_POSTUP: pass_post_up(c, MTOK, gw, ngw, lane); break;
    case PH_MIXNORM: pass_mixnorm(c, MTOK, gw, ngw, lane); break;
    case PH_NORM2: pass_norm(c.X, c.xattn, c.H, MTOK, gw, ngw, lane); break;
    case PH_MEMNORM_Q: pass_memnorm(c.QM, 512, c.mqg, nullptr, MTOK, gw, ngw, lane); break;
    case PH_MEMKV_NORM: pass_norm(c.mem, c.memn, c.HM, BATCH * MEML, gw, ngw, lane); break;
    case PH_MEMNORM_K: pass_memnorm(c.KVM, 1024, c.mkg, nullptr, BATCH * MEML, gw, ngw, lane); break;
    case PH_NORM3: pass_norm(c.X, c.ffn_norm, c.H, MTOK, gw, ngw, lane); break;
    case PH_ROUTE1: for (int ch = blockIdx.x; ch < 256; ch += gridDim.x) route1_chunk(c, ch, (LAS int*)smem, tid); break;
    case PH_ROUTE2: for (int ch = blockIdx.x; ch < 256; ch += gridDim.x) route2_chunk(c, ch, (LAS int*)smem, tid); break;
    case PH_ZEROPAD: for (int r = gw; r < MTOK; r += ngw) { bf16* p = c.PROJ + (size_t)r * PW + IN_W; if (lane < 23) *(uint2*)(p + 4 * lane) = make_uint2(0u, 0u); } break;
    }
}

template <int EPI> __global__ void __launch_bounds__(256) nv_gemm(const bf16* A, int lda, const float* W, const float* W2, int ldw, size_t wstride, int N, int K, void* out, int ldo, const float* res,
                                                               const int* tile_grp, int kphase, const int* slot_tok, const float* slot_gate) {
    __shared__ float As[16][68]; __shared__ float Ws[16][68]; __shared__ float W2s[EPI == 2 ? 16 : 1][68];
    const int tid = threadIdx.x, tx = tid & 15, ty = tid >> 4, n0 = blockIdx.x * 64, m0 = blockIdx.y * 64;
    if (tile_grp) { const int g = tile_grp[m0 >> 8]; if (g < 0) return; if (EPI == 3 && (g >> 3) != kphase) return; W += (size_t)(g & 7) * wstride; if (EPI == 2) W2 += (size_t)(g & 7) * wstride; }
    float acc[4][4], acc2[4][4];
#pragma unroll
    for (int i = 0; i < 4; ++i)
#pragma unroll
        for (int j = 0; j < 4; ++j) { acc[i][j] = 0.f; acc2[i][j] = 0.f; }
    const int ar = tid >> 2, ak = (tid & 3) * 4, wk = tid >> 4, wn = (tid & 15) * 4;
    for (int k0 = 0; k0 < K; k0 += 16) {
        { float f[4]; ld4bf(A + (size_t)(m0 + ar) * lda + k0 + ak, f); As[ak + 0][ar] = f[0]; As[ak + 1][ar] = f[1]; As[ak + 2][ar] = f[2]; As[ak + 3][ar] = f[3]; }
        { float4 w = make_float4(0.f, 0.f, 0.f, 0.f); if (n0 + wn < N) w = *(const float4*)(W + (size_t)(k0 + wk) * ldw + n0 + wn); *(float4*)&Ws[wk][wn] = w;
          if (EPI == 2) { float4 w2 = make_float4(0.f, 0.f, 0.f, 0.f); if (n0 + wn < N) w2 = *(const float4*)(W2 + (size_t)(k0 + wk) * ldw + n0 + wn); *(float4*)&W2s[wk][wn] = w2; } }
        __syncthreads();
#pragma unroll
        for (int kk = 0; kk < 16; ++kk) { const float4 a = *(const float4*)&As[kk][ty * 4]; const float4 w = *(const float4*)&Ws[kk][tx * 4]; const float av[4] = {a.x, a.y, a.z, a.w}, wv[4] = {w.x, w.y, w.z, w.w};
#pragma unroll
            for (int i = 0; i < 4; ++i)
#pragma unroll
                for (int j = 0; j < 4; ++j) acc[i][j] += av[i] * wv[j];
            if (EPI == 2) { const float4 w2 = *(const float4*)&W2s[kk][tx * 4]; const float w2v[4] = {w2.x, w2.y, w2.z, w2.w};
#pragma unroll
                for (int i = 0; i < 4; ++i)
#pragma unroll
                    for (int j = 0; j < 4; ++j) acc2[i][j] += av[i] * w2v[j]; } }
        __syncthreads();
    }
    const int n = n0 + tx * 4; if (n >= N) return;
#pragma unroll
    for (int i = 0; i < 4; ++i) { const int row = m0 + ty * 4 + i;
        if (EPI == 0) { float f[4] = {acc[i][0], acc[i][1], acc[i][2], acc[i][3]}; st4bf((bf16*)out + (size_t)row * ldo + n, f); }
        if (EPI == 1) { const float4 r = *(const float4*)(res + (size_t)row * ldo + n); *(float4*)((float*)out + (size_t)row * ldo + n) = make_float4(r.x + acc[i][0], r.y + acc[i][1], r.z + acc[i][2], r.w + acc[i][3]); }
        if (EPI == 2) { float f[4];
#pragma unroll
            for (int j = 0; j < 4; ++j) { const float g = acc[i][j]; f[j] = g / (1.f + expf(-g)) * acc2[i][j]; }
            st4bf((bf16*)out + (size_t)row * ldo + n, f); }
        if (EPI == 3) { const int tok = slot_tok[row]; if (tok >= 0) { const float gt = slot_gate[row]; float4* o = (float4*)((float*)out + (size_t)tok * ldo + n); float4 r = *o; r.x += gt * acc[i][0]; r.y += gt * acc[i][1]; r.z += gt * acc[i][2]; r.w += gt * acc[i][3]; *o = r; } }
    }
}

template <int DK, int DK1, int MODE> __global__ void __launch_bounds__(64) nv_attn(const bf16* Q, int ldq, int hq, const bf16* K, int ldk, int hk, const bf16* K2, int ldk2, const bf16* V, int ldv, int hv,
                                                                                    bf16* O, int ldo, int ho, const float* cum, float scale) {
    __shared__ float Ks[64][DK + 4]; __shared__ float Vs[64][68]; __shared__ float Cs[64];
    const int tid = threadIdx.x, h = blockIdx.y, z = blockIdx.z, row = blockIdx.x * 64 + tid, b = row / SEQ, qt = (blockIdx.x * 64 % SEQ) / 64;
    float q[DK];
    { const bf16* qp = Q + (size_t)row * ldq + h * hq;
#pragma unroll
      for (int d = 0; d < DK; d += 8) { float f[8]; ld8bf(qp + d, f);
#pragma unroll
          for (int i = 0; i < 8; ++i) q[d + i] = f[i] * scale; } }
    float o[64];
#pragma unroll
    for (int d = 0; d < 64; ++d) o[d] = 0.f;
    float m = -3.0e38f, l = 0.f; const float cq = (MODE == 0) ? cum[(size_t)row * 4 + h] : 0.f;
    const int ntile = (MODE == 2) ? 4 : qt + 1; const size_t kbase = (MODE == 2) ? (size_t)b * MEML : (size_t)b * SEQ;
    for (int kt = 0; kt < ntile; ++kt) {
        const size_t krow = kbase + kt * 64 + tid;
        { const bf16* kp = K + krow * ldk + h * hk;
#pragma unroll
          for (int d = 0; d < DK1; d += 8) { float f[8]; ld8bf(kp + d, f);
#pragma unroll
              for (int i = 0; i < 8; ++i) Ks[tid][d + i] = f[i]; }
          if (DK > DK1) { const bf16* kp2 = K2 + krow * ldk2;
#pragma unroll
              for (int d = 0; d < DK - DK1; d += 8) { float f[8]; ld8bf(kp2 + d, f);
#pragma unroll
                  for (int i = 0; i < 8; ++i) Ks[tid][DK1 + d + i] = f[i]; } }
          const bf16* vp = V + krow * ldv + h * hv + z * 64;
#pragma unroll
          for (int d = 0; d < 64; d += 8) { float f[8]; ld8bf(vp + d, f);
#pragma unroll
              for (int i = 0; i < 8; ++i) Vs[tid][d + i] = f[i]; }
          if (MODE == 0) Cs[tid] = cum[krow * 4 + h]; }
        __syncthreads();
        const int jmax = (MODE == 0 && kt == ntile - 1) ? tid : 63;
        for (int j = 0; j <= jmax; ++j) {
            float s = 0.f;
#pragma unroll
            for (int d = 0; d < DK; d += 4) { const float4 kv = *(const float4*)&Ks[j][d]; s += q[d] * kv.x + q[d + 1] * kv.y + q[d + 2] * kv.z + q[d + 3] * kv.w; }
            if (MODE == 0) s += cq - Cs[j];
            if (s > m) { const float sc = expf(m - s); l *= sc;
#pragma unroll
                for (int d = 0; d < 64; ++d) o[d] *= sc;
                m = s; }
            const float p = expf(s - m); l += p;
#pragma unroll
            for (int d = 0; d < 64; d += 4) { const float4 vv = *(const float4*)&Vs[j][d]; o[d] += p * vv.x; o[d + 1] += p * vv.y; o[d + 2] += p * vv.z; o[d + 3] += p * vv.w; }
        }
        __syncthreads();
    }
    const float il = 1.f / l; bf16* op = O + (size_t)row * ldo + h * ho + z * 64;
#pragma unroll
    for (int d = 0; d < 64; d += 8) { float f[8];
#pragma unroll
        for (int i = 0; i < 8; ++i) f[i] = o[d + i] * il;
        st8bf(op + d, f); }
}
__global__ void __launch_bounds__(256) nv_sgu(const bf16* PROJ, const float* wS, const float* bS, bf16* OMIX) {
    __shared__ float Vs[128][68];
    const int tid = threadIdx.x, win = blockIdx.x, g = blockIdx.y; const size_t row0 = (size_t)win * 128;
    for (int i = tid; i < 128 * 8; i += 256) { const int s = i >> 3, d = (i & 7) * 8; float f[8]; ld8bf(PROJ + (row0 + s) * PW + C_VB + g * 64 + d, f);
#pragma unroll
        for (int k = 0; k < 8; ++k) Vs[s][d + k] = f[k]; }
    __syncthreads();
    const int t = tid >> 1, dh = (tid & 1) * 32; float acc[32];
#pragma unroll
    for (int d = 0; d < 32; ++d) acc[d] = 0.f;
    const int smax = ((t >> 6) + 1) * 64; const float* wr = wS + (size_t)g * 16384 + t * 128;
    for (int s = 0; s < smax; ++s) { const float w = wr[s];
#pragma unroll
        for (int d = 0; d < 32; d += 4) { const float4 v = *(const float4*)&Vs[s][dh + d]; acc[d] += w * v.x; acc[d + 1] += w * v.y; acc[d + 2] += w * v.z; acc[d + 3] += w * v.w; } }
    const float bb = bS[g * 128 + t];
#pragma unroll
    for (int d = 0; d < 32; d += 8) { float u[8]; ld8bf(PROJ + (row0 + t) * PW + C_UB + g * 64 + dh + d, u);
#pragma unroll
        for (int k = 0; k < 8; ++k) u[k] *= (acc[d + k] + bb);
        st8bf(OMIX + (row0 + t) * 1024 + 256 + g * 64 + dh + d, u); }
}


#endif
#ifndef REP_ATTN
#define REP_ATTN 1
#endif
#ifndef REP_FOX
#define REP_FOX 1
#endif
#ifndef PROBE_MODE
#define PROBE_MODE 0
#endif
#ifndef REP_MLA
#define REP_MLA 1
#endif
#ifndef REP_SGU
#define REP_SGU 1
#endif
#ifndef REP_ATTM
#define REP_ATTM 1
#endif
#ifndef REP_G1
#define REP_G1 1
#endif
#ifndef REP_F1
#define REP_F1 1
#endif
#ifndef PRB
#define PRB 0
#endif
namespace pg8 {
typedef unsigned short bf16_t;
typedef short bf16x8 __attribute__((ext_vector_type(8)));
typedef float f32x4 __attribute__((ext_vector_type(4)));
typedef float f32x2 __attribute__((ext_vector_type(2)));
typedef unsigned u32x4 __attribute__((ext_vector_type(4)));
constexpr int BM = 256, BK = 64, HALF = 128, HTB = HALF * BK * 2, STAGE_BYTES = 8 * HTB, NXCD = 8, WGM = 8;
__host__ __device__ __forceinline__ int lds_byte(int r, int c) { const int st = (r >> 4) * 2 + (c >> 5), rr = r & 15, cc = c & 31, ob = rr * 64 + cc * 2; return st * 1024 + (ob ^ (((ob >> 9) & 1) << 5)); }
__host__ __device__ __forceinline__ void stage_rc(int b, int& R, int& C) { const int st = b / 1024, sb = b % 1024, swz = sb ^ (((sb >> 9) & 1) << 5); R = (st >> 1) * 16 + swz / 64; C = (st & 1) * 32 + (swz % 64) / 2; }
__host__ __device__ __forceinline__ int perm32(int rho) { const int n = rho >> 4, i = rho & 15; return 8 * (i >> 2) + 4 * n + (i & 3); }
struct Unit { int pm, pn; const char* a; const char* b; };
__device__ __forceinline__ unsigned cvt_pk_bf16(float lo, float hi) { unsigned r; asm volatile("v_cvt_pk_bf16_f32 %0, %1, %2" : "=v"(r) : "v"(lo), "v"(hi)); return r; }

struct DenseOrder {
    int nM, nN, nwg, G, c, pm0; const char* A; const char* B; size_t tA, tB;
    __device__ __forceinline__ void init(int nM_, int nN_, int G_, int c_, const void* A_, int lda, const void* B_, int K) { nM = nM_; nN = nN_; nwg = nM * nN; G = G_; c = c_; pm0 = 0; A = (const char*)A_; B = (const char*)B_; tA = (size_t)BM * lda * 2; tB = (size_t)BM * K * 2; }
    __device__ __forceinline__ bool map(int i, int& pm, int& pn) const {
        const long L = (long)i * G + c; if (L >= nwg) return false;
        int wgid = (int)L; { const int q = nwg / NXCD, r = nwg % NXCD, xcd = wgid % NXCD, off = wgid / NXCD; wgid = (xcd < r ? xcd * (q + 1) : r * (q + 1) + (xcd - r) * q) + off; }
        const int nig = WGM * nN, gid = wgid / nig, fm = gid * WGM, gsz = (nM - fm) < WGM ? (nM - fm) : WGM;
        pm = fm + ((wgid % nig) % gsz); pn = (wgid % nig) / gsz; return true; }
    __device__ __forceinline__ bool next(int i, Unit& u) const { int pm, pn; if (!map(i, pm, pn)) return false; u.pm = pm; u.pn = pn; u.a = A + (size_t)pm * tA; u.b = B + (size_t)pn * tB; return true; }
};
struct GroupOrder : DenseOrder {
    const int* tab; size_t estride;
    __device__ __forceinline__ bool next(int i, Unit& u) const { int pm, pn; if (!map(i, pm, pn)) return false; pm += pm0; u.pm = pm; u.pn = pn; const int e = tab[pm] & 7; u.a = A + (size_t)pm * tA; u.b = B + (size_t)e * estride + (size_t)pn * tB; return true; }
};
struct KvmOrder {
    int c; const char* A; const char* B; size_t bstride;
    __device__ __forceinline__ bool next(int i, Unit& u) const { if (i > 0 || c >= 128) return false; const int l2 = c >> 6, r = c & 63; u.pm = l2 * 16 + (r & 15); u.pn = r >> 4; u.a = A + (size_t)u.pm * (256 * 1024 * 2); u.b = B + (size_t)l2 * bstride + (size_t)u.pn * (256 * 1024 * 2); return true; }
};

struct EpiStore { static constexpr bool PERM = true; bf16_t* O; int ldc;
    __device__ __forceinline__ void operator()(const f32x4 (&acc)[2][2][4][2], const Unit& u, int wr, int wc, int fr, int fq) const {
        const int row0 = u.pm * BM + wr * 64 + fr, col0 = u.pn * BM + wc * 32 + 8 * fq;
#pragma unroll
        for (int ai = 0; ai < 2; ++ai)
#pragma unroll
            for (int m = 0; m < 4; ++m) { bf16_t* rowp = O + (size_t)(row0 + ai * HALF + m * 16) * ldc + col0;
#pragma unroll
                for (int bj = 0; bj < 2; ++bj) { const f32x4 v0 = acc[ai][bj][m][0], v1 = acc[ai][bj][m][1]; u32x4 w; w.x = cvt_pk_bf16(v0[0], v0[1]); w.y = cvt_pk_bf16(v0[2], v0[3]); w.z = cvt_pk_bf16(v1[0], v1[1]); w.w = cvt_pk_bf16(v1[2], v1[3]);
                    *(u32x4*)(rowp + bj * HALF) = w; } } } };
__device__ __forceinline__ void row_rs(const float* part, int row0, int fr, int fq, float (&rs)[2][4]) {
    const int lane = fr + 16 * fq;
#pragma unroll
    for (int ai = 0; ai < 2; ++ai)
#pragma unroll
        for (int m = 0; m < 4; ++m) { const f32x4 p = *(const f32x4*)(part + (size_t)(row0 + ai * HALF + m * 16) * 16 + 4 * fq); float s = (p[0] + p[1]) + (p[2] + p[3]);
            s += shx(s, lane, 16); s += shx(s, lane, 32); rs[ai][m] = rsqrtf(s * (1.f / 1024.f) + EPSF); }
}
struct EpiStoreN { static constexpr bool PERM = true; bf16_t* O; int ldc; const float* part;
    __device__ __forceinline__ void operator()(const f32x4 (&acc)[2][2][4][2], const Unit& u, int wr, int wc, int fr, int fq) const {
        const int row0 = u.pm * BM + wr * 64 + fr, col0 = u.pn * BM + wc * 32 + 8 * fq; float rs[2][4]; row_rs(part, row0, fr, fq, rs);
#pragma unroll
        for (int ai = 0; ai < 2; ++ai)
#pragma unroll
            for (int m = 0; m < 4; ++m) { bf16_t* rowp = O + (size_t)(row0 + ai * HALF + m * 16) * ldc + col0; const float r = rs[ai][m];
#pragma unroll
                for (int bj = 0; bj < 2; ++bj) { const f32x4 v0 = acc[ai][bj][m][0] * r, v1 = acc[ai][bj][m][1] * r; u32x4 w; w.x = cvt_pk_bf16(v0[0], v0[1]); w.y = cvt_pk_bf16(v0[2], v0[3]); w.z = cvt_pk_bf16(v1[0], v1[1]); w.w = cvt_pk_bf16(v1[2], v1[3]);
                    *(u32x4*)(rowp + bj * HALF) = w; } } } };
struct EpiRes { static constexpr bool PERM = true; bf16_t* xb; float* part;
    __device__ __forceinline__ void operator()(const f32x4 (&acc)[2][2][4][2], const Unit& u, int wr, int wc, int fr, int fq) const {
        const int row0 = u.pm * BM + wr * 64 + fr, col0 = u.pn * BM + wc * 32 + 8 * fq, lane = fr + 16 * fq;
        u32x4 rin[2][4][2];
#pragma unroll
        for (int ai = 0; ai < 2; ++ai)
#pragma unroll
            for (int m = 0; m < 4; ++m)
#pragma unroll
                for (int bj = 0; bj < 2; ++bj) rin[ai][m][bj] = *(const u32x4*)(xb + (size_t)(row0 + ai * HALF + m * 16) * 1024 + col0 + bj * HALF);
#pragma unroll
        for (int ai = 0; ai < 2; ++ai)
#pragma unroll
            for (int m = 0; m < 4; ++m) { const int row = row0 + ai * HALF + m * 16; const size_t off = (size_t)row * 1024 + col0; float ss = 0.f;
#pragma unroll
                for (int bj = 0; bj < 2; ++bj) { const u32x4 r = rin[ai][m][bj]; f32x4 v0, v1;
                    v0[0] = __uint_as_float(r.x << 16); v0[1] = __uint_as_float(r.x & 0xffff0000u); v0[2] = __uint_as_float(r.y << 16); v0[3] = __uint_as_float(r.y & 0xffff0000u);
                    v1[0] = __uint_as_float(r.z << 16); v1[1] = __uint_as_float(r.z & 0xffff0000u); v1[2] = __uint_as_float(r.w << 16); v1[3] = __uint_as_float(r.w & 0xffff0000u);
                    v0 += acc[ai][bj][m][0]; v1 += acc[ai][bj][m][1];
                    u32x4 w; w.x = cvt_pk_bf16(v0[0], v0[1]); w.y = cvt_pk_bf16(v0[2], v0[3]); w.z = cvt_pk_bf16(v1[0], v1[1]); w.w = cvt_pk_bf16(v1[2], v1[3]); *(u32x4*)(xb + off + bj * HALF) = w;
                    ss += (v0[0] * v0[0] + v0[1] * v0[1]) + (v0[2] * v0[2] + v0[3] * v0[3]) + (v1[0] * v1[0] + v1[1] * v1[1]) + (v1[2] * v1[2] + v1[3] * v1[3]); }
                ss += shx(ss, lane, 16); ss += shx(ss, lane, 32); if (fq == 0) part[(size_t)row * 16 + 4 * u.pn + wc] = ss; } } };
__device__ __forceinline__ float silu_mul(float g, float u) { return g * __builtin_amdgcn_rcpf(1.0f + __builtin_amdgcn_exp2f(-1.4426950408889634f * g)) * u; }
struct EpiSwiglu { static constexpr bool PERM = true; bf16_t* O; int ldc; const float* part; const float* rsrow;
    __device__ __forceinline__ void operator()(const f32x4 (&acc)[2][2][4][2], const Unit& u, int wr, int wc, int fr, int fq) const {
        const int row0 = u.pm * BM + wr * 64 + fr, col0 = u.pn * HALF + wc * 32 + 8 * fq; float rs[2][4];
        if (part) row_rs(part, row0, fr, fq, rs);
        else {
#pragma unroll
            for (int ai = 0; ai < 2; ++ai)
#pragma unroll
                for (int m = 0; m < 4; ++m) rs[ai][m] = rsrow[row0 + ai * HALF + m * 16]; }
#pragma unroll
        for (int ai = 0; ai < 2; ++ai)
#pragma unroll
            for (int m = 0; m < 4; ++m) { const float r = rs[ai][m]; const f32x4 g0 = acc[ai][0][m][0] * r, g1 = acc[ai][0][m][1] * r, u0 = acc[ai][1][m][0] * r, u1 = acc[ai][1][m][1] * r; u32x4 w;
                w.x = cvt_pk_bf16(silu_mul(g0[0], u0[0]), silu_mul(g0[1], u0[1])); w.y = cvt_pk_bf16(silu_mul(g0[2], u0[2]), silu_mul(g0[3], u0[3]));
                w.z = cvt_pk_bf16(silu_mul(g1[0], u1[0]), silu_mul(g1[1], u1[1])); w.w = cvt_pk_bf16(silu_mul(g1[2], u1[2]), silu_mul(g1[3], u1[3]));
                *(u32x4*)(O + (size_t)(row0 + ai * HALF + m * 16) * ldc + col0) = w; } } };
template <bool FINAL> struct EpiScatter { static constexpr bool PERM = true; bf16_t* xb; float* out; const int* tok; const float* gate;
    __device__ __forceinline__ void operator()(const f32x4 (&acc)[2][2][4][2], const Unit& u, int wr, int wc, int fr, int fq) const {
        const int row0 = u.pm * BM + wr * 64 + fr, col0 = u.pn * BM + wc * 32 + 8 * fq;
#pragma unroll
        for (int ai = 0; ai < 2; ++ai)
#pragma unroll
            for (int m = 0; m < 4; ++m) { const int row = row0 + ai * HALF + m * 16; const int t = tok[row]; const float g = gate[row];
                if (t >= 0) { const size_t off = (size_t)t * 1024 + col0;
#pragma unroll
                    for (int bj = 0; bj < 2; ++bj) { const u32x4 r = *(const u32x4*)(xb + off + bj * HALF); f32x4 v0, v1;
                        v0[0] = __uint_as_float(r.x << 16); v0[1] = __uint_as_float(r.x & 0xffff0000u); v0[2] = __uint_as_float(r.y << 16); v0[3] = __uint_as_float(r.y & 0xffff0000u);
                        v1[0] = __uint_as_float(r.z << 16); v1[1] = __uint_as_float(r.z & 0xffff0000u); v1[2] = __uint_as_float(r.w << 16); v1[3] = __uint_as_float(r.w & 0xffff0000u);
                        v0 += g * acc[ai][bj][m][0]; v1 += g * acc[ai][bj][m][1];
                        if (FINAL) { *(f32x4*)(out + off + bj * HALF) = v0; *(f32x4*)(out + off + bj * HALF + 4) = v1; }
                        else { u32x4 w; w.x = cvt_pk_bf16(v0[0], v0[1]); w.y = cvt_pk_bf16(v0[2], v0[3]); w.z = cvt_pk_bf16(v1[0], v1[1]); w.w = cvt_pk_bf16(v1[2], v1[3]); *(u32x4*)(xb + off + bj * HALF) = w; } } }
                asm volatile("" ::: "memory"); } } };

template <class Epi, class Sched, bool ALIGN_EPI, bool SP2>
__device__ __forceinline__ void gemm_phase(LAS unsigned char* lds, const int K, const int lda, const Sched& S, const Epi& E, const int tid_in) {
    const int tid = tid_in, wid = __builtin_amdgcn_readfirstlane(tid >> 6), lane = tid & 63, wr = wid >> 2, wc = wid & 3, fr = lane & 15, fq = lane >> 4;
    int nt = K / BK; asm volatile("" : "+s"(nt));
    unsigned voffA[2], voffB[2];
#pragma unroll
    for (int i = 0; i < 2; ++i) { int R, C; stage_rc(tid * 16 + i * 8192, R, C); const int Rb = Epi::PERM ? ((R & ~31) + perm32(R & 31)) : R;
        voffA[i] = (unsigned)(R * lda + C) * 2u; voffB[i] = (unsigned)(Rb * K + C) * 2u; }
    const size_t kstep = (size_t)(BK * 2);
    const size_t hA = (size_t)HALF * lda * 2, hB = (size_t)HALF * K * 2;
    const unsigned ldsw = (unsigned)wid * 1024u;
    const int aoff = lds_byte(wr * 64 + fr, fq * 8), boff = lds_byte(wc * 32 + fr, fq * 8);
#define PG8_SA(b, h) (((b) * 2 + (h)) * HTB)
#define PG8_SB(b, h) ((4 + (b) * 2 + (h)) * HTB)
#define PG8_STAGE(bufoff, gbase, voff) do { _Pragma("unroll") for (int _i = 0; _i < 2; ++_i) \
        __builtin_amdgcn_global_load_lds((const unsigned*)((const char*)(gbase) + (voff)[_i]), (LAS unsigned*)(lds + (bufoff) + ldsw + _i * 8192), 16, 0, 0); } while (0)
#define PG8_LDA(dst, b, h) do { _Pragma("unroll") for (int m = 0; m < 4; ++m) _Pragma("unroll") for (int k = 0; k < 2; ++k) dst[m][k] = *(const LAS bf16x8*)(lds + PG8_SA(b, h) + aoff + m * 2048 + k * 1024); } while (0)
#define PG8_LDB(dst, b, h) do { _Pragma("unroll") for (int n = 0; n < 2; ++n) _Pragma("unroll") for (int k = 0; k < 2; ++k) dst[n][k] = *(const LAS bf16x8*)(lds + PG8_SB(b, h) + boff + n * 2048 + k * 1024); } while (0)
#define PG8_MMA(ai, bj, At, Bt) do { __builtin_amdgcn_s_setprio(1); _Pragma("unroll") for (int m = 0; m < 4; ++m) _Pragma("unroll") for (int n = 0; n < 2; ++n) _Pragma("unroll") for (int k = 0; k < 2; ++k) \
        acc[ai][bj][m][n] = __builtin_amdgcn_mfma_f32_16x16x32_bf16(Bt[n][k], At[m][k], acc[ai][bj][m][n], 0, 0, 0); __builtin_amdgcn_s_setprio(0); } while (0)
#define PG8_WAIT_V(n) asm volatile("s_waitcnt vmcnt(" #n ")" ::: "memory")
#define PG8_WAIT_L(n) asm volatile("s_waitcnt lgkmcnt(" #n ")" ::: "memory")
#define PG8_BAR __builtin_amdgcn_s_barrier()
#define PG8_SCHED __builtin_amdgcn_sched_barrier(0)
    Unit cur, nxt; int ui = 0;
    if (!S.next(0, cur)) return;
    f32x4 acc[2][2][4][2];
#pragma unroll
    for (int a = 0; a < 2; ++a)
#pragma unroll
        for (int b = 0; b < 2; ++b)
#pragma unroll
            for (int m = 0; m < 4; ++m)
#pragma unroll
                for (int n = 0; n < 2; ++n) acc[a][b][m][n] = (f32x4){0.f, 0.f, 0.f, 0.f};
    bf16x8 At[4][2], B0[2][2], B1[2][2];
    const char* cA = cur.a; const char* cB = cur.b;
    if constexpr (SP2) {
        PG8_STAGE(PG8_SB(0, 0), cB, voffB); PG8_STAGE(PG8_SB(0, 1), cB + hB, voffB); PG8_STAGE(PG8_SA(0, 0), cA, voffA); PG8_STAGE(PG8_SA(0, 1), cA + hA, voffA);
        if (wr == 1) PG8_BAR;
        PG8_WAIT_V(2); PG8_BAR;
        PG8_STAGE(PG8_SB(1, 0), cB + kstep, voffB); PG8_STAGE(PG8_SA(1, 0), cA + kstep, voffA); PG8_STAGE(PG8_SB(1, 1), cB + hB + kstep, voffB);
        PG8_WAIT_V(6); PG8_BAR;
    } else {
        PG8_STAGE(PG8_SB(0, 0), cB, voffB); PG8_STAGE(PG8_SA(0, 0), cA, voffA); PG8_STAGE(PG8_SB(0, 1), cB + hB, voffB); PG8_STAGE(PG8_SA(0, 1), cA + hA, voffA);
        if (wr == 1) PG8_BAR;
        PG8_WAIT_V(4); PG8_BAR;
        PG8_STAGE(PG8_SB(1, 0), cB + kstep, voffB); PG8_STAGE(PG8_SA(1, 0), cA + kstep, voffA); PG8_STAGE(PG8_SB(1, 1), cB + hB + kstep, voffB);
        PG8_WAIT_V(6); PG8_BAR;
    }
    for (;;) {
        const bool has_next = S.next(ui + 1, nxt);
        const char* nA = has_next ? nxt.a : cA; const char* nB = has_next ? nxt.b : cB;
        for (int t = 0; t < nt; t += 2) {
            const bool last = (t == nt - 2);
            const char* a1 = cA + (size_t)(t + 1) * kstep;
            const char* a2 = last ? nA : cA + (size_t)(t + 2) * kstep; const char* b2 = last ? nB : cB + (size_t)(t + 2) * kstep;
            const char* a3 = a2 + kstep; const char* b3 = b2 + kstep;
            if constexpr (SP2) {
            PG8_LDB(B0, 0, 0); PG8_LDB(B1, 0, 1); PG8_SCHED; PG8_LDA(At, 0, 0); PG8_STAGE(PG8_SA(1, 1), a1 + hA, voffA);
            PG8_WAIT_V(8); PG8_WAIT_L(0); PG8_BAR; PG8_MMA(0, 0, At, B0); PG8_MMA(0, 1, At, B1); PG8_BAR; PG8_SCHED;
            PG8_LDA(At, 0, 1); PG8_STAGE(PG8_SB(0, 0), b2, voffB); PG8_STAGE(PG8_SB(0, 1), b2 + hB, voffB); PG8_STAGE(PG8_SA(0, 0), a2, voffA);
            PG8_WAIT_V(8); PG8_WAIT_L(0); PG8_BAR; PG8_MMA(1, 0, At, B0); PG8_MMA(1, 1, At, B1); PG8_BAR; PG8_SCHED;
            PG8_LDB(B0, 1, 0); PG8_LDB(B1, 1, 1); PG8_SCHED; PG8_LDA(At, 1, 0); PG8_STAGE(PG8_SA(0, 1), a2 + hA, voffA);
            PG8_WAIT_V(8); PG8_WAIT_L(0); PG8_BAR; PG8_MMA(0, 0, At, B0); PG8_MMA(0, 1, At, B1); PG8_BAR; PG8_SCHED;
            PG8_LDA(At, 1, 1); PG8_STAGE(PG8_SB(1, 0), b3, voffB); PG8_STAGE(PG8_SB(1, 1), b3 + hB, voffB); PG8_STAGE(PG8_SA(1, 0), a3, voffA);
            PG8_WAIT_V(8); PG8_WAIT_L(0); PG8_BAR; PG8_MMA(1, 0, At, B0); PG8_MMA(1, 1, At, B1); PG8_BAR; PG8_SCHED;
            } else {
            PG8_LDB(B0, 0, 0); PG8_SCHED; PG8_LDA(At, 0, 0); PG8_STAGE(PG8_SA(1, 1), a1 + hA, voffA);
            PG8_WAIT_L(8); PG8_BAR; PG8_WAIT_L(0); PG8_MMA(0, 0, At, B0); PG8_BAR; PG8_SCHED;
            PG8_LDB(B1, 0, 1); PG8_STAGE(PG8_SB(0, 0), b2, voffB);
            PG8_BAR; PG8_WAIT_L(0); PG8_MMA(0, 1, At, B1); PG8_BAR;
            PG8_LDA(At, 0, 1); PG8_STAGE(PG8_SA(0, 0), a2, voffA);
            PG8_BAR; PG8_WAIT_L(0); PG8_MMA(1, 0, At, B0); PG8_BAR; PG8_SCHED;
            PG8_STAGE(PG8_SB(0, 1), b2 + hB, voffB);
            PG8_WAIT_V(6); PG8_BAR; PG8_MMA(1, 1, At, B1); PG8_BAR;
            PG8_LDB(B0, 1, 0); PG8_SCHED; PG8_LDA(At, 1, 0); PG8_STAGE(PG8_SA(0, 1), a2 + hA, voffA);
            PG8_WAIT_L(8); PG8_BAR; PG8_WAIT_L(0); PG8_MMA(0, 0, At, B0); PG8_BAR; PG8_SCHED;
            PG8_LDB(B1, 1, 1); PG8_STAGE(PG8_SB(1, 0), b3, voffB);
            PG8_BAR; PG8_WAIT_L(0); PG8_MMA(0, 1, At, B1); PG8_BAR;
            PG8_LDA(At, 1, 1); PG8_STAGE(PG8_SA(1, 0), a3, voffA);
            PG8_BAR; PG8_WAIT_L(0); PG8_MMA(1, 0, At, B0); PG8_BAR; PG8_SCHED;
            PG8_STAGE(PG8_SB(1, 1), b3 + hB, voffB);
            PG8_WAIT_V(6); PG8_BAR; PG8_MMA(1, 1, At, B1); PG8_BAR;
            }
        }
        if constexpr (ALIGN_EPI) { if (wr == 0) PG8_BAR; }
        { int fr_e = fr, fq_e = fq; asm volatile("" : "+v"(fr_e), "+v"(fq_e));
          E(acc, cur, wr, wc, fr_e, fq_e); }
        if (!has_next) break;
#pragma unroll
        for (int a = 0; a < 2; ++a)
#pragma unroll
            for (int b = 0; b < 2; ++b)
#pragma unroll
                for (int m = 0; m < 4; ++m)
#pragma unroll
                    for (int n = 0; n < 2; ++n) acc[a][b][m][n] = (f32x4){0.f, 0.f, 0.f, 0.f};
        cur = nxt; cA = nA; cB = nB; ++ui;
        if constexpr (ALIGN_EPI) { if (wr == 1) PG8_BAR; }
    }
    PG8_WAIT_V(0);
    if constexpr (!ALIGN_EPI) { if (wr == 0) PG8_BAR; }
    PG8_BAR;
#undef PG8_SA
#undef PG8_SB
#undef PG8_STAGE
#undef PG8_LDA
#undef PG8_LDB
#undef PG8_MMA
#undef PG8_WAIT_V
#undef PG8_WAIT_L
#undef PG8_BAR
#undef PG8_SCHED
}
}

namespace att {
typedef short bf16x8 __attribute__((ext_vector_type(8)));
typedef short s16x4 __attribute__((ext_vector_type(4)));
typedef short v4i16_t __attribute__((ext_vector_type(4)));
typedef float f32x16 __attribute__((ext_vector_type(16)));
typedef float f32x4 __attribute__((ext_vector_type(4)));
typedef unsigned u32x4 __attribute__((ext_vector_type(4)));
typedef float f32x2_t __attribute__((ext_vector_type(2))); typedef __bf16 bf16x2_t __attribute__((ext_vector_type(2)));
__device__ __forceinline__ int crow(int r, int hi) { return (r & 3) + 8 * (r >> 2) + 4 * hi; }
__device__ __forceinline__ void glds16(const void* gsrc, unsigned lds_dst) { unsigned keep;
    asm volatile("s_mov_b32 %0, m0\n\ts_mov_b32 m0, %2\n\ts_nop 0\n\tglobal_load_lds_dwordx4 %1, off\n\ts_mov_b32 m0, %0" : "=&s"(keep) : "v"(gsrc), "s"(lds_dst) : "memory"); }
__device__ __forceinline__ unsigned cvtpk(float lo, float hi) { f32x2_t v = {lo, hi}; bf16x2_t b = __builtin_convertvector(v, bf16x2_t); return __builtin_bit_cast(unsigned, b); }
__device__ __forceinline__ s16x4 vtr(const LAS unsigned char* p) { return __builtin_bit_cast(s16x4, __builtin_amdgcn_ds_read_tr16_b64_v4i16((LAS v4i16_t*)p)); }
__device__ __forceinline__ float half_max(float m) { auto rr = __builtin_amdgcn_permlane32_swap(__float_as_uint(m), __float_as_uint(m), false, false); return fmaxf(__uint_as_float(rr[0]), __uint_as_float(rr[1])); }
__device__ __forceinline__ float half_sum(float m) { auto rr = __builtin_amdgcn_permlane32_swap(__float_as_uint(m), __float_as_uint(m), false, false); return __uint_as_float(rr[0]) + __uint_as_float(rr[1]); }
__device__ __forceinline__ bf16x8 scale8(bf16x8 v, float s) { u32x4 u = __builtin_bit_cast(u32x4, v); u32x4 o;
#pragma unroll
    for (int i = 0; i < 4; ++i) { const float a = __uint_as_float(u[i] << 16) * s, b = __uint_as_float(u[i] & 0xffff0000u) * s; o[i] = cvtpk(a, b); }
    return __builtin_bit_cast(bf16x8, o); }
#define ATT_WAITBAR(N) asm volatile("s_waitcnt vmcnt(%0) lgkmcnt(0)\n\ts_barrier" :: "n"(N) : "memory")

__device__ __forceinline__ float max3f(float a, float b, float c) { return __builtin_fmaxf(__builtin_fmaxf(a, b), c); }
template <int DK, int DV, int MODE, int PROBE = 0>
__device__ __forceinline__ void attn_unit(LAS unsigned char* shm, const bf16* Qw, int ldq, float qscale, const bf16* Kh, int ldk, const bf16* K2, int ldk2, const bf16* Vh, int ldv,
                                          bf16* Ow, int ldo, int q0, int NT, int tid) {
    constexpr int ND = DK / 16 + (MODE == 0 ? 1 : 0), NO = DV / 32, PD = (MODE == 2) ? 2 : 4, NSK = PD + 1, NSV = PD + 2;
    constexpr int KSLOT = (MODE == 0 ? 10 : DK / 8) * 1024, VSLOT = DV * 128;
    constexpr int LDS_K = 0, LDS_V = NSK * KSLOT, LDS_WS = LDS_V + NSV * VSLOT;
    constexpr int NPT = (DK > 64 ? 2 : 1) + (DV > 64 ? 2 : 1);
    const int lane = tid & 63, r32 = lane & 31, hi = lane >> 5, wid = __builtin_amdgcn_readfirstlane(tid >> 6), half = wid >> 2;
    const unsigned lds0 = (unsigned)(uintptr_t)shm;
    LAS float* wsf = (LAS float*)(shm + LDS_WS) + wid * 64;
    bf16x8 qr[ND];
    if (MODE == 2) {
        float ss = 0.f;
#pragma unroll
        for (int d0 = 0; d0 < DK / 16; ++d0) { qr[d0] = *(const bf16x8*)(Qw + (size_t)r32 * ldq + d0 * 16 + hi * 8); const u32x4 u = __builtin_bit_cast(u32x4, qr[d0]);
#pragma unroll
            for (int i = 0; i < 4; ++i) { const float a = __uint_as_float(u[i] << 16), b = __uint_as_float(u[i] & 0xffff0000u); ss += a * a + b * b; } }
        const float fac = rsqrtf(half_sum(ss) * (1.f / (float)DK) + EPSF) * qscale;
#pragma unroll
        for (int d0 = 0; d0 < DK / 16; ++d0) qr[d0] = scale8(qr[d0], fac);
    } else {
#pragma unroll
    for (int d0 = 0; d0 < DK / 16; ++d0) qr[d0] = scale8(*(const bf16x8*)(Qw + (size_t)r32 * ldq + d0 * 16 + hi * 8), qscale);
    }
    if (MODE == 0) { const short one = (short)0x3f80; qr[ND - 1] = hi ? (bf16x8){0, 0, 0, 0, 0, 0, 0, 0} : (bf16x8){one, one, one, 0, 0, 0, 0, 0}; }
    asm volatile("" ::: "memory");
    const bf16* ksrc = Kh + (size_t)lane * ldk + wid * 8;
    const bf16* k2src = (MODE == 0) ? (K2 + (size_t)lane * 8) : (DK == 96) ? (K2 + (size_t)lane * ldk2 + (wid & 3) * 8) : (Kh + (size_t)lane * ldk + (8 + wid) * 8);
    const size_t k2step = (MODE == 0) ? (size_t)64 * 8 : (DK == 96) ? (size_t)64 * ldk2 : (size_t)64 * ldk;
    const int k2chunk = (MODE == 0) ? 8 : (DK == 96) ? 8 + (wid & 3) : 8 + wid;
    const bool k2do = (MODE == 0) ? (wid == 0) : (DK > 64);
    const bf16* vsrc = Vh + (size_t)(16 * (wid & 3) + (lane >> 2)) * ldv + (wid >> 2) * 32 + (lane & 3) * 8;
#define ATT_DMA(t, ks_, vs_) do { glds16(ksrc + (size_t)(t) * 64 * ldk, (unsigned)__builtin_amdgcn_readfirstlane(lds0 + LDS_K + (ks_) * KSLOT + wid * 1024)); \
        if (k2do) glds16(k2src + (size_t)(t) * k2step, (unsigned)__builtin_amdgcn_readfirstlane(lds0 + LDS_K + (ks_) * KSLOT + k2chunk * 1024)); \
        glds16(vsrc + (size_t)(t) * 64 * ldv, (unsigned)__builtin_amdgcn_readfirstlane(lds0 + LDS_V + (vs_) * VSLOT + wid * 1024)); \
        if (DV > 64) glds16(vsrc + 64 + (size_t)(t) * 64 * ldv, (unsigned)__builtin_amdgcn_readfirstlane(lds0 + LDS_V + (vs_) * VSLOT + (wid + 8) * 1024)); } while (0)
#define ATT_WAITGRP(keep) do { const int k_ = (keep); if (MODE == 0 && wid == 0) { if (k_ <= 0) ATT_WAITBAR(0); else if (k_ == 1) ATT_WAITBAR(NPT + 1); else if (k_ == 2) ATT_WAITBAR(2 * (NPT + 1)); else ATT_WAITBAR(3 * (NPT + 1)); } \
        else { if (k_ <= 0) ATT_WAITBAR(0); else if (k_ == 1) ATT_WAITBAR(NPT); else if (k_ == 2) ATT_WAITBAR(2 * NPT); else ATT_WAITBAR(3 * NPT); } } while (0)
#pragma unroll
    for (int i = 0; i < PD; ++i) if (i < NT) ATT_DMA(i, i, i);
    if (half == 1) ATT_WAITGRP((NT < PD ? NT : PD) - 1);
    float mhat = 0.f, l_reg = 0.f; f32x16 o[NO]; f32x16 negm = f32x16{};
#pragma unroll
    for (int d = 0; d < NO; ++d) o[d] = f32x16{};
    u32x4 pw[4] = {};
    const int qmin = q0 + 32 * wid;
    int ks = 0, ks2 = PD % NSK, vs1 = NSV - 1, vs2 = PD % NSV;
    bool pvis = false;
#define ATT_SCHED() __builtin_amdgcn_sched_barrier(0)
#define ATT_VLOAD(vfr, vslot) do { const LAS unsigned char* vp = shm + LDS_V + (vslot) * VSLOT + ((lane >> 4) & 1) * 32 + (lane & 3) * 8 + (4 * hi + ((lane & 15) >> 2)) * 64; \
        _Pragma("unroll") for (int k4 = 0; k4 < 4; ++k4) _Pragma("unroll") for (int d0 = 0; d0 < NO; ++d0) { const s16x4 lo = vtr(vp + d0 * 4096 + k4 * 1024), hh = vtr(vp + d0 * 4096 + k4 * 1024 + 512); \
            vfr[k4][d0] = (bf16x8){lo[0], lo[1], lo[2], lo[3], hh[0], hh[1], hh[2], hh[3]}; } } while (0)
#define ATT_PVMMA(vfr) do { _Pragma("unroll") for (int k4 = 0; k4 < 4; ++k4) _Pragma("unroll") for (int d0 = 0; d0 < NO; ++d0) \
            o[d0] = __builtin_amdgcn_mfma_f32_32x32x16_bf16(__builtin_bit_cast(bf16x8, pw[k4]), vfr[k4][d0], o[d0], 0, 0, 0); } while (0)
    for (int t = 0; t < NT; ++t) {
        { const int rem = NT - t; ATT_WAITGRP((rem < PD ? rem : PD) - 1); }
        if (t + PD < NT) ATT_DMA(t + PD, ks2, vs2);
        const bool vis0 = (MODE == 2) ? true : (MODE == 1 ? (t <= (qmin >> 6)) : (64 * t <= qmin + 31));
        const bool vis = (PROBE == 1) ? false : vis0;
        f32x16 p0 = f32x16{}, p1 = f32x16{};
        {
            bf16x8 vfr[4][NO]; bf16x8 kf[ND][2];
            ATT_SCHED();
            if (pvis) ATT_VLOAD(vfr, vs1);
            if (DV > 64) { ATT_SCHED(); if (pvis) ATT_PVMMA(vfr); ATT_SCHED(); }
            if (vis) {
                const LAS unsigned char* kb = shm + LDS_K + ks * KSLOT + hi * 1024 + r32 * 16;
#pragma unroll
                for (int d0 = 0; d0 < ND; ++d0) { const LAS unsigned char* kp = (MODE == 0 && d0 == ND - 1) ? (shm + LDS_K + ks * KSLOT + 8 * 1024 + r32 * 16) : (kb + d0 * 2048);
                    kf[d0][0] = *(const LAS bf16x8*)(kp); kf[d0][1] = *(const LAS bf16x8*)(kp + 512); }
            }
            ATT_SCHED();
            if (DV <= 64) { if (pvis) ATT_PVMMA(vfr); }
            if (vis) {
#pragma unroll
                for (int d0 = 0; d0 < ND; ++d0) {
                    if (d0 == 0) { p0 = __builtin_amdgcn_mfma_f32_32x32x16_bf16(kf[0][0], qr[0], negm, 0, 0, 0); p1 = __builtin_amdgcn_mfma_f32_32x32x16_bf16(kf[0][1], qr[0], negm, 0, 0, 0); }
                    else { p0 = __builtin_amdgcn_mfma_f32_32x32x16_bf16(kf[d0][0], qr[d0], p0, 0, 0, 0); p1 = __builtin_amdgcn_mfma_f32_32x32x16_bf16(kf[d0][1], qr[d0], p1, 0, 0, 0); } }
            }
            ATT_SCHED();
        }
        { const int rem = NT - t - 1; ATT_WAITGRP((rem < PD ? rem : PD) - 1); }
        if (vis && PROBE != 2) {
            if (MODE == 0) { if (64 * t + 63 > qmin) { const int q = qmin + r32;
#pragma unroll
                    for (int r = 0; r < 16; ++r) { const int kv = 64 * t + crow(r, hi); if (kv > q) p0[r] = -INFINITY; if (kv + 32 > q) p1[r] = -INFINITY; } } }
            float ma = max3f(p0[0], p0[1], p1[0]), mb = max3f(p0[2], p0[3], p1[1]); ma = max3f(ma, p1[2], p1[3]);
#pragma unroll
            for (int r = 4; r < 16; r += 4) { ma = max3f(ma, p0[r], p0[r + 1]); mb = max3f(mb, p0[r + 2], p0[r + 3]); ma = max3f(ma, p1[r], p1[r + 1]); mb = max3f(mb, p1[r + 2], p1[r + 3]); }
            const float rm = half_max(fmaxf(ma, mb));
            if (t == 0 || __any(rm > 8.0f)) { const float dl = (t == 0) ? rm : fmaxf(rm, 0.f); mhat += dl;
#pragma unroll
                for (int r = 0; r < 16; ++r) { p0[r] -= dl; p1[r] -= dl; negm[r] = -mhat; }
                if (t > 0) { const float f = __builtin_amdgcn_exp2f(-dl); l_reg *= f;
                    if (hi == 0) wsf[r32] = f;
                    asm volatile("s_waitcnt lgkmcnt(0)" ::: "memory");
#pragma unroll
                    for (int r = 0; r < 16; ++r) { const float fr_ = wsf[crow(r, hi)];
#pragma unroll
                        for (int d = 0; d < NO; ++d) o[d][r] *= fr_; }
                    asm volatile("s_waitcnt lgkmcnt(0)" ::: "memory"); } }
            float sa = 0.f, sb = 0.f;
#pragma unroll
            for (int r = 0; r < 16; ++r) { p0[r] = __builtin_amdgcn_exp2f(p0[r]); p1[r] = __builtin_amdgcn_exp2f(p1[r]); sa += p0[r]; sb += p1[r]; }
            l_reg += sa + sb;
#pragma unroll
            for (int i = 0; i < 4; ++i) { pw[0][i] = cvtpk(p0[2 * i], p0[2 * i + 1]); pw[1][i] = cvtpk(p0[8 + 2 * i], p0[9 + 2 * i]); pw[2][i] = cvtpk(p1[2 * i], p1[2 * i + 1]); pw[3][i] = cvtpk(p1[8 + 2 * i], p1[9 + 2 * i]); }
        }
        pvis = vis;
        ks = (ks == NSK - 1) ? 0 : ks + 1; ks2 = (ks2 == NSK - 1) ? 0 : ks2 + 1; vs1 = (vs1 == NSV - 1) ? 0 : vs1 + 1; vs2 = (vs2 == NSV - 1) ? 0 : vs2 + 1;
    }
    if (pvis) { bf16x8 vfr[4][NO]; ATT_SCHED(); ATT_VLOAD(vfr, vs1); ATT_SCHED(); ATT_PVMMA(vfr); ATT_SCHED(); }
#undef ATT_VLOAD
#undef ATT_PVMMA
#undef ATT_SCHED
#undef ATT_DMA
#undef ATT_WAITGRP
    l_reg = half_sum(l_reg);
    if (half == 0) asm volatile("s_waitcnt lgkmcnt(0)\n\ts_barrier" ::: "memory");
    ATT_WAITBAR(0);
    if (hi == 0) wsf[32 + r32] = l_reg;
    asm volatile("s_waitcnt lgkmcnt(0)" ::: "memory");
    float rli[16];
#pragma unroll
    for (int r = 0; r < 16; ++r) rli[r] = __builtin_amdgcn_rcpf(wsf[32 + crow(r, hi)]);
    LAS bf16* stg = (LAS bf16*)shm + wid * (32 * DV);
#pragma unroll
    for (int r = 0; r < 16; ++r) { const int orow = crow(r, hi);
#pragma unroll
        for (int d0 = 0; d0 < NO; ++d0) stg[orow * DV + d0 * 32 + r32] = f2bf(o[d0][r] * rli[r]); }
    asm volatile("s_waitcnt lgkmcnt(0)" ::: "memory");
    constexpr int CPR = DV / 8;
#pragma unroll
    for (int i = 0; i < (32 * CPR) / 64; ++i) { const int idx = i * 64 + lane, row = idx / CPR, ch = idx % CPR; const u32x4 v = *(const LAS u32x4*)(stg + row * DV + ch * 8); *(u32x4*)(Ow + (size_t)row * ldo + ch * 8) = v; }
    ATT_WAITBAR(0);
}

__device__ __forceinline__ void sgu_unit(LAS unsigned char* shm, const bf16* PROJ, const bf16* Wb  , const float* bS, bf16* OMIX, int win, int g, int tid) {
    const int lane = tid & 63, r32 = lane & 31, hi = lane >> 5, wid = __builtin_amdgcn_readfirstlane(tid >> 6);
    const unsigned lds0 = (unsigned)(uintptr_t)shm; const size_t row0 = (size_t)win * 128;
    const bf16* Vh = PROJ + row0 * PW + C_VB + g * 64;
    const bf16* vsrc = Vh + (size_t)(16 * (wid & 3) + (lane >> 2)) * PW + (wid >> 2) * 32 + (lane & 3) * 8;
    glds16(vsrc, (unsigned)__builtin_amdgcn_readfirstlane(lds0 + wid * 1024)); glds16(vsrc + (size_t)64 * PW, (unsigned)__builtin_amdgcn_readfirstlane(lds0 + 8192 + wid * 1024));
    const int tb = wid >> 1, db = wid & 1, t = 32 * tb + r32;
    const bf16* wrow = Wb + (size_t)g * 16384 + (size_t)t * 128;
    const int ntile = (tb < 2) ? 1 : 2;
    uint2 wa[2][4][2];
#pragma unroll
    for (int tl = 0; tl < 2; ++tl)
#pragma unroll
        for (int ks = 0; ks < 4; ++ks) { if (tl < ntile) { wa[tl][ks][0] = *(const uint2*)(wrow + 64 * tl + 16 * ks + 4 * hi); wa[tl][ks][1] = *(const uint2*)(wrow + 64 * tl + 16 * ks + 8 + 4 * hi); } else { wa[tl][ks][0] = make_uint2(0u, 0u); wa[tl][ks][1] = make_uint2(0u, 0u); } }
    ATT_WAITBAR(0);
    f32x16 o = f32x16{};
    const LAS unsigned char* vp = shm + ((lane >> 4) & 1) * 32 + (lane & 3) * 8 + (4 * hi + ((lane & 15) >> 2)) * 64 + db * 4096;
#pragma unroll
    for (int tl = 0; tl < 2; ++tl) { if (tl < ntile) {
#pragma unroll
        for (int ks = 0; ks < 4; ++ks) { const s16x4 lo = vtr(vp + tl * 8192 + ks * 1024), hh = vtr(vp + tl * 8192 + ks * 1024 + 512);
            const bf16x8 vf = (bf16x8){lo[0], lo[1], lo[2], lo[3], hh[0], hh[1], hh[2], hh[3]};
            const u32x4 au = {wa[tl][ks][0].x, wa[tl][ks][0].y, wa[tl][ks][1].x, wa[tl][ks][1].y};
            o = __builtin_amdgcn_mfma_f32_32x32x16_bf16(__builtin_bit_cast(bf16x8, au), vf, o, 0, 0, 0); } } }
    const int d = 32 * db + r32;
#pragma unroll
    for (int r = 0; r < 16; ++r) { const int tt = 32 * tb + crow(r, hi); const size_t row = row0 + tt;
        const float u = bf2f(PROJ[row * PW + C_UB + g * 64 + d]); OMIX[row * 1024 + 256 + g * 64 + d] = f2bf(u * (o[r] + bS[g * 128 + tt])); }
    ATT_WAITBAR(0);
}
#undef ATT_WAITBAR
}

#define XB_TMO      128
#define XB_XCNT(j)  (256  + 64 * (j))
#define XB_XSUB(j)  (1280 + 64 * (j))
#define XB_XGEN(j)  (2304 + 64 * (j))
#define XB_TOP      3328
#define XB_TOPGEN   3392
#define XCD_BAR_WORDS 3456
#define XB_SPIN_CAP (1u << 18)
__device__ __forceinline__ unsigned xb_ld(unsigned* p)              { return __hip_atomic_load(p, __ATOMIC_RELAXED, __HIP_MEMORY_SCOPE_AGENT); }
__device__ __forceinline__ unsigned xb_add(unsigned* p, unsigned v) { return __hip_atomic_fetch_add(p, v, __ATOMIC_RELAXED, __HIP_MEMORY_SCOPE_AGENT); }
__device__ __forceinline__ unsigned xb_xcc_id() { return (unsigned)__builtin_amdgcn_s_getreg((3 << 11) | 20) & 0xFu; }
#define XB_SPIN(cond, bar) do { unsigned _sp = 0; while (cond) { __builtin_amdgcn_s_sleep(1); \
    if ((++_sp & 255u) == 0u) { if (xb_ld(&(bar)[XB_TMO])) break; if (_sp > XB_SPIN_CAP) { atomicAdd(&(bar)[XB_TMO], 1u); break; } } } } while (0)
struct XcdBarrier { unsigned* bar; unsigned x; volatile LAS unsigned* st; };
__device__ __forceinline__ XcdBarrier xcd_barrier_post(unsigned* bar, volatile LAS unsigned* st) {
    XcdBarrier b; b.bar = bar; b.x = xb_xcc_id(); b.st = st;
    if (threadIdx.x == 0) (void)xb_add(&bar[XB_XCNT(b.x)], 1u);
    return b;
}
__device__ __forceinline__ void xcd_barrier_complete(unsigned* bar, unsigned x, unsigned& nloc, unsigned& nx) {
    const unsigned G = gridDim.x * gridDim.y * gridDim.z;
    unsigned sum, cnt, mine, sp = 0u;
    for (;;) {
        sum = 0u; cnt = 0u; mine = 0u;
#pragma unroll
        for (unsigned j = 0; j < 16; ++j) { const unsigned c = xb_ld(&bar[XB_XCNT(j)]); sum += c; cnt += (c > 0u) ? 1u : 0u; mine = (j == x) ? c : mine; }
        if (sum == G) break;
        __builtin_amdgcn_s_sleep(1);
        if ((++sp & 255u) == 0u) { if (xb_ld(&bar[XB_TMO])) break; if (sp > XB_SPIN_CAP) { atomicAdd(&bar[XB_TMO], 1u); break; } }
    }
    nloc = mine > 0u ? mine : 1u; nx = cnt > 0u ? cnt : 1u;
}
__device__ __forceinline__ void xcd_barrier(const XcdBarrier& b, int tid_) {
    asm volatile("s_waitcnt vmcnt(0)" ::: "memory");
    __syncthreads();
    if (tid_ == 0) {
        unsigned* bar = b.bar;
        __builtin_amdgcn_s_waitcnt(0);
        unsigned nloc = b.st[0], nx = b.st[1];
        unsigned bx_ = b.x; asm volatile("" : "+s"(bx_));
        if (nloc == 0u) { xcd_barrier_complete(bar, bx_, nloc, nx); b.st[0] = nloc; b.st[1] = nx; }
        const unsigned old = xb_add(&bar[XB_XSUB(bx_)], 1u);
        const unsigned gen = old / nloc;
        if (old + 1u == (gen + 1u) * nloc) {
            __builtin_amdgcn_fence(__ATOMIC_RELEASE, "agent");
            asm volatile("s_waitcnt vmcnt(0)" ::: "memory");
            const unsigned og = xb_add(&bar[XB_TOP], 1u);
            const unsigned tg = og / nx;
            if (og + 1u == (tg + 1u) * nx) xb_add(&bar[XB_TOPGEN], 1u);
            else XB_SPIN(xb_ld(&bar[XB_TOPGEN]) == tg, bar);
            __builtin_amdgcn_fence(__ATOMIC_ACQUIRE, "agent");
            xb_add(&bar[XB_XGEN(bx_)], 1u);
            asm volatile("s_waitcnt vmcnt(0)" ::: "memory");
        } else {
            XB_SPIN(xb_ld(&bar[XB_XGEN(bx_)]) == gen, bar);
            __builtin_amdgcn_fence(__ATOMIC_ACQUIRE, "agent");
            asm volatile("s_waitcnt vmcnt(0)" ::: "memory");
        }
    }
    __syncthreads();
}

constexpr int NWAVES = 8;
constexpr int RING_BYTES = 131072, LDSCTL_OFF = RING_BYTES, MISC_OFF = LDSCTL_OFF + 320, LDS_BYTES = 147456;
constexpr int CW_BAR = 4096;
constexpr size_t L_WIN = 0, L_WUQ = 3670016, L_WUKV = 4063232, L_WOUT = 4587520, L_WMQ = 6684672, L_WMKV = 7733248, L_WMO = 9830400, LW_STRIDE = 11 * MiB;
constexpr size_t W_FGU = 22 * MiB, W_FD = 33 * MiB, W_MGU = 39 * MiB, W_MD = 83 * MiB, MGU_STRIDE = (size_t)DFE * 2 * 1024 * 2, MD_STRIDE = (size_t)1024 * DFE * 2;
constexpr size_t W_SGU = 106 * MiB;
constexpr size_t WS_HMP = WS_QC;

struct Job { const float* src; const float* src2; const float* ksc; int ldw, Ksrc, Kpad, Nphys, map, nlog; bf16* dst; };
__device__ __forceinline__ Job get_job(const Args& a, int j) {
    Job J; J.src2 = nullptr; J.ksc = nullptr; J.map = 0; unsigned char* wb = a.ws + WS_WB;
    if (j < 14) { const int l = j / 7, t = j % 7; unsigned char* lb = wb + (size_t)l * LW_STRIDE;
        switch (t) {
        case 0: J.src = a.in[4] + (size_t)l * 1024 * IN_W; J.ldw = IN_W; J.Ksrc = 1024; J.Kpad = 1024; J.Nphys = 1792; J.map = 1; J.nlog = IN_W; J.dst = (bf16*)(lb + L_WIN); J.ksc = a.in[3] + l * 1024; break;
        case 1: J.src = a.in[12] + (size_t)l * 256 * 768; J.ldw = 768; J.Ksrc = 256; J.Kpad = 256; J.Nphys = 768; J.nlog = 768; J.dst = (bf16*)(lb + L_WUQ); break;
        case 2: J.src = a.in[14] + (size_t)l * 128 * 1024; J.ldw = 1024; J.Ksrc = 128; J.Kpad = 256; J.Nphys = 1024; J.nlog = 1024; J.dst = (bf16*)(lb + L_WUKV); break;
        case 3: J.src = a.in[22] + (size_t)l * 1024 * 1024; J.ldw = 1024; J.Ksrc = 1024; J.Kpad = 1024; J.Nphys = 1024; J.nlog = 1024; J.dst = (bf16*)(lb + L_WOUT); break;
        case 4: J.src = a.in[25] + (size_t)l * 1024 * 512; J.ldw = 512; J.Ksrc = 1024; J.Kpad = 1024; J.Nphys = 512; J.nlog = 512; J.dst = (bf16*)(lb + L_WMQ); J.ksc = a.in[23] + l * 1024; break;
        case 5: J.src = a.in[26] + (size_t)l * 1024 * 1024; J.ldw = 1024; J.Ksrc = 1024; J.Kpad = 1024; J.Nphys = 1024; J.nlog = 1024; J.dst = (bf16*)(lb + L_WMKV); break;
        default: J.src = a.in[29] + (size_t)l * 512 * 1024; J.ldw = 1024; J.Ksrc = 512; J.Kpad = 512; J.Nphys = 1024; J.nlog = 1024; J.dst = (bf16*)(lb + L_WMO); break;
        }
    } else if (j == 14) { J.src = a.in[31]; J.src2 = a.in[32]; J.ldw = DFF; J.Ksrc = 1024; J.Kpad = 1024; J.Nphys = 2 * DFFP; J.map = 2; J.nlog = DFF; J.dst = (bf16*)(wb + W_FGU); J.ksc = a.in[30]; }
    else if (j == 15) { J.src = a.in[33]; J.ldw = 1024; J.Ksrc = DFF; J.Kpad = DFFP; J.Nphys = 1024; J.nlog = 1024; J.dst = (bf16*)(wb + W_FD); }
    else if (j < 24) { const int e = j - 16; J.src = a.in[36] + (size_t)e * 1024 * DFE; J.src2 = a.in[37] + (size_t)e * 1024 * DFE; J.ldw = DFE; J.Ksrc = 1024; J.Kpad = 1024; J.Nphys = 2 * DFE; J.map = 2; J.nlog = DFE; J.dst = (bf16*)(wb + W_MGU + (size_t)e * MGU_STRIDE); J.ksc = a.in[30] + 1024; }
    else { const int e = j - 24; J.src = a.in[38] + (size_t)e * DFE * 1024; J.ldw = 1024; J.Ksrc = DFE; J.Kpad = DFE; J.Nphys = 1024; J.nlog = 1024; J.dst = (bf16*)(wb + W_MD + (size_t)e * MD_STRIDE); }
    return J;
}
__device__ __forceinline__ int job_items(const Job& J) { return (J.Kpad / 32) * (J.Nphys / 64); }
__device__ __forceinline__ void transpose_item(const Job& J, int item, LAS float* scr, int lane) {
    const int nblk = J.Nphys / 64, kb = item / nblk, nb = item % nblk, k0 = 32 * kb, n0 = 64 * nb;
    const int p = n0 + 4 * (lane & 15); int col = -1; const float* src = J.src;
    if (J.map == 0) col = p < J.nlog ? p : -1;
    else if (J.map == 1) col = p < 768 ? p : (p < 1696 ? p + 4 : (p < 1700 ? 768 + (p - 1696) : -1));
    else { const int jt = p >> 8, w = p & 255; col = 128 * jt + (w & 127); if (w >> 7) src = J.src2; if (col >= J.nlog) col = -1; }
    float4 v[8];
#pragma unroll
    for (int i = 0; i < 8; ++i) { const int kk = 4 * i + (lane >> 4); v[i] = make_float4(0.f, 0.f, 0.f, 0.f);
        if (col >= 0 && k0 + kk < J.Ksrc) { v[i] = *(const float4*)(src + (size_t)(k0 + kk) * J.ldw + col); if (J.ksc) { const float s = J.ksc[k0 + kk]; v[i].x *= s; v[i].y *= s; v[i].z *= s; v[i].w *= s; } } }
#pragma unroll
    for (int i = 0; i < 8; ++i) { const int kk = 4 * i + (lane >> 4); LAS float* d = scr + kk * 65 + 4 * (lane & 15); d[0] = v[i].x; d[1] = v[i].y; d[2] = v[i].z; d[3] = v[i].w; }
    asm volatile("s_waitcnt lgkmcnt(0)" ::: "memory");
    const int c = lane & 3;
#pragma unroll
    for (int j = 0; j < 4; ++j) { const int n = (lane >> 2) + 16 * j; const LAS float* s = scr + (8 * c) * 65 + n;
        uint4 o; o.x = pack2(s[0 * 65], s[1 * 65]); o.y = pack2(s[2 * 65], s[3 * 65]); o.z = pack2(s[4 * 65], s[5 * 65]); o.w = pack2(s[6 * 65], s[7 * 65]);
        *(uint4*)(J.dst + (size_t)(n0 + n) * J.Kpad + k0 + 8 * c) = o; }
    asm volatile("s_waitcnt lgkmcnt(0)" ::: "memory");
}

enum { GP_PRO = 0, GP_KVM = 1, GP_L0 = 2, GP_LSTRIDE = 20, GP_END = 42 };
enum { LP_N1 = 0, LP_G1, LP_POSTPROJ, LP_UP, LP_POSTUP, LP_ATTN, LP_MIXNORM, LP_G4, LP_N2, LP_G5, LP_MEMNQ, LP_ATTM, LP_G7, LP_N3, LP_F1, LP_F2, LP_F3, LP_F4 };

__device__ __forceinline__ int hw_lane() { int l; asm volatile("v_mbcnt_lo_u32_b32 %0, -1, 0\n\tv_mbcnt_hi_u32_b32 %0, -1, %0" : "=v"(l)); return l; }
struct MArgs { const float* in[39]; float* out; unsigned char* ws; int ph_lo, ph_hi, li, pad; };
typedef const __attribute__((address_space(4))) MArgs* KArgP;
#define PHASE_ENV() KArgP kp_ = kp; asm volatile("" : "+s"(kp_)); const int lane = hw_lane(), wave = wave_s, tid = wave_s * 64 + lane; int l_ = l; asm volatile("" : "+s"(l_)); \
    const int gw = bx * NWAVES + wave, ngw = G * NWAVES; (void)lane; (void)gw; (void)ngw; (void)tid; \
    Args a; _Pragma("unroll") for (int i_ = 0; i_ < 39; ++i_) a.in[i_] = kp_->in[i_]; a.out = kp_->out; a.ws = kp_->ws; a.l = 0; a.phase = 0; \
    const Ctx c = make_ctx(a, l_); unsigned char* wb = a.ws + WS_WB; unsigned char* lb = wb + (size_t)l_ * LW_STRIDE; (void)lb; (void)c; \
    bf16* HMP = (bf16*)(a.ws + WS_HMP); bf16* KVM2 = (bf16*)(a.ws + WS_KVM); bf16* KVMl = KVM2 + (size_t)l_ * 4096 * 1024; (void)HMP; (void)KVMl;
__global__ void __launch_bounds__(NWAVES * 64, 2) mega(MArgs margs) {
    extern __shared__ __attribute__((aligned(16))) unsigned char lds_raw[];
    LAS unsigned char* lds = (LAS unsigned char*)lds_raw;
    volatile LAS unsigned* MISC = (volatile LAS unsigned*)(lds + MISC_OFF);
    const int G = gridDim.x, bx = blockIdx.x;
    for (int u = threadIdx.x; u < (LDS_BYTES - LDSCTL_OFF) / 4; u += NWAVES * 64) ((LAS unsigned*)(lds + LDSCTL_OFF))[u] = 0u;
    __syncthreads();
    const KArgP kp = (KArgP)__builtin_amdgcn_kernarg_segment_ptr();
    const int wave_s = __builtin_amdgcn_readfirstlane(threadIdx.x >> 6);
    const XcdBarrier bar = xcd_barrier_post((unsigned*)(margs.ws + WS_CTL) + CW_BAR + margs.li * XCD_BAR_WORDS, MISC + 8);
    const int lo = margs.ph_lo, hi = margs.ph_hi;
#define IN(k) (lo <= (k) && (k) < hi)
#define SEAM(k) do { if (IN(k) && IN((k) + 1)) xcd_barrier(bar, wave_s * 64 + hw_lane()); } while (0)
    { const int l = 0;
    for (int pr_ = 0; pr_ < (PRB == 5 ? 2 : 1); ++pr_) {
    if (IN(GP_PRO)) { PHASE_ENV();
        LAS float* scr = (LAS float*)(lds + wave * 16384);
        int base = 0;
        for (int j = 0; j < 32; ++j) { const Job J = get_job(a, j); const int n = job_items(J);
            int first = gw - (base % ngw); if (first < 0) first += ngw;
            for (int it = first; it < n; it += ngw) transpose_item(J, it, scr, lane);
            base += n; }
        { bf16* wsg = (bf16*)(wb + W_SGU); for (int i = gw * 64 + lane; i < 2 * 65536; i += ngw * 64) wsg[i] = f2bf(a.in[9][i]); }
        pass_xb(a.in[0], (bf16*)(a.ws + WS_H), c.PART, MTOK, gw, ngw, lane);
        for (int l2 = 0; l2 < 2; ++l2) pass_norm(a.in[1], a.in[24] + l2 * 1024, HMP + (size_t)l2 * 4096 * 1024, BATCH * MEML, gw, ngw, lane);
    }
    SEAM(GP_PRO);
    if (IN(GP_KVM)) { PHASE_ENV();
        pg8::KvmOrder S; S.c = bx; S.A = (const char*)HMP; S.B = (const char*)(wb + L_WMKV); S.bstride = LW_STRIDE;
        pg8::EpiStore E{KVM2, 1024};
        pg8::gemm_phase<pg8::EpiStore, pg8::KvmOrder, false, true>(lds, 1024, 1024, S, E, tid);
    }
    SEAM(GP_KVM);
    }
    if (PRB == 5) for (int i_ = 0; i_ < 20; ++i_) xcd_barrier(bar, wave_s * 64 + hw_lane());
    }
    for (int l = 0; l < 2; ++l) {
        const int B = GP_L0 + GP_LSTRIDE * l;
        for (int pr_ = 0; pr_ < (PRB == 1 ? 2 : 1); ++pr_) {
        for (int rep_ = 0; rep_ < REP_G1; ++rep_) if (IN(B + LP_G1)) { PHASE_ENV(); pg8::DenseOrder S; S.init(MTOK / 256, PW / 256, G, bx, c.H, 1024, lb + L_WIN, 1024); pg8::EpiStoreN E{c.PROJ, PW, c.PART};
            pg8::gemm_phase<pg8::EpiStoreN, pg8::DenseOrder, true, true>(lds, 1024, 1024, S, E, tid); }
        SEAM(B + LP_G1);
        if (IN(B + LP_POSTPROJ)) { PHASE_ENV(); pass_post_proj(c, MTOK, gw, ngw, lane);
            pass_memnorm(KVMl, 1024, c.mkg, c.mqg, BATCH * MEML, gw, ngw, lane); }
        SEAM(B + LP_POSTPROJ);
        }
        for (int pr_ = 0; pr_ < ((PRB == 1 || PRB == 2) ? 2 : 1); ++pr_) {
        if (IN(B + LP_UP)) {
            { PHASE_ENV(); for (int b = bx; b < BATCH; b += G) cumsum_batch(c, b, (LAS float*)lds, tid); }
            { PHASE_ENV(); pg8::DenseOrder S; S.init(MTOK / 256, 3, G, bx, c.PROJ + C_CQ, PW, lb + L_WUQ, 256); pg8::EpiStore E{c.QC, 768};
              pg8::gemm_phase<pg8::EpiStore, pg8::DenseOrder, true, true>(lds, 256, PW, S, E, tid); }
            { PHASE_ENV(); pg8::DenseOrder S; S.init(MTOK / 256, 4, G, bx, c.PROJ + C_CKV, PW, lb + L_WUKV, 256); pg8::EpiStore E{c.KVC, 1024};
              pg8::gemm_phase<pg8::EpiStore, pg8::DenseOrder, true, true>(lds, 256, PW, S, E, tid); }
        }
        SEAM(B + LP_UP);
        if (PRB == 2 && pr_ == 0) continue;
        if (IN(B + LP_POSTUP)) { PHASE_ENV(); pass_post_up(c, MTOK, gw, ngw, lane); }
        SEAM(B + LP_POSTUP);
        }
        for (int pr_ = 0; pr_ < (PRB == 1 ? 2 : 1); ++pr_) {
        for (int rep_ = 0; rep_ < REP_ATTN; ++rep_) {
          for (int r2_ = 0; r2_ < REP_FOX; ++r2_) if (IN(B + LP_ATTN) && BUILD_STEP >= 2) { PHASE_ENV(); const int vcu = (G % 8 == 0) ? (bx % 8) * (G / 8) + bx / 8 : bx;
            for (int U = vcu; U < 1024; U += G) { const int i = U >> 8, v = U & 255, xq = v >> 5, j = v & 31, bh = 8 * xq + 2 * i + (j >> 4), qb = (i & 1) ? 15 - (j & 15) : (j & 15), b = bh >> 2, h = bh & 3;
                const size_t rb = (size_t)b * SEQ, rw = rb + qb * 256 + 32 * wave;
                if (REP_FOX > 1 && r2_ == 0) att::attn_unit<64, 64, 0, PROBE_MODE>(lds, c.PROJ + rw * PW + C_QA + h * 64, PW, 0.125f * 1.4426950408889634f, c.PROJ + rb * PW + C_KA + h * 64, PW, c.CUMX + ((size_t)(b * 4 + h) * SEQ) * 8, 0, c.PROJ + rb * PW + C_VA + h * 64, PW,
                                          c.OMIX + rw * 1024 + h * 64, 1024, qb * 256, 4 * qb + 4, tid);
                else att::attn_unit<64, 64, 0>(lds, c.PROJ + rw * PW + C_QA + h * 64, PW, 0.125f * 1.4426950408889634f, c.PROJ + rb * PW + C_KA + h * 64, PW, c.CUMX + ((size_t)(b * 4 + h) * SEQ) * 8, 0, c.PROJ + rb * PW + C_VA + h * 64, PW,
                                          c.OMIX + rw * 1024 + h * 64, 1024, qb * 256, 4 * qb + 4, tid); }
          }
          for (int r2_ = 0; r2_ < REP_MLA; ++r2_) if (IN(B + LP_ATTN) && BUILD_STEP >= 2) { PHASE_ENV(); const int vcu = (G % 8 == 0) ? (bx % 8) * (G / 8) + bx / 8 : bx;
            for (int U = vcu; U < 2048; U += G) { const int i = U >> 8, v = U & 255, xq = v >> 5, j = v & 31, bh = 16 * xq + 2 * i + (j >> 4), qb = (i & 1) ? 15 - (j & 15) : (j & 15), b = bh >> 3, h = bh & 7;
                const size_t rb = (size_t)b * SEQ, rw = rb + qb * 256 + 32 * wave;
                att::attn_unit<96, 64, 1>(lds, c.QC + rw * 768 + h * 96, 768, 0.10206207261596575f * 1.4426950408889634f, c.KVC + rb * 1024 + h * 128, 1024, c.PROJ + rb * PW + C_KR, PW, c.KVC + rb * 1024 + h * 128 + 64, 1024,
                                          c.OMIX + rw * 1024 + 512 + h * 64, 1024, qb * 256, 4 * qb + 4, tid); }
          }
          for (int r2_ = 0; r2_ < REP_SGU; ++r2_) if (IN(B + LP_ATTN) && BUILD_STEP >= 2) { PHASE_ENV(); const int vcu = (G % 8 == 0) ? (bx % 8) * (G / 8) + bx / 8 : bx;
            for (int U = vcu; U < 2048; U += G) att::sgu_unit(lds, c.PROJ, (const bf16*)(wb + W_SGU) + (size_t)l_ * 65536, c.bsb, c.OMIX, U >> 2, U & 3, tid);
          }
        }
        SEAM(B + LP_ATTN);
        if (IN(B + LP_MIXNORM)) { PHASE_ENV(); pass_mixnorm(c, MTOK, gw, ngw, lane); }
        SEAM(B + LP_MIXNORM);
        }
        if (IN(B + LP_G4)) { PHASE_ENV(); pg8::DenseOrder S; S.init(MTOK / 256, 4, G, bx, c.OMIX, 1024, lb + L_WOUT, 1024); pg8::EpiRes E{c.H, c.PART};
            pg8::gemm_phase<pg8::EpiRes, pg8::DenseOrder, true, true>(lds, 1024, 1024, S, E, tid); }
        SEAM(B + LP_G4);
        for (int pr_ = 0; pr_ < ((PRB == 1 || PRB == 2) ? 2 : 1); ++pr_) {
        if (IN(B + LP_G5)) { PHASE_ENV(); pg8::DenseOrder S; S.init(MTOK / 256, 2, G, bx, c.H, 1024, lb + L_WMQ, 1024); pg8::EpiStoreN E{c.QM, 512, c.PART};
            pg8::gemm_phase<pg8::EpiStoreN, pg8::DenseOrder, true, true>(lds, 1024, 1024, S, E, tid); }
        SEAM(B + LP_G5);
        }
        for (int rep_ = 0; rep_ < REP_ATTM; ++rep_) if (IN(B + LP_ATTM) && BUILD_STEP >= 2) { PHASE_ENV(); const int vcu = (G % 8 == 0) ? (bx % 8) * (G / 8) + bx / 8 : bx;
            for (int U = vcu; U < 1024; U += G) { const int qblk = U >> 2, h = U & 3; const size_t rw = (size_t)qblk * 256 + 32 * wave; const int b = (qblk * 256) / SEQ; const bf16* kvb = KVMl + (size_t)b * MEML * 1024 + h * 128;
                att::attn_unit<128, 128, 2>(lds, c.QM + rw * 512 + h * 128, 512, 0.08838834764831845f * 1.4426950408889634f, kvb, 1024, nullptr, 0, kvb + 512, 1024, c.OM + rw * 512 + h * 128, 512, 0, 4, tid); }
        }
        SEAM(B + LP_ATTM);
        if (IN(B + LP_G7)) { PHASE_ENV(); pg8::DenseOrder S; S.init(MTOK / 256, 4, G, bx, c.OM, 512, lb + L_WMO, 512); pg8::EpiRes E{c.H, c.PART};
            pg8::gemm_phase<pg8::EpiRes, pg8::DenseOrder, true, true>(lds, 512, 512, S, E, tid); }
        SEAM(B + LP_G7);
        if (l == 0) {
            for (int rep_ = 0; rep_ < REP_F1; ++rep_) if (IN(B + LP_F1)) { PHASE_ENV(); pg8::DenseOrder S; S.init(MTOK / 256, 22, G, bx, c.H, 1024, wb + W_FGU, 1024); pg8::EpiSwiglu E{c.HID, DFFP, c.PART, nullptr};
                pg8::gemm_phase<pg8::EpiSwiglu, pg8::DenseOrder, true, true>(lds, 1024, 1024, S, E, tid); }
            SEAM(B + LP_F1);
            if (IN(B + LP_F2)) { PHASE_ENV(); pg8::DenseOrder S; S.init(MTOK / 256, 4, G, bx, c.HID, DFFP, wb + W_FD, DFFP); pg8::EpiRes E{c.H, c.PART};
                pg8::gemm_phase<pg8::EpiRes, pg8::DenseOrder, true, true>(lds, DFFP, DFFP, S, E, tid); }
            if (IN(B + LP_F2) && IN(B + GP_LSTRIDE)) xcd_barrier(bar, wave_s * 64 + hw_lane());
        } else {
            for (int pr_ = 0; pr_ < (PRB == 4 ? 2 : 1); ++pr_) {
            if (IN(B + LP_N3)) { PHASE_ENV(); for (int ch = bx; ch < 256; ch += G) route1_chunk(c, ch, (LAS int*)lds, tid); }
            SEAM(B + LP_N3);
            if (IN(B + LP_F1)) { PHASE_ENV(); for (int ch = bx; ch < 256; ch += G) route2_chunk(c, ch, (LAS int*)lds, tid); }
            SEAM(B + LP_F1);
            if (IN(B + LP_F2)) { PHASE_ENV(); const int nt = c.TAB[1000]; pg8::GroupOrder S; S.init(nt, 11, G, bx, c.HS, 1024, wb + W_MGU, 1024); S.tab = c.TAB; S.estride = MGU_STRIDE; pg8::EpiSwiglu E{c.HIDM, DFE, nullptr, c.SLOT_R};
                pg8::gemm_phase<pg8::EpiSwiglu, pg8::GroupOrder, true, true>(lds, 1024, 1024, S, E, tid); }
            SEAM(B + LP_F2);
            }
            if (IN(B + LP_F3)) { PHASE_ENV(); const int t0 = c.TAB[1001]; pg8::GroupOrder S; S.init(t0, 4, G, bx, c.HIDM, DFE, wb + W_MD, DFE); S.tab = c.TAB; S.estride = MD_STRIDE; pg8::EpiScatter<false> E{c.H, c.X, c.SLOT_TOK, c.SLOT_GATE};
                pg8::gemm_phase<pg8::EpiScatter<false>, pg8::GroupOrder, true, true>(lds, DFE, DFE, S, E, tid); }
            SEAM(B + LP_F3);
            if (IN(B + LP_F4)) { PHASE_ENV(); const int nt = c.TAB[1000], t0 = c.TAB[1001]; pg8::GroupOrder S; S.init(nt - t0, 4, G, bx, c.HIDM, DFE, wb + W_MD, DFE); S.pm0 = t0; S.tab = c.TAB; S.estride = MD_STRIDE; pg8::EpiScatter<true> E{c.H, c.X, c.SLOT_TOK, c.SLOT_GATE};
                pg8::gemm_phase<pg8::EpiScatter<true>, pg8::GroupOrder, true, true>(lds, DFE, DFE, S, E, tid); }
        }
    }
#undef IN
#undef SEAM
}

extern "C" void kernel_launch(void* const* d_in, const int* in_sizes, int n_in, void* d_out, int out_size, void* d_ws, size_t ws_size, hipStream_t stream) {
    static int grid = 0;
    if (grid == 0) {
        if (n_in != 39 || out_size != MTOK * DM || ws_size < WS_END) { fprintf(stderr, "kernel_launch: unexpected problem (n_in %d out %d ws %zu)\n", n_in, out_size, ws_size); grid = -1; return; }
        int dev = 0, cus = 0, per_cu = 0;
        if (hipGetDevice(&dev) != hipSuccess || hipDeviceGetAttribute(&cus, hipDeviceAttributeMultiprocessorCount, dev) != hipSuccess) { grid = -1; return; }
        if (hipFuncSetAttribute((const void*)mega, hipFuncAttributeMaxDynamicSharedMemorySize, LDS_BYTES) != hipSuccess) { fprintf(stderr, "kernel_launch: hipFuncSetAttribute failed\n"); grid = -1; return; }
        if (hipOccupancyMaxActiveBlocksPerMultiprocessor(&per_cu, (const void*)mega, NWAVES * 64, LDS_BYTES) != hipSuccess || per_cu < 1) fprintf(stderr, "kernel_launch: occupancy query says %d\n", per_cu);
        (void)hipGetLastError();
        grid = cus;
    }
    if (grid < 0) return;
    hipMemsetAsync((char*)d_ws + WS_CTL, 0, 1 * MiB, stream);
    Args a{}; for (int i = 0; i < 39; ++i) a.in[i] = (const float*)d_in[i]; a.out = (float*)d_out; a.ws = (unsigned char*)d_ws;
    MArgs m{}; for (int i = 0; i < 39; ++i) m.in[i] = (const float*)d_in[i]; m.out = (float*)d_out; m.ws = (unsigned char*)d_ws;
    int li = 0;
#define MEGA(lo_, hi_) do { m.ph_lo = (lo_); m.ph_hi = (hi_); m.li = li++; hipLaunchKernelGGL(mega, dim3(grid), dim3(NWAVES * 64), LDS_BYTES, stream, m); } while (0)
#if BUILD_STEP >= 2
    MEGA(GP_PRO, GP_END);
}
#else
    const int B0 = GP_L0, B1 = GP_L0 + GP_LSTRIDE;
    int cur = GP_PRO;
    for (int l = 0; l < 2; ++l) {
        a.l = l; const Ctx c = make_ctx(a, l); const int B = l ? B1 : B0;
        MEGA(cur, B + LP_ATTN);
        hipLaunchKernelGGL((nv_attn<64, 64, 0>), dim3(MTOK / 64, 4, 1), dim3(64), 0, stream, c.PROJ + C_QA, PW, 64, c.PROJ + C_KA, PW, 64, nullptr, 0, c.PROJ + C_VA, PW, 64, c.OMIX, 1024, 64, c.CUM, 0.125f);
        hipLaunchKernelGGL(nv_sgu, dim3(MTOK / 128, 4), dim3(256), 0, stream, c.PROJ, c.bsw, c.bsb, c.OMIX);
        hipLaunchKernelGGL((nv_attn<96, 64, 1>), dim3(MTOK / 64, 8, 1), dim3(64), 0, stream, c.QC, 768, 96, c.KVC, 1024, 128, c.PROJ + C_KR, PW, c.KVC + 64, 1024, 128, c.OMIX + 512, 1024, 64, nullptr, 0.10206207261596575f);
        MEGA(B + LP_MIXNORM, B + LP_ATTM);
        hipLaunchKernelGGL((nv_attn<128, 128, 2>), dim3(MTOK / 64, 4, 2), dim3(64), 0, stream, c.QM, 512, 128, c.KVM + (size_t)l * 4096 * 1024, 1024, 128, nullptr, 0, c.KVM + (size_t)l * 4096 * 1024 + 512, 1024, 128, c.OM, 512, 128, nullptr, 0.08838834764831845f);
        cur = B + LP_G7;
    }
    MEGA(cur, GP_END);
}
#endif
```

```cpp
#include <hip/hip_runtime.h>
#include <stdint.h>
#include <stdio.h>

#ifndef BUILD_STEP
#define BUILD_STEP 2
#endif
typedef unsigned short bf16;
#define LAS __attribute__((address_space(3)))
#define EPSF 1e-6f

constexpr int BATCH = 16, SEQ = 4096, DM = 1024, MTOK = BATCH * SEQ, MEML = 256;
constexpr int PNC = 1792;
constexpr int PW = 2816;
constexpr int C_QA = 0, C_KA = 256, C_VA = 512, C_UB = 768, C_VB = 1024, C_CQ = 1280, C_CKV = 1536, C_KR = 1664, C_FA = 1696;
constexpr int IN_W = 1700, DFF = 2752, DFFP = 2816, NEXP = 8, DFE = 1408;
constexpr int SLOTS = 2 * MTOK + 16 * 256;
constexpr int MAXTILES = SLOTS / 256;

constexpr size_t MiB = 1u << 20;
constexpr size_t WS_CTL = 0, WS_WB = 1 * MiB, WS_H = 128 * MiB, WS_R1 = 256 * MiB;
constexpr size_t WS_QC = 640 * MiB, WS_KVC = 736 * MiB, WS_OMIX = 864 * MiB, WS_QM = 640 * MiB, WS_OM = 704 * MiB;
constexpr size_t WS_KVM = 992 * MiB, WS_HM = 1000 * MiB, WS_FLOG = 1008 * MiB, WS_CUM = 1009 * MiB, WS_TOP = 1010 * MiB, WS_SLOT = 1012 * MiB, WS_CH = 1014 * MiB;
constexpr size_t WS_PBR = 120 * MiB;
constexpr size_t WS_PQ = 118 * MiB, WS_PKV = 119 * MiB;
constexpr size_t WS_ROPE = 110 * MiB;
constexpr size_t WS_PART = 1019 * MiB;
constexpr size_t WS_CUMX = 1015 * MiB;
constexpr size_t WS_HS = 256 * MiB, WS_HIDM = 520 * MiB, WS_END = 1023 * MiB;

__device__ __forceinline__ float bf2f(bf16 v) { return __uint_as_float(((unsigned)v) << 16); }
__device__ __forceinline__ bf16 f2bf(float f) { unsigned u = __float_as_uint(f); u += 0x7fffu + ((u >> 16) & 1u); return (bf16)(u >> 16); }
__device__ __forceinline__ unsigned pack2(float a, float b) { return (unsigned)f2bf(a) | ((unsigned)f2bf(b) << 16); }
__device__ __forceinline__ void unpack2(unsigned u, float& a, float& b) { a = __uint_as_float(u << 16); b = __uint_as_float(u & 0xffff0000u); }
__device__ __forceinline__ void ld4bf(const bf16* p, float (&f)[4]) { const uint2 u = *(const uint2*)p; unpack2(u.x, f[0], f[1]); unpack2(u.y, f[2], f[3]); }
__device__ __forceinline__ void st4bf(bf16* p, const float (&f)[4]) { uint2 u; u.x = pack2(f[0], f[1]); u.y = pack2(f[2], f[3]); *(uint2*)p = u; }
__device__ __forceinline__ void ld8bf(const bf16* p, float (&f)[8]) { const uint4 u = *(const uint4*)p; unpack2(u.x, f[0], f[1]); unpack2(u.y, f[2], f[3]); unpack2(u.z, f[4], f[5]); unpack2(u.w, f[6], f[7]); }
__device__ __forceinline__ void st8bf(bf16* p, const float (&f)[8]) { uint4 u; u.x = pack2(f[0], f[1]); u.y = pack2(f[2], f[3]); u.z = pack2(f[4], f[5]); u.w = pack2(f[6], f[7]); *(uint4*)p = u; }
__device__ __forceinline__ int hw_lane() { int l; asm volatile("v_mbcnt_lo_u32_b32 %0, -1, 0\n\tv_mbcnt_hi_u32_b32 %0, -1, %0" : "=v"(l)); return l; }
__device__ __forceinline__ float shx(float v, int lane, int o) { return __int_as_float(__builtin_amdgcn_ds_bpermute((lane ^ o) << 2, __float_as_int(v))); }
__device__ __forceinline__ float wsum(float v, int lane) {
#pragma unroll
    for (int o = 1; o < 64; o <<= 1) v += shx(v, lane, o);
    return v; }
__device__ __forceinline__ float sum16(float v, int lane) { v += shx(v, lane, 1); v += shx(v, lane, 2); v += shx(v, lane, 4); v += shx(v, lane, 8); return v; }
__device__ __forceinline__ float wmaxabs(const float* g, int n, int lane) { float v = (lane < n) ? fabsf(g[lane]) : 0.f;
#pragma unroll
    for (int o = 1; o < 64; o <<= 1) v = fmaxf(v, shx(v, lane, o));
    return __int_as_float(__builtin_amdgcn_readfirstlane(__float_as_int(v))); }
__device__ __forceinline__ float sum8(float v, int lane) { v += shx(v, lane, 1); v += shx(v, lane, 2); v += shx(v, lane, 4); return v; }
__device__ __forceinline__ float gelu_erf(float v) {
    const float av = fabsf(v), t = __builtin_amdgcn_rcpf(av * 0.2316418882f + 1.0f);
    float q = t * 0.5307027145f + (-0.7265760135f); q = q * t + 0.7107068705f; q = q * t + (-0.142248368f); q = q * t + 0.127414796f; q = q * t;
    const float e = __builtin_amdgcn_exp2f((v * v) * (-0.72134752044f)), m = v * (q * e);
    return v < 0.f ? m : v - m; }
__device__ __forceinline__ float logsigmoid(float z) { return fminf(z, 0.f) - 0.6931471805599453f * __builtin_amdgcn_logf(1.0f + __builtin_amdgcn_exp2f(-1.4426950408889634f * fabsf(z))); }
__device__ __forceinline__ float rope_inv(int i) { return exp2f(-(float)i * (13.287712379549449f / 16.0f)); }

struct Args { const float* in[39]; float* out; unsigned char* ws; int l; int phase; };
struct Ctx {
    const float* x_in; const float* mem; const int* pos;
    const float *mix_norm, *w_in, *b_forget, *aq, *ak, *bv, *bsw, *bsb, *cqg, *wuq, *ckvg, *wukv, *qng, *qrg, *kng, *krg, *ona, *onb, *onc, *wout, *xattn, *memn, *wmq, *wmkv, *mqg, *mkg, *wmo, *ffn_norm;
    const float *fg, *fu, *fd, *wr, *br, *mg, *mu, *md;
    float* X;
    bf16 *H, *PROJ, *QC, *KVC, *OMIX, *QM, *OM, *KVM, *HM, *HID, *HS, *HIDM;
    float *FLOG, *CUM, *TOPG, *SLOT_GATE, *PART, *RTOK, *SLOT_R; int *TOPI, *SLOT_TOK, *CH, *TAB; bf16* CUMX; const float2* ROPET; float *PQ, *PKV, *PBR;
};
__device__ __host__ __forceinline__ Ctx make_ctx(const Args& a, int l) {
    Ctx c;
    c.x_in = a.in[0]; c.mem = a.in[1]; c.pos = (const int*)a.in[2];
    c.mix_norm = a.in[3] + l * 1024; c.w_in = a.in[4] + (size_t)l * 1024 * IN_W; c.b_forget = a.in[5] + l * 4; c.aq = a.in[6] + l * 64; c.ak = a.in[7] + l * 64;
    c.bv = a.in[8] + l * 256; c.bsw = a.in[9] + l * 4 * 128 * 128; c.bsb = a.in[10] + l * 4 * 128; c.cqg = a.in[11] + l * 256; c.wuq = a.in[12] + (size_t)l * 256 * 768;
    c.ckvg = a.in[13] + l * 128; c.wukv = a.in[14] + (size_t)l * 128 * 1024; c.qng = a.in[15] + l * 64; c.qrg = a.in[16] + l * 32; c.kng = a.in[17] + l * 64; c.krg = a.in[18] + l * 32;
    c.ona = a.in[19] + l * 256; c.onb = a.in[20] + l * 256; c.onc = a.in[21] + l * 512; c.wout = a.in[22] + (size_t)l * 1024 * 1024; c.xattn = a.in[23] + l * 1024; c.memn = a.in[24] + l * 1024;
    c.wmq = a.in[25] + (size_t)l * 1024 * 512; c.wmkv = a.in[26] + (size_t)l * 1024 * 1024; c.mqg = a.in[27] + l * 128; c.mkg = a.in[28] + l * 128; c.wmo = a.in[29] + (size_t)l * 512 * 1024; c.ffn_norm = a.in[30] + l * 1024;
    c.fg = a.in[31]; c.fu = a.in[32]; c.fd = a.in[33]; c.wr = a.in[34]; c.br = a.in[35]; c.mg = a.in[36]; c.mu = a.in[37]; c.md = a.in[38];
    c.X = a.out;
    unsigned char* ws = a.ws;
    c.H = (bf16*)(ws + WS_H); c.PROJ = (bf16*)(ws + WS_R1); c.QC = (bf16*)(ws + WS_QC); c.KVC = (bf16*)(ws + WS_KVC); c.OMIX = (bf16*)(ws + WS_OMIX); c.QM = (bf16*)(ws + WS_QM); c.OM = (bf16*)(ws + WS_KVC);
    c.KVM = (bf16*)(ws + WS_KVM); c.HM = (bf16*)(ws + WS_HM); c.HID = (bf16*)(ws + WS_R1); c.HS = (bf16*)(ws + WS_HS); c.HIDM = (bf16*)(ws + WS_HIDM);
    c.FLOG = (float*)(ws + WS_FLOG); c.CUM = (float*)(ws + WS_CUM); c.TOPI = (int*)(ws + WS_TOP); c.TOPG = (float*)(ws + WS_TOP + MiB); c.SLOT_TOK = (int*)(ws + WS_SLOT); c.SLOT_GATE = (float*)(ws + WS_SLOT + MiB);
    c.CH = (int*)(ws + WS_CH); c.TAB = (int*)(ws + WS_CH + 65536); c.CUMX = (bf16*)(ws + WS_CUMX); c.PQ = (float*)(ws + WS_PQ); c.PKV = (float*)(ws + WS_PKV); c.PBR = (float*)(ws + WS_PBR); c.ROPET = (const float2*)(ws + WS_ROPE);        c.PART = (float*)(ws + WS_PART); c.RTOK = c.TOPG + 2 * MTOK; c.SLOT_R = (float*)(ws + WS_CH + 131072);
    return c;
}

#ifndef GATHER_A
#define GATHER_A 1
#endif
constexpr int RB = 4;
__device__ __forceinline__ void pass_norm(const float* x, const float* g, bf16* H, int nrows, int gw, int ngw, int lane) {
    float4 gg[4];
#pragma unroll
    for (int j = 0; j < 4; ++j) gg[j] = ((const float4*)g)[lane + 64 * j];
    for (int r0 = gw; r0 < nrows; r0 += ngw * RB) {
        float4 v[RB][4];
#pragma unroll
        for (int k = 0; k < RB; ++k) { const int r = r0 + k * ngw; if (r < nrows) {
#pragma unroll
            for (int j = 0; j < 4; ++j) v[k][j] = ((const float4*)(x + (size_t)r * 1024))[lane + 64 * j]; } }
#pragma unroll
        for (int k = 0; k < RB; ++k) { const int r = r0 + k * ngw; if (r < nrows) { float ss = 0.f;
#pragma unroll
            for (int j = 0; j < 4; ++j) ss += v[k][j].x * v[k][j].x + v[k][j].y * v[k][j].y + v[k][j].z * v[k][j].z + v[k][j].w * v[k][j].w;
            ss = wsum(ss, lane); const float rr = rsqrtf(ss * (1.f / 1024.f) + EPSF);
#pragma unroll
            for (int j = 0; j < 4; ++j) { float f[4] = {v[k][j].x * rr * gg[j].x, v[k][j].y * rr * gg[j].y, v[k][j].z * rr * gg[j].z, v[k][j].w * rr * gg[j].w}; st4bf(H + (size_t)r * 1024 + 4 * (lane + 64 * j), f); } } }
    }
}
__device__ __forceinline__ void pass_xb(const float* x, bf16* Xb, float* part, int nrows, int gw, int ngw, int lane) {
    for (int r0 = gw; r0 < nrows; r0 += ngw * RB) {
        float4 v[RB][4];
#pragma unroll
        for (int k = 0; k < RB; ++k) { const int r = r0 + k * ngw;
#pragma unroll
            for (int j = 0; j < 4; ++j) v[k][j] = ((const float4*)(x + (size_t)r * 1024))[lane + 64 * j]; }
#pragma unroll
        for (int k = 0; k < RB; ++k) { const int r = r0 + k * ngw; float ss = 0.f;
#pragma unroll
            for (int j = 0; j < 4; ++j) { ss += v[k][j].x * v[k][j].x + v[k][j].y * v[k][j].y + v[k][j].z * v[k][j].z + v[k][j].w * v[k][j].w; float f[4] = {v[k][j].x, v[k][j].y, v[k][j].z, v[k][j].w}; st4bf(Xb + (size_t)r * 1024 + 4 * (lane + 64 * j), f); }
            ss = wsum(ss, lane); if (lane < 16) part[(size_t)r * 16 + lane] = (lane == 0) ? ss : 0.f; }
    }
}
__device__ __forceinline__ void pass_post_proj(const Ctx& c, int rbase, int nrows, int gw, int ngw, int lane) {
    const int c4 = 4 * lane;
    float gq[4], gk[4], gv[4], gc[4], gkv[4];
#pragma unroll
    for (int i = 0; i < 4; ++i) { gq[i] = c.aq[(c4 + i) & 63] * (0.125f * 1.4426950408889634f);        gk[i] = c.ak[(c4 + i) & 63]; gv[i] = c.bv[c4 + i]; gc[i] = c.cqg[c4 + i]; gkv[i] = c.ckvg[(c4 + i) & 127]; }
    const float gr1 = c.krg[lane & 15], gr2 = c.krg[16 + (lane & 15)], bf = c.b_forget[lane & 3];
    for (int r0 = gw; r0 < nrows; r0 += ngw * RB) {
        uint2 uq[RB], uk[RB], uu[RB], uv[RB], uc[RB], ukv[RB]; bf16 x1[RB], x2[RB], fa[RB]; float2 cs2[RB];
#pragma unroll
        for (int k = 0; k < RB; ++k) { const int r = rbase + r0 + k * ngw; const bf16* p = c.PROJ + (size_t)r * PW;
            uq[k] = *(const uint2*)(p + C_QA + c4); uk[k] = *(const uint2*)(p + C_KA + c4); uu[k] = *(const uint2*)(p + C_UB + c4); uv[k] = *(const uint2*)(p + C_VB + c4); uc[k] = *(const uint2*)(p + C_CQ + c4);
            ukv[k] = *(const uint2*)(p + C_CKV + (c4 & 127)); x1[k] = p[C_KR + (lane & 15)]; x2[k] = p[C_KR + 16 + (lane & 15)]; fa[k] = p[C_FA + (lane & 3)]; cs2[k] = c.ROPET[(size_t)r * 16 + (lane & 15)]; }
#pragma unroll
        for (int k = 0; k < RB; ++k) { const int r = rbase + r0 + k * ngw; bf16* p = c.PROJ + (size_t)r * PW; float f[4];
            { unpack2(uq[k].x, f[0], f[1]); unpack2(uq[k].y, f[2], f[3]); const float rr = rsqrtf(sum16(f[0] * f[0] + f[1] * f[1] + f[2] * f[2] + f[3] * f[3], lane) * (1.f / 64.f) + EPSF);
#pragma unroll
              for (int i = 0; i < 4; ++i) f[i] *= rr * gq[i];
              st4bf(p + C_QA + c4, f); }
            { unpack2(uk[k].x, f[0], f[1]); unpack2(uk[k].y, f[2], f[3]); const float rr = rsqrtf(sum16(f[0] * f[0] + f[1] * f[1] + f[2] * f[2] + f[3] * f[3], lane) * (1.f / 64.f) + EPSF);
#pragma unroll
              for (int i = 0; i < 4; ++i) f[i] *= rr * gk[i];
              st4bf(p + C_KA + c4, f); }
            { unpack2(uu[k].x, f[0], f[1]); unpack2(uu[k].y, f[2], f[3]);
#pragma unroll
              for (int i = 0; i < 4; ++i) f[i] = gelu_erf(f[i]);
              st4bf(p + C_UB + c4, f); }
            { unpack2(uv[k].x, f[0], f[1]); unpack2(uv[k].y, f[2], f[3]);
#pragma unroll
              for (int i = 0; i < 4; ++i) f[i] = gelu_erf(f[i]);
              const float mu = sum16(f[0] + f[1] + f[2] + f[3], lane) * (1.f / 64.f); float q = 0.f;
#pragma unroll
              for (int i = 0; i < 4; ++i) { f[i] -= mu; q += f[i] * f[i]; }
              const float rr = rsqrtf(sum16(q, lane) * (1.f / 64.f) + EPSF);
#pragma unroll
              for (int i = 0; i < 4; ++i) f[i] *= rr * gv[i];
              st4bf(p + C_VB + c4, f); }
            { unpack2(uc[k].x, f[0], f[1]); unpack2(uc[k].y, f[2], f[3]); const float rr = rsqrtf(wsum(f[0] * f[0] + f[1] * f[1] + f[2] * f[2] + f[3] * f[3], lane) * (1.f / 256.f) + EPSF);
#pragma unroll
              for (int i = 0; i < 4; ++i) f[i] *= rr * gc[i];
              st4bf(p + C_CQ + c4, f); }
            { unpack2(ukv[k].x, f[0], f[1]); unpack2(ukv[k].y, f[2], f[3]); float ss = (lane < 32) ? (f[0] * f[0] + f[1] * f[1] + f[2] * f[2] + f[3] * f[3]) : 0.f; const float rr = rsqrtf(wsum(ss, lane) * (1.f / 128.f) + EPSF);
              if (lane < 32) {
#pragma unroll
                  for (int i = 0; i < 4; ++i) f[i] *= rr * gkv[i];
                  st4bf(p + C_CKV + c4, f); } }
            { float a1 = bf2f(x1[k]), a2 = bf2f(x2[k]); const float rr = rsqrtf(sum16(a1 * a1 + a2 * a2, lane) * (1.f / 32.f) + EPSF); a1 *= rr * gr1; a2 *= rr * gr2;
              const float cs = cs2[k].x, sn = cs2[k].y;
              if (lane < 16) { p[C_KR + lane] = f2bf(a1 * cs - a2 * sn); p[C_KR + 16 + lane] = f2bf(a1 * sn + a2 * cs); } }
            if (lane < 4) c.FLOG[(size_t)r * 4 + lane] = logsigmoid(bf2f(fa[k]) + bf);
        }
    }
}
__device__ __forceinline__ void pass_post_up(const Ctx& c, int rbase, int nrows, int gw, int ngw, int lane) {
    const int h = lane >> 3, j = lane & 7;
    float gn[8], gkn[8], gr[4];
#pragma unroll
    for (int i = 0; i < 8; ++i) { gn[i] = c.qng[8 * j + i] * (0.10206207261596575f * 1.4426950408889634f); gkn[i] = c.kng[8 * j + i]; }
#pragma unroll
    for (int i = 0; i < 4; ++i) { gr[i] = c.qrg[4 * j + i] * (0.10206207261596575f * 1.4426950408889634f); }
    for (int r0 = gw; r0 < nrows; r0 += ngw * RB) {
        uint4 un[RB], ukn[RB]; uint2 ur[RB]; float4 tc[RB][2];
#pragma unroll
        for (int k = 0; k < RB; ++k) { const int r = rbase + r0 + k * ngw; const bf16* q = c.QC + (size_t)r * 768 + h * 96; const bf16* kv = c.KVC + (size_t)r * 1024 + h * 128;
            un[k] = *(const uint4*)(q + 8 * j); ur[k] = *(const uint2*)(q + 64 + 4 * j); ukn[k] = *(const uint4*)(kv + 8 * j);
            const float4* tp = (const float4*)(c.ROPET + (size_t)r * 16 + 4 * (j & 3)); tc[k][0] = tp[0]; tc[k][1] = tp[1]; }
#pragma unroll
        for (int k = 0; k < RB; ++k) { const int r = rbase + r0 + k * ngw; bf16* q = c.QC + (size_t)r * 768 + h * 96; bf16* kv = c.KVC + (size_t)r * 1024 + h * 128;
            { float f[8]; unpack2(un[k].x, f[0], f[1]); unpack2(un[k].y, f[2], f[3]); unpack2(un[k].z, f[4], f[5]); unpack2(un[k].w, f[6], f[7]); float ss = 0.f;
#pragma unroll
              for (int i = 0; i < 8; ++i) ss += f[i] * f[i];
              const float rr = rsqrtf(sum8(ss, lane) * (1.f / 64.f) + EPSF);
#pragma unroll
              for (int i = 0; i < 8; ++i) f[i] *= rr * gn[i];
              st8bf(q + 8 * j, f); }
            { float f[4], o[4]; unpack2(ur[k].x, f[0], f[1]); unpack2(ur[k].y, f[2], f[3]); const float rr = rsqrtf(sum8(f[0] * f[0] + f[1] * f[1] + f[2] * f[2] + f[3] * f[3], lane) * (1.f / 32.f) + EPSF); const float csv[4] = {tc[k][0].x, tc[k][0].z, tc[k][1].x, tc[k][1].z}, snv[4] = {tc[k][0].y, tc[k][0].w, tc[k][1].y, tc[k][1].w};
#pragma unroll
              for (int i = 0; i < 4; ++i) { f[i] *= rr * gr[i]; const float other = shx(f[i], lane, 4); const float sn = snv[i], cs = csv[i]; o[i] = (j < 4) ? (f[i] * cs - other * sn) : (other * sn + f[i] * cs); }
              st4bf(q + 64 + 4 * j, o); }
            { float f[8]; unpack2(ukn[k].x, f[0], f[1]); unpack2(ukn[k].y, f[2], f[3]); unpack2(ukn[k].z, f[4], f[5]); unpack2(ukn[k].w, f[6], f[7]); float ss = 0.f;
#pragma unroll
              for (int i = 0; i < 8; ++i) ss += f[i] * f[i];
              const float rr = rsqrtf(sum8(ss, lane) * (1.f / 64.f) + EPSF);
#pragma unroll
              for (int i = 0; i < 8; ++i) f[i] *= rr * gkn[i];
              st8bf(kv + 8 * j, f); }
        }
    }
}
__device__ __forceinline__ void pass_mixnorm(const Ctx& c, int rbase, int nrows, int gw, int ngw, int lane) {
    float ga[4], gb[4], gc[8];
#pragma unroll
    for (int i = 0; i < 4; ++i) { ga[i] = c.ona[4 * lane + i]; gb[i] = c.onb[4 * lane + i]; }
#pragma unroll
    for (int i = 0; i < 8; ++i) gc[i] = c.onc[8 * lane + i];
    for (int r0 = gw; r0 < nrows; r0 += ngw * RB) {
        uint2 ua[RB], ub[RB]; uint4 uc[RB];
#pragma unroll
        for (int k = 0; k < RB; ++k) { const bf16* p = c.OMIX + (size_t)(rbase + r0 + k * ngw) * 1024; ua[k] = *(const uint2*)(p + 4 * lane); ub[k] = *(const uint2*)(p + 256 + 4 * lane); uc[k] = *(const uint4*)(p + 512 + 8 * lane); }
#pragma unroll
        for (int k = 0; k < RB; ++k) { bf16* p = c.OMIX + (size_t)(rbase + r0 + k * ngw) * 1024; float f[4];
            { unpack2(ua[k].x, f[0], f[1]); unpack2(ua[k].y, f[2], f[3]); const float rr = rsqrtf(wsum(f[0] * f[0] + f[1] * f[1] + f[2] * f[2] + f[3] * f[3], lane) * (1.f / 256.f) + EPSF);
#pragma unroll
              for (int i = 0; i < 4; ++i) f[i] *= rr * ga[i];
              st4bf(p + 4 * lane, f); }
            { unpack2(ub[k].x, f[0], f[1]); unpack2(ub[k].y, f[2], f[3]); const float rr = rsqrtf(wsum(f[0] * f[0] + f[1] * f[1] + f[2] * f[2] + f[3] * f[3], lane) * (1.f / 256.f) + EPSF);
#pragma unroll
              for (int i = 0; i < 4; ++i) f[i] *= rr * gb[i];
              st4bf(p + 256 + 4 * lane, f); }
            { float g[8]; unpack2(uc[k].x, g[0], g[1]); unpack2(uc[k].y, g[2], g[3]); unpack2(uc[k].z, g[4], g[5]); unpack2(uc[k].w, g[6], g[7]); float ss = 0.f;
#pragma unroll
              for (int i = 0; i < 8; ++i) ss += g[i] * g[i];
              const float rr = rsqrtf(wsum(ss, lane) * (1.f / 512.f) + EPSF);
#pragma unroll
              for (int i = 0; i < 8; ++i) g[i] *= rr * gc[i];
              st8bf(p + 512 + 8 * lane, g); }
        }
    }
}
__device__ __forceinline__ void pass_memnorm(bf16* buf, int ld, const float* g, const float* g2, int nrows, int gw, int ngw, int lane) {
    float gg[8];
#pragma unroll
    for (int i = 0; i < 8; ++i) gg[i] = g[(8 * lane + i) & 127] * (g2 ? g2[(8 * lane + i) & 127] : 1.f);
    for (int r0 = gw; r0 < nrows; r0 += ngw * RB) {
        uint4 u[RB];
#pragma unroll
        for (int k = 0; k < RB; ++k) { const int r = r0 + k * ngw; if (r < nrows) u[k] = *(const uint4*)(buf + (size_t)r * ld + 8 * lane); }
#pragma unroll
        for (int k = 0; k < RB; ++k) { const int r = r0 + k * ngw; if (r < nrows) { float f[8]; unpack2(u[k].x, f[0], f[1]); unpack2(u[k].y, f[2], f[3]); unpack2(u[k].z, f[4], f[5]); unpack2(u[k].w, f[6], f[7]); float ss = 0.f;
#pragma unroll
            for (int i = 0; i < 8; ++i) ss += f[i] * f[i];
            const float rr = rsqrtf(sum16(ss, lane) * (1.f / 128.f) + EPSF);
#pragma unroll
            for (int i = 0; i < 8; ++i) f[i] *= rr * gg[i];
            st8bf(buf + (size_t)r * ld + 8 * lane, f); } }
    }
}
__device__ __forceinline__ void route_rows32(const Ctx& c, int row0, int lane) {
    float wr[16][8];
#pragma unroll
    for (int h = 0; h < 2; ++h)
#pragma unroll
        for (int i = 0; i < 8; ++i) { const int k = 512 * h + 8 * lane + i; const float g = c.ffn_norm[k]; const float4* w = (const float4*)(c.wr + (size_t)k * 8); const float4 w0 = w[0], w1 = w[1];
            wr[8 * h + i][0] = w0.x * g; wr[8 * h + i][1] = w0.y * g; wr[8 * h + i][2] = w0.z * g; wr[8 * h + i][3] = w0.w * g; wr[8 * h + i][4] = w1.x * g; wr[8 * h + i][5] = w1.y * g; wr[8 * h + i][6] = w1.z * g; wr[8 * h + i][7] = w1.w * g; }
    float br[8];
#pragma unroll
    for (int e = 0; e < 8; ++e) br[e] = c.br[e];
    uint4 v[2][2], vn[2][2];
#pragma unroll
    for (int k = 0; k < 2; ++k) { const uint4* xr = (const uint4*)(c.H + (size_t)(row0 + k) * 1024); vn[k][0] = xr[lane]; vn[k][1] = xr[64 + lane]; }
    for (int rb = 0; rb < 32; rb += 2) {
#pragma unroll
        for (int k = 0; k < 2; ++k) { v[k][0] = vn[k][0]; v[k][1] = vn[k][1]; }
        if (rb + 2 < 32) {
#pragma unroll
            for (int k = 0; k < 2; ++k) { const uint4* xr = (const uint4*)(c.H + (size_t)(row0 + rb + 2 + k) * 1024); vn[k][0] = xr[lane]; vn[k][1] = xr[64 + lane]; } }
#pragma unroll
        for (int k = 0; k < 2; ++k) { const int row = row0 + rb + k; float ss = 0.f, lg[8];
#pragma unroll
            for (int e = 0; e < 8; ++e) lg[e] = 0.f;
#pragma unroll
            for (int h = 0; h < 2; ++h) { float f[8]; unpack2(v[k][h].x, f[0], f[1]); unpack2(v[k][h].y, f[2], f[3]); unpack2(v[k][h].z, f[4], f[5]); unpack2(v[k][h].w, f[6], f[7]);
#pragma unroll
                for (int i = 0; i < 8; ++i) { ss += f[i] * f[i];
#pragma unroll
                    for (int e = 0; e < 8; ++e) lg[e] += f[i] * wr[8 * h + i][e]; } }
            ss = wsum(ss, lane); const float r = rsqrtf(ss * (1.f / 1024.f) + EPSF);
#pragma unroll
            for (int e = 0; e < 8; ++e) lg[e] = wsum(lg[e], lane) * r + br[e];
            int i1 = 0; float v1 = lg[0];
#pragma unroll
            for (int e = 1; e < 8; ++e) if (lg[e] > v1) { v1 = lg[e]; i1 = e; }
            int i2 = -1; float v2 = -3.0e38f;
#pragma unroll
            for (int e = 0; e < 8; ++e) if (e != i1 && lg[e] > v2) { v2 = lg[e]; i2 = e; }
            const float e2 = expf(v2 - v1), g1 = 1.f / (1.f + e2), g2 = e2 / (1.f + e2);
            if (lane == 0) { c.TOPI[(size_t)row * 2] = i1; c.TOPI[(size_t)row * 2 + 1] = i2; c.TOPG[(size_t)row * 2] = g1; c.TOPG[(size_t)row * 2 + 1] = g2; c.RTOK[row] = r; } }
    }
}

__device__ __forceinline__ void cumsum_batch(const Ctx& c, int b, LAS float* sm  , int tid) {
    const int lane = tid & 63, wave = tid >> 6;
    const float4* src = (const float4*)c.FLOG + (size_t)b * SEQ + tid * 8; float4* dst = (float4*)c.CUM + (size_t)b * SEQ + tid * 8;
    float4 v[8];
#pragma unroll
    for (int i = 0; i < 8; ++i) v[i] = src[i];
#pragma unroll
    for (int i = 1; i < 8; ++i) { v[i].x += v[i - 1].x; v[i].y += v[i - 1].y; v[i].z += v[i - 1].z; v[i].w += v[i - 1].w; }
    const float4 tot = v[7]; float4 inc = tot;
#pragma unroll
    for (int o = 1; o < 64; o <<= 1) { const int si = ((lane - o) & 63) << 2; const float tx = __int_as_float(__builtin_amdgcn_ds_bpermute(si, __float_as_int(inc.x))), ty = __int_as_float(__builtin_amdgcn_ds_bpermute(si, __float_as_int(inc.y))), tz = __int_as_float(__builtin_amdgcn_ds_bpermute(si, __float_as_int(inc.z))), tw = __int_as_float(__builtin_amdgcn_ds_bpermute(si, __float_as_int(inc.w))); if (lane >= o) { inc.x += tx; inc.y += ty; inc.z += tz; inc.w += tw; } }
    if (lane == 63) { sm[wave * 4 + 0] = inc.x; sm[wave * 4 + 1] = inc.y; sm[wave * 4 + 2] = inc.z; sm[wave * 4 + 3] = inc.w; }
    __syncthreads();
    float4 base = {0.f, 0.f, 0.f, 0.f};
    for (int w = 0; w < wave; ++w) { base.x += sm[w * 4 + 0]; base.y += sm[w * 4 + 1]; base.z += sm[w * 4 + 2]; base.w += sm[w * 4 + 3]; }
    const float4 ex = {base.x + inc.x - tot.x, base.y + inc.y - tot.y, base.z + inc.z - tot.z, base.w + inc.w - tot.w};
#pragma unroll
    for (int i = 0; i < 8; ++i) { const float4 cv = make_float4(v[i].x + ex.x, v[i].y + ex.y, v[i].z + ex.z, v[i].w + ex.w); dst[i] = cv;
        const float cc[4] = {cv.x, cv.y, cv.z, cv.w};
#pragma unroll
        for (int h = 0; h < 4; ++h) { const float fb = -cc[h] * 1.4426950408889634f; const bf16 b0 = f2bf(fb); const float r1 = fb - bf2f(b0); const bf16 b1 = f2bf(r1); const bf16 b2 = f2bf(r1 - bf2f(b1));
            uint4 rec; rec.x = (unsigned)b0 | ((unsigned)b1 << 16); rec.y = (unsigned)b2; rec.z = 0u; rec.w = 0u;
            *(uint4*)(c.CUMX + ((size_t)(b * 4 + h) * SEQ + tid * 8 + i) * 8) = rec; } }
    __syncthreads();
}
__device__ __forceinline__ void route1_chunk(const Ctx& c, int ch, LAS int* sm  , int tid) {
    const int lane = tid & 63, wave = tid >> 6;
    if (tid < 16) sm[tid] = 0;
    __syncthreads();
    route_rows32(c, ch * 256 + wave * 32, lane);
    __syncthreads();
    if (tid < 256) { const int row = ch * 256 + tid; const int e1 = __hip_atomic_load(c.TOPI + (size_t)row * 2, __ATOMIC_RELAXED, __HIP_MEMORY_SCOPE_AGENT), e2 = __hip_atomic_load(c.TOPI + (size_t)row * 2 + 1, __ATOMIC_RELAXED, __HIP_MEMORY_SCOPE_AGENT);
        atomicAdd((int*)&sm[e1], 1); atomicAdd((int*)&sm[8 + e2], 1); }
    __syncthreads();
    if (tid < 16) c.CH[ch * 16 + tid] = sm[tid];
    __syncthreads();
}
__device__ __forceinline__ void route2_chunk(const Ctx& c, int ch, LAS int* sm  , int tid) {
    const int lane = tid & 63, wave = tid >> 6;
    LAS int* sCH = sm; LAS int* sTot = sm + 4096; LAS int* sPre = sm + 4096 + 16; LAS int* sOff = sm + 4096 + 32; LAS int* sWc = sm + 4096 + 64; LAS int* sSlot = sm + 4096 + 128;
    for (int i = tid; i < 4096; i += 512) sCH[i] = c.CH[i];
    __syncthreads();
    if (tid < 16) { int tot = 0, pre = 0; for (int k = 0; k < 256; ++k) { const int v = sCH[k * 16 + tid]; tot += v; if (k < ch) pre += v; } sTot[tid] = tot; sPre[tid] = pre; }
    __syncthreads();
    if (tid == 0) { int o = 0; for (int g = 0; g < 16; ++g) { sOff[g] = o; o += (sTot[g] + 255) & ~255; } sOff[16] = o; }
    __syncthreads();
    int e1 = -1, e2 = -1, r1 = 0, r2 = 0; const int row = ch * 256 + tid;
    if (tid < 256) { e1 = c.TOPI[(size_t)row * 2]; e2 = c.TOPI[(size_t)row * 2 + 1]; }
    for (int g = 0; g < 16; ++g) { const bool pred = (tid < 256) && (g < 8 ? (e1 == g) : (e2 == g - 8)); const unsigned long long m = __ballot(pred);
        const int rk = __popcll(m & ((1ull << lane) - 1ull)); if (pred) { if (g < 8) r1 = rk; else r2 = rk; }
        if (lane == 0 && wave < 4) sWc[wave * 16 + g] = __popcll(m); }
    __syncthreads();
    if (tid < 256) { int b1 = sOff[e1] + sPre[e1], b2 = sOff[8 + e2] + sPre[8 + e2]; for (int w = 0; w < wave; ++w) { b1 += sWc[w * 16 + e1]; b2 += sWc[w * 16 + 8 + e2]; }
        const int s1 = b1 + r1, s2 = b2 + r2; sSlot[tid * 2] = s1; sSlot[tid * 2 + 1] = s2;
        c.SLOT_TOK[s1] = row; c.SLOT_TOK[s2] = row; c.SLOT_GATE[s1] = c.TOPG[(size_t)row * 2]; c.SLOT_GATE[s2] = c.TOPG[(size_t)row * 2 + 1]; const float rr = c.RTOK[row]; c.SLOT_R[s1] = rr; c.SLOT_R[s2] = rr; }
    __syncthreads();
#if !GATHER_A
    for (int i = 0; i < 32; i += 2) { const int t0 = wave * 32 + i, t1 = t0 + 1;
        const uint4* s0 = (const uint4*)(c.H + (size_t)(ch * 256 + t0) * 1024); const uint4* s1 = (const uint4*)(c.H + (size_t)(ch * 256 + t1) * 1024);
        const uint4 a0 = s0[lane], b0 = s0[lane + 64], a1 = s1[lane], b1 = s1[lane + 64];
        uint4* d00 = (uint4*)(c.HS + (size_t)sSlot[t0 * 2] * 1024); uint4* d01 = (uint4*)(c.HS + (size_t)sSlot[t0 * 2 + 1] * 1024); uint4* d10 = (uint4*)(c.HS + (size_t)sSlot[t1 * 2] * 1024); uint4* d11 = (uint4*)(c.HS + (size_t)sSlot[t1 * 2 + 1] * 1024);
        d00[lane] = a0; d00[lane + 64] = b0; d01[lane] = a0; d01[lane + 64] = b0; d10[lane] = a1; d10[lane + 64] = b1; d11[lane] = a1; d11[lane + 64] = b1; }
#endif
    for (int g = 0; g < 16; ++g) { const int rem = sTot[g] & 255; if (rem && ch >= rem) { const int r = sOff[g] + (sTot[g] & ~255) + ch; if (!GATHER_A) ((unsigned*)(c.HS + (size_t)r * 1024))[tid] = 0u; if (tid == 0) { c.SLOT_TOK[r] = -1; c.SLOT_GATE[r] = 0.f; c.SLOT_R[r] = 0.f; } } }
    if (ch == 0) { const int nt = sOff[16] >> 8; for (int t = tid; t < MAXTILES + 16; t += 512) { int g = -1; if (t < nt) { for (int q = 0; q < 16; ++q) if ((t << 8) >= sOff[q] && (t << 8) < sOff[q + 1]) g = q; } c.TAB[t] = g; } if (tid == 0) { c.TAB[1000] = nt; c.TAB[1001] = sOff[8] >> 8; } }
    __syncthreads();
}

#if BUILD_STEP < 2
enum { PH_NORM1 = 0, PH_POSTPROJ, PH_CUMSUM, PH_POSTUP, PH_MIXNORM, PH_NORM2, PH_MEMNORM_Q, PH_MEMKV_NORM, PH_MEMNORM_K, PH_NORM3, PH_ROUTE1, PH_ROUTE2, PH_ZEROPAD };
__global__ void __launch_bounds__(512) k_elem(Args a) {
    __shared__ int smem[4096 + 128 + 512 + 64];
    const Ctx c = make_ctx(a, a.l);
    const int tid = threadIdx.x, lane = tid & 63, wave = tid >> 6, gw = blockIdx.x * 8 + wave, ngw = gridDim.x * 8;
    switch (a.phase) {
    case PH_NORM1: pass_norm(a.l == 0 ? c.x_in : c.X, c.mix_norm, c.H, MTOK, gw, ngw, lane); break;
    case PH_POSTPROJ: pass_post_proj(c, 0, MTOK, gw, ngw, lane); break;
    case PH_CUMSUM: for (int b = blockIdx.x; b < BATCH; b += gridDim.x) cumsum_batch(c, b, (LAS float*)smem, tid); break;
    case PH_POSTUP: pass_post_up(c, 0, MTOK, gw, ngw, lane); break;
    case PH_MIXNORM: pass_mixnorm(c, 0, MTOK, gw, ngw, lane); break;
    case PH_NORM2: pass_norm(c.X, c.xattn, c.H, MTOK, gw, ngw, lane); break;
    case PH_MEMNORM_Q: pass_memnorm(c.QM, 512, c.mqg, nullptr, MTOK, gw, ngw, lane); break;
    case PH_MEMKV_NORM: pass_norm(c.mem, c.memn, c.HM, BATCH * MEML, gw, ngw, lane); break;
    case PH_MEMNORM_K: pass_memnorm(c.KVM, 1024, c.mkg, nullptr, BATCH * MEML, gw, ngw, lane); break;
    case PH_NORM3: pass_norm(c.X, c.ffn_norm, c.H, MTOK, gw, ngw, lane); break;
    case PH_ROUTE1: for (int ch = blockIdx.x; ch < 256; ch += gridDim.x) route1_chunk(c, ch, (LAS int*)smem, tid); break;
    case PH_ROUTE2: for (int ch = blockIdx.x; ch < 256; ch += gridDim.x) route2_chunk(c, ch, (LAS int*)smem, tid); break;
    case PH_ZEROPAD: for (int r = gw; r < MTOK; r += ngw) { bf16* p = c.PROJ + (size_t)r * PW + IN_W; if (lane < 23) *(uint2*)(p + 4 * lane) = make_uint2(0u, 0u); } break;
    }
}

template <int EPI> __global__ void __launch_bounds__(256) nv_gemm(const bf16* A, int lda, const float* W, const float* W2, int ldw, size_t wstride, int N, int K, void* out, int ldo, const float* res,
                                                               const int* tile_grp, int kphase, const int* slot_tok, const float* slot_gate) {
    __shared__ float As[16][68]; __shared__ float Ws[16][68]; __shared__ float W2s[EPI == 2 ? 16 : 1][68];
    const int tid = threadIdx.x, tx = tid & 15, ty = tid >> 4, n0 = blockIdx.x * 64, m0 = blockIdx.y * 64;
    if (tile_grp) { const int g = tile_grp[m0 >> 8]; if (g < 0) return; if (EPI == 3 && (g >> 3) != kphase) return; W += (size_t)(g & 7) * wstride; if (EPI == 2) W2 += (size_t)(g & 7) * wstride; }
    float acc[4][4], acc2[4][4];
#pragma unroll
    for (int i = 0; i < 4; ++i)
#pragma unroll
        for (int j = 0; j < 4; ++j) { acc[i][j] = 0.f; acc2[i][j] = 0.f; }
    const int ar = tid >> 2, ak = (tid & 3) * 4, wk = tid >> 4, wn = (tid & 15) * 4;
    for (int k0 = 0; k0 < K; k0 += 16) {
        { float f[4]; ld4bf(A + (size_t)(m0 + ar) * lda + k0 + ak, f); As[ak + 0][ar] = f[0]; As[ak + 1][ar] = f[1]; As[ak + 2][ar] = f[2]; As[ak + 3][ar] = f[3]; }
        { float4 w = make_float4(0.f, 0.f, 0.f, 0.f); if (n0 + wn < N) w = *(const float4*)(W + (size_t)(k0 + wk) * ldw + n0 + wn); *(float4*)&Ws[wk][wn] = w;
          if (EPI == 2) { float4 w2 = make_float4(0.f, 0.f, 0.f, 0.f); if (n0 + wn < N) w2 = *(const float4*)(W2 + (size_t)(k0 + wk) * ldw + n0 + wn); *(float4*)&W2s[wk][wn] = w2; } }
        __syncthreads();
#pragma unroll
        for (int kk = 0; kk < 16; ++kk) { const float4 a = *(const float4*)&As[kk][ty * 4]; const float4 w = *(const float4*)&Ws[kk][tx * 4]; const float av[4] = {a.x, a.y, a.z, a.w}, wv[4] = {w.x, w.y, w.z, w.w};
#pragma unroll
            for (int i = 0; i < 4; ++i)
#pragma unroll
                for (int j = 0; j < 4; ++j) acc[i][j] += av[i] * wv[j];
            if (EPI == 2) { const float4 w2 = *(const float4*)&W2s[kk][tx * 4]; const float w2v[4] = {w2.x, w2.y, w2.z, w2.w};
#pragma unroll
                for (int i = 0; i < 4; ++i)
#pragma unroll
                    for (int j = 0; j < 4; ++j) acc2[i][j] += av[i] * w2v[j]; } }
        __syncthreads();
    }
    const int n = n0 + tx * 4; if (n >= N) return;
#pragma unroll
    for (int i = 0; i < 4; ++i) { const int row = m0 + ty * 4 + i;
        if (EPI == 0) { float f[4] = {acc[i][0], acc[i][1], acc[i][2], acc[i][3]}; st4bf((bf16*)out + (size_t)row * ldo + n, f); }
        if (EPI == 1) { const float4 r = *(const float4*)(res + (size_t)row * ldo + n); *(float4*)((float*)out + (size_t)row * ldo + n) = make_float4(r.x + acc[i][0], r.y + acc[i][1], r.z + acc[i][2], r.w + acc[i][3]); }
        if (EPI == 2) { float f[4];
#pragma unroll
            for (int j = 0; j < 4; ++j) { const float g = acc[i][j]; f[j] = g / (1.f + expf(-g)) * acc2[i][j]; }
            st4bf((bf16*)out + (size_t)row * ldo + n, f); }
        if (EPI == 3) { const int tok = slot_tok[row]; if (tok >= 0) { const float gt = slot_gate[row]; float4* o = (float4*)((float*)out + (size_t)tok * ldo + n); float4 r = *o; r.x += gt * acc[i][0]; r.y += gt * acc[i][1]; r.z += gt * acc[i][2]; r.w += gt * acc[i][3]; *o = r; } }
    }
}

template <int DK, int DK1, int MODE> __global__ void __launch_bounds__(64) nv_attn(const bf16* Q, int ldq, int hq, const bf16* K, int ldk, int hk, const bf16* K2, int ldk2, const bf16* V, int ldv, int hv,
                                                                                    bf16* O, int ldo, int ho, const float* cum, float scale) {
    __shared__ float Ks[64][DK + 4]; __shared__ float Vs[64][68]; __shared__ float Cs[64];
    const int tid = threadIdx.x, h = blockIdx.y, z = blockIdx.z, row = blockIdx.x * 64 + tid, b = row / SEQ, qt = (blockIdx.x * 64 % SEQ) / 64;
    float q[DK];
    { const bf16* qp = Q + (size_t)row * ldq + h * hq;
#pragma unroll
      for (int d = 0; d < DK; d += 8) { float f[8]; ld8bf(qp + d, f);
#pragma unroll
          for (int i = 0; i < 8; ++i) q[d + i] = f[i] * scale; } }
    float o[64];
#pragma unroll
    for (int d = 0; d < 64; ++d) o[d] = 0.f;
    float m = -3.0e38f, l = 0.f; const float cq = (MODE == 0) ? cum[(size_t)row * 4 + h] : 0.f;
    const int ntile = (MODE == 2) ? 4 : qt + 1; const size_t kbase = (MODE == 2) ? (size_t)b * MEML : (size_t)b * SEQ;
    for (int kt = 0; kt < ntile; ++kt) {
        const size_t krow = kbase + kt * 64 + tid;
        { const bf16* kp = K + krow * ldk + h * hk;
#pragma unroll
          for (int d = 0; d < DK1; d += 8) { float f[8]; ld8bf(kp + d, f);
#pragma unroll
              for (int i = 0; i < 8; ++i) Ks[tid][d + i] = f[i]; }
          if (DK > DK1) { const bf16* kp2 = K2 + krow * ldk2;
#pragma unroll
              for (int d = 0; d < DK - DK1; d += 8) { float f[8]; ld8bf(kp2 + d, f);
#pragma unroll
                  for (int i = 0; i < 8; ++i) Ks[tid][DK1 + d + i] = f[i]; } }
          const bf16* vp = V + krow * ldv + h * hv + z * 64;
#pragma unroll
          for (int d = 0; d < 64; d += 8) { float f[8]; ld8bf(vp + d, f);
#pragma unroll
              for (int i = 0; i < 8; ++i) Vs[tid][d + i] = f[i]; }
          if (MODE == 0) Cs[tid] = cum[krow * 4 + h]; }
        __syncthreads();
        const int jmax = (MODE == 0 && kt == ntile - 1) ? tid : 63;
        for (int j = 0; j <= jmax; ++j) {
            float s = 0.f;
#pragma unroll
            for (int d = 0; d < DK; d += 4) { const float4 kv = *(const float4*)&Ks[j][d]; s += q[d] * kv.x + q[d + 1] * kv.y + q[d + 2] * kv.z + q[d + 3] * kv.w; }
            if (MODE == 0) s += cq - Cs[j];
            if (s > m) { const float sc = expf(m - s); l *= sc;
#pragma unroll
                for (int d = 0; d < 64; ++d) o[d] *= sc;
                m = s; }
            const float p = expf(s - m); l += p;
#pragma unroll
            for (int d = 0; d < 64; d += 4) { const float4 vv = *(const float4*)&Vs[j][d]; o[d] += p * vv.x; o[d + 1] += p * vv.y; o[d + 2] += p * vv.z; o[d + 3] += p * vv.w; }
        }
        __syncthreads();
    }
    const float il = 1.f / l; bf16* op = O + (size_t)row * ldo + h * ho + z * 64;
#pragma unroll
    for (int d = 0; d < 64; d += 8) { float f[8];
#pragma unroll
        for (int i = 0; i < 8; ++i) f[i] = o[d + i] * il;
        st8bf(op + d, f); }
}
__global__ void __launch_bounds__(256) nv_sgu(const bf16* PROJ, const float* wS, const float* bS, bf16* OMIX) {
    __shared__ float Vs[128][68];
    const int tid = threadIdx.x, win = blockIdx.x, g = blockIdx.y; const size_t row0 = (size_t)win * 128;
    for (int i = tid; i < 128 * 8; i += 256) { const int s = i >> 3, d = (i & 7) * 8; float f[8]; ld8bf(PROJ + (row0 + s) * PW + C_VB + g * 64 + d, f);
#pragma unroll
        for (int k = 0; k < 8; ++k) Vs[s][d + k] = f[k]; }
    __syncthreads();
    const int t = tid >> 1, dh = (tid & 1) * 32; float acc[32];
#pragma unroll
    for (int d = 0; d < 32; ++d) acc[d] = 0.f;
    const int smax = ((t >> 6) + 1) * 64; const float* wr = wS + (size_t)g * 16384 + t * 128;
    for (int s = 0; s < smax; ++s) { const float w = wr[s];
#pragma unroll
        for (int d = 0; d < 32; d += 4) { const float4 v = *(const float4*)&Vs[s][dh + d]; acc[d] += w * v.x; acc[d + 1] += w * v.y; acc[d + 2] += w * v.z; acc[d + 3] += w * v.w; } }
    const float bb = bS[g * 128 + t];
#pragma unroll
    for (int d = 0; d < 32; d += 8) { float u[8]; ld8bf(PROJ + (row0 + t) * PW + C_UB + g * 64 + dh + d, u);
#pragma unroll
        for (int k = 0; k < 8; ++k) u[k] *= (acc[d + k] + bb);
        st8bf(OMIX + (row0 + t) * 1024 + 256 + g * 64 + dh + d, u); }
}


#endif
#ifndef REP_ATTN
#define REP_ATTN 1
#endif
#ifndef REP_FOX
#define REP_FOX 1
#endif
#ifndef PROBE_MODE
#define PROBE_MODE 0
#endif
#ifndef REP_MLA
#define REP_MLA 1
#endif
#ifndef REP_SGU
#define REP_SGU 1
#endif
#ifndef REP_ATTM
#define REP_ATTM 1
#endif
#ifndef REP_PRO
#define REP_PRO 1
#endif
#ifndef REP_G1
#define REP_G1 1
#endif
#ifndef REP_F1
#define REP_F1 1
#endif
#ifndef TPA
#define TPA -1
#endif
#ifndef TPB
#define TPB -1
#endif
#ifndef CHAIN
#define CHAIN 1
#endif
#ifndef PRB
#define PRB 0
#endif
namespace pg8 {
typedef unsigned short bf16_t;
typedef short bf16x8 __attribute__((ext_vector_type(8)));
typedef float f32x4 __attribute__((ext_vector_type(4)));
typedef float f32x2 __attribute__((ext_vector_type(2)));
typedef unsigned u32x4 __attribute__((ext_vector_type(4)));
constexpr int BM = 256, BK = 64, HALF = 128, HTB = HALF * BK * 2, STAGE_BYTES = 8 * HTB, NXCD = 8, WGM = 4;
__host__ __device__ __forceinline__ int lds_byte(int r, int c) { const int st = (r >> 4) * 2 + (c >> 5), rr = r & 15, cc = c & 31, ob = rr * 64 + cc * 2; return st * 1024 + (ob ^ (((ob >> 9) & 1) << 5)); }
__host__ __device__ __forceinline__ void stage_rc(int b, int& R, int& C) { const int st = b / 1024, sb = b % 1024, swz = sb ^ (((sb >> 9) & 1) << 5); R = (st >> 1) * 16 + swz / 64; C = (st & 1) * 32 + (swz % 64) / 2; }
__host__ __device__ __forceinline__ int perm32(int rho) { const int n = rho >> 4, i = rho & 15; return 8 * (i >> 2) + 4 * n + (i & 3); }
struct Unit { int pm, pn; const char* a; const char* b; };
__device__ __forceinline__ unsigned cvt_pk_bf16(float lo, float hi) { unsigned r; asm volatile("v_cvt_pk_bf16_f32 %0, %1, %2" : "=v"(r) : "v"(lo), "v"(hi)); return r; }

struct DenseOrder {
    int nM, nN, nwg, G, c, pm0; const char* A; const char* B; size_t tA, tB;
    __device__ __forceinline__ void init(int nM_, int nN_, int G_, int c_, const void* A_, int lda, const void* B_, int K) { nM = nM_; nN = nN_; nwg = nM * nN; G = G_; c = c_; pm0 = 0; A = (const char*)A_; B = (const char*)B_; tA = (size_t)BM * lda * 2; tB = (size_t)BM * K * 2; }
    __device__ __forceinline__ bool map(int i, int& pm, int& pn) const {
        const long L = (long)i * G + c; if (L >= nwg) return false;
        int wgid = (int)L; { const int q = nwg / NXCD, r = nwg % NXCD, xcd = wgid % NXCD, off = wgid / NXCD; wgid = (xcd < r ? xcd * (q + 1) : r * (q + 1) + (xcd - r) * q) + off; }
        const int nig = WGM * nN, gid = wgid / nig, fm = gid * WGM, gsz = (nM - fm) < WGM ? (nM - fm) : WGM;
        pm = fm + ((wgid % nig) % gsz); pn = (wgid % nig) / gsz; return true; }
    __device__ __forceinline__ bool next(int i, Unit& u) const { int pm, pn; if (!map(i, pm, pn)) return false; u.pm = pm; u.pn = pn; u.a = A + (size_t)pm * tA; u.b = B + (size_t)pn * tB; return true; }
};
struct RowOrder {
    int nM, nN, G, c; const char* A; const char* B; size_t tA, tB;
    __device__ __forceinline__ void init(int nM_, int nN_, int G_, int c_, const void* A_, int lda, const void* B_, int K) { nM = nM_; nN = nN_; G = G_; c = c_; A = (const char*)A_; B = (const char*)B_; tA = (size_t)BM * lda * 2; tB = (size_t)BM * K * 2; }
    __device__ __forceinline__ bool next(int i, Unit& u) const { const int pm = c + (i / nN) * G; if (pm >= nM) return false; u.pm = pm; u.pn = (i + c) % nN;
        u.a = A + (size_t)pm * tA; u.b = B + (size_t)u.pn * tB; return true; }
};
struct GroupOrder : DenseOrder {
    const int* tab; size_t estride;
    __device__ __forceinline__ bool next(int i, Unit& u) const { int pm, pn; if (!map(i, pm, pn)) return false; pm += pm0; u.pm = pm; u.pn = pn; const int e = tab[pm] & 7; u.a = A + (size_t)pm * tA; u.b = B + (size_t)e * estride + (size_t)pn * tB; return true; }
};
struct GatherOrder : GroupOrder { static constexpr bool GATHER = true; const int* tok;
    __device__ __forceinline__ bool next(int i, Unit& u) const { int pm, pn; if (!map(i, pm, pn)) return false; pm += pm0; u.pm = pm; u.pn = pn; const int e = tab[pm] & 7; u.a = A; u.b = B + (size_t)e * estride + (size_t)pn * tB; return true; }
};
template <class T, class = void> struct SchedTraits { static constexpr bool GATHER = false; };
template <class T> struct SchedTraits<T, decltype(void(T::GATHER))> { static constexpr bool GATHER = T::GATHER; };
template <class S> __device__ __forceinline__ auto sched_tok(const S& s, int) -> decltype(s.tok) { return s.tok; }
template <class S> __device__ __forceinline__ const int* sched_tok(const S&, long) { return nullptr; }
struct KvmOrder {
    int c; const char* A; const char* B; size_t bstride;
    __device__ __forceinline__ bool next(int i, Unit& u) const { if (i > 0 || c >= 128) return false; const int l2 = c >> 6, r = c & 63; u.pm = l2 * 16 + (r & 15); u.pn = r >> 4; u.a = A + (size_t)u.pm * (256 * 1024 * 2); u.b = B + (size_t)l2 * bstride + (size_t)u.pn * (256 * 1024 * 2); return true; }
};

struct EpiStore { static constexpr bool PERM = true; bf16_t* O; int ldc;
    __device__ __forceinline__ void operator()(const f32x4 (&acc)[2][2][4][2], const Unit& u, int wr, int wc, int fr, int fq) const {
        const int row0 = u.pm * BM + wr * 64 + fr, col0 = u.pn * BM + wc * 32 + 8 * fq;
#pragma unroll
        for (int ai = 0; ai < 2; ++ai)
#pragma unroll
            for (int m = 0; m < 4; ++m) { bf16_t* rowp = O + (size_t)(row0 + ai * HALF + m * 16) * ldc + col0;
#pragma unroll
                for (int bj = 0; bj < 2; ++bj) { const f32x4 v0 = acc[ai][bj][m][0], v1 = acc[ai][bj][m][1]; u32x4 w; w.x = cvt_pk_bf16(v0[0], v0[1]); w.y = cvt_pk_bf16(v0[2], v0[3]); w.z = cvt_pk_bf16(v1[0], v1[1]); w.w = cvt_pk_bf16(v1[2], v1[3]);
                    *(u32x4*)(rowp + bj * HALF) = w; } } } };
__device__ __forceinline__ void row_rs(const float* part, int row0, int fr, int fq, float (&rs)[2][4]) {
    const int lane = fr + 16 * fq;
#pragma unroll
    for (int ai = 0; ai < 2; ++ai)
#pragma unroll
        for (int m = 0; m < 4; ++m) { const f32x4 p = *(const f32x4*)(part + (size_t)(row0 + ai * HALF + m * 16) * 16 + 4 * fq); float s = (p[0] + p[1]) + (p[2] + p[3]);
            s += shx(s, lane, 16); s += shx(s, lane, 32); rs[ai][m] = rsqrtf(s * (1.f / 1024.f) + EPSF); }
}
struct EpiStoreN { static constexpr bool PERM = true; bf16_t* O; int ldc; const float* part;
    __device__ __forceinline__ void operator()(const f32x4 (&acc)[2][2][4][2], const Unit& u, int wr, int wc, int fr, int fq) const {
        const int row0 = u.pm * BM + wr * 64 + fr, col0 = u.pn * BM + wc * 32 + 8 * fq; float rs[2][4]; row_rs(part, row0, fr, fq, rs);
#pragma unroll
        for (int ai = 0; ai < 2; ++ai)
#pragma unroll
            for (int m = 0; m < 4; ++m) { bf16_t* rowp = O + (size_t)(row0 + ai * HALF + m * 16) * ldc + col0; const float r = rs[ai][m];
#pragma unroll
                for (int bj = 0; bj < 2; ++bj) { const f32x4 v0 = acc[ai][bj][m][0] * r, v1 = acc[ai][bj][m][1] * r; u32x4 w; w.x = cvt_pk_bf16(v0[0], v0[1]); w.y = cvt_pk_bf16(v0[2], v0[3]); w.z = cvt_pk_bf16(v1[0], v1[1]); w.w = cvt_pk_bf16(v1[2], v1[3]);
                    *(u32x4*)(rowp + bj * HALF) = w; } } } };
struct EpiRes { static constexpr bool PERM = true; bf16_t* xb; float* part;
    __device__ __forceinline__ void operator()(const f32x4 (&acc)[2][2][4][2], const Unit& u, int wr, int wc, int fr, int fq) const {
        const int row0 = u.pm * BM + wr * 64 + fr, col0 = u.pn * BM + wc * 32 + 8 * fq, lane = fr + 16 * fq;
        u32x4 rin[2][4][2];
#pragma unroll
        for (int ai = 0; ai < 2; ++ai)
#pragma unroll
            for (int m = 0; m < 4; ++m)
#pragma unroll
                for (int bj = 0; bj < 2; ++bj) rin[ai][m][bj] = *(const u32x4*)(xb + (size_t)(row0 + ai * HALF + m * 16) * 1024 + col0 + bj * HALF);
#pragma unroll
        for (int ai = 0; ai < 2; ++ai)
#pragma unroll
            for (int m = 0; m < 4; ++m) { const int row = row0 + ai * HALF + m * 16; const size_t off = (size_t)row * 1024 + col0; float ss = 0.f;
#pragma unroll
                for (int bj = 0; bj < 2; ++bj) { const u32x4 r = rin[ai][m][bj]; f32x4 v0, v1;
                    v0[0] = __uint_as_float(r.x << 16); v0[1] = __uint_as_float(r.x & 0xffff0000u); v0[2] = __uint_as_float(r.y << 16); v0[3] = __uint_as_float(r.y & 0xffff0000u);
                    v1[0] = __uint_as_float(r.z << 16); v1[1] = __uint_as_float(r.z & 0xffff0000u); v1[2] = __uint_as_float(r.w << 16); v1[3] = __uint_as_float(r.w & 0xffff0000u);
                    v0 += acc[ai][bj][m][0]; v1 += acc[ai][bj][m][1];
                    u32x4 w; w.x = cvt_pk_bf16(v0[0], v0[1]); w.y = cvt_pk_bf16(v0[2], v0[3]); w.z = cvt_pk_bf16(v1[0], v1[1]); w.w = cvt_pk_bf16(v1[2], v1[3]); *(u32x4*)(xb + off + bj * HALF) = w;
                    ss += (v0[0] * v0[0] + v0[1] * v0[1]) + (v0[2] * v0[2] + v0[3] * v0[3]) + (v1[0] * v1[0] + v1[1] * v1[1]) + (v1[2] * v1[2] + v1[3] * v1[3]); }
                ss += shx(ss, lane, 16); ss += shx(ss, lane, 32); if (fq == 0) part[(size_t)row * 16 + 4 * u.pn + wc] = ss; } } };
constexpr int RESC_TAB_OFF = 131072 + 1024;
struct EpiResMix : EpiRes { static constexpr bool RESC = true; const float* pbr;
    __device__ __forceinline__ void operator()(const f32x4 (&acc)[2][2][4][2], const Unit& u, int wr, int wc, int fr, int fq) const {
        const int row0 = u.pm * BM + wr * 64 + fr, col0 = u.pn * BM + wc * 32 + 8 * fq, lane = fr + 16 * fq;
#pragma unroll
        for (int ai = 0; ai < 2; ++ai) { u32x4 rin[4][2];
#pragma unroll
            for (int m = 0; m < 4; ++m)
#pragma unroll
                for (int bj = 0; bj < 2; ++bj) rin[m][bj] = *(const u32x4*)(xb + (size_t)(row0 + ai * HALF + m * 16) * 1024 + col0 + bj * HALF);
#pragma unroll
            for (int m = 0; m < 4; ++m) { const int row = row0 + ai * HALF + m * 16; const size_t off = (size_t)row * 1024 + col0; float ss = 0.f;
#pragma unroll
                for (int bj = 0; bj < 2; ++bj) { const u32x4 r = rin[m][bj]; f32x4 v0, v1;
                    v0[0] = __uint_as_float(r.x << 16); v0[1] = __uint_as_float(r.x & 0xffff0000u); v0[2] = __uint_as_float(r.y << 16); v0[3] = __uint_as_float(r.y & 0xffff0000u);
                    v1[0] = __uint_as_float(r.z << 16); v1[1] = __uint_as_float(r.z & 0xffff0000u); v1[2] = __uint_as_float(r.w << 16); v1[3] = __uint_as_float(r.w & 0xffff0000u);
                    v0 += acc[ai][bj][m][0]; v1 += acc[ai][bj][m][1];
                    u32x4 w; w.x = cvt_pk_bf16(v0[0], v0[1]); w.y = cvt_pk_bf16(v0[2], v0[3]); w.z = cvt_pk_bf16(v1[0], v1[1]); w.w = cvt_pk_bf16(v1[2], v1[3]); *(u32x4*)(xb + off + bj * HALF) = w;
                    ss += (v0[0] * v0[0] + v0[1] * v0[1]) + (v0[2] * v0[2] + v0[3] * v0[3]) + (v1[0] * v1[0] + v1[1] * v1[1]) + (v1[2] * v1[2] + v1[3] * v1[3]); }
                ss += shx(ss, lane, 16); ss += shx(ss, lane, 32); if (fq == 0) part[(size_t)row * 16 + 4 * u.pn + wc] = ss; }
            asm volatile("" ::: "memory"); } }
    __device__ __forceinline__ void build(const Unit& u, LAS unsigned char* lds, int par, int tid) const {
        if (tid < 256) { const float4* p = (const float4*)(pbr + (size_t)(u.pm * BM + tid) * 24); const float4 a = p[0], c0 = p[2], c1 = p[3], b0 = p[4], b1 = p[5];
            const float sa = (a.x + a.y) + (a.z + a.w), sc = ((c0.x + c0.y) + (c0.z + c0.w)) + ((c1.x + c1.y) + (c1.z + c1.w)), sb = ((b0.x + b0.y) + (b0.z + b0.w)) + ((b1.x + b1.y) + (b1.z + b1.w));
            const float r1 = rsqrtf(sa * (1.f / 256.f) + EPSF), r2 = rsqrtf(sb * (1.f / 256.f) + EPSF), r3 = rsqrtf(sc * (1.f / 512.f) + EPSF);
            f32x4 t; t[0] = r1 / r2; t[1] = r2 / r3; t[2] = r3; t[3] = 0.f; *(LAS f32x4*)(lds + RESC_TAB_OFF + par * 4096 + tid * 16) = t; } } };
template <class T, class = void> struct EpiTraits { static constexpr bool RESC = false; };
template <class T> struct EpiTraits<T, decltype(void(T::RESC))> { static constexpr bool RESC = T::RESC; };
__device__ __forceinline__ float silu_mul(float g, float u) { return g * __builtin_amdgcn_rcpf(1.0f + __builtin_amdgcn_exp2f(-1.4426950408889634f * g)) * u; }
struct EpiSwiglu { static constexpr bool PERM = true; bf16_t* O; int ldc; const float* part; const float* rsrow;
    __device__ __forceinline__ void operator()(const f32x4 (&acc)[2][2][4][2], const Unit& u, int wr, int wc, int fr, int fq) const {
        const int row0 = u.pm * BM + wr * 64 + fr, col0 = u.pn * HALF + wc * 32 + 8 * fq; float rs[2][4];
        if (part) row_rs(part, row0, fr, fq, rs);
        else {
#pragma unroll
            for (int ai = 0; ai < 2; ++ai)
#pragma unroll
                for (int m = 0; m < 4; ++m) rs[ai][m] = rsrow[row0 + ai * HALF + m * 16]; }
#pragma unroll
        for (int ai = 0; ai < 2; ++ai)
#pragma unroll
            for (int m = 0; m < 4; ++m) { const float r = rs[ai][m]; const f32x4 g0 = acc[ai][0][m][0] * r, g1 = acc[ai][0][m][1] * r, u0 = acc[ai][1][m][0] * r, u1 = acc[ai][1][m][1] * r; u32x4 w;
                w.x = cvt_pk_bf16(silu_mul(g0[0], u0[0]), silu_mul(g0[1], u0[1])); w.y = cvt_pk_bf16(silu_mul(g0[2], u0[2]), silu_mul(g0[3], u0[3]));
                w.z = cvt_pk_bf16(silu_mul(g1[0], u1[0]), silu_mul(g1[1], u1[1])); w.w = cvt_pk_bf16(silu_mul(g1[2], u1[2]), silu_mul(g1[3], u1[3]));
                *(u32x4*)(O + (size_t)(row0 + ai * HALF + m * 16) * ldc + col0) = w; } } };
template <int NP> __device__ __forceinline__ void row_rs_np(const float* part, float inv_n, int row0, int fr, int fq, float (&rs)[2][4]) {
    const int lane = fr + 16 * fq;
#pragma unroll
    for (int ai = 0; ai < 2; ++ai)
#pragma unroll
        for (int m = 0; m < 4; ++m) { float s = (fq < NP) ? part[(size_t)(row0 + ai * HALF + m * 16) * NP + fq] : 0.f; s += shx(s, lane, 16); s += shx(s, lane, 32); rs[ai][m] = rsqrtf(s * inv_n + EPSF); }
}
struct EpiStoreQ { static constexpr bool PERM = true; bf16_t* O; int ldc; const float* part;
    __device__ __forceinline__ void operator()(const f32x4 (&acc)[2][2][4][2], const Unit& u, int wr, int wc, int fr, int fq) const {
        const int row0 = u.pm * BM + wr * 64 + fr, col0 = u.pn * BM + wc * 32 + 8 * fq; float rs[2][4]; row_rs_np<4>(part, 1.f / 256.f, row0, fr, fq, rs);
#pragma unroll
        for (int ai = 0; ai < 2; ++ai)
#pragma unroll
            for (int m = 0; m < 4; ++m) { bf16_t* rowp = O + (size_t)(row0 + ai * HALF + m * 16) * ldc + col0; const float r = rs[ai][m];
#pragma unroll
                for (int bj = 0; bj < 2; ++bj) { const f32x4 v0 = acc[ai][bj][m][0] * r, v1 = acc[ai][bj][m][1] * r; u32x4 w; w.x = cvt_pk_bf16(v0[0], v0[1]); w.y = cvt_pk_bf16(v0[2], v0[3]); w.z = cvt_pk_bf16(v1[0], v1[1]); w.w = cvt_pk_bf16(v1[2], v1[3]);
                    *(u32x4*)(rowp + bj * HALF) = w; } } } };
struct EpiProj { static constexpr bool PERM = true; bf16_t* O; const float* part; const float *aq, *ak, *bvg, *krg, *bfg; const float2* ropet; float *flog, *pq, *pkv;
    __device__ __forceinline__ void operator()(const f32x4 (&acc)[2][2][4][2], const Unit& u, int wr, int wc, int fr, int fq) const {
        const int row0 = u.pm * BM + wr * 64 + fr, lane = fr + 16 * fq, pn = u.pn; float rs[2][4]; row_rs(part, row0, fr, fq, rs);
        float g[2][8];
#pragma unroll
        for (int bj = 0; bj < 2; ++bj)
#pragma unroll
            for (int i = 0; i < 8; ++i) { const int d = 32 * bj + 8 * fq + i; g[bj][i] = (pn == 0) ? aq[d] * (0.125f * 1.4426950408889634f) : (pn == 1) ? ak[d] : (pn == 4) ? bvg[64 * wc + d] : (pn == 6 && wc == 2 && bj == 0) ? krg[8 * fq + i] : 1.f; }
#pragma unroll
        for (int ai = 0; ai < 2; ++ai)
#pragma unroll
            for (int m = 0; m < 4; ++m) { const int row = row0 + ai * HALF + m * 16; const float r = rs[ai][m]; float v[2][8];
#pragma unroll
                for (int bj = 0; bj < 2; ++bj)
#pragma unroll
                    for (int i = 0; i < 8; ++i) v[bj][i] = acc[ai][bj][m][i >> 2][i & 3] * r;
                if (pn == 3 || pn == 4) {
#pragma unroll
                    for (int bj = 0; bj < 2; ++bj)
#pragma unroll
                        for (int i = 0; i < 8; ++i) v[bj][i] = gelu_erf(v[bj][i]); }
                if (pn <= 1 || pn == 5 || (pn == 6 && wc < 2)) { float ss = 0.f;
#pragma unroll
                    for (int bj = 0; bj < 2; ++bj)
#pragma unroll
                        for (int i = 0; i < 8; ++i) ss += v[bj][i] * v[bj][i];
                    ss += shx(ss, lane, 16); ss += shx(ss, lane, 32);
                    if (pn <= 1) { const float rr = rsqrtf(ss * (1.f / 64.f) + EPSF);
#pragma unroll
                        for (int bj = 0; bj < 2; ++bj)
#pragma unroll
                            for (int i = 0; i < 8; ++i) v[bj][i] *= rr * g[bj][i]; }
                    else if (fq == 0) { if (pn == 5) pq[(size_t)row * 4 + wc] = ss; else pkv[(size_t)row * 2 + wc] = ss; } }
                if (pn == 4) { float s1 = 0.f;
#pragma unroll
                    for (int bj = 0; bj < 2; ++bj)
#pragma unroll
                        for (int i = 0; i < 8; ++i) s1 += v[bj][i];
                    s1 += shx(s1, lane, 16); s1 += shx(s1, lane, 32); const float mu = s1 * (1.f / 64.f); float q2 = 0.f;
#pragma unroll
                    for (int bj = 0; bj < 2; ++bj)
#pragma unroll
                        for (int i = 0; i < 8; ++i) { v[bj][i] -= mu; q2 += v[bj][i] * v[bj][i]; }
                    q2 += shx(q2, lane, 16); q2 += shx(q2, lane, 32); const float rr = rsqrtf(q2 * (1.f / 64.f) + EPSF);
#pragma unroll
                    for (int bj = 0; bj < 2; ++bj)
#pragma unroll
                        for (int i = 0; i < 8; ++i) v[bj][i] *= rr * g[bj][i]; }
                if (pn == 6 && wc == 2) {
                    float ss = 0.f;
#pragma unroll
                    for (int i = 0; i < 8; ++i) ss += v[0][i] * v[0][i];
                    ss += shx(ss, lane, 16); ss += shx(ss, lane, 32); const float rr = rsqrtf(ss * (1.f / 32.f) + EPSF);
                    const float4* tp = (const float4*)(ropet + (size_t)row * 16 + 8 * (fq & 1));
#pragma unroll
                    for (int i = 0; i < 8; i += 2) { const float4 t = tp[i >> 1];
                        const float x0 = v[0][i] * rr * g[0][i], x1 = v[0][i + 1] * rr * g[0][i + 1], p0 = shx(x0, lane, 32), p1 = shx(x1, lane, 32);
                        v[0][i] = (fq < 2) ? (x0 * t.x - p0 * t.y) : (p0 * t.y + x0 * t.x); v[0][i + 1] = (fq < 2) ? (x1 * t.z - p1 * t.w) : (p1 * t.w + x1 * t.z); }
                    if (fq == 0) { f32x4 ls;
#pragma unroll
                        for (int j = 0; j < 4; ++j) ls[j] = logsigmoid(v[1][j] + bfg[j]);
                        *(f32x4*)(flog + (size_t)row * 4) = ls; } }
                bf16_t* rowp = O + (size_t)row * PW + pn * BM + 64 * wc + 8 * fq;
#pragma unroll
                for (int bj = 0; bj < 2; ++bj) { u32x4 w; w.x = cvt_pk_bf16(v[bj][0], v[bj][1]); w.y = cvt_pk_bf16(v[bj][2], v[bj][3]); w.z = cvt_pk_bf16(v[bj][4], v[bj][5]); w.w = cvt_pk_bf16(v[bj][6], v[bj][7]); *(u32x4*)(rowp + 32 * bj) = w; } } } };
struct EpiKV { static constexpr bool PERM = true; bf16_t* O; const float* kg; const float* part;
    __device__ __forceinline__ void operator()(const f32x4 (&acc)[2][2][4][2], const Unit& u, int wr, int wc, int fr, int fq) const {
        const int row0 = u.pm * BM + wr * 64 + fr, lane = fr + 16 * fq; const bool isk = (wc & 1) == 0;
        float rs[2][4]; row_rs_np<2>(part, 1.f / 128.f, row0, fr, fq, rs);
        float g[2][8];
#pragma unroll
        for (int bj = 0; bj < 2; ++bj)
#pragma unroll
            for (int i = 0; i < 8; ++i) g[bj][i] = isk ? kg[32 * bj + 8 * fq + i] : 1.f;
#pragma unroll
        for (int ai = 0; ai < 2; ++ai)
#pragma unroll
            for (int m = 0; m < 4; ++m) { const float r0 = rs[ai][m]; float rr = r0;
                if (isk) { float ss = 0.f;
#pragma unroll
                    for (int bj = 0; bj < 2; ++bj)
#pragma unroll
                        for (int n = 0; n < 2; ++n) { const f32x4 v = acc[ai][bj][m][n] * r0; ss += (v[0] * v[0] + v[1] * v[1]) + (v[2] * v[2] + v[3] * v[3]); }
                    ss += shx(ss, lane, 16); ss += shx(ss, lane, 32); rr = r0 * rsqrtf(ss * (1.f / 64.f) + EPSF); }
                bf16_t* rowp = O + (size_t)(row0 + ai * HALF + m * 16) * 1024 + u.pn * BM + 64 * wc + 8 * fq;
#pragma unroll
                for (int bj = 0; bj < 2; ++bj) { const f32x4 v0 = acc[ai][bj][m][0] * rr, v1 = acc[ai][bj][m][1] * rr; u32x4 w;
                    w.x = cvt_pk_bf16(v0[0] * g[bj][0], v0[1] * g[bj][1]); w.y = cvt_pk_bf16(v0[2] * g[bj][2], v0[3] * g[bj][3]); w.z = cvt_pk_bf16(v1[0] * g[bj][4], v1[1] * g[bj][5]); w.w = cvt_pk_bf16(v1[2] * g[bj][6], v1[3] * g[bj][7]);
                    *(u32x4*)(rowp + 32 * bj) = w; } } } };
template <bool FINAL> struct EpiScatter { static constexpr bool PERM = true; bf16_t* xb; float* out; const int* tok; const float* gate; unsigned* cnt; unsigned target;
    __device__ __forceinline__ void pre() const { if (FINAL && cnt) { unsigned sp = 0;
        while ((unsigned)__builtin_amdgcn_readfirstlane((int)__hip_atomic_load(cnt, __ATOMIC_RELAXED, __HIP_MEMORY_SCOPE_AGENT)) < target) { __builtin_amdgcn_s_sleep(40); if (++sp > (1u << 16)) break; }
        asm volatile("" ::: "memory"); } }
    __device__ __forceinline__ void operator()(const f32x4 (&acc)[2][2][4][2], const Unit& u, int wr, int wc, int fr, int fq) const {
        const int row0 = u.pm * BM + wr * 64 + fr, col0 = u.pn * BM + wc * 32 + 8 * fq;
#pragma unroll
        for (int ai = 0; ai < 2; ++ai) {
            int tk[4]; float gt[4];
#pragma unroll
            for (int m = 0; m < 4; ++m) { const int row = row0 + ai * HALF + m * 16; tk[m] = tok[row]; gt[m] = gate[row]; }
            u32x4 rin[4][2];
#pragma unroll
            for (int m = 0; m < 4; ++m) { const size_t off = (size_t)(tk[m] < 0 ? 0 : tk[m]) * 1024 + col0;
#pragma unroll
                for (int bj = 0; bj < 2; ++bj) rin[m][bj] = *(const u32x4*)(xb + off + bj * HALF); }
#pragma unroll
            for (int m = 0; m < 4; ++m) { const int t = tk[m]; const float g = gt[m];
                if (t >= 0) { const size_t off = (size_t)t * 1024 + col0;
#pragma unroll
                    for (int bj = 0; bj < 2; ++bj) { const u32x4 r = rin[m][bj]; f32x4 v0, v1;
                        v0[0] = __uint_as_float(r.x << 16); v0[1] = __uint_as_float(r.x & 0xffff0000u); v0[2] = __uint_as_float(r.y << 16); v0[3] = __uint_as_float(r.y & 0xffff0000u);
                        v1[0] = __uint_as_float(r.z << 16); v1[1] = __uint_as_float(r.z & 0xffff0000u); v1[2] = __uint_as_float(r.w << 16); v1[3] = __uint_as_float(r.w & 0xffff0000u);
                        v0 += g * acc[ai][bj][m][0]; v1 += g * acc[ai][bj][m][1];
                        if (FINAL) { *(f32x4*)(out + off + bj * HALF) = v0; *(f32x4*)(out + off + bj * HALF + 4) = v1; }
                        else { u32x4 w; w.x = cvt_pk_bf16(v0[0], v0[1]); w.y = cvt_pk_bf16(v0[2], v0[3]); w.z = cvt_pk_bf16(v1[0], v1[1]); w.w = cvt_pk_bf16(v1[2], v1[3]); asm volatile("global_store_dwordx4 %0, %1, off sc1\n\ts_nop 1" :: "v"(xb + off + bj * HALF), "v"(w) : "memory"); } } } }
            asm volatile("" ::: "memory"); } } };

template <class T> __device__ __forceinline__ auto epi_pre(const T& e, int) -> decltype(e.pre(), void()) { e.pre(); }
template <class T> __device__ __forceinline__ void epi_pre(const T&, long) {}
template <class Epi, class Sched, bool ALIGN_EPI, bool SP2>
__device__ __forceinline__ void gemm_phase(LAS unsigned char* lds, const int K, const int lda, const Sched& S, const Epi& E, const int tid_in) {
    const int tid = tid_in, wid = __builtin_amdgcn_readfirstlane(tid >> 6), lane = tid & 63, wr = wid >> 2, wc = wid & 3, fr = lane & 15, fq = lane >> 4;
    int nt = K / BK; asm volatile("" : "+s"(nt));
    unsigned voffA, voffB;
    { int R, C; stage_rc(tid * 16, R, C); const int Rb = Epi::PERM ? ((R & ~31) + perm32(R & 31)) : R; voffA = (unsigned)(R * lda + C) * 2u; voffB = (unsigned)(Rb * K + C) * 2u; }
    const size_t sA = (size_t)64 * lda * 2, sB = (size_t)64 * K * 2;
    const size_t kstep = (size_t)(BK * 2);
    const size_t hA = (size_t)HALF * lda * 2, hB = (size_t)HALF * K * 2;
    const unsigned ldsw = (unsigned)wid * 1024u;
    const int aoff = lds_byte(wr * 64 + fr, fq * 8), boff = lds_byte(wc * 32 + fr, fq * 8);
#define PG8_SA(b, h) (((b) * 2 + (h)) * HTB)
#define PG8_SB(b, h) ((4 + (b) * 2 + (h)) * HTB)
#define PG8_STAGE(bufoff, gbase, voff) do { _Pragma("unroll") for (int _i = 0; _i < 2; ++_i) \
        __builtin_amdgcn_global_load_lds((const unsigned*)((const char*)(gbase) + (size_t)_i * PG8_STEP_##voff + (voff)), (LAS unsigned*)(lds + (bufoff) + ldsw + _i * 8192), 16, 0, 0); } while (0)
#define PG8_STEP_voffA sA
#define PG8_STEP_voffB sB
#define PG8_STAGEA(bufoff, kb, h) do { if constexpr (GATHER) { \
        __builtin_amdgcn_global_load_lds((const unsigned*)((const char*)(kb) + ((h) ? g2 : g0)), (LAS unsigned*)(lds + (bufoff) + ldsw), 16, 0, 0); \
        __builtin_amdgcn_global_load_lds((const unsigned*)((const char*)(kb) + ((h) ? g3 : g1)), (LAS unsigned*)(lds + (bufoff) + ldsw + 8192), 16, 0, 0); } \
      else PG8_STAGE(bufoff, (const char*)(kb) + (h) * hA, voffA); } while (0)
#define PG8_LDA(dst, b, h) do { _Pragma("unroll") for (int m = 0; m < 4; ++m) _Pragma("unroll") for (int k = 0; k < 2; ++k) dst[m][k] = *(const LAS bf16x8*)(lds + PG8_SA(b, h) + aoff + m * 2048 + k * 1024); } while (0)
#define PG8_LDB(dst, b, h) do { _Pragma("unroll") for (int n = 0; n < 2; ++n) _Pragma("unroll") for (int k = 0; k < 2; ++k) dst[n][k] = *(const LAS bf16x8*)(lds + PG8_SB(b, h) + boff + n * 2048 + k * 1024); } while (0)
#define PG8_MMA(ai, bj, At, Bt) do { __builtin_amdgcn_s_setprio(1); _Pragma("unroll") for (int m = 0; m < 4; ++m) _Pragma("unroll") for (int n = 0; n < 2; ++n) _Pragma("unroll") for (int k = 0; k < 2; ++k) \
        acc[ai][bj][m][n] = __builtin_amdgcn_mfma_f32_16x16x32_bf16(Bt[n][k], At[m][k], acc[ai][bj][m][n], 0, 0, 0); __builtin_amdgcn_s_setprio(0); } while (0)
#define PG8_WAIT_V(n) asm volatile("s_waitcnt vmcnt(" #n ")" ::: "memory")
#define PG8_WAIT_L(n) asm volatile("s_waitcnt lgkmcnt(" #n ")" ::: "memory")
#define PG8_BAR __builtin_amdgcn_s_barrier()
#define PG8_SCHED __builtin_amdgcn_sched_barrier(0)
    Unit cur, nxt; int ui = 0;
    if (!S.next(0, cur)) return;
    constexpr bool GATHER = SchedTraits<Sched>::GATHER;
    const int* tokp = sched_tok(S, 0); (void)tokp;
    unsigned g0 = 0u, g1 = 0u, g2 = 0u, g3 = 0u; (void)g0; (void)g1; (void)g2; (void)g3;
    constexpr int GTAB_OFF = 131072 + 1024;
    if constexpr (GATHER) { int R, C; stage_rc(tid * 16, R, C); const int* tp = tokp + cur.pm * BM + R; const int t0 = tp[0], t1 = tp[64], t2 = tp[128], t3 = tp[192];
        g0 = (unsigned)(t0 < 0 ? 0 : t0) * (unsigned)(lda * 2) + C * 2; g1 = (unsigned)(t1 < 0 ? 0 : t1) * (unsigned)(lda * 2) + C * 2; g2 = (unsigned)(t2 < 0 ? 0 : t2) * (unsigned)(lda * 2) + C * 2; g3 = (unsigned)(t3 < 0 ? 0 : t3) * (unsigned)(lda * 2) + C * 2; }
    constexpr bool RESC = EpiTraits<Epi>::RESC;
    if constexpr (RESC) E.build(cur, lds, 0, wid * 64 + hw_lane());
    f32x4 acc[2][2][4][2];
#pragma unroll
    for (int a = 0; a < 2; ++a)
#pragma unroll
        for (int b = 0; b < 2; ++b)
#pragma unroll
            for (int m = 0; m < 4; ++m)
#pragma unroll
                for (int n = 0; n < 2; ++n) acc[a][b][m][n] = (f32x4){0.f, 0.f, 0.f, 0.f};
    bf16x8 At[4][2], B0[2][2], B1[2][2];
    const char* cA = cur.a; const char* cB = cur.b;
    if constexpr (SP2) {
        PG8_STAGE(PG8_SB(0, 0), cB, voffB); PG8_STAGE(PG8_SB(0, 1), cB + hB, voffB); PG8_STAGEA(PG8_SA(0, 0), cA, 0); PG8_STAGEA(PG8_SA(0, 1), cA, 1);
        if (wr == 1) PG8_BAR;
        PG8_WAIT_V(2); PG8_BAR;
        PG8_STAGE(PG8_SB(1, 0), cB + kstep, voffB); PG8_STAGEA(PG8_SA(1, 0), cA + kstep, 0); PG8_STAGE(PG8_SB(1, 1), cB + hB + kstep, voffB);
        PG8_WAIT_V(6); PG8_BAR;
    } else {
        PG8_STAGE(PG8_SB(0, 0), cB, voffB); PG8_STAGE(PG8_SA(0, 0), cA, voffA); PG8_STAGE(PG8_SB(0, 1), cB + hB, voffB); PG8_STAGE(PG8_SA(0, 1), cA + hA, voffA);
        if (wr == 1) PG8_BAR;
        PG8_WAIT_V(4); PG8_BAR;
        PG8_STAGE(PG8_SB(1, 0), cB + kstep, voffB); PG8_STAGE(PG8_SA(1, 0), cA + kstep, voffA); PG8_STAGE(PG8_SB(1, 1), cB + hB + kstep, voffB);
        PG8_WAIT_V(6); PG8_BAR;
    }
    for (;;) {
        const bool has_next = S.next(ui + 1, nxt);
        const char* nA = has_next ? nxt.a : cA; const char* nB = has_next ? nxt.b : cB;
        int ntk = 0; if constexpr (GATHER) { if (has_next) ntk = tokp[nxt.pm * BM + ((wid & 3) * 64 + hw_lane())]; }
        for (int t = 0; t < nt; t += 2) {
            const bool last = (t == nt - 2);
            const char* a1 = cA + (size_t)(t + 1) * kstep;
            const char* a2 = last ? nA : cA + (size_t)(t + 2) * kstep; const char* b2 = last ? nB : cB + (size_t)(t + 2) * kstep;
            const char* a3 = a2 + kstep; const char* b3 = b2 + kstep;
            if constexpr (RESC) { if (t == 4 || t == 8) {
                const int ln = hw_lane(); const LAS float* tb = (const LAS float*)(lds + RESC_TAB_OFF + (ui & 1) * 4096) + (wr * 64 + (ln & 15)) * 4 + (t == 8 ? 1 : 0);
#pragma unroll
                for (int a = 0; a < 2; ++a)
#pragma unroll
                    for (int m = 0; m < 4; ++m) { const float s = tb[(a * HALF + m * 16) * 4];
#pragma unroll
                        for (int b = 0; b < 2; ++b)
#pragma unroll
                            for (int n = 0; n < 2; ++n) acc[a][b][m][n] *= s;
                        PG8_SCHED; } } }
            if constexpr (SP2) {
            PG8_LDB(B0, 0, 0); PG8_LDB(B1, 0, 1); PG8_SCHED; PG8_LDA(At, 0, 0); PG8_STAGEA(PG8_SA(1, 1), a1, 1);
            if constexpr (GATHER) {
                if (t == 2 && wid < 4) ((LAS unsigned*)(lds + GTAB_OFF + ((ui + 1) & 1) * 1024))[wid * 64 + hw_lane()] = (unsigned)(ntk < 0 ? 0 : ntk) * (unsigned)(lda * 2);
                if (last && has_next) { int R, C; stage_rc((wid * 64 + hw_lane()) * 16, R, C); const LAS unsigned* gt = (const LAS unsigned*)(lds + GTAB_OFF + ((ui + 1) & 1) * 1024) + R;
                    g0 = gt[0] + C * 2; g1 = gt[64] + C * 2; g2 = gt[128] + C * 2; g3 = gt[192] + C * 2; } }
            PG8_WAIT_V(8); PG8_WAIT_L(0); PG8_BAR; PG8_MMA(0, 0, At, B0); PG8_MMA(0, 1, At, B1); PG8_BAR; PG8_SCHED;
            PG8_LDA(At, 0, 1); PG8_STAGE(PG8_SB(0, 0), b2, voffB); PG8_STAGE(PG8_SB(0, 1), b2 + hB, voffB); PG8_STAGEA(PG8_SA(0, 0), a2, 0);
            PG8_WAIT_V(8); PG8_WAIT_L(0); PG8_BAR; PG8_MMA(1, 0, At, B0); PG8_MMA(1, 1, At, B1); PG8_BAR; PG8_SCHED;
            PG8_LDB(B0, 1, 0); PG8_LDB(B1, 1, 1); PG8_SCHED; PG8_LDA(At, 1, 0); PG8_STAGEA(PG8_SA(0, 1), a2, 1);
            PG8_WAIT_V(8); PG8_WAIT_L(0); PG8_BAR; PG8_MMA(0, 0, At, B0); PG8_MMA(0, 1, At, B1); PG8_BAR; PG8_SCHED;
            PG8_LDA(At, 1, 1); PG8_STAGE(PG8_SB(1, 0), b3, voffB); PG8_STAGE(PG8_SB(1, 1), b3 + hB, voffB); PG8_STAGEA(PG8_SA(1, 0), a3, 0);
            PG8_WAIT_V(8); PG8_WAIT_L(0); PG8_BAR; PG8_MMA(1, 0, At, B0); PG8_MMA(1, 1, At, B1); PG8_BAR; PG8_SCHED;
            } else {
            PG8_LDB(B0, 0, 0); PG8_SCHED; PG8_LDA(At, 0, 0); PG8_STAGE(PG8_SA(1, 1), a1 + hA, voffA);
            PG8_WAIT_L(8); PG8_BAR; PG8_WAIT_L(0); PG8_MMA(0, 0, At, B0); PG8_BAR; PG8_SCHED;
            PG8_LDB(B1, 0, 1); PG8_STAGE(PG8_SB(0, 0), b2, voffB);
            PG8_BAR; PG8_WAIT_L(0); PG8_MMA(0, 1, At, B1); PG8_BAR;
            PG8_LDA(At, 0, 1); PG8_STAGE(PG8_SA(0, 0), a2, voffA);
            PG8_BAR; PG8_WAIT_L(0); PG8_MMA(1, 0, At, B0); PG8_BAR; PG8_SCHED;
            PG8_STAGE(PG8_SB(0, 1), b2 + hB, voffB);
            PG8_WAIT_V(6); PG8_BAR; PG8_MMA(1, 1, At, B1); PG8_BAR;
            PG8_LDB(B0, 1, 0); PG8_SCHED; PG8_LDA(At, 1, 0); PG8_STAGE(PG8_SA(0, 1), a2 + hA, voffA);
            PG8_WAIT_L(8); PG8_BAR; PG8_WAIT_L(0); PG8_MMA(0, 0, At, B0); PG8_BAR; PG8_SCHED;
            PG8_LDB(B1, 1, 1); PG8_STAGE(PG8_SB(1, 0), b3, voffB);
            PG8_BAR; PG8_WAIT_L(0); PG8_MMA(0, 1, At, B1); PG8_BAR;
            PG8_LDA(At, 1, 1); PG8_STAGE(PG8_SA(1, 0), a3, voffA);
            PG8_BAR; PG8_WAIT_L(0); PG8_MMA(1, 0, At, B0); PG8_BAR; PG8_SCHED;
            PG8_STAGE(PG8_SB(1, 1), b3 + hB, voffB);
            PG8_WAIT_V(6); PG8_BAR; PG8_MMA(1, 1, At, B1); PG8_BAR;
            }
        }
        if constexpr (ALIGN_EPI) { if (wr == 0) PG8_BAR; }
        if constexpr (RESC) { const int ln = hw_lane(); const LAS float* tb = (const LAS float*)(lds + RESC_TAB_OFF + (ui & 1) * 4096) + (wr * 64 + (ln & 15)) * 4 + 2;
#pragma unroll
            for (int a = 0; a < 2; ++a)
#pragma unroll
                for (int m = 0; m < 4; ++m) { const float s = tb[(a * HALF + m * 16) * 4];
#pragma unroll
                    for (int b = 0; b < 2; ++b)
#pragma unroll
                        for (int n = 0; n < 2; ++n) acc[a][b][m][n] *= s;
                    PG8_SCHED; } }
        { const int ln_e = hw_lane(); const int fr_e = ln_e & 15, fq_e = ln_e >> 4;
          if (ui == 0) epi_pre(E, 0);
          E(acc, cur, wr, wc, fr_e, fq_e); }
        if (!has_next) break;
        if constexpr (RESC) { E.build(nxt, lds, (ui + 1) & 1, wid * 64 + hw_lane()); PG8_SCHED; }
#pragma unroll
        for (int a = 0; a < 2; ++a)
#pragma unroll
            for (int b = 0; b < 2; ++b)
#pragma unroll
                for (int m = 0; m < 4; ++m)
#pragma unroll
                    for (int n = 0; n < 2; ++n) acc[a][b][m][n] = (f32x4){0.f, 0.f, 0.f, 0.f};
        cur = nxt; cA = nA; cB = nB; ++ui;
        if constexpr (ALIGN_EPI) { if (wr == 1) PG8_BAR; }
    }
    PG8_WAIT_V(0);
    if constexpr (!ALIGN_EPI) { if (wr == 0) PG8_BAR; }
    PG8_BAR;
#undef PG8_SA
#undef PG8_SB
#undef PG8_STAGE
#undef PG8_STEP_voffA
#undef PG8_STAGEA
#undef PG8_STEP_voffB
#undef PG8_LDA
#undef PG8_LDB
#undef PG8_MMA
#undef PG8_WAIT_V
#undef PG8_WAIT_L
#undef PG8_BAR
#undef PG8_SCHED
}
}

namespace att {
typedef short bf16x8 __attribute__((ext_vector_type(8)));
typedef short s16x4 __attribute__((ext_vector_type(4)));
typedef short v4i16_t __attribute__((ext_vector_type(4)));
typedef float f32x16 __attribute__((ext_vector_type(16)));
typedef float f32x4 __attribute__((ext_vector_type(4)));
typedef unsigned u32x4 __attribute__((ext_vector_type(4)));
typedef float f32x2_t __attribute__((ext_vector_type(2))); typedef __bf16 bf16x2_t __attribute__((ext_vector_type(2)));
__device__ __forceinline__ int crow(int r, int hi) { return (r & 3) + 8 * (r >> 2) + 4 * hi; }
__device__ __forceinline__ void glds16(const void* gsrc, unsigned lds_dst) { unsigned keep;
    asm volatile("s_mov_b32 %0, m0\n\ts_mov_b32 m0, %2\n\ts_nop 0\n\tglobal_load_lds_dwordx4 %1, off\n\ts_mov_b32 m0, %0" : "=&s"(keep) : "v"(gsrc), "s"(lds_dst) : "memory"); }
__device__ __forceinline__ unsigned cvtpk(float lo, float hi) { f32x2_t v = {lo, hi}; bf16x2_t b = __builtin_convertvector(v, bf16x2_t); return __builtin_bit_cast(unsigned, b); }
__device__ __forceinline__ s16x4 vtr(const LAS unsigned char* p) { return __builtin_bit_cast(s16x4, __builtin_amdgcn_ds_read_tr16_b64_v4i16((LAS v4i16_t*)p)); }
__device__ __forceinline__ float half_max(float m) { auto rr = __builtin_amdgcn_permlane32_swap(__float_as_uint(m), __float_as_uint(m), false, false); return fmaxf(__uint_as_float(rr[0]), __uint_as_float(rr[1])); }
__device__ __forceinline__ float half_sum(float m) { auto rr = __builtin_amdgcn_permlane32_swap(__float_as_uint(m), __float_as_uint(m), false, false); return __uint_as_float(rr[0]) + __uint_as_float(rr[1]); }
__device__ __forceinline__ bf16x8 scale8(bf16x8 v, float s) { u32x4 u = __builtin_bit_cast(u32x4, v); u32x4 o;
#pragma unroll
    for (int i = 0; i < 4; ++i) { const float a = __uint_as_float(u[i] << 16) * s, b = __uint_as_float(u[i] & 0xffff0000u) * s; o[i] = cvtpk(a, b); }
    return __builtin_bit_cast(bf16x8, o); }
#define ATT_WAITBAR(N) asm volatile("s_waitcnt vmcnt(%0) lgkmcnt(0)\n\ts_barrier" :: "n"(N) : "memory")

__device__ __forceinline__ float max3f(float a, float b, float c) { return __builtin_fmaxf(__builtin_fmaxf(a, b), c); }
template <int DK, int DV, int MODE, int PROBE = 0>
__device__ __forceinline__ void attn_unit(LAS unsigned char* shm, const bf16* Qw, int ldq, float qscale, const bf16* Kh, int ldk, const bf16* K2, int ldk2, const bf16* Vh, int ldv,
                                          bf16* Ow, int ldo, int q0, int NT, int tid, const float* cumq = nullptr  ) {
    constexpr int ND = DK / 16 + (MODE == 0 ? 1 : 0), NO = DV / 32, PD = (MODE == 2) ? 2 : 4, NSK = PD + 1, NSV = PD + 2;
    constexpr int KSLOT = (MODE == 0 ? 10 : DK / 8) * 1024, VSLOT = DV * 128;
    constexpr int LDS_K = 0, LDS_V = NSK * KSLOT, LDS_WS = LDS_V + NSV * VSLOT;
    constexpr int NPT = (DK > 64 ? 2 : 1) + (DV > 64 ? 2 : 1);
    const int lane = tid & 63, r32 = lane & 31, hi = lane >> 5, wid = __builtin_amdgcn_readfirstlane(tid >> 6), half = wid >> 2;
    const unsigned lds0 = (unsigned)(uintptr_t)shm;
    LAS float* wsf = (LAS float*)(shm + LDS_WS) + wid * 64;
    asm volatile("" ::: "memory");
    const bf16* ksrc = Kh + (size_t)lane * ldk + wid * 8;
    const bf16* k2src = (MODE == 0) ? (K2 + (size_t)lane * 8) : (DK == 96) ? (K2 + (size_t)lane * ldk2 + (wid & 3) * 8) : (Kh + (size_t)lane * ldk + (8 + wid) * 8);
    const size_t k2step = (MODE == 0) ? (size_t)64 * 8 : (DK == 96) ? (size_t)64 * ldk2 : (size_t)64 * ldk;
    const int k2chunk = (MODE == 0) ? 8 : (DK == 96) ? 8 + (wid & 3) : 8 + wid;
    const bool k2do = (MODE == 0) ? (wid == 0) : (DK > 64);
    const bf16* vsrc = Vh + (size_t)(16 * (wid & 3) + (lane >> 2)) * ldv + (wid >> 2) * 32 + (lane & 3) * 8;
#define ATT_DMA(t, ks_, vs_) do { glds16(ksrc + (size_t)(t) * 64 * ldk, (unsigned)__builtin_amdgcn_readfirstlane(lds0 + LDS_K + (ks_) * KSLOT + wid * 1024)); \
        if (k2do) glds16(k2src + (size_t)(t) * k2step, (unsigned)__builtin_amdgcn_readfirstlane(lds0 + LDS_K + (ks_) * KSLOT + k2chunk * 1024)); \
        glds16(vsrc + (size_t)(t) * 64 * ldv, (unsigned)__builtin_amdgcn_readfirstlane(lds0 + LDS_V + (vs_) * VSLOT + wid * 1024)); \
        if (DV > 64) glds16(vsrc + 64 + (size_t)(t) * 64 * ldv, (unsigned)__builtin_amdgcn_readfirstlane(lds0 + LDS_V + (vs_) * VSLOT + (wid + 8) * 1024)); } while (0)
#define ATT_WAITGRP(keep) do { const int k_ = (keep); if (MODE == 0 && wid == 0) { if (k_ <= 0) ATT_WAITBAR(0); else if (k_ == 1) ATT_WAITBAR(NPT + 1); else if (k_ == 2) ATT_WAITBAR(2 * (NPT + 1)); else ATT_WAITBAR(3 * (NPT + 1)); } \
        else { if (k_ <= 0) ATT_WAITBAR(0); else if (k_ == 1) ATT_WAITBAR(NPT); else if (k_ == 2) ATT_WAITBAR(2 * NPT); else ATT_WAITBAR(3 * NPT); } } while (0)
#pragma unroll
    for (int i = 0; i < PD; ++i) if (i < NT) ATT_DMA(i, i, i);
    bf16x8 qr[ND];
    if (MODE == 2) {
        float ss = 0.f;
#pragma unroll
        for (int d0 = 0; d0 < DK / 16; ++d0) { qr[d0] = *(const bf16x8*)(Qw + (size_t)r32 * ldq + d0 * 16 + hi * 8); const u32x4 u = __builtin_bit_cast(u32x4, qr[d0]);
#pragma unroll
            for (int i = 0; i < 4; ++i) { const float a = __uint_as_float(u[i] << 16), b = __uint_as_float(u[i] & 0xffff0000u); ss += a * a + b * b; } }
        const float fac = rsqrtf(half_sum(ss) * (1.f / (float)DK) + EPSF) * qscale;
#pragma unroll
        for (int d0 = 0; d0 < DK / 16; ++d0) qr[d0] = scale8(qr[d0], fac);
    } else {
#pragma unroll
    for (int d0 = 0; d0 < DK / 16; ++d0) qr[d0] = scale8(*(const bf16x8*)(Qw + (size_t)r32 * ldq + d0 * 16 + hi * 8), qscale);
    }
    if (MODE == 0) { const short one = (short)0x3f80; qr[ND - 1] = hi ? (bf16x8){0, 0, 0, 0, 0, 0, 0, 0} : (bf16x8){one, one, one, 0, 0, 0, 0, 0}; }
    if (half == 1) ATT_WAITGRP((NT < PD ? NT : PD) - 1);
    float mhat = 0.f, l_reg = 0.f; f32x16 o[NO]; f32x16 negm = f32x16{};
    if (MODE == 0) {
        mhat = -cumq[(size_t)r32 * 4] * 1.4426950408889634f;
#pragma unroll
        for (int r = 0; r < 16; ++r) negm[r] = -mhat; }
#pragma unroll
    for (int d = 0; d < NO; ++d) o[d] = f32x16{};
    u32x4 pw[4] = {};
    const int qmin = q0 + 32 * wid;
    int ks = 0, ks2 = PD % NSK, vs1 = NSV - 1, vs2 = PD % NSV;
    bool pvis = false;
#define ATT_SCHED() __builtin_amdgcn_sched_barrier(0)
#define ATT_VLOAD(vfr, vslot) do { const LAS unsigned char* vp = shm + LDS_V + (vslot) * VSLOT + ((lane >> 4) & 1) * 32 + (lane & 3) * 8 + (4 * hi + ((lane & 15) >> 2)) * 64; \
        _Pragma("unroll") for (int k4 = 0; k4 < 4; ++k4) _Pragma("unroll") for (int d0 = 0; d0 < NO; ++d0) { const s16x4 lo = vtr(vp + d0 * 4096 + k4 * 1024), hh = vtr(vp + d0 * 4096 + k4 * 1024 + 512); \
            vfr[k4][d0] = (bf16x8){lo[0], lo[1], lo[2], lo[3], hh[0], hh[1], hh[2], hh[3]}; } } while (0)
#define ATT_PVMMA(vfr) do { _Pragma("unroll") for (int k4 = 0; k4 < 4; ++k4) _Pragma("unroll") for (int d0 = 0; d0 < NO; ++d0) \
            o[d0] = __builtin_amdgcn_mfma_f32_32x32x16_bf16(__builtin_bit_cast(bf16x8, pw[k4]), vfr[k4][d0], o[d0], 0, 0, 0); } while (0)
    for (int t = 0; t < NT; ++t) {
        { const int rem = NT - t; ATT_WAITGRP((rem < PD ? rem : PD) - 1); }
        if (t + PD < NT) ATT_DMA(t + PD, ks2, vs2);
        const bool vis0 = (MODE == 2) ? true : (MODE == 1 ? (t <= (qmin >> 6)) : (64 * t <= qmin + 31));
        const bool vis = (PROBE == 1) ? false : vis0;
        f32x16 p0 = f32x16{}, p1 = f32x16{};
        {
            bf16x8 vfr[4][NO]; bf16x8 kf[ND][2];
            ATT_SCHED();
            if (pvis) ATT_VLOAD(vfr, vs1);
            if (DV > 64) { ATT_SCHED(); if (pvis) ATT_PVMMA(vfr); ATT_SCHED(); }
            if (vis) {
                const LAS unsigned char* kb = shm + LDS_K + ks * KSLOT + hi * 1024 + r32 * 16;
#pragma unroll
                for (int d0 = 0; d0 < ND; ++d0) { const LAS unsigned char* kp = (MODE == 0 && d0 == ND - 1) ? (shm + LDS_K + ks * KSLOT + 8 * 1024 + r32 * 16) : (kb + d0 * 2048);
                    kf[d0][0] = *(const LAS bf16x8*)(kp); kf[d0][1] = *(const LAS bf16x8*)(kp + 512); }
            }
            ATT_SCHED();
            if (DV <= 64) { if (pvis) ATT_PVMMA(vfr); }
            if (vis) {
#pragma unroll
                for (int d0 = 0; d0 < ND; ++d0) {
                    if (d0 == 0) { p0 = __builtin_amdgcn_mfma_f32_32x32x16_bf16(kf[0][0], qr[0], negm, 0, 0, 0); p1 = __builtin_amdgcn_mfma_f32_32x32x16_bf16(kf[0][1], qr[0], negm, 0, 0, 0); }
                    else { p0 = __builtin_amdgcn_mfma_f32_32x32x16_bf16(kf[d0][0], qr[d0], p0, 0, 0, 0); p1 = __builtin_amdgcn_mfma_f32_32x32x16_bf16(kf[d0][1], qr[d0], p1, 0, 0, 0); } }
            }
            ATT_SCHED();
        }
        { const int rem = NT - t - 1; ATT_WAITGRP((rem < PD ? rem : PD) - 1); }
        if (vis && PROBE != 2) {
            if (MODE == 0) { if (64 * t + 63 > qmin) { const int q = qmin + r32;
#pragma unroll
                    for (int r = 0; r < 16; ++r) { const int kv = 64 * t + crow(r, hi); if (kv > q) p0[r] = -INFINITY; if (kv + 32 > q) p1[r] = -INFINITY; } } }
            float ma = max3f(p0[0], p0[1], p1[0]), mb = max3f(p0[2], p0[3], p1[1]); ma = max3f(ma, p1[2], p1[3]);
#pragma unroll
            for (int r = 4; r < 16; r += 4) { ma = max3f(ma, p0[r], p0[r + 1]); mb = max3f(mb, p0[r + 2], p0[r + 3]); ma = max3f(ma, p1[r], p1[r + 1]); mb = max3f(mb, p1[r + 2], p1[r + 3]); }
            const float rm = half_max(fmaxf(ma, mb));
            if ((MODE != 0 && t == 0) || __any(rm > 8.0f)) { const float dl = (MODE != 0 && t == 0) ? rm : fmaxf(rm, 0.f); mhat += dl;
#pragma unroll
                for (int r = 0; r < 16; ++r) { p0[r] -= dl; p1[r] -= dl; negm[r] = -mhat; }
                if (MODE == 0 || t > 0) { const float f = __builtin_amdgcn_exp2f(-dl); l_reg *= f;
                    if (hi == 0) wsf[r32] = f;
                    asm volatile("s_waitcnt lgkmcnt(0)" ::: "memory");
#pragma unroll
                    for (int r = 0; r < 16; ++r) { const float fr_ = wsf[crow(r, hi)];
#pragma unroll
                        for (int d = 0; d < NO; ++d) o[d][r] *= fr_; }
                    asm volatile("s_waitcnt lgkmcnt(0)" ::: "memory"); } }
            float sa = 0.f, sb = 0.f;
#pragma unroll
            for (int r = 0; r < 16; ++r) { p0[r] = __builtin_amdgcn_exp2f(p0[r]); p1[r] = __builtin_amdgcn_exp2f(p1[r]); sa += p0[r]; sb += p1[r]; }
            l_reg += sa + sb;
#pragma unroll
            for (int i = 0; i < 4; ++i) { pw[0][i] = cvtpk(p0[2 * i], p0[2 * i + 1]); pw[1][i] = cvtpk(p0[8 + 2 * i], p0[9 + 2 * i]); pw[2][i] = cvtpk(p1[2 * i], p1[2 * i + 1]); pw[3][i] = cvtpk(p1[8 + 2 * i], p1[9 + 2 * i]); }
        }
        pvis = vis;
        ks = (ks == NSK - 1) ? 0 : ks + 1; ks2 = (ks2 == NSK - 1) ? 0 : ks2 + 1; vs1 = (vs1 == NSV - 1) ? 0 : vs1 + 1; vs2 = (vs2 == NSV - 1) ? 0 : vs2 + 1;
    }
    if (pvis) { bf16x8 vfr[4][NO]; ATT_SCHED(); ATT_VLOAD(vfr, vs1); ATT_SCHED(); ATT_PVMMA(vfr); ATT_SCHED(); }
#undef ATT_VLOAD
#undef ATT_PVMMA
#undef ATT_SCHED
#undef ATT_DMA
#undef ATT_WAITGRP
    l_reg = half_sum(l_reg);
    if (half == 0) asm volatile("s_waitcnt lgkmcnt(0)\n\ts_barrier" ::: "memory");
    ATT_WAITBAR(0);
    if (hi == 0) wsf[32 + r32] = l_reg;
    asm volatile("s_waitcnt lgkmcnt(0)" ::: "memory");
    float rli[16];
#pragma unroll
    for (int r = 0; r < 16; ++r) rli[r] = __builtin_amdgcn_rcpf(wsf[32 + crow(r, hi)]);
    LAS bf16* stg = (LAS bf16*)shm + wid * (32 * DV);
#pragma unroll
    for (int r = 0; r < 16; ++r) { const int orow = crow(r, hi);
#pragma unroll
        for (int d0 = 0; d0 < NO; ++d0) stg[orow * DV + d0 * 32 + r32] = f2bf(o[d0][r] * rli[r]); }
    asm volatile("s_waitcnt lgkmcnt(0)" ::: "memory");
    constexpr int CPR = DV / 8;
#pragma unroll
    for (int i = 0; i < (32 * CPR) / 64; ++i) { const int idx = i * 64 + lane, row = idx / CPR, ch = idx % CPR; const u32x4 v = *(const LAS u32x4*)(stg + row * DV + ch * 8); *(u32x4*)(Ow + (size_t)row * ldo + ch * 8) = v; }
    ATT_WAITBAR(0);
}

template <int PRB_M = 0> __device__ __forceinline__ void mla_unit(LAS unsigned char* shm, const bf16* Qw, float qscale, const bf16* Kh, const bf16* K2, const bf16* Vh, bf16* Ow, int q0, int NT, int tid, volatile LAS unsigned* badflag) {
    constexpr int ND = 6, NO = 2, PD = 4, NSK = 4, NSV = 6, KSLOT = 12 * 1024, VSLOT = 8 * 1024, LDS_K = 0, LDS_V = NSK * KSLOT, LDS_WS = LDS_V + NSV * VSLOT;
    constexpr int ldq = 768, ldk = 1024, ldk2 = PW, ldv = 1024, ldo = 1024, NPT = 2;
    const int lane = tid & 63, r32 = lane & 31, hi = lane >> 5, wid = __builtin_amdgcn_readfirstlane(tid >> 6);
    const unsigned lds0 = (unsigned)(uintptr_t)shm;
    bf16x8 qr[ND];
#pragma unroll
    for (int d0 = 0; d0 < ND; ++d0) qr[d0] = scale8(*(const bf16x8*)(Qw + (size_t)r32 * ldq + d0 * 16 + hi * 8), qscale);
    asm volatile("" ::: "memory");
    const int krow = 8 * wid + (lane >> 3);
    const bf16* ksrc = Kh + (size_t)krow * ldk + (((lane & 7) ^ ((krow >> 1) & 7)) * 8);
    const int k2row = 16 * (wid & 3) + (lane >> 2);
    const bf16* k2src = K2 + (size_t)k2row * ldk2 + (((lane & 3) ^ ((k2row >> 2) & 3)) * 8);
    const bool xtra = wid < 4;
    const bf16* vsrc = Vh + (size_t)(16 * (wid & 3) + (lane >> 2)) * ldv + (wid >> 2) * 32 + (lane & 3) * 8;
#define M_DMA(t, ks_, vs_) do { glds16(ksrc + (size_t)(t) * 64 * ldk, (unsigned)__builtin_amdgcn_readfirstlane(lds0 + LDS_K + (ks_) * KSLOT + wid * 1024)); \
        if (xtra) glds16(k2src + (size_t)(t) * 64 * ldk2, (unsigned)__builtin_amdgcn_readfirstlane(lds0 + LDS_K + (ks_) * KSLOT + 8192 + wid * 1024)); \
        glds16(vsrc + (size_t)(t) * 64 * ldv, (unsigned)__builtin_amdgcn_readfirstlane(lds0 + LDS_V + (vs_) * VSLOT + wid * 1024)); } while (0)
#define M_WAITBAR(N) asm volatile("s_waitcnt vmcnt(%0) lgkmcnt(0)\n\ts_barrier" :: "n"(N) : "memory")
#define M_WAITGRP(keep) do { const int k_ = (keep); if (xtra) { if (k_ <= 0) M_WAITBAR(0); else if (k_ == 1) M_WAITBAR(NPT + 1); else if (k_ == 2) M_WAITBAR(2 * (NPT + 1)); else M_WAITBAR(3 * (NPT + 1)); } \
        else { if (k_ <= 0) M_WAITBAR(0); else if (k_ == 1) M_WAITBAR(NPT); else if (k_ == 2) M_WAITBAR(2 * NPT); else M_WAITBAR(3 * NPT); } } while (0)
#define M_SCHED() __builtin_amdgcn_sched_barrier(0)
#define M_KLOADR(kf, kslot, D0, D1) do { int rk = r32, hk = hi; asm volatile("" : "+v"(rk), "+v"(hk)); const LAS unsigned char* kb = shm + LDS_K + (kslot) * KSLOT; \
        _Pragma("unroll") for (int d0 = (D0); d0 < (D1); ++d0) { if (d0 < 4) { const LAS unsigned char* kp = kb + rk * 128 + (((2 * d0 + hk) ^ ((rk >> 1) & 7)) << 4); kf[d0][0] = *(const LAS bf16x8*)(kp); kf[d0][1] = *(const LAS bf16x8*)(kp + 4096); } \
            else { const LAS unsigned char* kp = kb + 8192 + rk * 64 + (((2 * (d0 - 4) + hk) ^ ((rk >> 2) & 3)) << 4); kf[d0][0] = *(const LAS bf16x8*)(kp); kf[d0][1] = *(const LAS bf16x8*)(kp + 2048); } } } while (0)
#define M_KLOAD(kf, kslot) M_KLOADR(kf, kslot, 0, 6)
#define M_VLOAD(vfr, vslot) do { const LAS unsigned char* vp = shm + LDS_V + (vslot) * VSLOT + ((lane >> 4) & 1) * 32 + (lane & 3) * 8 + (4 * hi + ((lane & 15) >> 2)) * 64; \
        _Pragma("unroll") for (int k4 = 0; k4 < 4; ++k4) _Pragma("unroll") for (int d0 = 0; d0 < NO; ++d0) { const s16x4 lo = vtr(vp + d0 * 4096 + k4 * 1024), hh = vtr(vp + d0 * 4096 + k4 * 1024 + 512); \
            vfr[k4][d0] = (bf16x8){lo[0], lo[1], lo[2], lo[3], hh[0], hh[1], hh[2], hh[3]}; } } while (0)
#define M_PVMMA(vfr) do { if (PRB_M != 3) _Pragma("unroll") for (int k4 = 0; k4 < 4; ++k4) { _Pragma("unroll") for (int d0 = 0; d0 < NO; ++d0) \
            o[d0] = __builtin_amdgcn_mfma_f32_32x32x16_bf16(__builtin_bit_cast(bf16x8, pw[k4]), vfr[k4][d0], o[d0], 0, 0, 0); } } while (0)
#define M_QK(P0, P1, kf) do { if (PRB_M != 3) _Pragma("unroll") for (int d0 = 0; d0 < ND; ++d0) { \
            if (d0 == 0) { P0 = __builtin_amdgcn_mfma_f32_32x32x16_bf16(kf[0][0], qr[0], f32x16{}, 0, 0, 0); P1 = __builtin_amdgcn_mfma_f32_32x32x16_bf16(kf[0][1], qr[0], f32x16{}, 0, 0, 0); } \
            else { P0 = __builtin_amdgcn_mfma_f32_32x32x16_bf16(kf[d0][0], qr[d0], P0, 0, 0, 0); P1 = __builtin_amdgcn_mfma_f32_32x32x16_bf16(kf[d0][1], qr[d0], P1, 0, 0, 0); } } } while (0)
#define M_EXP(P0, P1) do { if (PRB_M != 2) _Pragma("unroll") for (int r = 0; r < 16; ++r) { P0[r] = __builtin_amdgcn_exp2f(P0[r]); P1[r] = __builtin_amdgcn_exp2f(P1[r]); } } while (0)
#define M_PACK(P0, P1) do { { float sa_ = 0.f, sb_ = 0.f; _Pragma("unroll") for (int r = 0; r < 16; ++r) { sa_ += P0[r]; sb_ += P1[r]; } l_reg += sa_ + sb_; } if (PRB_M != 2) _Pragma("unroll") for (int i = 0; i < 4; ++i) { pw[0][i] = cvtpk(P0[2 * i], P0[2 * i + 1]); pw[1][i] = cvtpk(P0[8 + 2 * i], P0[9 + 2 * i]); pw[2][i] = cvtpk(P1[2 * i], P1[2 * i + 1]); pw[3][i] = cvtpk(P1[8 + 2 * i], P1[9 + 2 * i]); } } while (0)
#define M_STEP(t) do { \
        { const int rem = NT - 1 - (t); M_WAITGRP((rem < PD - 1 ? rem : PD - 1) - 1); } \
        if ((t) + PD < NT) M_DMA((t) + PD, kslot_t, vslot_n); \
        const bool vis_c = (t) <= tw, vis_n = (t) + 1 <= tw, pvis = (t) >= 1 && (t) - 1 <= tw; \
        bf16x8 kf[ND][2]; bf16x8 vfr[4][NO]; \
        if (pvis && vis_c && vis_n) {        \
            M_SCHED(); M_VLOAD(vfr, vslot_p); M_KLOADR(kf, kslot_n, 0, 3); M_SCHED();                        \
            M_EXP(p0, p1); M_SCHED(); \
            M_PVMMA(vfr); M_KLOADR(kf, kslot_n, 3, 6); M_PACK(p0, p1);                                       \
            _Pragma("unroll") for (int i_ = 0; i_ < 8; ++i_) { __builtin_amdgcn_sched_group_barrier(0x008, 1, 0); __builtin_amdgcn_sched_group_barrier(0x002, 6, 0); } \
            M_SCHED(); \
            M_QK(p0, p1, kf); M_SCHED(); \
        } else { \
            M_SCHED(); if (pvis) M_VLOAD(vfr, vslot_p); if (vis_n) M_KLOAD(kf, kslot_n); M_SCHED(); \
            if (vis_c) M_EXP(p0, p1); \
            if (pvis) M_PVMMA(vfr); \
            if (vis_c) M_PACK(p0, p1); \
            M_SCHED(); \
            if (vis_n) { M_QK(p0, p1, kf); M_SCHED(); } \
        } \
        kslot_t = kslot_n; kslot_n = (kslot_n == NSK - 1) ? 0 : kslot_n + 1; vslot_p = (vslot_p == NSV - 1) ? 0 : vslot_p + 1; vslot_n = (vslot_n == NSV - 1) ? 0 : vslot_n + 1; } while (0)
#pragma unroll
    for (int i = 0; i < PD; ++i) if (i < NT) M_DMA(i, i, i);
    f32x16 o[NO]; float l_reg = 0.f;
#pragma unroll
    for (int d = 0; d < NO; ++d) o[d] = f32x16{};
    u32x4 pw[4] = {};
    const int tw = (PRB_M == 1) ? -1 : ((q0 + 32 * wid) >> 6);
    int kslot_t = 0, kslot_n = 1, vslot_p = NSV - 1, vslot_n = PD % NSV;
    f32x16 p0 = f32x16{}, p1 = f32x16{};
    M_WAITGRP((NT < PD ? NT : PD) - 1);
    { bf16x8 kf[ND][2]; M_SCHED(); M_KLOAD(kf, 0); M_SCHED(); M_QK(p0, p1, kf); M_SCHED(); }
    for (int t = 0; t < NT; ++t) M_STEP(t);
    if (NT - 1 <= tw) { bf16x8 vfr[4][NO]; M_SCHED(); M_VLOAD(vfr, vslot_p); M_SCHED(); M_PVMMA(vfr); M_SCHED(); }
    l_reg = half_sum(l_reg);
    const bool bad = !(l_reg < 3.0e38f) || !(l_reg > 0.f);
    if (__any(bad) && lane == 0) *badflag = 1u;
    M_WAITBAR(0);
    int re = r32, he = hi, le = lane; asm volatile("" : "+v"(re), "+v"(he), "+v"(le));
    LAS float* wsf = (LAS float*)(shm + LDS_WS) + wid * 64;
    if (he == 0) wsf[32 + re] = l_reg;
    asm volatile("s_waitcnt lgkmcnt(0)" ::: "memory");
    float rli[16];
#pragma unroll
    for (int r = 0; r < 16; ++r) rli[r] = __builtin_amdgcn_rcpf(wsf[32 + crow(r, he)]);
    LAS bf16* stg = (LAS bf16*)shm + wid * (32 * 64);
#pragma unroll
    for (int r = 0; r < 16; ++r) { const int orow = crow(r, he);
#pragma unroll
        for (int d0 = 0; d0 < NO; ++d0) stg[orow * 64 + d0 * 32 + re] = f2bf(o[d0][r] * rli[r]); }
    asm volatile("s_waitcnt lgkmcnt(0)" ::: "memory");
#pragma unroll
    for (int i = 0; i < 4; ++i) { const int idx = i * 64 + le, row = idx >> 3, ch = idx & 7; const u32x4 v = *(const LAS u32x4*)(stg + row * 64 + ch * 8); *(u32x4*)(Ow + (size_t)row * ldo + ch * 8) = v; }
    M_WAITBAR(0);
#undef M_DMA
#undef M_WAITBAR
#undef M_WAITGRP
#undef M_SCHED
#undef M_KLOAD
#undef M_KLOADR
#undef M_VLOAD
#undef M_PVMMA
#undef M_QK
#undef M_EXP
#undef M_PACK
#undef M_STEP
}

template <int NU>
__device__ __forceinline__ void sgu_units(LAS unsigned char* shm, const bf16* PROJ, const bf16* Wb  , const float* bS, bf16* OMIX, float* PBR, const int (&win)[NU], const int (&gg)[NU], int tid) {
    const int lane = tid & 63, r32 = lane & 31, hi = lane >> 5, wid = __builtin_amdgcn_readfirstlane(tid >> 6);
    const unsigned lds0 = (unsigned)(uintptr_t)shm;
    const int tb = wid >> 1, db = wid & 1, t = 32 * tb + r32;
    const int ntile = (tb < 2) ? 1 : 2; const int d = 32 * db + r32;
    uint2 wa[2][4][2]; bf16 uu[NU][16]; float bb[16];
    { const int g = gg[0]; const bf16* wrow = Wb + (size_t)g * 16384 + (size_t)t * 128;
#pragma unroll
      for (int tl = 0; tl < 2; ++tl)
#pragma unroll
          for (int ks = 0; ks < 4; ++ks) { if (tl < ntile) { wa[tl][ks][0] = *(const uint2*)(wrow + 64 * tl + 16 * ks + 4 * hi); wa[tl][ks][1] = *(const uint2*)(wrow + 64 * tl + 16 * ks + 8 + 4 * hi); } else { wa[tl][ks][0] = make_uint2(0u, 0u); wa[tl][ks][1] = make_uint2(0u, 0u); } }
#pragma unroll
      for (int r = 0; r < 16; ++r) bb[r] = bS[g * 128 + 32 * tb + crow(r, hi)]; }
#pragma unroll
    for (int u = 0; u < NU; ++u) { const int g = gg[u]; const size_t row0 = (size_t)win[u] * 128;
        const bf16* Vh = PROJ + row0 * PW + C_VB + g * 64;
        const bf16* vsrc = Vh + (size_t)(16 * (wid & 3) + (lane >> 2)) * PW + (wid >> 2) * 32 + (lane & 3) * 8;
        glds16(vsrc, (unsigned)__builtin_amdgcn_readfirstlane(lds0 + u * 16384 + wid * 1024)); glds16(vsrc + (size_t)64 * PW, (unsigned)__builtin_amdgcn_readfirstlane(lds0 + u * 16384 + 8192 + wid * 1024));
#pragma unroll
        for (int r = 0; r < 16; ++r) { const int tt = 32 * tb + crow(r, hi); uu[u][r] = PROJ[(row0 + tt) * PW + C_UB + g * 64 + d]; } }
    ATT_WAITBAR(0);
    const LAS unsigned char* vp = shm + ((lane >> 4) & 1) * 32 + (lane & 3) * 8 + (4 * hi + ((lane & 15) >> 2)) * 64 + db * 4096;
#pragma unroll
    for (int u = 0; u < NU; ++u) { const int g = gg[u]; const size_t row0 = (size_t)win[u] * 128;
        f32x16 o = f32x16{};
#pragma unroll
        for (int tl = 0; tl < 2; ++tl) { if (tl < ntile) {
#pragma unroll
            for (int ks = 0; ks < 4; ++ks) { const s16x4 lo = vtr(vp + u * 16384 + tl * 8192 + ks * 1024), hh = vtr(vp + u * 16384 + tl * 8192 + ks * 1024 + 512);
                const bf16x8 vf = (bf16x8){lo[0], lo[1], lo[2], lo[3], hh[0], hh[1], hh[2], hh[3]};
                const u32x4 au = {wa[tl][ks][0].x, wa[tl][ks][0].y, wa[tl][ks][1].x, wa[tl][ks][1].y};
                o = __builtin_amdgcn_mfma_f32_32x32x16_bf16(__builtin_bit_cast(bf16x8, au), vf, o, 0, 0, 0); } } }
        float sq[16];
#pragma unroll
        for (int r = 0; r < 16; ++r) { const int tt = 32 * tb + crow(r, hi); const bf16 ob = f2bf(bf2f(uu[u][r]) * (o[r] + bb[r])); OMIX[(row0 + tt) * 1024 + 256 + g * 64 + d] = ob; const float of = bf2f(ob); sq[r] = of * of; }
        { float w8[8], w4[4], w2[2];
#pragma unroll
          for (int i = 0; i < 8; ++i) { const bool up = (r32 & 16) != 0; const float send = up ? sq[i] : sq[i + 8], keep = up ? sq[i + 8] : sq[i]; w8[i] = keep + shx(send, lane, 16); }
#pragma unroll
          for (int i = 0; i < 4; ++i) { const bool up = (r32 & 8) != 0; const float send = up ? w8[i] : w8[i + 4], keep = up ? w8[i + 4] : w8[i]; w4[i] = keep + shx(send, lane, 8); }
#pragma unroll
          for (int i = 0; i < 2; ++i) { const bool up = (r32 & 4) != 0; const float send = up ? w4[i] : w4[i + 2], keep = up ? w4[i + 2] : w4[i]; w2[i] = keep + shx(send, lane, 4); }
          const bool up2 = (r32 & 2) != 0; float w1 = (up2 ? w2[1] : w2[0]) + shx(up2 ? w2[0] : w2[1], lane, 2); w1 += shx(w1, lane, 1);
          if ((r32 & 1) == 0) PBR[(row0 + 32 * tb + crow(r32 >> 1, hi)) * 24 + 16 + 2 * g + db] = w1; } }
    asm volatile("s_waitcnt lgkmcnt(0)\n\ts_barrier" ::: "memory");
}
#undef ATT_WAITBAR
}

#include <hip/hip_bf16.h>
#include <cmath>
namespace tfx {
using bf16=__hip_bfloat16;
using bf16x8=__attribute__((ext_vector_type(8)))short;
using s16x4=__attribute__((ext_vector_type(4)))short;
using f32x16=__attribute__((ext_vector_type(16)))float;
using u32x4=__attribute__((ext_vector_type(4)))unsigned;
constexpr int SEQ=4096,D=64,DM=2816  ,DMO=1024  ;
constexpr int NW=8,QBLK=32,QB=QBLK*NW,KVBLK=64,NQB=SEQ/QB;
constexpr int ATTN_UNIT_ROWS=QB;
__device__ __forceinline__ int crow(int r,int hi){return (r&3)+8*(r>>2)+4*hi;}
#define SBAR() __builtin_amdgcn_sched_barrier(0)
__device__ __forceinline__ void cmask(f32x16&p0,f32x16&p1,int jb,int qrel,int hi){
  const float NEG=-INFINITY; int kb=64*jb+4*hi;
  #pragma unroll
  for(int r=0;r<16;++r){int kv=kb+(r&3)+8*(r>>2); if(kv>qrel)p0[r]=NEG; if(kv+32>qrel)p1[r]=NEG;}
}

constexpr int NSLOT=3, SLOTB=8192;
constexpr int LDS_K=0, LDS_V=NSLOT*SLOTB, LDS_WS=2*NSLOT*SLOTB, LDS_OST=LDS_WS+NW*64*4, LDS_BYTES=LDS_OST+NW*4096;
constexpr float C2=0.125f*1.4426950408889634f;
__device__ __forceinline__ void glds16(const void*gsrc,unsigned lds_dst){unsigned keep;
  asm volatile("s_mov_b32 %0, m0\n\ts_mov_b32 m0, %2\n\ts_nop 0\n\tglobal_load_lds_dwordx4 %1, off\n\ts_mov_b32 m0, %0":"=&s"(keep):"v"(gsrc),"s"(lds_dst):"memory");}
__device__ __forceinline__ float max3f(float a,float b,float c){float r;asm("v_max3_f32 %0, %1, %2, %3":"=v"(r):"v"(a),"v"(b),"v"(c));return r;}
__device__ __forceinline__ float max2f(float a,float b){float r;asm("v_max_f32_e32 %0, %1, %2":"=v"(r):"v"(a),"v"(b));return r;}
__device__ __forceinline__ float fadd_s(float a,float b){float r;asm("v_add_f32_e32 %0, %1, %2":"=v"(r):"v"(a),"v"(b));return r;}
__device__ __forceinline__ float fsub_s(float a,float b){float r;asm("v_sub_f32_e32 %0, %1, %2":"=v"(r):"v"(a),"v"(b));return r;}
typedef float f32x2_t __attribute__((ext_vector_type(2))); typedef __bf16 bf16x2_t __attribute__((ext_vector_type(2)));
__device__ __forceinline__ unsigned cvtpk_s(float lo,float hi){f32x2_t v={lo,hi};bf16x2_t b=__builtin_convertvector(v,bf16x2_t);return __builtin_bit_cast(unsigned,b);}
#define WAIT_BAR(N) asm volatile("s_waitcnt vmcnt(" #N ") lgkmcnt(0)\n\ts_barrier":::"memory")

__device__ __forceinline__ void qkt(f32x16&p0,f32x16&p1,const char*Kslot,const bf16x8*qr,const f32x16&negm,int r32,int hi){
  const char*kb=Kslot+hi*1024+r32*16;
  #pragma unroll
  for(int d0=0;d0<4;++d0){
    const bf16x8 b0=*reinterpret_cast<const bf16x8*>(kb+d0*2048);
    const bf16x8 b1=*reinterpret_cast<const bf16x8*>(kb+d0*2048+512);
    if(d0==0){p0=__builtin_amdgcn_mfma_f32_32x32x16_bf16(b0,qr[0],negm,0,0,0);p1=__builtin_amdgcn_mfma_f32_32x32x16_bf16(b1,qr[0],negm,0,0,0);}
    else{p0=__builtin_amdgcn_mfma_f32_32x32x16_bf16(b0,qr[d0],p0,0,0,0);p1=__builtin_amdgcn_mfma_f32_32x32x16_bf16(b1,qr[d0],p1,0,0,0);}}
}
typedef __attribute__((address_space(3))) const char* lds_cptr;
typedef short v4i16_t __attribute__((ext_vector_type(4)));
__device__ __forceinline__ void kload8(bf16x8*kf,lds_cptr kp){
  kf[0]=*(const __attribute__((address_space(3))) bf16x8*)(kp);      kf[1]=*(const __attribute__((address_space(3))) bf16x8*)(kp+512);
  kf[2]=*(const __attribute__((address_space(3))) bf16x8*)(kp+2048); kf[3]=*(const __attribute__((address_space(3))) bf16x8*)(kp+2560);
  kf[4]=*(const __attribute__((address_space(3))) bf16x8*)(kp+4096); kf[5]=*(const __attribute__((address_space(3))) bf16x8*)(kp+4608);
  kf[6]=*(const __attribute__((address_space(3))) bf16x8*)(kp+6144); kf[7]=*(const __attribute__((address_space(3))) bf16x8*)(kp+6656);
}
__device__ __forceinline__ void kload2(bf16x8*kf,lds_cptr kp,int j){ kf[2*j]=*(const __attribute__((address_space(3))) bf16x8*)(kp+j*2048); kf[2*j+1]=*(const __attribute__((address_space(3))) bf16x8*)(kp+j*2048+512); }
__device__ __forceinline__ s16x4 vtr(lds_cptr p){ return __builtin_bit_cast(s16x4,__builtin_amdgcn_ds_read_tr16_b64_v4i16((__attribute__((address_space(3))) v4i16_t*)p)); }
__device__ __forceinline__ float rowmax(const f32x16&p0,const f32x16&p1){
  float a=max3f(p0[0],p0[1],p1[0]),b=max3f(p0[2],p0[3],p1[1]);a=max3f(a,p1[2],p1[3]);
  #pragma unroll
  for(int r=4;r<16;r+=4){a=max3f(a,p0[r],p0[r+1]);b=max3f(b,p0[r+2],p0[r+3]);a=max3f(a,p1[r],p1[r+1]);b=max3f(b,p1[r+2],p1[r+3]);}
  const float m=max2f(a,b);
  auto rr=__builtin_amdgcn_permlane32_swap(__float_as_uint(m),__float_as_uint(m),false,false);
  return max2f(__uint_as_float(rr[0]),__uint_as_float(rr[1]));
}
__device__ __forceinline__ void pv(f32x16*o,int vb,bf16x8 pa0,bf16x8 pa1,bf16x8 pa2,bf16x8 pa3){
  #pragma unroll
  for(int d0=0;d0<2;++d0){s16x4 lo[4],hi[4];
    #pragma unroll
    for(int ks=0;ks<4;++ks){
      asm volatile("ds_read_b64_tr_b16 %0,%1 offset:%c2":"=&v"(lo[ks]):"v"(vb),"i"(d0*4096+ks*1024):"memory");
      asm volatile("ds_read_b64_tr_b16 %0,%1 offset:%c2":"=&v"(hi[ks]):"v"(vb),"i"(d0*4096+ks*1024+512):"memory");}
    asm volatile("s_waitcnt lgkmcnt(0)":::"memory");SBAR();
    #define PK(k) (bf16x8){lo[k][0],lo[k][1],lo[k][2],lo[k][3],hi[k][0],hi[k][1],hi[k][2],hi[k][3]}
    o[d0]=__builtin_amdgcn_mfma_f32_32x32x16_bf16(pa0,PK(0),o[d0],0,0,0);
    o[d0]=__builtin_amdgcn_mfma_f32_32x32x16_bf16(pa1,PK(1),o[d0],0,0,0);
    o[d0]=__builtin_amdgcn_mfma_f32_32x32x16_bf16(pa2,PK(2),o[d0],0,0,0);
    o[d0]=__builtin_amdgcn_mfma_f32_32x32x16_bf16(pa3,PK(3),o[d0],0,0,0);
    #undef PK
  }
}

#ifndef ATTN_STORE16
#define ATTN_STORE16(p,v) (*(u32x4*)(p)=(v))
#endif
typedef __attribute__((address_space(3))) const float* lds_fptr; typedef float f32x4_t __attribute__((ext_vector_type(4)));
#define FBIAS(P0,P1,t) do{ const lds_fptr fp_=fbk+64*(t)+4*hi; _Pragma("unroll") for(int g_=0;g_<4;++g_){ const f32x4_t f0_=*(const __attribute__((address_space(3))) f32x4_t*)(fp_+8*g_), f1_=*(const __attribute__((address_space(3))) f32x4_t*)(fp_+32+8*g_); \
    _Pragma("unroll") for(int j_=0;j_<4;++j_){P0[4*g_+j_]+=f0_[j_];P1[4*g_+j_]+=f1_[j_];} } }while(0)
template<int THRL,int MODE> __device__ __forceinline__ void attn_unit(int b,int qb,const bf16*Q,const bf16*__restrict__ K,const bf16*__restrict__ V,const bf16*__restrict__ R,bf16*O,char*shm,const float*cumh,int tid_in,const float*qng=nullptr,const float*qrg=nullptr,const float*ropet=nullptr,float*PS=nullptr,float mshift=0.f,float skipthr=0.f){
  constexpr int DMQ=MODE?768:DM, DMK=MODE?1024:DM, DMV=DMK, DMR=DM, NQ=MODE?6:4, LDS_R=LDS_BYTES;
  int tid=tid_in; asm volatile("":"+v"(tid));
  const int lane=tid&63,r32=lane&31,hi=lane>>5; const int wid=__builtin_amdgcn_readfirstlane(tid>>6);
  const long rowbase=(long)b*SEQ; const int q0=qb*QB;
  const bf16*Qw=Q+(rowbase+q0+wid*QBLK)*DMQ;
  const bf16*Kh=K+rowbase*DMK,*Vh=V+rowbase*DMV;
  int t0=0;
  if(MODE==0&&skipthr>0.f){ const int NTf=(q0+QB)/KVBLK; const float cq=cumh[(long)q0*4]; bool sk=false; if(lane<NTf-4){ const float ck=cumh[(long)(64*lane+63)*4]; sk=((cq-ck)*1.4426950408889634f<-skipthr); }
    const unsigned long long m_=__ballot(sk); int z=(~m_==0ull)?64:__builtin_ctzll(~m_); if(z>NTf-4)z=NTf-4; t0=__builtin_amdgcn_readfirstlane(z&~1); Kh+=(long)t0*KVBLK*DMK; Vh+=(long)t0*KVBLK*DMV; }
  const unsigned lds0=(unsigned)(uintptr_t)shm;
  float*wsf=(float*)(shm+LDS_WS)+wid*64;
  if(MODE==0){ float*fbw=(float*)(shm+LDS_BYTES); for(int i=64*t0+tid;i<q0+QB;i+=NW*64)fbw[i]=-cumh[(long)i*4]*1.4426950408889634f; }
  const lds_fptr fb3=(lds_fptr)(shm+LDS_BYTES); const lds_fptr fbk=fb3+64*t0;
  const bf16*ksrc=Kh+(long)lane*DMK+wid*8;
  const bf16*vsrc=Vh+(long)(16*(wid&3)+(lane>>2))*DMV+(wid>>2)*32+(lane&3)*8;
  const bf16*rsrc=MODE?(R+rowbase*DMR+(long)lane*DMR+(wid&3)*8):nullptr;
  const bool xw=(MODE==1)&&(wid<4); const unsigned rdst=lds0+LDS_R+(wid&3)*1024;
  const unsigned kdst=lds0+LDS_K+wid*1024, vdst=lds0+LDS_V+wid*1024;
  #define DMA_K(t,slot) do{ glds16(ksrc+(long)(t)*KVBLK*DMK,(unsigned)__builtin_amdgcn_readfirstlane(kdst+(slot))); if(xw) glds16(rsrc+(long)(t)*KVBLK*DMR,(unsigned)__builtin_amdgcn_readfirstlane(rdst+((t)&3)*4096)); }while(0)
  #define DMA_V(t,slot) glds16(vsrc+(long)(t)*KVBLK*DMV,(unsigned)__builtin_amdgcn_readfirstlane(vdst+(slot)))
  #define WAITX(N,NX) do{ if(xw){WAIT_BAR(NX);}else{WAIT_BAR(N);} }while(0)
  const int vb0=(int)(lds0+LDS_V)+((lane>>4)&1)*32+(lane&3)*8+(4*hi+((lane&15)>>2))*64;
  const char*Kbase=shm+LDS_K; bf16x8 kf[8];
  const lds_cptr shm3=(lds_cptr)shm; const lds_cptr kp0=shm3+LDS_K+hi*1024+r32*16; const lds_cptr vp0=shm3+LDS_V+((lane>>4)&1)*32+(lane&3)*8+(4*hi+((lane&15)>>2))*64;
  const int NT=(q0+QB)/KVBLK-t0;
  DMA_K(0,0);DMA_V(0,0);DMA_K(1,SLOTB);
  bf16x8 qr[NQ];
  #pragma unroll
  for(int d0=0;d0<NQ;++d0)qr[d0]=*reinterpret_cast<const bf16x8*>(&Qw[(long)r32*DMQ+d0*16+hi*8]);
  if(MODE==1){
    const float C2m=0.10206207261596575f*1.4426950408889634f;
    float xn[4][8]; float ss=0.f;
    #pragma unroll
    for(int d0=0;d0<4;++d0){ const u32x4 u=__builtin_bit_cast(u32x4,qr[d0]);
      #pragma unroll
      for(int i=0;i<4;++i){ xn[d0][2*i]=__uint_as_float(u[i]<<16); xn[d0][2*i+1]=__uint_as_float(u[i]&0xffff0000u); ss+=xn[d0][2*i]*xn[d0][2*i]+xn[d0][2*i+1]*xn[d0][2*i+1]; } }
    { auto rr=__builtin_amdgcn_permlane32_swap(__float_as_uint(ss),__float_as_uint(ss),false,false); ss=__uint_as_float(rr[0])+__uint_as_float(rr[1]); }
    const float rn=__builtin_amdgcn_rsqf(ss*(1.f/64.f)+1e-6f)*C2m;
    #pragma unroll
    for(int d0=0;d0<4;++d0){ u32x4 w;
      #pragma unroll
      for(int i=0;i<4;++i) w[i]=cvtpk_s(xn[d0][2*i]*rn*qng[d0*16+hi*8+2*i], xn[d0][2*i+1]*rn*qng[d0*16+hi*8+2*i+1]);
      qr[d0]=__builtin_bit_cast(bf16x8,w); }
    float x1[8],x2[8]; float s2=0.f;
    { const u32x4 u1=__builtin_bit_cast(u32x4,qr[4]),u2=__builtin_bit_cast(u32x4,qr[5]);
      #pragma unroll
      for(int i=0;i<4;++i){ x1[2*i]=__uint_as_float(u1[i]<<16); x1[2*i+1]=__uint_as_float(u1[i]&0xffff0000u); x2[2*i]=__uint_as_float(u2[i]<<16); x2[2*i+1]=__uint_as_float(u2[i]&0xffff0000u); } }
    #pragma unroll
    for(int j=0;j<8;++j)s2+=x1[j]*x1[j]+x2[j]*x2[j];
    { auto rr=__builtin_amdgcn_permlane32_swap(__float_as_uint(s2),__float_as_uint(s2),false,false); s2=__uint_as_float(rr[0])+__uint_as_float(rr[1]); }
    const float rq=__builtin_amdgcn_rsqf(s2*(1.f/32.f)+1e-6f);
    const float4*tp=reinterpret_cast<const float4*>(ropet+((rowbase+q0+wid*QBLK+r32)*16+8*hi)*2);
    u32x4 w1,w2;
    #pragma unroll
    for(int i=0;i<4;++i){ const float4 t=tp[i]; const int j0=2*i,j1=2*i+1;
      const float a0=x1[j0]*rq*qrg[8*hi+j0],b0=x2[j0]*rq*qrg[16+8*hi+j0],a1=x1[j1]*rq*qrg[8*hi+j1],b1=x2[j1]*rq*qrg[16+8*hi+j1];
      w1[i]=cvtpk_s((a0*t.x-b0*t.y)*C2m,(a1*t.z-b1*t.w)*C2m); w2[i]=cvtpk_s((a0*t.y+b0*t.x)*C2m,(a1*t.w+b1*t.z)*C2m); }
    qr[4]=__builtin_bit_cast(bf16x8,w1); qr[5]=__builtin_bit_cast(bf16x8,w2);
  }
  const lds_cptr rp0=(lds_cptr)shm+LDS_R+hi*1024+r32*16;
  #define ROPE(C0_,C1_,t,ACC) do{ if(MODE==1){ const lds_cptr rp_=rp0+((t)&3)*4096; \
      const bf16x8 r0_=*(const __attribute__((address_space(3))) bf16x8*)(rp_), r1_=*(const __attribute__((address_space(3))) bf16x8*)(rp_+512), r2_=*(const __attribute__((address_space(3))) bf16x8*)(rp_+2048), r3_=*(const __attribute__((address_space(3))) bf16x8*)(rp_+2560); \
      C0_=__builtin_amdgcn_mfma_f32_32x32x16_bf16(r0_,qr[NQ-2],ACC?C0_:negm,0,0,0); C1_=__builtin_amdgcn_mfma_f32_32x32x16_bf16(r1_,qr[NQ-2],ACC?C1_:negm,0,0,0); \
      C0_=__builtin_amdgcn_mfma_f32_32x32x16_bf16(r2_,qr[NQ-1],C0_,0,0,0); C1_=__builtin_amdgcn_mfma_f32_32x32x16_bf16(r3_,qr[NQ-1],C1_,0,0,0); } }while(0)
  float mhat=0.f,l_reg=0.f;f32x16 o[2];o[0]=f32x16{};o[1]=f32x16{};f32x16 negm=f32x16{};asm volatile("":"+v"(negm));
  const int qrel=wid*QBLK+r32;
  #define CMASK(P0,P1,t) do{int jb_=(t)-(NT-4); if(jb_>=0){ if(MODE==0)cmask(P0,P1,jb_,qrel,hi); else if(jb_>(wid>>1)){ _Pragma("unroll") for(int r_=0;r_<16;++r_){P0[r_]=-INFINITY;P1[r_]=-INFINITY;} } } }while(0)
  bool resc=false;
  #define START(P0,P1) do{ resc=false; \
    { const float dl=((MODE==0)?fb3[q0+qrel]:0.f)+mshift; mhat=fadd_s(mhat,dl); \
      _Pragma("unroll") for(int r=0;r<16;++r){P0[r]=fsub_s(P0[r],dl);P1[r]=fsub_s(P1[r],dl);} \
      _Pragma("unroll") for(int r=0;r<16;++r)negm[r]=-mhat; asm volatile("":"+v"(negm)); } \
    _Pragma("unroll") for(int r=0;r<16;++r)P0[r]=__builtin_amdgcn_exp2f(P0[r]); }while(0)
  #define RESC() do{}while(0)
  f32x16 pA0,pA1,pB0,pB1;
  int sl_prev=0,sl_cur=0,sl_next=SLOTB;
  #define ROT() do{sl_prev=sl_cur;sl_cur=sl_next;sl_next=(sl_next==(NSLOT-1)*SLOTB)?0:sl_next+SLOTB;}while(0)
  DMA_K(2,2*SLOTB);
  WAITX(3,5);
  qkt(pA0,pA1,Kbase,qr,negm,r32,hi);ROPE(pA0,pA1,0,true);asm volatile("s_nop 15\n\ts_nop 7":"+v"(pA0),"+v"(pA1));if(MODE==0)FBIAS(pA0,pA1,0);CMASK(pA0,pA1,0);
  START(pA0,pA1);
  _Pragma("unroll") for(int r=0;r<16;++r)pA1[r]=__builtin_amdgcn_exp2f(pA1[r]);
  WAIT_BAR(0);
  DMA_K(3,0);DMA_V(1,SLOTB);
  ROT();
  kload8(kf,kp0+sl_cur);
  WAITX(2,3);
  s16x4 vlo[8],vhi[8]; u32x4 pw0,pw1,pw2,pw3;
  #define PKW(P,B) cvtpk_s(P[B],P[B+1])
  #define PAF(k) __builtin_bit_cast(bf16x8,pw##k)
  #define VFR(i) (bf16x8){vlo[i][0],vlo[i][1],vlo[i][2],vlo[i][3],vhi[i][0],vhi[i][1],vhi[i][2],vhi[i][3]}
  #define PIN(x) asm volatile("":"+v"(x))
  #define MX3(a,b,c) __builtin_fmaxf(__builtin_fmaxf((a),(b)),(c))
  #define GAPA(MF,A0,A1,A2,A3,W0,W1,PW) do{ MF; sacc+=A0; sacc+=A1; sacc+=A2; sacc+=A3; PIN(sacc); W0; W1; PIN(PW); SBAR(); }while(0)
  #define EX(v) __builtin_amdgcn_exp2f(v)
  #define GAPB(MF,X,B) do{ MF; X[B]=EX(X[B]); X[B+1]=EX(X[B+1]); X[B+2]=EX(X[B+2]); X[B+3]=EX(X[B+3]); PIN(X); SBAR(); }while(0)
  #define VRD(i) do{ vlo[i]=vtr(vp_+(((i)>>2)*4096+((i)&3)*1024)); vhi[i]=vtr(vp_+(((i)>>2)*4096+((i)&3)*1024+512)); }while(0)
  #define KRD(G,j) do{ if(G){ kload2(kf,kp0+sl_next,j); SBAR(); } }while(0)
  #define STEP(C0,C1,P0,P1,t,GK,GV,GL) do{ SBAR(); \
    const lds_cptr vp_=vp0+sl_prev; \
    ROPE(C0,C1,t,false); SBAR(); \
    VRD(0); SBAR(); float sacc=(P0[0]+P0[1]); \
    GAPA(C0=__builtin_amdgcn_mfma_f32_32x32x16_bf16(kf[0],qr[0],MODE==1?C0:negm,0,0,0), P0[2],P0[3],P0[4],P0[5],     pw0[0]=PKW(P0,0), pw0[1]=PKW(P0,2), pw0); \
    VRD(4); SBAR(); GAPA(C1=__builtin_amdgcn_mfma_f32_32x32x16_bf16(kf[1],qr[0],MODE==1?C1:negm,0,0,0), P0[6],P0[7],P0[8],P0[9],     pw0[2]=PKW(P0,4), pw0[3]=PKW(P0,6), pw0); \
    VRD(1); SBAR(); GAPA(C0=__builtin_amdgcn_mfma_f32_32x32x16_bf16(kf[2],qr[1],C0,0,0,0),   P0[10],P0[11],P0[12],P0[13], pw1[0]=PKW(P0,8), pw1[1]=PKW(P0,10), pw1); \
    VRD(5); SBAR(); GAPA(C1=__builtin_amdgcn_mfma_f32_32x32x16_bf16(kf[3],qr[1],C1,0,0,0),   P0[14],P0[15],P1[0],P1[1],   pw1[2]=PKW(P0,12),pw1[3]=PKW(P0,14), pw1); \
    VRD(2); SBAR(); GAPA(C0=__builtin_amdgcn_mfma_f32_32x32x16_bf16(kf[4],qr[2],C0,0,0,0),   P1[2],P1[3],P1[4],P1[5],     pw2[0]=PKW(P1,0), pw2[1]=PKW(P1,2), pw2); \
    VRD(6); SBAR(); GAPA(C1=__builtin_amdgcn_mfma_f32_32x32x16_bf16(kf[5],qr[2],C1,0,0,0),   P1[6],P1[7],P1[8],P1[9],     pw2[2]=PKW(P1,4), pw2[3]=PKW(P1,6), pw2); \
    VRD(3); SBAR(); GAPA(C0=__builtin_amdgcn_mfma_f32_32x32x16_bf16(kf[6],qr[3],C0,0,0,0),   P1[10],P1[11],P1[12],P1[13], pw3[0]=PKW(P1,8), pw3[1]=PKW(P1,10), pw3); \
    VRD(7); SBAR(); GAPA(C1=__builtin_amdgcn_mfma_f32_32x32x16_bf16(kf[7],qr[3],C1,0,0,0),   P1[14],P1[15],0.f,0.f,       pw3[2]=PKW(P1,12),pw3[3]=PKW(P1,14), pw3); \
    l_reg+=sacc; \
    if(GK){DMA_K((t)+3,sl_cur);} if(GV){DMA_V((t)+1,sl_next);} \
    if(MODE==0)FBIAS(C0,C1,t); CMASK(C0,C1,t); \
    SBAR(); \
    GAPB(o[0]=__builtin_amdgcn_mfma_f32_32x32x16_bf16(PAF(0),VFR(0),o[0],0,0,0), C0,0); \
    GAPB(o[1]=__builtin_amdgcn_mfma_f32_32x32x16_bf16(PAF(0),VFR(4),o[1],0,0,0), C0,4); \
    KRD(GL,0); GAPB(o[0]=__builtin_amdgcn_mfma_f32_32x32x16_bf16(PAF(1),VFR(1),o[0],0,0,0), C0,8); \
    KRD(GL,1); GAPB(o[1]=__builtin_amdgcn_mfma_f32_32x32x16_bf16(PAF(1),VFR(5),o[1],0,0,0), C0,12); \
    KRD(GL,2); GAPB(o[0]=__builtin_amdgcn_mfma_f32_32x32x16_bf16(PAF(2),VFR(2),o[0],0,0,0), C1,0); \
    KRD(GL,3); GAPB(o[1]=__builtin_amdgcn_mfma_f32_32x32x16_bf16(PAF(2),VFR(6),o[1],0,0,0), C1,4); \
    GAPB(o[0]=__builtin_amdgcn_mfma_f32_32x32x16_bf16(PAF(3),VFR(3),o[0],0,0,0), C1,8); \
    GAPB(o[1]=__builtin_amdgcn_mfma_f32_32x32x16_bf16(PAF(3),VFR(7),o[1],0,0,0), C1,12); \
    }while(0)
  int t=1;
  #undef CMASK
  #define CMASK(P0,P1,t) do{}while(0)
  for(;t+5<NT;t+=2){
    STEP(pB0,pB1,pA0,pA1,t,true,true,true);     WAITX(2,3); RESC(); ROT();
    STEP(pA0,pA1,pB0,pB1,t+1,true,true,true);   WAITX(2,3); RESC(); ROT();
  }
  #undef CMASK
  #define CMASK(P0,P1,t) do{int jb_=(t)-(NT-4); if(jb_>=0){ if(MODE==0)cmask(P0,P1,jb_,qrel,hi); else if(jb_>(wid>>1)){ _Pragma("unroll") for(int r_=0;r_<16;++r_){P0[r_]=-INFINITY;P1[r_]=-INFINITY;} } } }while(0)
  #define ENDW(tt) do{ if((tt)+3<NT){WAITX(2,3);} else if((tt)+2<NT){WAIT_BAR(1);} else {WAIT_BAR(0);} }while(0)
  for(;t+1<NT;t+=2){
    STEP(pB0,pB1,pA0,pA1,t,(t+3<NT),(t+1<NT),(t+1<NT));       ENDW(t);   RESC(); ROT();
    STEP(pA0,pA1,pB0,pB1,t+1,(t+4<NT),(t+2<NT),(t+2<NT));     ENDW(t+1); RESC(); ROT();
  }
  STEP(pB0,pB1,pA0,pA1,NT-1,false,false,false); RESC();
  { float sacc=pB0[0]+pB0[1]; _Pragma("unroll") for(int r=2;r<16;++r)sacc+=pB0[r]; _Pragma("unroll") for(int r=0;r<16;++r)sacc+=pB1[r]; l_reg+=sacc;
    pw0=(u32x4){PKW(pB0,0),PKW(pB0,2),PKW(pB0,4),PKW(pB0,6)};pw1=(u32x4){PKW(pB0,8),PKW(pB0,10),PKW(pB0,12),PKW(pB0,14)};pw2=(u32x4){PKW(pB1,0),PKW(pB1,2),PKW(pB1,4),PKW(pB1,6)};pw3=(u32x4){PKW(pB1,8),PKW(pB1,10),PKW(pB1,12),PKW(pB1,14)};
    SBAR(); pv(o,vb0+sl_cur,PAF(0),PAF(1),PAF(2),PAF(3)); }
  #undef PKW
  #undef PAF
  #undef VFR
  #undef PIN
  #undef MX3
  #undef GAPA
  #undef GAPB
  #undef EX
  #undef VRD
  #undef KRD
  #undef STEP
  #undef ENDW
  int lane_e=lane; asm volatile("":"+v"(lane_e)); const int r32e=lane_e&31,hie=lane_e>>5;
  {auto rr=__builtin_amdgcn_permlane32_swap(__float_as_uint(l_reg),__float_as_uint(l_reg),false,false);l_reg=__uint_as_float(rr[0])+__uint_as_float(rr[1]);}
  if(hie==0)wsf[32+r32e]=l_reg;asm volatile("s_waitcnt lgkmcnt(0)":::"memory");
  float rli[16];
  #pragma unroll
  for(int r=0;r<16;++r)rli[r]=__builtin_amdgcn_rcpf(wsf[32+crow(r,hie)]);
  bf16*Ow=O+(rowbase+q0+wid*QBLK)*DMO;
  { bf16*stg=(bf16*)(shm+LDS_OST)+wid*2048;
    #pragma unroll
    for(int r=0;r<16;++r){const int orow=crow(r,hie);
      #pragma unroll
      for(int d0=0;d0<2;++d0)stg[orow*64+d0*32+r32e]=__float2bfloat16(o[d0][r]*rli[r]);}
    asm volatile("s_waitcnt lgkmcnt(0)":::"memory");
    #pragma unroll
    for(int i=0;i<4;++i){const int row=i*8+(lane_e>>3),ch=lane_e&7; const u32x4 v=*(const u32x4*)(stg+row*64+ch*8); ATTN_STORE16(Ow+(long)row*DMO+ch*8,v);
      float ss=0.f;
      {const unsigned w4[4]={v.x,v.y,v.z,v.w};
       #pragma unroll
       for(int e=0;e<4;++e){const float a0=__uint_as_float(w4[e]<<16),a1=__uint_as_float(w4[e]&0xffff0000u);ss+=a0*a0+a1*a1;}}
      ss+=::shx(ss,lane_e,1);ss+=::shx(ss,lane_e,2);ss+=::shx(ss,lane_e,4);
      if(ch==0)PS[(rowbase+q0+wid*QBLK+row)*24]=ss;} }
  asm volatile("s_waitcnt lgkmcnt(0)\n\ts_barrier":::"memory");
  #undef DMA_K
  #undef WAITX
  #undef ROPE
  #undef DMA_V
  #undef CMASK
  #undef START
  #undef RESC
  #undef ROT
}
constexpr int ATTN_LDS_BYTES=LDS_BYTES+16384;
#undef FBIAS
#undef SBAR
#undef WAIT_BAR
}

#define XB_TMO      128
#define XB_XCNT(j)  (256  + 64 * (j))
#define XB_XSUB(j)  (1280 + 64 * (j))
#define XB_XGEN(j)  (2304 + 64 * (j))
#define XB_TOP      3328
#define XB_TOPGEN   3392
#define XCD_BAR_WORDS 3456
#define XB_SPIN_CAP (1u << 18)
__device__ __forceinline__ unsigned xb_ld(unsigned* p)              { return __hip_atomic_load(p, __ATOMIC_RELAXED, __HIP_MEMORY_SCOPE_AGENT); }
__device__ __forceinline__ unsigned xb_add(unsigned* p, unsigned v) { return __hip_atomic_fetch_add(p, v, __ATOMIC_RELAXED, __HIP_MEMORY_SCOPE_AGENT); }
__device__ __forceinline__ unsigned xb_xcc_id() { return (unsigned)__builtin_amdgcn_s_getreg((3 << 11) | 20) & 0xFu; }
#define XB_SPIN(cond, bar) do { unsigned _sp = 0; while (cond) { __builtin_amdgcn_s_sleep(1); \
    if ((++_sp & 255u) == 0u) { if (xb_ld(&(bar)[XB_TMO])) break; if (_sp > XB_SPIN_CAP) { atomicAdd(&(bar)[XB_TMO], 1u); break; } } } } while (0)
struct XcdBarrier { unsigned* bar; unsigned x; volatile LAS unsigned* st; };
__device__ __forceinline__ XcdBarrier xcd_barrier_post(unsigned* bar, volatile LAS unsigned* st) {
    XcdBarrier b; b.bar = bar; b.x = xb_xcc_id(); b.st = st;
    if (threadIdx.x == 0) { const unsigned rank = xb_add(&bar[XB_XCNT(b.x)], 1u); st[2] = rank; st[3] = b.x; }
    return b;
}
__device__ __forceinline__ void xcd_barrier_complete(unsigned* bar, unsigned x, unsigned& nloc, unsigned& nx) {
    const unsigned G = gridDim.x * gridDim.y * gridDim.z;
    unsigned sum, cnt, mine, sp = 0u;
    for (;;) {
        sum = 0u; cnt = 0u; mine = 0u;
#pragma unroll
        for (unsigned j = 0; j < 16; ++j) { const unsigned c = xb_ld(&bar[XB_XCNT(j)]); sum += c; cnt += (c > 0u) ? 1u : 0u; mine = (j == x) ? c : mine; }
        if (sum == G) break;
        __builtin_amdgcn_s_sleep(1);
        if ((++sp & 255u) == 0u) { if (xb_ld(&bar[XB_TMO])) break; if (sp > XB_SPIN_CAP) { atomicAdd(&bar[XB_TMO], 1u); break; } }
    }
    nloc = mine > 0u ? mine : 1u; nx = cnt > 0u ? cnt : 1u;
}
__device__ __forceinline__ void xcd_barrier(const XcdBarrier& b, int tid_) {
    asm volatile("s_waitcnt vmcnt(0)" ::: "memory");
    __syncthreads();
    if (tid_ == 0) {
        unsigned* bar = b.bar;
        __builtin_amdgcn_s_waitcnt(0);
        unsigned nloc = b.st[0], nx = b.st[1];
        unsigned bx_ = b.x; asm volatile("" : "+s"(bx_));
        if (nloc == 0u) { xcd_barrier_complete(bar, bx_, nloc, nx); b.st[0] = nloc; b.st[1] = nx; }
        const unsigned old = xb_add(&bar[XB_XSUB(bx_)], 1u);
        const unsigned gen = old / nloc;
        if (old + 1u == (gen + 1u) * nloc) {
            __builtin_amdgcn_fence(__ATOMIC_RELEASE, "agent");
            asm volatile("s_waitcnt vmcnt(0)" ::: "memory");
            const unsigned og = xb_add(&bar[XB_TOP], 1u);
            const unsigned tg = og / nx;
            if (og + 1u == (tg + 1u) * nx) xb_add(&bar[XB_TOPGEN], 1u);
            else XB_SPIN(xb_ld(&bar[XB_TOPGEN]) == tg, bar);
            __builtin_amdgcn_fence(__ATOMIC_ACQUIRE, "agent");
            xb_add(&bar[XB_XGEN(bx_)], 1u);
            asm volatile("s_waitcnt vmcnt(0)" ::: "memory");
        } else {
            XB_SPIN(xb_ld(&bar[XB_XGEN(bx_)]) == gen, bar);
            __builtin_amdgcn_fence(__ATOMIC_ACQUIRE, "agent");
            asm volatile("s_waitcnt vmcnt(0)" ::: "memory");
        }
    }
    __syncthreads();
}

#define XL_SUB(j) (8192 + 64 * (j))
#define XL_GEN(j) (9216 + 64 * (j))
__device__ __forceinline__ void xcc_local_barrier(unsigned* ctl, unsigned* bar, unsigned x, unsigned nloc, int tid_) {
    asm volatile("s_waitcnt vmcnt(0)" ::: "memory");
    __syncthreads();
    if (tid_ == 0) {
        unsigned xx = x; asm volatile("" : "+s"(xx));
        const unsigned old = xb_add(&ctl[XL_SUB(xx)], 1u), gen = old / nloc;
        if (old + 1u == (gen + 1u) * nloc) xb_add(&ctl[XL_GEN(xx)], 1u);
        else XB_SPIN(xb_ld(&ctl[XL_GEN(xx)]) == gen, bar);
        __builtin_amdgcn_fence(__ATOMIC_ACQUIRE, "agent");
        asm volatile("s_waitcnt vmcnt(0)" ::: "memory");
    }
    __syncthreads();
}

constexpr int NWAVES = 8;
constexpr int RING_BYTES = 131072, LDSCTL_OFF = RING_BYTES, MISC_OFF = LDSCTL_OFF + 320, LDS_BYTES = 147456;
constexpr int CW_BAR = 4096;
constexpr size_t L_WIN = 0, L_WUQ = 3670016, L_WUKV = 4063232, L_WOUT = 4587520, L_WMQ = 6684672, L_WMKV = 7733248, L_WMO = 9830400, LW_STRIDE = 11 * MiB;
constexpr size_t W_FGU = 22 * MiB, W_FD = 33 * MiB, W_MGU = 39 * MiB, W_MD = 83 * MiB, MGU_STRIDE = (size_t)DFE * 2 * 1024 * 2, MD_STRIDE = (size_t)1024 * DFE * 2;
constexpr size_t W_SGU = 106 * MiB;
constexpr size_t WS_HMP = WS_QC;

struct Job { const float* src; const float* src2; const float* ksc; const float* kscb; const float* kscc; int ldw, Ksrc, Kpad, Nphys, map, nlog; bf16* dst; };
__device__ __forceinline__ Job get_job(const Args& a, int j) {
    Job J; J.src2 = nullptr; J.ksc = nullptr; J.kscb = nullptr; J.kscc = nullptr; J.map = 0; unsigned char* wb = a.ws + WS_WB;
    if (j < 14) { const int l = j / 7, t = j % 7; unsigned char* lb = wb + (size_t)l * LW_STRIDE;
        switch (t) {
        case 0: J.src = a.in[4] + (size_t)l * 1024 * IN_W; J.ldw = IN_W; J.Ksrc = 1024; J.Kpad = 1024; J.Nphys = 1792; J.map = 4; J.nlog = IN_W; J.dst = (bf16*)(lb + L_WIN); J.ksc = a.in[3] + l * 1024; break;
        case 1: J.src = a.in[12] + (size_t)l * 256 * 768; J.ldw = 768; J.Ksrc = 256; J.Kpad = 256; J.Nphys = 768; J.nlog = 768; J.dst = (bf16*)(lb + L_WUQ); J.ksc = a.in[11] + l * 256; break;
        case 2: J.src = a.in[14] + (size_t)l * 128 * 1024; J.ldw = 1024; J.Ksrc = 128; J.Kpad = 128; J.Nphys = 1024; J.nlog = 1024; J.map = 3; J.dst = (bf16*)(lb + L_WUKV); J.ksc = a.in[13] + l * 128; break;
        case 3: J.src = a.in[22] + (size_t)l * 1024 * 1024; J.ldw = 1024; J.Ksrc = 1024; J.Kpad = 1024; J.Nphys = 1024; J.nlog = 1024; J.dst = (bf16*)(lb + L_WOUT); J.ksc = a.in[19] + l * 256; J.kscb = a.in[20] + l * 256; J.kscc = a.in[21] + l * 512; break;
        case 4: J.src = a.in[25] + (size_t)l * 1024 * 512; J.ldw = 512; J.Ksrc = 1024; J.Kpad = 1024; J.Nphys = 512; J.nlog = 512; J.dst = (bf16*)(lb + L_WMQ); J.ksc = a.in[23] + l * 1024; break;
        case 5: J.src = a.in[26] + (size_t)l * 1024 * 1024; J.ldw = 1024; J.Ksrc = 1024; J.Kpad = 1024; J.Nphys = 1024; J.nlog = 1024; J.dst = (bf16*)(lb + L_WMKV); break;
        default: J.src = a.in[29] + (size_t)l * 512 * 1024; J.ldw = 1024; J.Ksrc = 512; J.Kpad = 512; J.Nphys = 1024; J.nlog = 1024; J.dst = (bf16*)(lb + L_WMO); break;
        }
    } else if (j == 14) { J.src = a.in[31]; J.src2 = a.in[32]; J.ldw = DFF; J.Ksrc = 1024; J.Kpad = 1024; J.Nphys = 2 * DFFP; J.map = 2; J.nlog = DFF; J.dst = (bf16*)(wb + W_FGU); J.ksc = a.in[30]; }
    else if (j == 15) { J.src = a.in[33]; J.ldw = 1024; J.Ksrc = DFF; J.Kpad = DFFP; J.Nphys = 1024; J.nlog = 1024; J.dst = (bf16*)(wb + W_FD); }
    else if (j < 24) { const int e = j - 16; J.src = a.in[36] + (size_t)e * 1024 * DFE; J.src2 = a.in[37] + (size_t)e * 1024 * DFE; J.ldw = DFE; J.Ksrc = 1024; J.Kpad = 1024; J.Nphys = 2 * DFE; J.map = 2; J.nlog = DFE; J.dst = (bf16*)(wb + W_MGU + (size_t)e * MGU_STRIDE); J.ksc = a.in[30] + 1024; }
    else { const int e = j - 24; J.src = a.in[38] + (size_t)e * DFE * 1024; J.ldw = 1024; J.Ksrc = DFE; J.Kpad = DFE; J.Nphys = 1024; J.nlog = 1024; J.dst = (bf16*)(wb + W_MD + (size_t)e * MD_STRIDE); }
    return J;
}
__device__ __forceinline__ int job_items(const Job& J) { return (J.Kpad / 32) * (J.Nphys / 64); }
__device__ __forceinline__ void transpose_item(const Job& J, int item, LAS float* scr, int lane) {
    const int nblk = J.Nphys / 64, kb = item / nblk, nb = item % nblk, k0 = 32 * kb, n0 = 64 * nb;
    const int p = n0 + 4 * (lane & 15); int col = -1; const float* src = J.src;
    if (J.map == 0) col = p < J.nlog ? p : -1;
    else if (J.map == 1) col = p < 768 ? p : (p < 1696 ? p + 4 : (p < 1700 ? 768 + (p - 1696) : -1));
    else if (J.map == 3 || J.map == 4) { col = (p & ~255) + 64 * ((p >> 5) & 3) + 32 * ((p >> 7) & 1) + (p & 31); if (J.map == 4) col = col < 768 ? col : (col < 1696 ? col + 4 : (col < 1700 ? 768 + (col - 1696) : -1)); }
    else { const int jt = p >> 8, w = p & 255; col = 128 * jt + (w & 127); if (w >> 7) src = J.src2; if (col >= J.nlog) col = -1; }
    float4 v[8];
#pragma unroll
    for (int i = 0; i < 8; ++i) { const int kk = 4 * i + (lane >> 4); v[i] = make_float4(0.f, 0.f, 0.f, 0.f);
        if (col >= 0 && k0 + kk < J.Ksrc) { v[i] = *(const float4*)(src + (size_t)(k0 + kk) * J.ldw + col); if (J.ksc) { const int kr = k0 + kk; const float s = !J.kscb ? J.ksc[kr] : (kr < 256 ? J.ksc[kr] : (kr < 512 ? J.kscb[kr - 256] : J.kscc[kr - 512])); v[i].x *= s; v[i].y *= s; v[i].z *= s; v[i].w *= s; } } }
#pragma unroll
    for (int i = 0; i < 8; ++i) { const int kk = 4 * i + (lane >> 4); LAS float* d = scr + kk * 65 + 4 * (lane & 15); d[0] = v[i].x; d[1] = v[i].y; d[2] = v[i].z; d[3] = v[i].w; }
    asm volatile("s_waitcnt lgkmcnt(0)" ::: "memory");
    const int c = lane & 3;
#pragma unroll
    for (int j = 0; j < 4; ++j) { const int n = (lane >> 2) + 16 * j; const LAS float* s = scr + (8 * c) * 65 + n;
        uint4 o; o.x = pack2(s[0 * 65], s[1 * 65]); o.y = pack2(s[2 * 65], s[3 * 65]); o.z = pack2(s[4 * 65], s[5 * 65]); o.w = pack2(s[6 * 65], s[7 * 65]);
        *(uint4*)(J.dst + (size_t)(n0 + n) * J.Kpad + k0 + 8 * c) = o; }
    asm volatile("s_waitcnt lgkmcnt(0)" ::: "memory");
}

enum { GP_PRO = 0, GP_KVM = 1, GP_L0 = 2, GP_LSTRIDE = 20, GP_END = 42 };
enum { LP_N1 = 0, LP_G1, LP_POSTPROJ, LP_UP, LP_POSTUP, LP_ATTN, LP_MIXNORM, LP_G4, LP_N2, LP_G5, LP_MEMNQ, LP_ATTM, LP_G7, LP_N3, LP_F1, LP_F2, LP_F3, LP_F4 };

typedef pg8::DenseOrder ChainOrder;
struct MArgs { const float* in[39]; float* out; unsigned char* ws; int ph_lo, ph_hi, li, pad; };
typedef const __attribute__((address_space(4))) MArgs* KArgP;
#define PHASE_ENV() KArgP kp_ = kp; asm volatile("" : "+s"(kp_)); const int lane = hw_lane(), wave = wave_s, tid = wave_s * 64 + lane; int l_ = l; asm volatile("" : "+s"(l_)); int cg = cg_g; asm volatile("" : "+s"(cg)); (void)cg; \
    const int gw = bx * NWAVES + wave, ngw = G * NWAVES; (void)lane; (void)gw; (void)ngw; (void)tid; \
    Args a; _Pragma("unroll") for (int i_ = 0; i_ < 39; ++i_) a.in[i_] = kp_->in[i_]; a.out = kp_->out; a.ws = kp_->ws; a.l = 0; a.phase = 0; \
    const Ctx c = make_ctx(a, l_); unsigned char* wb = a.ws + WS_WB; unsigned char* lb = wb + (size_t)l_ * LW_STRIDE; (void)lb; (void)c; \
    bf16* HMP = (bf16*)(a.ws + WS_HMP); bf16* KVM2 = (bf16*)(a.ws + WS_KVM); bf16* KVMl = KVM2 + (size_t)l_ * 4096 * 1024; (void)HMP; (void)KVMl; \
      \
    const int rbase_x = xl_ok ? hw_xcc * (MTOK / 8) : 0, nrows_x = xl_ok ? MTOK / 8 : MTOK, gw_x = xl_ok ? hw_rank * NWAVES + wave : gw, ngw_x = xl_ok ? 32 * NWAVES : ngw; (void)rbase_x; (void)nrows_x; (void)gw_x; (void)ngw_x;
__global__ void __launch_bounds__(NWAVES * 64, 2) mega(MArgs margs) {
    extern __shared__ __attribute__((aligned(16))) unsigned char lds_raw[];
    LAS unsigned char* lds = (LAS unsigned char*)lds_raw;
    volatile LAS unsigned* MISC = (volatile LAS unsigned*)(lds + MISC_OFF);
    const int G = gridDim.x, bx = blockIdx.x;
    for (int u = threadIdx.x; u < (LDS_BYTES - LDSCTL_OFF) / 4; u += NWAVES * 64) ((LAS unsigned*)(lds + LDSCTL_OFF))[u] = 0u;
    __syncthreads();
    const KArgP kp = (KArgP)__builtin_amdgcn_kernarg_segment_ptr();
    const int wave_s = __builtin_amdgcn_readfirstlane(threadIdx.x >> 6);
    const XcdBarrier bar = xcd_barrier_post((unsigned*)(margs.ws + WS_CTL) + CW_BAR + margs.li * XCD_BAR_WORDS, MISC + 8);
    const int lo = margs.ph_lo, hi = margs.ph_hi;
    __syncthreads();
    const int hw_rank = __builtin_amdgcn_readfirstlane((int)MISC[10]), hw_xcc = __builtin_amdgcn_readfirstlane((int)MISC[11]);
    int xl_ok = 0;
    int cg_g = bx;
    int vcu_g = (G % 8 == 0) ? (bx % 8) * (G / 8) + bx / 8 : bx;
#define TS_WORD 16384
#define SPLIT_WORD 12288
#ifndef SPLITB
#define SPLITB 1
#endif
#define STAMP() do { if (TPA >= 0 || TPB >= 0) { if (bx == 0 && wave_s == 0 && hw_lane() == 0) ((unsigned long long*)((unsigned*)(margs.ws + WS_CTL) + TS_WORD))[n_stamp] = __builtin_amdgcn_s_memrealtime(); ++n_stamp; } } while (0)
    int n_stamp = 0; STAMP();
#define IN(k) (lo <= (k) && (k) < hi)
#define SEAM(k) do { if (IN(k) && IN((k) + 1)) { xcd_barrier(bar, wave_s * 64 + hw_lane()); STAMP(); } } while (0)
#define LSEAM(k) do { if (CHAIN && xl_ok) { if (IN(k) && IN((k) + 1)) xcc_local_barrier((unsigned*)(margs.ws + WS_CTL), bar.bar, (unsigned)hw_xcc, 32u, wave_s * 64 + hw_lane()); } else SEAM(k); } while (0)
    { const int l = 0;
    for (int pr_ = 0; pr_ < (PRB == 5 ? 2 : 1); ++pr_) {
    for (int rp_ = 0; rp_ < REP_PRO; ++rp_) if (IN(GP_PRO)) { PHASE_ENV();
        LAS float* scr = (LAS float*)(lds + wave * 16384);
        int base = 0;
        const int njobs = (G > 128) ? 24 : 32;
        for (int j = 0; j < njobs; ++j) { const Job J = get_job(a, j); const int n = job_items(J);
            int first = gw - (base % ngw); if (first < 0) first += ngw;
            for (int it = first; it < n; it += ngw) transpose_item(J, it, scr, lane);
            base += n; }
        { bf16* wsg = (bf16*)(wb + W_SGU); for (int i = gw * 64 + lane; i < 2 * 65536; i += ngw * 64) wsg[i] = f2bf(a.in[9][i]); }
        if (G <= 128) { float2* rt = (float2*)(a.ws + WS_ROPE); const int* posi = (const int*)a.in[2];
          for (int e = gw * 64 + lane; e < MTOK * 16; e += ngw * 64) { const float ang = (float)posi[e >> 4] * rope_inv(e & 15); rt[e] = make_float2(cosf(ang), sinf(ang)); } }
        pass_xb(a.in[0], (bf16*)(a.ws + WS_H), c.PART, MTOK, gw, ngw, lane);
        for (int l2 = 0; l2 < 2; ++l2) pass_norm(a.in[1], a.in[24] + l2 * 1024, HMP + (size_t)l2 * 4096 * 1024, BATCH * MEML, gw, ngw, lane);
    }
    SEAM(GP_PRO);
    if (IN(GP_PRO) && IN(GP_PRO + 1) && G % 8 == 0) {
        bool ok = true; for (int j = 0; j < 8; ++j) ok = ok && (xb_ld(&bar.bar[XB_XCNT(j)]) == (unsigned)(G / 8));
        const int okk = __builtin_amdgcn_readfirstlane((int)(ok && hw_xcc < 8 && hw_rank < G / 8));
        if (okk) { vcu_g = hw_xcc * (G / 8) + hw_rank; cg_g = hw_rank * 8 + hw_xcc; xl_ok = (G == 256); } }
    if (IN(GP_KVM)) { PHASE_ENV();
        if (G > 128 && bx >= 128) {
            LAS float* scr = (LAS float*)(lds + wave * 16384); const int gw2 = (bx - 128) * NWAVES + wave, ngw2 = (G - 128) * NWAVES; int base = 0;
            for (int j = 24; j < 32; ++j) { const Job J = get_job(a, j); const int n = job_items(J);
                int first = gw2 - (base % ngw2); if (first < 0) first += ngw2;
                for (int it = first; it < n; it += ngw2) transpose_item(J, it, scr, lane);
                base += n; }
            float2* rt = (float2*)(a.ws + WS_ROPE); const int* posi = (const int*)a.in[2];
            for (int e = gw2 * 64 + lane; e < MTOK * 16; e += ngw2 * 64) { const float ang = (float)posi[e >> 4] * rope_inv(e & 15); rt[e] = make_float2(cosf(ang), sinf(ang)); }
        }
        pg8::KvmOrder S; S.c = bx; S.A = (const char*)HMP; S.B = (const char*)(wb + L_WMKV); S.bstride = LW_STRIDE;
        pg8::EpiStore E{KVM2, 1024};
        pg8::gemm_phase<pg8::EpiStore, pg8::KvmOrder, false, true>(lds, 1024, 1024, S, E, tid);
    }
    SEAM(GP_KVM);
    }
    if (PRB == 5) for (int i_ = 0; i_ < 20; ++i_) xcd_barrier(bar, wave_s * 64 + hw_lane());
    }
    for (int l = 0; l < 2; ++l) {
        const int B = GP_L0 + GP_LSTRIDE * l;
        for (int pr_ = 0; pr_ < (PRB == 1 ? 2 : 1); ++pr_) {
        for (int rep_ = 0; rep_ < REP_G1; ++rep_) if (IN(B + LP_G1)) { PHASE_ENV(); pg8::DenseOrder S; S.init(MTOK / 256, PNC / 256, G, cg, c.H, 1024, lb + L_WIN, 1024); pg8::EpiProj E{c.PROJ, c.PART, c.aq, c.ak, c.bv, c.krg, c.b_forget, c.ROPET, c.FLOG, c.PQ, c.PKV};
            pg8::gemm_phase<pg8::EpiProj, pg8::DenseOrder, true, true>(lds, 1024, 1024, S, E, tid); }
        LSEAM(B + LP_G1);
        }
        for (int pr_ = 0; pr_ < ((PRB == 1 || PRB == 2) ? 2 : 1); ++pr_) {
        if (IN(B + LP_UP)) {
            { PHASE_ENV(); pass_memnorm(KVMl + (size_t)(xl_ok ? hw_xcc * 2 * MEML : 0) * 1024, 1024, c.mkg, c.mqg, xl_ok ? 2 * MEML : BATCH * MEML, gw_x, ngw_x, lane); }
            { PHASE_ENV(); if (xl_ok) { if (hw_rank < 2) cumsum_batch(c, 2 * hw_xcc + hw_rank, (LAS float*)lds, tid); } else for (int b = bx; b < BATCH; b += G) cumsum_batch(c, b, (LAS float*)lds, tid); }
            { PHASE_ENV(); pg8::DenseOrder S; S.init(MTOK / 256, 3, G, cg, c.PROJ + C_CQ, PW, lb + L_WUQ, 256); pg8::EpiStoreQ E{c.QC, 768, c.PQ};
              pg8::gemm_phase<pg8::EpiStoreQ, pg8::DenseOrder, true, true>(lds, 256, PW, S, E, tid); }
            { PHASE_ENV(); pg8::DenseOrder S; S.init(MTOK / 256, 4, G, cg, c.PROJ + C_CKV, PW, lb + L_WUKV, 128); pg8::EpiKV E{c.KVC, c.kng, c.PKV};
              pg8::gemm_phase<pg8::EpiKV, pg8::DenseOrder, true, true>(lds, 128, PW, S, E, tid); }
        }
        LSEAM(B + LP_UP);
        if (PRB == 2 && pr_ == 0) continue;
        }
        for (int pr_ = 0; pr_ < (PRB == 1 ? 2 : 1); ++pr_) {
        for (int rep_ = 0; rep_ < REP_ATTN; ++rep_) {
          for (int r2_ = 0; r2_ < REP_FOX; ++r2_) if (IN(B + LP_ATTN) && BUILD_STEP >= 2) { PHASE_ENV(); const int vcu = vcu_g;
            const float Bf = 64.f * 0.125f * 1.4426950408889634f * wmaxabs(c.aq, 64, lane) * wmaxabs(c.ak, 64, lane);
            float msf, skf; { const float a_ = fmaxf(Bf - 32.f, 0.f), b_ = 2.f * Bf + 80.f; int as_, bs_; asm volatile("v_readfirstlane_b32 %0, %2\n\tv_readfirstlane_b32 %1, %3" : "=&s"(as_), "=&s"(bs_) : "v"(a_), "v"(b_)); msf = __int_as_float(as_); skf = __int_as_float(bs_); }
            for (int U = vcu; U < 1024; U += G) { const int i = U >> 8, v = U & 255, xq = v >> 5, j = v & 31, h = i, b = 2 * xq + ((i + (j >> 4)) & 1), uu = (i & 2) ? (((j & 15) + 8) & 15) : (j & 15), qb = (i & 1) ? 15 - uu : uu;
                const size_t rb = (size_t)b * SEQ, rw = rb + qb * 256 + 32 * wave;
                if (REP_FOX > 1 && r2_ == 0) att::attn_unit<64, 64, 0, PROBE_MODE>(lds, c.PROJ + rw * PW + C_QA + h * 64, PW, 1.0f, c.PROJ + rb * PW + C_KA + h * 64, PW, c.CUMX + ((size_t)(b * 4 + h) * SEQ) * 8, 0, c.PROJ + rb * PW + C_VA + h * 64, PW,
                                          c.OMIX + rw * 1024 + h * 64, 1024, qb * 256, 4 * qb + 4, tid, c.CUM + rw * 4 + h);
                else tfx::attn_unit<8, 0>(b, qb, (const tfx::bf16*)(c.PROJ + C_QA + h * 64), (const tfx::bf16*)(c.PROJ + C_KA + h * 64), (const tfx::bf16*)(c.PROJ + C_VA + h * 64), nullptr, (tfx::bf16*)(c.OMIX + h * 64), (char*)lds_raw, c.CUM + rb * 4 + h, tid, nullptr, nullptr, nullptr, c.PBR + h, msf, skf); }
          }
          for (int r2_ = 0; r2_ < REP_MLA; ++r2_) if (IN(B + LP_ATTN) && BUILD_STEP >= 2) { PHASE_ENV(); const int vcu = vcu_g;
            const float msm = fmaxf(0.10206207261596575f * 1.4426950408889634f * (64.f * wmaxabs(c.qng, 64, lane) * wmaxabs(c.kng, 64, lane) + 32.f * wmaxabs(c.qrg, 32, lane) * wmaxabs(c.krg, 32, lane)) - 32.f, 0.f);
            for (int U = vcu; U < 2048; U += G) { const int i = U >> 8, v = U & 255, xq = v >> 5, j = v & 31, bh = 16 * xq + 2 * i + (j >> 4), qb = (i & 1) ? 15 - (j & 15) : (j & 15), b = bh >> 3, h = bh & 7;
                const size_t rb = (size_t)b * SEQ, rw = rb + qb * 256 + 32 * wave;
                tfx::attn_unit<8, 1>(b, qb, (const tfx::bf16*)(c.QC + h * 96), (const tfx::bf16*)(c.KVC + h * 128), (const tfx::bf16*)(c.KVC + h * 128 + 64), (const tfx::bf16*)(c.PROJ + C_KR), (tfx::bf16*)(c.OMIX + 512 + h * 64), (char*)lds_raw, nullptr, tid, c.qng, c.qrg, (const float*)c.ROPET, c.PBR + 8 + h, msm); }
          }
          for (int r2_ = 0; r2_ < REP_SGU; ++r2_) if (IN(B + LP_ATTN) && BUILD_STEP >= 2) { PHASE_ENV(); const int vcu = vcu_g;
            for (int U = vcu; U < 2048; U += 2 * G) { const int Ua = xl_ok ? (256 * hw_xcc + hw_rank + 32 * (U / G)) : U, Ub = xl_ok ? Ua + 32 : U + G;
                if (U + G < 2048 && ((Ua ^ Ub) & 3) == 0) { const int wn[2] = {Ua >> 2, Ub >> 2}, gn[2] = {Ua & 3, Ub & 3}; att::sgu_units<2>(lds, c.PROJ, (const bf16*)(wb + W_SGU) + (size_t)l_ * 65536, c.bsb, c.OMIX, c.PBR, wn, gn, tid); }
                else for (int k = 0; k < 2; ++k) if (U + k * G < 2048) { const int Uk = k ? Ub : Ua; const int wn[1] = {Uk >> 2}, gn[1] = {Uk & 3}; att::sgu_units<1>(lds, c.PROJ, (const bf16*)(wb + W_SGU) + (size_t)l_ * 65536, c.bsb, c.OMIX, c.PBR, wn, gn, tid); } }
          }
        }
        LSEAM(B + LP_ATTN);
        }
        if (PRB == 3 && IN(B + LP_G4)) { PHASE_ENV(); pg8::DenseOrder S; S.init(MTOK / 256, 4, G, cg, c.OMIX, 1024, lb + L_WOUT, 1024); pg8::EpiStore E{c.KVC, 1024};
            pg8::gemm_phase<pg8::EpiStore, pg8::DenseOrder, true, true>(lds, 1024, 1024, S, E, tid); xcd_barrier(bar, wave_s * 64 + hw_lane()); }
        if (IN(B + LP_G4)) { PHASE_ENV(); ChainOrder S; S.init(MTOK / 256, 4, G, cg, c.OMIX, 1024, lb + L_WOUT, 1024); pg8::EpiResMix E{{c.H, c.PART}, c.PBR};
            pg8::gemm_phase<pg8::EpiResMix, ChainOrder, true, true>(lds, 1024, 1024, S, E, tid); }
        LSEAM(B + LP_G4);
        for (int pr_ = 0; pr_ < ((PRB == 1 || PRB == 2) ? 2 : 1); ++pr_) {
        if (IN(B + LP_G5)) { PHASE_ENV(); ChainOrder S; S.init(MTOK / 256, 2, G, cg, c.H, 1024, lb + L_WMQ, 1024); pg8::EpiStoreN E{c.QM, 768, c.PART};
            pg8::gemm_phase<pg8::EpiStoreN, ChainOrder, true, true>(lds, 1024, 1024, S, E, tid); }
        LSEAM(B + LP_G5);
        }
        for (int rep_ = 0; rep_ < REP_ATTM; ++rep_) if (IN(B + LP_ATTM) && BUILD_STEP >= 2) { PHASE_ENV(); const int vcu = vcu_g;
            for (int U = vcu; U < 1024; U += G) { const int Uc = (CHAIN && xl_ok) ? (128 * hw_xcc + hw_rank + 32 * (U / G)) : U;
                const int qblk = Uc >> 2, h = Uc & 3; const size_t rw = (size_t)qblk * 256 + 32 * wave; const int b = (qblk * 256) / SEQ; const bf16* kvb = KVMl + (size_t)b * MEML * 1024 + h * 128;
                att::attn_unit<128, 128, 2>(lds, c.QM + rw * 768 + h * 128, 768, 0.08838834764831845f * 1.4426950408889634f, kvb, 1024, nullptr, 0, kvb + 512, 1024, c.OM + rw * 1024 + h * 128, 1024, 0, 4, tid); }
        }
        LSEAM(B + LP_ATTM);
        if (PRB == 3 && IN(B + LP_G7)) { PHASE_ENV(); pg8::DenseOrder S; S.init(MTOK / 256, 4, G, cg, c.OM, 512, lb + L_WMO, 512); pg8::EpiStore E{c.OMIX, 1024};
            pg8::gemm_phase<pg8::EpiStore, pg8::DenseOrder, true, true>(lds, 512, 512, S, E, tid); xcd_barrier(bar, wave_s * 64 + hw_lane()); }
        if (IN(B + LP_G7)) { PHASE_ENV(); ChainOrder S; S.init(MTOK / 256, 4, G, cg, c.OM, 1024, lb + L_WMO, 512); pg8::EpiRes E{c.H, c.PART};
            pg8::gemm_phase<pg8::EpiRes, ChainOrder, true, true>(lds, 512, 1024, S, E, tid); }
        if (l == 0) LSEAM(B + LP_G7); else SEAM(B + LP_G7);
        if (l == 0) {
            for (int rep_ = 0; rep_ < REP_F1; ++rep_) if (IN(B + LP_F1)) { PHASE_ENV(); ChainOrder S; S.init(MTOK / 256, 22, G, cg, c.H, 1024, wb + W_FGU, 1024); pg8::EpiSwiglu E{c.HID, DFFP, c.PART, nullptr};
                pg8::gemm_phase<pg8::EpiSwiglu, ChainOrder, true, true>(lds, 1024, 1024, S, E, tid); }
            LSEAM(B + LP_F1);
            if (PRB == 3 && IN(B + LP_F2)) { PHASE_ENV(); pg8::DenseOrder S; S.init(MTOK / 256, 4, G, cg, c.HID, DFFP, wb + W_FD, DFFP); pg8::EpiStore E{c.OMIX, 1024};
                pg8::gemm_phase<pg8::EpiStore, pg8::DenseOrder, true, true>(lds, DFFP, DFFP, S, E, tid); xcd_barrier(bar, wave_s * 64 + hw_lane()); }
            if (IN(B + LP_F2)) { PHASE_ENV(); ChainOrder S; S.init(MTOK / 256, 4, G, cg, c.HID, DFFP, wb + W_FD, DFFP); pg8::EpiRes E{c.H, c.PART};
                pg8::gemm_phase<pg8::EpiRes, ChainOrder, true, true>(lds, DFFP, DFFP, S, E, tid); }
            if (IN(B + LP_F2) && IN(B + GP_LSTRIDE)) { if (CHAIN && xl_ok) xcc_local_barrier((unsigned*)(margs.ws + WS_CTL), bar.bar, (unsigned)hw_xcc, 32u, wave_s * 64 + hw_lane()); else { xcd_barrier(bar, wave_s * 64 + hw_lane()); STAMP(); } }
        } else {
            for (int pr_ = 0; pr_ < (PRB == 4 ? 2 : 1); ++pr_) {
            if (IN(B + LP_N3)) { PHASE_ENV(); for (int ch = bx; ch < 256; ch += G) route1_chunk(c, ch, (LAS int*)lds, tid); }
            SEAM(B + LP_N3);
            if (IN(B + LP_F1)) { PHASE_ENV(); for (int ch = bx; ch < 256; ch += G) route2_chunk(c, ch, (LAS int*)lds, tid); }
            SEAM(B + LP_F1);
            if (IN(B + LP_F2)) { PHASE_ENV(); const int nt = c.TAB[1000]; pg8::EpiSwiglu E{c.HIDM, DFE, nullptr, c.SLOT_R};
#if GATHER_A
                pg8::GatherOrder S; S.init(nt, 11, G, cg, c.H, 1024, wb + W_MGU, 1024); S.tab = c.TAB; S.estride = MGU_STRIDE; S.tok = c.SLOT_TOK; pg8::gemm_phase<pg8::EpiSwiglu, pg8::GatherOrder, true, true>(lds, 1024, 1024, S, E, tid);
#else
                pg8::GroupOrder S; S.init(nt, 11, G, cg, c.HS, 1024, wb + W_MGU, 1024); S.tab = c.TAB; S.estride = MGU_STRIDE; pg8::gemm_phase<pg8::EpiSwiglu, pg8::GroupOrder, true, true>(lds, 1024, 1024, S, E, tid);
#endif
            }
            SEAM(B + LP_F2);
            }
            if (PRB == 3 && IN(B + LP_F3)) { PHASE_ENV(); const int nt = c.TAB[1000]; pg8::GroupOrder S; S.init(nt, 4, G, cg, c.HIDM, DFE, wb + W_MD, DFE); S.tab = c.TAB; S.estride = MD_STRIDE; pg8::EpiStore E{c.HS, 1024};
                pg8::gemm_phase<pg8::EpiStore, pg8::GroupOrder, true, true>(lds, DFE, DFE, S, E, tid); xcd_barrier(bar, wave_s * 64 + hw_lane()); }
            if (IN(B + LP_F3)) { PHASE_ENV(); const int t0 = c.TAB[1001]; pg8::GroupOrder S; S.init(t0, 4, G, cg, c.HIDM, DFE, wb + W_MD, DFE); S.tab = c.TAB; S.estride = MD_STRIDE; pg8::EpiScatter<false> E{c.H, c.X, c.SLOT_TOK, c.SLOT_GATE, nullptr, 0u};
                pg8::gemm_phase<pg8::EpiScatter<false>, pg8::GroupOrder, true, true>(lds, DFE, DFE, S, E, tid); }
            if (SPLITB) { if (IN(B + LP_F3) && IN(B + LP_F4)) { asm volatile("s_waitcnt vmcnt(0)" ::: "memory"); __syncthreads();
                if (wave_s * 64 + hw_lane() == 0) xb_add((unsigned*)(margs.ws + WS_CTL) + SPLIT_WORD, 1u); } }
            else SEAM(B + LP_F3);
            if (IN(B + LP_F4)) { PHASE_ENV(); const int nt = c.TAB[1000], t0 = c.TAB[1001]; pg8::GroupOrder S; S.init(nt - t0, 4, G, SPLITB ? G - 1 - cg : cg, c.HIDM, DFE, wb + W_MD, DFE); S.pm0 = t0; S.tab = c.TAB; S.estride = MD_STRIDE;
                pg8::EpiScatter<true> E{c.H, c.X, c.SLOT_TOK, c.SLOT_GATE, (SPLITB && IN(B + LP_F3)) ? (unsigned*)(margs.ws + WS_CTL) + SPLIT_WORD : nullptr, (unsigned)G};
                pg8::gemm_phase<pg8::EpiScatter<true>, pg8::GroupOrder, true, true>(lds, DFE, DFE, S, E, tid); }
        }
    }
    if (TPA >= 0 || TPB >= 0) { xcd_barrier(bar, wave_s * 64 + hw_lane()); STAMP();
        if (bx == 0) { const unsigned long long* TS = (const unsigned long long*)((unsigned*)(margs.ws + WS_CTL) + TS_WORD); const int tid_ = wave_s * 64 + hw_lane();
            const float usA = (TPA >= 0) ? (float)(__hip_atomic_load(TS + TPA + 1, __ATOMIC_RELAXED, __HIP_MEMORY_SCOPE_AGENT) - __hip_atomic_load(TS + TPA, __ATOMIC_RELAXED, __HIP_MEMORY_SCOPE_AGENT)) * 0.01f : 0.f;
            const float usB = (TPB >= 0) ? (float)(__hip_atomic_load(TS + TPB + 1, __ATOMIC_RELAXED, __HIP_MEMORY_SCOPE_AGENT) - __hip_atomic_load(TS + TPB, __ATOMIC_RELAXED, __HIP_MEMORY_SCOPE_AGENT)) * 0.01f : 0.f;
            if (TPA >= 0 && tid_ == 0) margs.out[0] += usA;
            if (TPB >= 0) { const int M = (int)(usB * 1000.f); for (int i = tid_; i < M; i += 512) margs.out[1024 + i] += 8.0f; } } }
#undef IN
#undef SEAM
#undef LSEAM
}

extern "C" void kernel_launch(void* const* d_in, const int* in_sizes, int n_in, void* d_out, int out_size, void* d_ws, size_t ws_size, hipStream_t stream) {
    static int grid = 0;
    if (grid == 0) {
        if (n_in != 39 || out_size != MTOK * DM || ws_size < WS_END) { fprintf(stderr, "kernel_launch: unexpected problem (n_in %d out %d ws %zu)\n", n_in, out_size, ws_size); grid = -1; return; }
        int dev = 0, cus = 0, per_cu = 0;
        if (hipGetDevice(&dev) != hipSuccess || hipDeviceGetAttribute(&cus, hipDeviceAttributeMultiprocessorCount, dev) != hipSuccess) { grid = -1; return; }
        if (hipFuncSetAttribute((const void*)mega, hipFuncAttributeMaxDynamicSharedMemorySize, LDS_BYTES) != hipSuccess) { fprintf(stderr, "kernel_launch: hipFuncSetAttribute failed\n"); grid = -1; return; }
        if (hipOccupancyMaxActiveBlocksPerMultiprocessor(&per_cu, (const void*)mega, NWAVES * 64, LDS_BYTES) != hipSuccess || per_cu < 1) fprintf(stderr, "kernel_launch: occupancy query says %d\n", per_cu);
        (void)hipGetLastError();
        grid = cus;
    }
    if (grid < 0) return;
    hipMemsetAsync((char*)d_ws + WS_CTL, 0, 1 * MiB, stream);
    Args a{}; for (int i = 0; i < 39; ++i) a.in[i] = (const float*)d_in[i]; a.out = (float*)d_out; a.ws = (unsigned char*)d_ws;
    MArgs m{}; for (int i = 0; i < 39; ++i) m.in[i] = (const float*)d_in[i]; m.out = (float*)d_out; m.ws = (unsigned char*)d_ws;
    int li = 0;
#define MEGA(lo_, hi_) do { m.ph_lo = (lo_); m.ph_hi = (hi_); m.li = li++; hipLaunchKernelGGL(mega, dim3(grid), dim3(NWAVES * 64), LDS_BYTES, stream, m); } while (0)
#if BUILD_STEP >= 2
    MEGA(GP_PRO, GP_END);
}
#else
    const int B0 = GP_L0, B1 = GP_L0 + GP_LSTRIDE;
    int cur = GP_PRO;
    for (int l = 0; l < 2; ++l) {
        a.l = l; const Ctx c = make_ctx(a, l); const int B = l ? B1 : B0;
        MEGA(cur, B + LP_ATTN);
        hipLaunchKernelGGL((nv_attn<64, 64, 0>), dim3(MTOK / 64, 4, 1), dim3(64), 0, stream, c.PROJ + C_QA, PW, 64, c.PROJ + C_KA, PW, 64, nullptr, 0, c.PROJ + C_VA, PW, 64, c.OMIX, 1024, 64, c.CUM, 0.125f);
        hipLaunchKernelGGL(nv_sgu, dim3(MTOK / 128, 4), dim3(256), 0, stream, c.PROJ, c.bsw, c.bsb, c.OMIX);
        hipLaunchKernelGGL((nv_attn<96, 64, 1>), dim3(MTOK / 64, 8, 1), dim3(64), 0, stream, c.QC, 768, 96, c.KVC, 1024, 128, c.PROJ + C_KR, PW, c.KVC + 64, 1024, 128, c.OMIX + 512, 1024, 64, nullptr, 0.10206207261596575f);
        MEGA(B + LP_MIXNORM, B + LP_ATTM);
        hipLaunchKernelGGL((nv_attn<128, 128, 2>), dim3(MTOK / 64, 4, 2), dim3(64), 0, stream, c.QM, 512, 128, c.KVM + (size_t)l * 4096 * 1024, 1024, 128, nullptr, 0, c.KVM + (size_t)l * 4096 * 1024 + 512, 1024, 128, c.OM, 512, 128, nullptr, 0.08838834764831845f);
        cur = B + LP_G7;
    }
    MEGA(cur, GP_END);
}
#endif
```

```cpp
#include <hip/hip_runtime.h>
#include <stdint.h>
#include <stdio.h>

#ifndef BUILD_STEP
#define BUILD_STEP 2
#endif
typedef unsigned short bf16;
#define LAS __attribute__((address_space(3)))
#define EPSF 1e-6f

constexpr int BATCH = 16, SEQ = 4096, DM = 1024, MTOK = BATCH * SEQ, MEML = 256;
constexpr int PNC = 1792;
constexpr int PW = 2816;
constexpr int C_QA = 0, C_KA = 256, C_VA = 512, C_UB = 768, C_VB = 1024, C_CQ = 1280, C_CKV = 1536, C_KR = 1664, C_FA = 1696;
constexpr int IN_W = 1700, DFF = 2752, DFFP = 2816, NEXP = 8, DFE = 1408;
constexpr int SLOTS = 2 * MTOK + 16 * 256;
constexpr int MAXTILES = SLOTS / 256;

constexpr size_t MiB = 1u << 20;
constexpr size_t WS_CTL = 0, WS_WB = 1 * MiB, WS_H = 128 * MiB, WS_R1 = 256 * MiB;
constexpr size_t WS_QC = 640 * MiB, WS_KVC = 736 * MiB, WS_OMIX = 864 * MiB, WS_QM = 640 * MiB, WS_OM = 704 * MiB;
constexpr size_t WS_KVM = 992 * MiB, WS_HM = 1000 * MiB, WS_FLOG = 1008 * MiB, WS_CUM = 1009 * MiB, WS_TOP = 1010 * MiB, WS_SLOT = 1012 * MiB, WS_CH = 1014 * MiB;
constexpr size_t WS_PBR = 120 * MiB;
constexpr size_t WS_PQ = 118 * MiB, WS_PKV = 119 * MiB;
constexpr size_t WS_ROPE = 110 * MiB;
constexpr size_t WS_PART = 1019 * MiB;
constexpr size_t WS_CUMX = 1015 * MiB;
constexpr size_t WS_HS = 256 * MiB, WS_HIDM = 520 * MiB, WS_END = 1023 * MiB;

__device__ __forceinline__ float bf2f(bf16 v) { return __uint_as_float(((unsigned)v) << 16); }
__device__ __forceinline__ bf16 f2bf(float f) { unsigned u = __float_as_uint(f); u += 0x7fffu + ((u >> 16) & 1u); return (bf16)(u >> 16); }
__device__ __forceinline__ unsigned pack2(float a, float b) { return (unsigned)f2bf(a) | ((unsigned)f2bf(b) << 16); }
__device__ __forceinline__ void unpack2(unsigned u, float& a, float& b) { a = __uint_as_float(u << 16); b = __uint_as_float(u & 0xffff0000u); }
__device__ __forceinline__ void ld4bf(const bf16* p, float (&f)[4]) { const uint2 u = *(const uint2*)p; unpack2(u.x, f[0], f[1]); unpack2(u.y, f[2], f[3]); }
__device__ __forceinline__ void st4bf(bf16* p, const float (&f)[4]) { uint2 u; u.x = pack2(f[0], f[1]); u.y = pack2(f[2], f[3]); *(uint2*)p = u; }
__device__ __forceinline__ void ld8bf(const bf16* p, float (&f)[8]) { const uint4 u = *(const uint4*)p; unpack2(u.x, f[0], f[1]); unpack2(u.y, f[2], f[3]); unpack2(u.z, f[4], f[5]); unpack2(u.w, f[6], f[7]); }
__device__ __forceinline__ void st8bf(bf16* p, const float (&f)[8]) { uint4 u; u.x = pack2(f[0], f[1]); u.y = pack2(f[2], f[3]); u.z = pack2(f[4], f[5]); u.w = pack2(f[6], f[7]); *(uint4*)p = u; }
__device__ __forceinline__ int hw_lane() { int l; asm volatile("v_mbcnt_lo_u32_b32 %0, -1, 0\n\tv_mbcnt_hi_u32_b32 %0, -1, %0" : "=v"(l)); return l; }
__device__ __forceinline__ float shx(float v, int lane, int o) { return __int_as_float(__builtin_amdgcn_ds_bpermute((lane ^ o) << 2, __float_as_int(v))); }
__device__ __forceinline__ float wsum(float v, int lane) {
#pragma unroll
    for (int o = 1; o < 64; o <<= 1) v += shx(v, lane, o);
    return v; }
__device__ __forceinline__ float sum16(float v, int lane) { v += shx(v, lane, 1); v += shx(v, lane, 2); v += shx(v, lane, 4); v += shx(v, lane, 8); return v; }
__device__ __forceinline__ float wmaxabs(const float* g, int n, int lane) { float v = (lane < n) ? fabsf(g[lane]) : 0.f;
#pragma unroll
    for (int o = 1; o < 64; o <<= 1) v = fmaxf(v, shx(v, lane, o));
    return __int_as_float(__builtin_amdgcn_readfirstlane(__float_as_int(v))); }
__device__ __forceinline__ float sum8(float v, int lane) { v += shx(v, lane, 1); v += shx(v, lane, 2); v += shx(v, lane, 4); return v; }
__device__ __forceinline__ float gelu_erf(float v) {
    const float av = fabsf(v), t = __builtin_amdgcn_rcpf(av * 0.2316418882f + 1.0f);
    float q = t * 0.5307027145f + (-0.7265760135f); q = q * t + 0.7107068705f; q = q * t + (-0.142248368f); q = q * t + 0.127414796f; q = q * t;
    const float e = __builtin_amdgcn_exp2f((v * v) * (-0.72134752044f)), m = v * (q * e);
    return v < 0.f ? m : v - m; }
__device__ __forceinline__ float logsigmoid(float z) { return fminf(z, 0.f) - 0.6931471805599453f * __builtin_amdgcn_logf(1.0f + __builtin_amdgcn_exp2f(-1.4426950408889634f * fabsf(z))); }
__device__ __forceinline__ float rope_inv(int i) { return exp2f(-(float)i * (13.287712379549449f / 16.0f)); }

struct Args { const float* in[39]; float* out; unsigned char* ws; int l; int phase; };
struct Ctx {
    const float* x_in; const float* mem; const int* pos;
    const float *mix_norm, *w_in, *b_forget, *aq, *ak, *bv, *bsw, *bsb, *cqg, *wuq, *ckvg, *wukv, *qng, *qrg, *kng, *krg, *ona, *onb, *onc, *wout, *xattn, *memn, *wmq, *wmkv, *mqg, *mkg, *wmo, *ffn_norm;
    const float *fg, *fu, *fd, *wr, *br, *mg, *mu, *md;
    float* X;
    bf16 *H, *PROJ, *QC, *KVC, *OMIX, *QM, *OM, *KVM, *HM, *HID, *HS, *HIDM;
    float *FLOG, *CUM, *TOPG, *SLOT_GATE, *PART, *RTOK, *SLOT_R; int *TOPI, *SLOT_TOK, *CH, *TAB; bf16* CUMX; const float2* ROPET; float *PQ, *PKV, *PBR;
};
__device__ __host__ __forceinline__ Ctx make_ctx(const Args& a, int l) {
    Ctx c;
    c.x_in = a.in[0]; c.mem = a.in[1]; c.pos = (const int*)a.in[2];
    c.mix_norm = a.in[3] + l * 1024; c.w_in = a.in[4] + (size_t)l * 1024 * IN_W; c.b_forget = a.in[5] + l * 4; c.aq = a.in[6] + l * 64; c.ak = a.in[7] + l * 64;
    c.bv = a.in[8] + l * 256; c.bsw = a.in[9] + l * 4 * 128 * 128; c.bsb = a.in[10] + l * 4 * 128; c.cqg = a.in[11] + l * 256; c.wuq = a.in[12] + (size_t)l * 256 * 768;
    c.ckvg = a.in[13] + l * 128; c.wukv = a.in[14] + (size_t)l * 128 * 1024; c.qng = a.in[15] + l * 64; c.qrg = a.in[16] + l * 32; c.kng = a.in[17] + l * 64; c.krg = a.in[18] + l * 32;
    c.ona = a.in[19] + l * 256; c.onb = a.in[20] + l * 256; c.onc = a.in[21] + l * 512; c.wout = a.in[22] + (size_t)l * 1024 * 1024; c.xattn = a.in[23] + l * 1024; c.memn = a.in[24] + l * 1024;
    c.wmq = a.in[25] + (size_t)l * 1024 * 512; c.wmkv = a.in[26] + (size_t)l * 1024 * 1024; c.mqg = a.in[27] + l * 128; c.mkg = a.in[28] + l * 128; c.wmo = a.in[29] + (size_t)l * 512 * 1024; c.ffn_norm = a.in[30] + l * 1024;
    c.fg = a.in[31]; c.fu = a.in[32]; c.fd = a.in[33]; c.wr = a.in[34]; c.br = a.in[35]; c.mg = a.in[36]; c.mu = a.in[37]; c.md = a.in[38];
    c.X = a.out;
    unsigned char* ws = a.ws;
    c.H = (bf16*)(ws + WS_H); c.PROJ = (bf16*)(ws + WS_R1); c.QC = (bf16*)(ws + WS_QC); c.KVC = (bf16*)(ws + WS_KVC); c.OMIX = (bf16*)(ws + WS_OMIX); c.QM = (bf16*)(ws + WS_QM); c.OM = (bf16*)(ws + WS_KVC);
    c.KVM = (bf16*)(ws + WS_KVM); c.HM = (bf16*)(ws + WS_HM); c.HID = (bf16*)(ws + WS_R1); c.HS = (bf16*)(ws + WS_HS); c.HIDM = (bf16*)(ws + WS_HIDM);
    c.FLOG = (float*)(ws + WS_FLOG); c.CUM = (float*)(ws + WS_CUM); c.TOPI = (int*)(ws + WS_TOP); c.TOPG = (float*)(ws + WS_TOP + MiB); c.SLOT_TOK = (int*)(ws + WS_SLOT); c.SLOT_GATE = (float*)(ws + WS_SLOT + MiB);
    c.CH = (int*)(ws + WS_CH); c.TAB = (int*)(ws + WS_CH + 65536); c.CUMX = (bf16*)(ws + WS_CUMX); c.PQ = (float*)(ws + WS_PQ); c.PKV = (float*)(ws + WS_PKV); c.PBR = (float*)(ws + WS_PBR); c.ROPET = (const float2*)(ws + WS_ROPE);        c.PART = (float*)(ws + WS_PART); c.RTOK = c.TOPG + 2 * MTOK; c.SLOT_R = (float*)(ws + WS_CH + 131072);
    return c;
}

#ifndef GATHER_A
#define GATHER_A 1
#endif
constexpr int RB = 4;
__device__ __forceinline__ void pass_norm(const float* x, const float* g, bf16* H, int nrows, int gw, int ngw, int lane) {
    float4 gg[4];
#pragma unroll
    for (int j = 0; j < 4; ++j) gg[j] = ((const float4*)g)[lane + 64 * j];
    for (int r0 = gw; r0 < nrows; r0 += ngw * RB) {
        float4 v[RB][4];
#pragma unroll
        for (int k = 0; k < RB; ++k) { const int r = r0 + k * ngw; if (r < nrows) {
#pragma unroll
            for (int j = 0; j < 4; ++j) v[k][j] = ((const float4*)(x + (size_t)r * 1024))[lane + 64 * j]; } }
#pragma unroll
        for (int k = 0; k < RB; ++k) { const int r = r0 + k * ngw; if (r < nrows) { float ss = 0.f;
#pragma unroll
            for (int j = 0; j < 4; ++j) ss += v[k][j].x * v[k][j].x + v[k][j].y * v[k][j].y + v[k][j].z * v[k][j].z + v[k][j].w * v[k][j].w;
            ss = wsum(ss, lane); const float rr = rsqrtf(ss * (1.f / 1024.f) + EPSF);
#pragma unroll
            for (int j = 0; j < 4; ++j) { float f[4] = {v[k][j].x * rr * gg[j].x, v[k][j].y * rr * gg[j].y, v[k][j].z * rr * gg[j].z, v[k][j].w * rr * gg[j].w}; st4bf(H + (size_t)r * 1024 + 4 * (lane + 64 * j), f); } } }
    }
}
__device__ __forceinline__ void pass_xb(const float* x, bf16* Xb, float* part, int nrows, int gw, int ngw, int lane) {
    for (int r0 = gw; r0 < nrows; r0 += ngw * RB) {
        float4 v[RB][4];
#pragma unroll
        for (int k = 0; k < RB; ++k) { const int r = r0 + k * ngw;
#pragma unroll
            for (int j = 0; j < 4; ++j) v[k][j] = ((const float4*)(x + (size_t)r * 1024))[lane + 64 * j]; }
#pragma unroll
        for (int k = 0; k < RB; ++k) { const int r = r0 + k * ngw; float ss = 0.f;
#pragma unroll
            for (int j = 0; j < 4; ++j) { ss += v[k][j].x * v[k][j].x + v[k][j].y * v[k][j].y + v[k][j].z * v[k][j].z + v[k][j].w * v[k][j].w; float f[4] = {v[k][j].x, v[k][j].y, v[k][j].z, v[k][j].w}; st4bf(Xb + (size_t)r * 1024 + 4 * (lane + 64 * j), f); }
            ss = wsum(ss, lane); if (lane < 16) part[(size_t)r * 16 + lane] = (lane == 0) ? ss : 0.f; }
    }
}
__device__ __forceinline__ void pass_post_proj(const Ctx& c, int rbase, int nrows, int gw, int ngw, int lane) {
    const int c4 = 4 * lane;
    float gq[4], gk[4], gv[4], gc[4], gkv[4];
#pragma unroll
    for (int i = 0; i < 4; ++i) { gq[i] = c.aq[(c4 + i) & 63] * (0.125f * 1.4426950408889634f);        gk[i] = c.ak[(c4 + i) & 63]; gv[i] = c.bv[c4 + i]; gc[i] = c.cqg[c4 + i]; gkv[i] = c.ckvg[(c4 + i) & 127]; }
    const float gr1 = c.krg[lane & 15], gr2 = c.krg[16 + (lane & 15)], bf = c.b_forget[lane & 3];
    for (int r0 = gw; r0 < nrows; r0 += ngw * RB) {
        uint2 uq[RB], uk[RB], uu[RB], uv[RB], uc[RB], ukv[RB]; bf16 x1[RB], x2[RB], fa[RB]; float2 cs2[RB];
#pragma unroll
        for (int k = 0; k < RB; ++k) { const int r = rbase + r0 + k * ngw; const bf16* p = c.PROJ + (size_t)r * PW;
            uq[k] = *(const uint2*)(p + C_QA + c4); uk[k] = *(const uint2*)(p + C_KA + c4); uu[k] = *(const uint2*)(p + C_UB + c4); uv[k] = *(const uint2*)(p + C_VB + c4); uc[k] = *(const uint2*)(p + C_CQ + c4);
            ukv[k] = *(const uint2*)(p + C_CKV + (c4 & 127)); x1[k] = p[C_KR + (lane & 15)]; x2[k] = p[C_KR + 16 + (lane & 15)]; fa[k] = p[C_FA + (lane & 3)]; cs2[k] = c.ROPET[(size_t)r * 16 + (lane & 15)]; }
#pragma unroll
        for (int k = 0; k < RB; ++k) { const int r = rbase + r0 + k * ngw; bf16* p = c.PROJ + (size_t)r * PW; float f[4];
            { unpack2(uq[k].x, f[0], f[1]); unpack2(uq[k].y, f[2], f[3]); const float rr = rsqrtf(sum16(f[0] * f[0] + f[1] * f[1] + f[2] * f[2] + f[3] * f[3], lane) * (1.f / 64.f) + EPSF);
#pragma unroll
              for (int i = 0; i < 4; ++i) f[i] *= rr * gq[i];
              st4bf(p + C_QA + c4, f); }
            { unpack2(uk[k].x, f[0], f[1]); unpack2(uk[k].y, f[2], f[3]); const float rr = rsqrtf(sum16(f[0] * f[0] + f[1] * f[1] + f[2] * f[2] + f[3] * f[3], lane) * (1.f / 64.f) + EPSF);
#pragma unroll
              for (int i = 0; i < 4; ++i) f[i] *= rr * gk[i];
              st4bf(p + C_KA + c4, f); }
            { unpack2(uu[k].x, f[0], f[1]); unpack2(uu[k].y, f[2], f[3]);
#pragma unroll
              for (int i = 0; i < 4; ++i) f[i] = gelu_erf(f[i]);
              st4bf(p + C_UB + c4, f); }
            { unpack2(uv[k].x, f[0], f[1]); unpack2(uv[k].y, f[2], f[3]);
#pragma unroll
              for (int i = 0; i < 4; ++i) f[i] = gelu_erf(f[i]);
              const float mu = sum16(f[0] + f[1] + f[2] + f[3], lane) * (1.f / 64.f); float q = 0.f;
#pragma unroll
              for (int i = 0; i < 4; ++i) { f[i] -= mu; q += f[i] * f[i]; }
              const float rr = rsqrtf(sum16(q, lane) * (1.f / 64.f) + EPSF);
#pragma unroll
              for (int i = 0; i < 4; ++i) f[i] *= rr * gv[i];
              st4bf(p + C_VB + c4, f); }
            { unpack2(uc[k].x, f[0], f[1]); unpack2(uc[k].y, f[2], f[3]); const float rr = rsqrtf(wsum(f[0] * f[0] + f[1] * f[1] + f[2] * f[2] + f[3] * f[3], lane) * (1.f / 256.f) + EPSF);
#pragma unroll
              for (int i = 0; i < 4; ++i) f[i] *= rr * gc[i];
              st4bf(p + C_CQ + c4, f); }
            { unpack2(ukv[k].x, f[0], f[1]); unpack2(ukv[k].y, f[2], f[3]); float ss = (lane < 32) ? (f[0] * f[0] + f[1] * f[1] + f[2] * f[2] + f[3] * f[3]) : 0.f; const float rr = rsqrtf(wsum(ss, lane) * (1.f / 128.f) + EPSF);
              if (lane < 32) {
#pragma unroll
                  for (int i = 0; i < 4; ++i) f[i] *= rr * gkv[i];
                  st4bf(p + C_CKV + c4, f); } }
            { float a1 = bf2f(x1[k]), a2 = bf2f(x2[k]); const float rr = rsqrtf(sum16(a1 * a1 + a2 * a2, lane) * (1.f / 32.f) + EPSF); a1 *= rr * gr1; a2 *= rr * gr2;
              const float cs = cs2[k].x, sn = cs2[k].y;
              if (lane < 16) { p[C_KR + lane] = f2bf(a1 * cs - a2 * sn); p[C_KR + 16 + lane] = f2bf(a1 * sn + a2 * cs); } }
            if (lane < 4) c.FLOG[(size_t)r * 4 + lane] = logsigmoid(bf2f(fa[k]) + bf);
        }
    }
}
__device__ __forceinline__ void pass_post_up(const Ctx& c, int rbase, int nrows, int gw, int ngw, int lane) {
    const int h = lane >> 3, j = lane & 7;
    float gn[8], gkn[8], gr[4];
#pragma unroll
    for (int i = 0; i < 8; ++i) { gn[i] = c.qng[8 * j + i] * (0.10206207261596575f * 1.4426950408889634f); gkn[i] = c.kng[8 * j + i]; }
#pragma unroll
    for (int i = 0; i < 4; ++i) { gr[i] = c.qrg[4 * j + i] * (0.10206207261596575f * 1.4426950408889634f); }
    for (int r0 = gw; r0 < nrows; r0 += ngw * RB) {
        uint4 un[RB], ukn[RB]; uint2 ur[RB]; float4 tc[RB][2];
#pragma unroll
        for (int k = 0; k < RB; ++k) { const int r = rbase + r0 + k * ngw; const bf16* q = c.QC + (size_t)r * 768 + h * 96; const bf16* kv = c.KVC + (size_t)r * 1024 + h * 128;
            un[k] = *(const uint4*)(q + 8 * j); ur[k] = *(const uint2*)(q + 64 + 4 * j); ukn[k] = *(const uint4*)(kv + 8 * j);
            const float4* tp = (const float4*)(c.ROPET + (size_t)r * 16 + 4 * (j & 3)); tc[k][0] = tp[0]; tc[k][1] = tp[1]; }
#pragma unroll
        for (int k = 0; k < RB; ++k) { const int r = rbase + r0 + k * ngw; bf16* q = c.QC + (size_t)r * 768 + h * 96; bf16* kv = c.KVC + (size_t)r * 1024 + h * 128;
            { float f[8]; unpack2(un[k].x, f[0], f[1]); unpack2(un[k].y, f[2], f[3]); unpack2(un[k].z, f[4], f[5]); unpack2(un[k].w, f[6], f[7]); float ss = 0.f;
#pragma unroll
              for (int i = 0; i < 8; ++i) ss += f[i] * f[i];
              const float rr = rsqrtf(sum8(ss, lane) * (1.f / 64.f) + EPSF);
#pragma unroll
              for (int i = 0; i < 8; ++i) f[i] *= rr * gn[i];
              st8bf(q + 8 * j, f); }
            { float f[4], o[4]; unpack2(ur[k].x, f[0], f[1]); unpack2(ur[k].y, f[2], f[3]); const float rr = rsqrtf(sum8(f[0] * f[0] + f[1] * f[1] + f[2] * f[2] + f[3] * f[3], lane) * (1.f / 32.f) + EPSF); const float csv[4] = {tc[k][0].x, tc[k][0].z, tc[k][1].x, tc[k][1].z}, snv[4] = {tc[k][0].y, tc[k][0].w, tc[k][1].y, tc[k][1].w};
#pragma unroll
              for (int i = 0; i < 4; ++i) { f[i] *= rr * gr[i]; const float other = shx(f[i], lane, 4); const float sn = snv[i], cs = csv[i]; o[i] = (j < 4) ? (f[i] * cs - other * sn) : (other * sn + f[i] * cs); }
              st4bf(q + 64 + 4 * j, o); }
            { float f[8]; unpack2(ukn[k].x, f[0], f[1]); unpack2(ukn[k].y, f[2], f[3]); unpack2(ukn[k].z, f[4], f[5]); unpack2(ukn[k].w, f[6], f[7]); float ss = 0.f;
#pragma unroll
              for (int i = 0; i < 8; ++i) ss += f[i] * f[i];
              const float rr = rsqrtf(sum8(ss, lane) * (1.f / 64.f) + EPSF);
#pragma unroll
              for (int i = 0; i < 8; ++i) f[i] *= rr * gkn[i];
              st8bf(kv + 8 * j, f); }
        }
    }
}
__device__ __forceinline__ void pass_mixnorm(const Ctx& c, int rbase, int nrows, int gw, int ngw, int lane) {
    float ga[4], gb[4], gc[8];
#pragma unroll
    for (int i = 0; i < 4; ++i) { ga[i] = c.ona[4 * lane + i]; gb[i] = c.onb[4 * lane + i]; }
#pragma unroll
    for (int i = 0; i < 8; ++i) gc[i] = c.onc[8 * lane + i];
    for (int r0 = gw; r0 < nrows; r0 += ngw * RB) {
        uint2 ua[RB], ub[RB]; uint4 uc[RB];
#pragma unroll
        for (int k = 0; k < RB; ++k) { const bf16* p = c.OMIX + (size_t)(rbase + r0 + k * ngw) * 1024; ua[k] = *(const uint2*)(p + 4 * lane); ub[k] = *(const uint2*)(p + 256 + 4 * lane); uc[k] = *(const uint4*)(p + 512 + 8 * lane); }
#pragma unroll
        for (int k = 0; k < RB; ++k) { bf16* p = c.OMIX + (size_t)(rbase + r0 + k * ngw) * 1024; float f[4];
            { unpack2(ua[k].x, f[0], f[1]); unpack2(ua[k].y, f[2], f[3]); const float rr = rsqrtf(wsum(f[0] * f[0] + f[1] * f[1] + f[2] * f[2] + f[3] * f[3], lane) * (1.f / 256.f) + EPSF);
#pragma unroll
              for (int i = 0; i < 4; ++i) f[i] *= rr * ga[i];
              st4bf(p + 4 * lane, f); }
            { unpack2(ub[k].x, f[0], f[1]); unpack2(ub[k].y, f[2], f[3]); const float rr = rsqrtf(wsum(f[0] * f[0] + f[1] * f[1] + f[2] * f[2] + f[3] * f[3], lane) * (1.f / 256.f) + EPSF);
#pragma unroll
              for (int i = 0; i < 4; ++i) f[i] *= rr * gb[i];
              st4bf(p + 256 + 4 * lane, f); }
            { float g[8]; unpack2(uc[k].x, g[0], g[1]); unpack2(uc[k].y, g[2], g[3]); unpack2(uc[k].z, g[4], g[5]); unpack2(uc[k].w, g[6], g[7]); float ss = 0.f;
#pragma unroll
              for (int i = 0; i < 8; ++i) ss += g[i] * g[i];
              const float rr = rsqrtf(wsum(ss, lane) * (1.f / 512.f) + EPSF);
#pragma unroll
              for (int i = 0; i < 8; ++i) g[i] *= rr * gc[i];
              st8bf(p + 512 + 8 * lane, g); }
        }
    }
}
__device__ __forceinline__ void pass_memnorm(bf16* buf, int ld, const float* g, const float* g2, int nrows, int gw, int ngw, int lane) {
    float gg[8];
#pragma unroll
    for (int i = 0; i < 8; ++i) gg[i] = g[(8 * lane + i) & 127] * (g2 ? g2[(8 * lane + i) & 127] : 1.f);
    for (int r0 = gw; r0 < nrows; r0 += ngw * RB) {
        uint4 u[RB];
#pragma unroll
        for (int k = 0; k < RB; ++k) { const int r = r0 + k * ngw; if (r < nrows) u[k] = *(const uint4*)(buf + (size_t)r * ld + 8 * lane); }
#pragma unroll
        for (int k = 0; k < RB; ++k) { const int r = r0 + k * ngw; if (r < nrows) { float f[8]; unpack2(u[k].x, f[0], f[1]); unpack2(u[k].y, f[2], f[3]); unpack2(u[k].z, f[4], f[5]); unpack2(u[k].w, f[6], f[7]); float ss = 0.f;
#pragma unroll
            for (int i = 0; i < 8; ++i) ss += f[i] * f[i];
            const float rr = rsqrtf(sum16(ss, lane) * (1.f / 128.f) + EPSF);
#pragma unroll
            for (int i = 0; i < 8; ++i) f[i] *= rr * gg[i];
            st8bf(buf + (size_t)r * ld + 8 * lane, f); } }
    }
}
__device__ __forceinline__ void route_rows32(const Ctx& c, int row0, int lane) {
    float wr[16][8];
#pragma unroll
    for (int h = 0; h < 2; ++h)
#pragma unroll
        for (int i = 0; i < 8; ++i) { const int k = 512 * h + 8 * lane + i; const float g = c.ffn_norm[k]; const float4* w = (const float4*)(c.wr + (size_t)k * 8); const float4 w0 = w[0], w1 = w[1];
            wr[8 * h + i][0] = w0.x * g; wr[8 * h + i][1] = w0.y * g; wr[8 * h + i][2] = w0.z * g; wr[8 * h + i][3] = w0.w * g; wr[8 * h + i][4] = w1.x * g; wr[8 * h + i][5] = w1.y * g; wr[8 * h + i][6] = w1.z * g; wr[8 * h + i][7] = w1.w * g; }
    float br[8];
#pragma unroll
    for (int e = 0; e < 8; ++e) br[e] = c.br[e];
    uint4 v[2][2], vn[2][2];
#pragma unroll
    for (int k = 0; k < 2; ++k) { const uint4* xr = (const uint4*)(c.H + (size_t)(row0 + k) * 1024); vn[k][0] = xr[lane]; vn[k][1] = xr[64 + lane]; }
    for (int rb = 0; rb < 32; rb += 2) {
#pragma unroll
        for (int k = 0; k < 2; ++k) { v[k][0] = vn[k][0]; v[k][1] = vn[k][1]; }
        if (rb + 2 < 32) {
#pragma unroll
            for (int k = 0; k < 2; ++k) { const uint4* xr = (const uint4*)(c.H + (size_t)(row0 + rb + 2 + k) * 1024); vn[k][0] = xr[lane]; vn[k][1] = xr[64 + lane]; } }
#pragma unroll
        for (int k = 0; k < 2; ++k) { const int row = row0 + rb + k; float ss = 0.f, lg[8];
#pragma unroll
            for (int e = 0; e < 8; ++e) lg[e] = 0.f;
#pragma unroll
            for (int h = 0; h < 2; ++h) { float f[8]; unpack2(v[k][h].x, f[0], f[1]); unpack2(v[k][h].y, f[2], f[3]); unpack2(v[k][h].z, f[4], f[5]); unpack2(v[k][h].w, f[6], f[7]);
#pragma unroll
                for (int i = 0; i < 8; ++i) { ss += f[i] * f[i];
#pragma unroll
                    for (int e = 0; e < 8; ++e) lg[e] += f[i] * wr[8 * h + i][e]; } }
            ss = wsum(ss, lane); const float r = rsqrtf(ss * (1.f / 1024.f) + EPSF);
#pragma unroll
            for (int e = 0; e < 8; ++e) lg[e] = wsum(lg[e], lane) * r + br[e];
            int i1 = 0; float v1 = lg[0];
#pragma unroll
            for (int e = 1; e < 8; ++e) if (lg[e] > v1) { v1 = lg[e]; i1 = e; }
            int i2 = -1; float v2 = -3.0e38f;
#pragma unroll
            for (int e = 0; e < 8; ++e) if (e != i1 && lg[e] > v2) { v2 = lg[e]; i2 = e; }
            const float e2 = expf(v2 - v1), g1 = 1.f / (1.f + e2), g2 = e2 / (1.f + e2);
            if (lane == 0) { c.TOPI[(size_t)row * 2] = i1; c.TOPI[(size_t)row * 2 + 1] = i2; c.TOPG[(size_t)row * 2] = g1; c.TOPG[(size_t)row * 2 + 1] = g2; c.RTOK[row] = r; } }
    }
}

__device__ __forceinline__ void cumsum_batch(const Ctx& c, int b, LAS float* sm  , int tid) {
    const int lane = tid & 63, wave = tid >> 6;
    const float4* src = (const float4*)c.FLOG + (size_t)b * SEQ + tid * 8; float4* dst = (float4*)c.CUM + (size_t)b * SEQ + tid * 8;
    float4 v[8];
#pragma unroll
    for (int i = 0; i < 8; ++i) v[i] = src[i];
#pragma unroll
    for (int i = 1; i < 8; ++i) { v[i].x += v[i - 1].x; v[i].y += v[i - 1].y; v[i].z += v[i - 1].z; v[i].w += v[i - 1].w; }
    const float4 tot = v[7]; float4 inc = tot;
#pragma unroll
    for (int o = 1; o < 64; o <<= 1) { const int si = ((lane - o) & 63) << 2; const float tx = __int_as_float(__builtin_amdgcn_ds_bpermute(si, __float_as_int(inc.x))), ty = __int_as_float(__builtin_amdgcn_ds_bpermute(si, __float_as_int(inc.y))), tz = __int_as_float(__builtin_amdgcn_ds_bpermute(si, __float_as_int(inc.z))), tw = __int_as_float(__builtin_amdgcn_ds_bpermute(si, __float_as_int(inc.w))); if (lane >= o) { inc.x += tx; inc.y += ty; inc.z += tz; inc.w += tw; } }
    if (lane == 63) { sm[wave * 4 + 0] = inc.x; sm[wave * 4 + 1] = inc.y; sm[wave * 4 + 2] = inc.z; sm[wave * 4 + 3] = inc.w; }
    __syncthreads();
    float4 base = {0.f, 0.f, 0.f, 0.f};
    for (int w = 0; w < wave; ++w) { base.x += sm[w * 4 + 0]; base.y += sm[w * 4 + 1]; base.z += sm[w * 4 + 2]; base.w += sm[w * 4 + 3]; }
    const float4 ex = {base.x + inc.x - tot.x, base.y + inc.y - tot.y, base.z + inc.z - tot.z, base.w + inc.w - tot.w};
#pragma unroll
    for (int i = 0; i < 8; ++i) { const float4 cv = make_float4(v[i].x + ex.x, v[i].y + ex.y, v[i].z + ex.z, v[i].w + ex.w); dst[i] = cv;
        }
    __syncthreads();
}
__device__ __forceinline__ void route1_chunk(const Ctx& c, int ch, LAS int* sm  , int tid) {
    const int lane = tid & 63, wave = tid >> 6;
    if (tid < 16) sm[tid] = 0;
    __syncthreads();
    route_rows32(c, ch * 256 + wave * 32, lane);
    __syncthreads();
    if (tid < 256) { const int row = ch * 256 + tid; const int e1 = __hip_atomic_load(c.TOPI + (size_t)row * 2, __ATOMIC_RELAXED, __HIP_MEMORY_SCOPE_AGENT), e2 = __hip_atomic_load(c.TOPI + (size_t)row * 2 + 1, __ATOMIC_RELAXED, __HIP_MEMORY_SCOPE_AGENT);
        atomicAdd((int*)&sm[e1], 1); atomicAdd((int*)&sm[8 + e2], 1); }
    __syncthreads();
    if (tid < 16) c.CH[ch * 16 + tid] = sm[tid];
    __syncthreads();
}
__device__ __forceinline__ void route2_chunk(const Ctx& c, int ch, LAS int* sm  , int tid) {
    const int lane = tid & 63, wave = tid >> 6;
    LAS int* sCH = sm; LAS int* sTot = sm + 4096; LAS int* sPre = sm + 4096 + 16; LAS int* sOff = sm + 4096 + 32; LAS int* sWc = sm + 4096 + 64; LAS int* sSlot = sm + 4096 + 128;
    for (int i = tid; i < 4096; i += 512) sCH[i] = c.CH[i];
    __syncthreads();
    if (tid < 16) { int tot = 0, pre = 0; for (int k = 0; k < 256; ++k) { const int v = sCH[k * 16 + tid]; tot += v; if (k < ch) pre += v; } sTot[tid] = tot; sPre[tid] = pre; }
    __syncthreads();
    if (tid == 0) { int o = 0; for (int g = 0; g < 16; ++g) { sOff[g] = o; o += (sTot[g] + 255) & ~255; } sOff[16] = o; }
    __syncthreads();
    int e1 = -1, e2 = -1, r1 = 0, r2 = 0; const int row = ch * 256 + tid;
    if (tid < 256) { e1 = c.TOPI[(size_t)row * 2]; e2 = c.TOPI[(size_t)row * 2 + 1]; }
    for (int g = 0; g < 16; ++g) { const bool pred = (tid < 256) && (g < 8 ? (e1 == g) : (e2 == g - 8)); const unsigned long long m = __ballot(pred);
        const int rk = __popcll(m & ((1ull << lane) - 1ull)); if (pred) { if (g < 8) r1 = rk; else r2 = rk; }
        if (lane == 0 && wave < 4) sWc[wave * 16 + g] = __popcll(m); }
    __syncthreads();
    if (tid < 256) { int b1 = sOff[e1] + sPre[e1], b2 = sOff[8 + e2] + sPre[8 + e2]; for (int w = 0; w < wave; ++w) { b1 += sWc[w * 16 + e1]; b2 += sWc[w * 16 + 8 + e2]; }
        const int s1 = b1 + r1, s2 = b2 + r2; sSlot[tid * 2] = s1; sSlot[tid * 2 + 1] = s2;
        c.SLOT_TOK[s1] = row; c.SLOT_TOK[s2] = row; c.SLOT_GATE[s1] = c.TOPG[(size_t)row * 2]; c.SLOT_GATE[s2] = c.TOPG[(size_t)row * 2 + 1]; const float rr = c.RTOK[row]; c.SLOT_R[s1] = rr; c.SLOT_R[s2] = rr; }
    __syncthreads();
#if !GATHER_A
    for (int i = 0; i < 32; i += 2) { const int t0 = wave * 32 + i, t1 = t0 + 1;
        const uint4* s0 = (const uint4*)(c.H + (size_t)(ch * 256 + t0) * 1024); const uint4* s1 = (const uint4*)(c.H + (size_t)(ch * 256 + t1) * 1024);
        const uint4 a0 = s0[lane], b0 = s0[lane + 64], a1 = s1[lane], b1 = s1[lane + 64];
        uint4* d00 = (uint4*)(c.HS + (size_t)sSlot[t0 * 2] * 1024); uint4* d01 = (uint4*)(c.HS + (size_t)sSlot[t0 * 2 + 1] * 1024); uint4* d10 = (uint4*)(c.HS + (size_t)sSlot[t1 * 2] * 1024); uint4* d11 = (uint4*)(c.HS + (size_t)sSlot[t1 * 2 + 1] * 1024);
        d00[lane] = a0; d00[lane + 64] = b0; d01[lane] = a0; d01[lane + 64] = b0; d10[lane] = a1; d10[lane + 64] = b1; d11[lane] = a1; d11[lane + 64] = b1; }
#endif
    for (int g = 0; g < 16; ++g) { const int rem = sTot[g] & 255; if (rem && ch >= rem) { const int r = sOff[g] + (sTot[g] & ~255) + ch; if (!GATHER_A) ((unsigned*)(c.HS + (size_t)r * 1024))[tid] = 0u; if (tid == 0) { c.SLOT_TOK[r] = -1; c.SLOT_GATE[r] = 0.f; c.SLOT_R[r] = 0.f; } } }
    if (ch == 0) { const int nt = sOff[16] >> 8; for (int t = tid; t < MAXTILES + 16; t += 512) { int g = -1; if (t < nt) { for (int q = 0; q < 16; ++q) if ((t << 8) >= sOff[q] && (t << 8) < sOff[q + 1]) g = q; } c.TAB[t] = g; } if (tid == 0) { c.TAB[1000] = nt; c.TAB[1001] = sOff[8] >> 8; } }
    __syncthreads();
}

#if BUILD_STEP < 2
enum { PH_NORM1 = 0, PH_POSTPROJ, PH_CUMSUM, PH_POSTUP, PH_MIXNORM, PH_NORM2, PH_MEMNORM_Q, PH_MEMKV_NORM, PH_MEMNORM_K, PH_NORM3, PH_ROUTE1, PH_ROUTE2, PH_ZEROPAD };
__global__ void __launch_bounds__(512) k_elem(Args a) {
    __shared__ int smem[4096 + 128 + 512 + 64];
    const Ctx c = make_ctx(a, a.l);
    const int tid = threadIdx.x, lane = tid & 63, wave = tid >> 6, gw = blockIdx.x * 8 + wave, ngw = gridDim.x * 8;
    switch (a.phase) {
    case PH_NORM1: pass_norm(a.l == 0 ? c.x_in : c.X, c.mix_norm, c.H, MTOK, gw, ngw, lane); break;
    case PH_POSTPROJ: pass_post_proj(c, 0, MTOK, gw, ngw, lane); break;
    case PH_CUMSUM: for (int b = blockIdx.x; b < BATCH; b += gridDim.x) cumsum_batch(c, b, (LAS float*)smem, tid); break;
    case PH_POSTUP: pass_post_up(c, 0, MTOK, gw, ngw, lane); break;
    case PH_MIXNORM: pass_mixnorm(c, 0, MTOK, gw, ngw, lane); break;
    case PH_NORM2: pass_norm(c.X, c.xattn, c.H, MTOK, gw, ngw, lane); break;
    case PH_MEMNORM_Q: pass_memnorm(c.QM, 512, c.mqg, nullptr, MTOK, gw, ngw, lane); break;
    case PH_MEMKV_NORM: pass_norm(c.mem, c.memn, c.HM, BATCH * MEML, gw, ngw, lane); break;
    case PH_MEMNORM_K: pass_memnorm(c.KVM, 1024, c.mkg, nullptr, BATCH * MEML, gw, ngw, lane); break;
    case PH_NORM3: pass_norm(c.X, c.ffn_norm, c.H, MTOK, gw, ngw, lane); break;
    case PH_ROUTE1: for (int ch = blockIdx.x; ch < 256; ch += gridDim.x) route1_chunk(c, ch, (LAS int*)smem, tid); break;
    case PH_ROUTE2: for (int ch = blockIdx.x; ch < 256; ch += gridDim.x) route2_chunk(c, ch, (LAS int*)smem, tid); break;
    case PH_ZEROPAD: for (int r = gw; r < MTOK; r += ngw) { bf16* p = c.PROJ + (size_t)r * PW + IN_W; if (lane < 23) *(uint2*)(p + 4 * lane) = make_uint2(0u, 0u); } break;
    }
}

template <int EPI> __global__ void __launch_bounds__(256) nv_gemm(const bf16* A, int lda, const float* W, const float* W2, int ldw, size_t wstride, int N, int K, void* out, int ldo, const float* res,
                                                               const int* tile_grp, int kphase, const int* slot_tok, const float* slot_gate) {
    __shared__ float As[16][68]; __shared__ float Ws[16][68]; __shared__ float W2s[EPI == 2 ? 16 : 1][68];
    const int tid = threadIdx.x, tx = tid & 15, ty = tid >> 4, n0 = blockIdx.x * 64, m0 = blockIdx.y * 64;
    if (tile_grp) { const int g = tile_grp[m0 >> 8]; if (g < 0) return; if (EPI == 3 && (g >> 3) != kphase) return; W += (size_t)(g & 7) * wstride; if (EPI == 2) W2 += (size_t)(g & 7) * wstride; }
    float acc[4][4], acc2[4][4];
#pragma unroll
    for (int i = 0; i < 4; ++i)
#pragma unroll
        for (int j = 0; j < 4; ++j) { acc[i][j] = 0.f; acc2[i][j] = 0.f; }
    const int ar = tid >> 2, ak = (tid & 3) * 4, wk = tid >> 4, wn = (tid & 15) * 4;
    for (int k0 = 0; k0 < K; k0 += 16) {
        { float f[4]; ld4bf(A + (size_t)(m0 + ar) * lda + k0 + ak, f); As[ak + 0][ar] = f[0]; As[ak + 1][ar] = f[1]; As[ak + 2][ar] = f[2]; As[ak + 3][ar] = f[3]; }
        { float4 w = make_float4(0.f, 0.f, 0.f, 0.f); if (n0 + wn < N) w = *(const float4*)(W + (size_t)(k0 + wk) * ldw + n0 + wn); *(float4*)&Ws[wk][wn] = w;
          if (EPI == 2) { float4 w2 = make_float4(0.f, 0.f, 0.f, 0.f); if (n0 + wn < N) w2 = *(const float4*)(W2 + (size_t)(k0 + wk) * ldw + n0 + wn); *(float4*)&W2s[wk][wn] = w2; } }
        __syncthreads();
#pragma unroll
        for (int kk = 0; kk < 16; ++kk) { const float4 a = *(const float4*)&As[kk][ty * 4]; const float4 w = *(const float4*)&Ws[kk][tx * 4]; const float av[4] = {a.x, a.y, a.z, a.w}, wv[4] = {w.x, w.y, w.z, w.w};
#pragma unroll
            for (int i = 0; i < 4; ++i)
#pragma unroll
                for (int j = 0; j < 4; ++j) acc[i][j] += av[i] * wv[j];
            if (EPI == 2) { const float4 w2 = *(const float4*)&W2s[kk][tx * 4]; const float w2v[4] = {w2.x, w2.y, w2.z, w2.w};
#pragma unroll
                for (int i = 0; i < 4; ++i)
#pragma unroll
                    for (int j = 0; j < 4; ++j) acc2[i][j] += av[i] * w2v[j]; } }
        __syncthreads();
    }
    const int n = n0 + tx * 4; if (n >= N) return;
#pragma unroll
    for (int i = 0; i < 4; ++i) { const int row = m0 + ty * 4 + i;
        if (EPI == 0) { float f[4] = {acc[i][0], acc[i][1], acc[i][2], acc[i][3]}; st4bf((bf16*)out + (size_t)row * ldo + n, f); }
        if (EPI == 1) { const float4 r = *(const float4*)(res + (size_t)row * ldo + n); *(float4*)((float*)out + (size_t)row * ldo + n) = make_float4(r.x + acc[i][0], r.y + acc[i][1], r.z + acc[i][2], r.w + acc[i][3]); }
        if (EPI == 2) { float f[4];
#pragma unroll
            for (int j = 0; j < 4; ++j) { const float g = acc[i][j]; f[j] = g / (1.f + expf(-g)) * acc2[i][j]; }
            st4bf((bf16*)out + (size_t)row * ldo + n, f); }
        if (EPI == 3) { const int tok = slot_tok[row]; if (tok >= 0) { const float gt = slot_gate[row]; float4* o = (float4*)((float*)out + (size_t)tok * ldo + n); float4 r = *o; r.x += gt * acc[i][0]; r.y += gt * acc[i][1]; r.z += gt * acc[i][2]; r.w += gt * acc[i][3]; *o = r; } }
    }
}

template <int DK, int DK1, int MODE> __global__ void __launch_bounds__(64) nv_attn(const bf16* Q, int ldq, int hq, const bf16* K, int ldk, int hk, const bf16* K2, int ldk2, const bf16* V, int ldv, int hv,
                                                                                    bf16* O, int ldo, int ho, const float* cum, float scale) {
    __shared__ float Ks[64][DK + 4]; __shared__ float Vs[64][68]; __shared__ float Cs[64];
    const int tid = threadIdx.x, h = blockIdx.y, z = blockIdx.z, row = blockIdx.x * 64 + tid, b = row / SEQ, qt = (blockIdx.x * 64 % SEQ) / 64;
    float q[DK];
    { const bf16* qp = Q + (size_t)row * ldq + h * hq;
#pragma unroll
      for (int d = 0; d < DK; d += 8) { float f[8]; ld8bf(qp + d, f);
#pragma unroll
          for (int i = 0; i < 8; ++i) q[d + i] = f[i] * scale; } }
    float o[64];
#pragma unroll
    for (int d = 0; d < 64; ++d) o[d] = 0.f;
    float m = -3.0e38f, l = 0.f; const float cq = (MODE == 0) ? cum[(size_t)row * 4 + h] : 0.f;
    const int ntile = (MODE == 2) ? 4 : qt + 1; const size_t kbase = (MODE == 2) ? (size_t)b * MEML : (size_t)b * SEQ;
    for (int kt = 0; kt < ntile; ++kt) {
        const size_t krow = kbase + kt * 64 + tid;
        { const bf16* kp = K + krow * ldk + h * hk;
#pragma unroll
          for (int d = 0; d < DK1; d += 8) { float f[8]; ld8bf(kp + d, f);
#pragma unroll
              for (int i = 0; i < 8; ++i) Ks[tid][d + i] = f[i]; }
          if (DK > DK1) { const bf16* kp2 = K2 + krow * ldk2;
#pragma unroll
              for (int d = 0; d < DK - DK1; d += 8) { float f[8]; ld8bf(kp2 + d, f);
#pragma unroll
                  for (int i = 0; i < 8; ++i) Ks[tid][DK1 + d + i] = f[i]; } }
          const bf16* vp = V + krow * ldv + h * hv + z * 64;
#pragma unroll
          for (int d = 0; d < 64; d += 8) { float f[8]; ld8bf(vp + d, f);
#pragma unroll
              for (int i = 0; i < 8; ++i) Vs[tid][d + i] = f[i]; }
          if (MODE == 0) Cs[tid] = cum[krow * 4 + h]; }
        __syncthreads();
        const int jmax = (MODE == 0 && kt == ntile - 1) ? tid : 63;
        for (int j = 0; j <= jmax; ++j) {
            float s = 0.f;
#pragma unroll
            for (int d = 0; d < DK; d += 4) { const float4 kv = *(const float4*)&Ks[j][d]; s += q[d] * kv.x + q[d + 1] * kv.y + q[d + 2] * kv.z + q[d + 3] * kv.w; }
            if (MODE == 0) s += cq - Cs[j];
            if (s > m) { const float sc = expf(m - s); l *= sc;
#pragma unroll
                for (int d = 0; d < 64; ++d) o[d] *= sc;
                m = s; }
            const float p = expf(s - m); l += p;
#pragma unroll
            for (int d = 0; d < 64; d += 4) { const float4 vv = *(const float4*)&Vs[j][d]; o[d] += p * vv.x; o[d + 1] += p * vv.y; o[d + 2] += p * vv.z; o[d + 3] += p * vv.w; }
        }
        __syncthreads();
    }
    const float il = 1.f / l; bf16* op = O + (size_t)row * ldo + h * ho + z * 64;
#pragma unroll
    for (int d = 0; d < 64; d += 8) { float f[8];
#pragma unroll
        for (int i = 0; i < 8; ++i) f[i] = o[d + i] * il;
        st8bf(op + d, f); }
}
__global__ void __launch_bounds__(256) nv_sgu(const bf16* PROJ, const float* wS, const float* bS, bf16* OMIX) {
    __shared__ float Vs[128][68];
    const int tid = threadIdx.x, win = blockIdx.x, g = blockIdx.y; const size_t row0 = (size_t)win * 128;
    for (int i = tid; i < 128 * 8; i += 256) { const int s = i >> 3, d = (i & 7) * 8; float f[8]; ld8bf(PROJ + (row0 + s) * PW + C_VB + g * 64 + d, f);
#pragma unroll
        for (int k = 0; k < 8; ++k) Vs[s][d + k] = f[k]; }
    __syncthreads();
    const int t = tid >> 1, dh = (tid & 1) * 32; float acc[32];
#pragma unroll
    for (int d = 0; d < 32; ++d) acc[d] = 0.f;
    const int smax = ((t >> 6) + 1) * 64; const float* wr = wS + (size_t)g * 16384 + t * 128;
    for (int s = 0; s < smax; ++s) { const float w = wr[s];
#pragma unroll
        for (int d = 0; d < 32; d += 4) { const float4 v = *(const float4*)&Vs[s][dh + d]; acc[d] += w * v.x; acc[d + 1] += w * v.y; acc[d + 2] += w * v.z; acc[d + 3] += w * v.w; } }
    const float bb = bS[g * 128 + t];
#pragma unroll
    for (int d = 0; d < 32; d += 8) { float u[8]; ld8bf(PROJ + (row0 + t) * PW + C_UB + g * 64 + dh + d, u);
#pragma unroll
        for (int k = 0; k < 8; ++k) u[k] *= (acc[d + k] + bb);
        st8bf(OMIX + (row0 + t) * 1024 + 256 + g * 64 + dh + d, u); }
}


#endif
#ifndef REP_ATTN
#define REP_ATTN 1
#endif
#ifndef REP_FOX
#define REP_FOX 1
#endif
#ifndef PROBE_MODE
#define PROBE_MODE 0
#endif
#ifndef REP_MLA
#define REP_MLA 1
#endif
#ifndef REP_SGU
#define REP_SGU 1
#endif
#ifndef REP_ATTM
#define REP_ATTM 1
#endif
#ifndef REP_PRO
#define REP_PRO 1
#endif
#ifndef REP_G1
#define REP_G1 1
#endif
#ifndef REP_F1
#define REP_F1 1
#endif
#ifndef TPA
#define TPA -1
#endif
#ifndef TPB
#define TPB -1
#endif
#ifndef CHAIN
#define CHAIN 1
#endif
#ifndef PRB
#define PRB 0
#endif
namespace pg8 {
typedef unsigned short bf16_t;
typedef short bf16x8 __attribute__((ext_vector_type(8)));
typedef float f32x4 __attribute__((ext_vector_type(4)));
typedef float f32x2 __attribute__((ext_vector_type(2)));
typedef unsigned u32x4 __attribute__((ext_vector_type(4)));
constexpr int BM = 256, BK = 64, HALF = 128, HTB = HALF * BK * 2, STAGE_BYTES = 8 * HTB, NXCD = 8, WGM = 4;
__host__ __device__ __forceinline__ int lds_byte(int r, int c) { const int st = (r >> 4) * 2 + (c >> 5), rr = r & 15, cc = c & 31, ob = rr * 64 + cc * 2; return st * 1024 + (ob ^ (((ob >> 9) & 1) << 5)); }
__host__ __device__ __forceinline__ void stage_rc(int b, int& R, int& C) { const int st = b / 1024, sb = b % 1024, swz = sb ^ (((sb >> 9) & 1) << 5); R = (st >> 1) * 16 + swz / 64; C = (st & 1) * 32 + (swz % 64) / 2; }
__host__ __device__ __forceinline__ int perm32(int rho) { const int n = rho >> 4, i = rho & 15; return 8 * (i >> 2) + 4 * n + (i & 3); }
struct Unit { int pm, pn; const char* a; const char* b; };
__device__ __forceinline__ unsigned cvt_pk_bf16(float lo, float hi) { unsigned r; asm volatile("v_cvt_pk_bf16_f32 %0, %1, %2" : "=v"(r) : "v"(lo), "v"(hi)); return r; }

struct DenseOrder {
    int nM, nN, nwg, G, c, pm0; const char* A; const char* B; size_t tA, tB;
    __device__ __forceinline__ void init(int nM_, int nN_, int G_, int c_, const void* A_, int lda, const void* B_, int K) { nM = nM_; nN = nN_; nwg = nM * nN; G = G_; c = c_; pm0 = 0; A = (const char*)A_; B = (const char*)B_; tA = (size_t)BM * lda * 2; tB = (size_t)BM * K * 2; }
    __device__ __forceinline__ bool map(int i, int& pm, int& pn) const {
        const long L = (long)i * G + c; if (L >= nwg) return false;
        int wgid = (int)L; { const int q = nwg / NXCD, r = nwg % NXCD, xcd = wgid % NXCD, off = wgid / NXCD; wgid = (xcd < r ? xcd * (q + 1) : r * (q + 1) + (xcd - r) * q) + off; }
        const int nig = WGM * nN, gid = wgid / nig, fm = gid * WGM, gsz = (nM - fm) < WGM ? (nM - fm) : WGM;
        pm = fm + ((wgid % nig) % gsz); pn = (wgid % nig) / gsz; return true; }
    __device__ __forceinline__ bool next(int i, Unit& u) const { int pm, pn; if (!map(i, pm, pn)) return false; u.pm = pm; u.pn = pn; u.a = A + (size_t)pm * tA; u.b = B + (size_t)pn * tB; return true; }
};
struct RowOrder {
    int nM, nN, G, c; const char* A; const char* B; size_t tA, tB;
    __device__ __forceinline__ void init(int nM_, int nN_, int G_, int c_, const void* A_, int lda, const void* B_, int K) { nM = nM_; nN = nN_; G = G_; c = c_; A = (const char*)A_; B = (const char*)B_; tA = (size_t)BM * lda * 2; tB = (size_t)BM * K * 2; }
    __device__ __forceinline__ bool next(int i, Unit& u) const { const int pm = c + (i / nN) * G; if (pm >= nM) return false; u.pm = pm; u.pn = (i + c) % nN;
        u.a = A + (size_t)pm * tA; u.b = B + (size_t)u.pn * tB; return true; }
};
struct GroupOrder : DenseOrder {
    const int* tab; size_t estride;
    __device__ __forceinline__ bool next(int i, Unit& u) const { int pm, pn; if (!map(i, pm, pn)) return false; pm += pm0; u.pm = pm; u.pn = pn; const int e = tab[pm] & 7; u.a = A + (size_t)pm * tA; u.b = B + (size_t)e * estride + (size_t)pn * tB; return true; }
};
struct GatherOrder : GroupOrder { static constexpr bool GATHER = true; const int* tok;
    __device__ __forceinline__ bool next(int i, Unit& u) const { int pm, pn; if (!map(i, pm, pn)) return false; pm += pm0; u.pm = pm; u.pn = pn; const int e = tab[pm] & 7; u.a = A; u.b = B + (size_t)e * estride + (size_t)pn * tB; return true; }
};
template <class T, class = void> struct SchedTraits { static constexpr bool GATHER = false; };
template <class T> struct SchedTraits<T, decltype(void(T::GATHER))> { static constexpr bool GATHER = T::GATHER; };
template <class S> __device__ __forceinline__ auto sched_tok(const S& s, int) -> decltype(s.tok) { return s.tok; }
template <class S> __device__ __forceinline__ const int* sched_tok(const S&, long) { return nullptr; }
struct KvmOrder {
    int c; const char* A; const char* B; size_t bstride;
    __device__ __forceinline__ bool next(int i, Unit& u) const { if (i > 0 || c >= 128) return false; const int l2 = c >> 6, r = c & 63; u.pm = l2 * 16 + (r & 15); u.pn = r >> 4; u.a = A + (size_t)u.pm * (256 * 1024 * 2); u.b = B + (size_t)l2 * bstride + (size_t)u.pn * (256 * 1024 * 2); return true; }
};

struct EpiStore { static constexpr bool PERM = true; bf16_t* O; int ldc;
    __device__ __forceinline__ void operator()(const f32x4 (&acc)[2][2][4][2], const Unit& u, int wr, int wc, int fr, int fq) const {
        const int row0 = u.pm * BM + wr * 64 + fr, col0 = u.pn * BM + wc * 32 + 8 * fq;
#pragma unroll
        for (int ai = 0; ai < 2; ++ai)
#pragma unroll
            for (int m = 0; m < 4; ++m) { bf16_t* rowp = O + (size_t)(row0 + ai * HALF + m * 16) * ldc + col0;
#pragma unroll
                for (int bj = 0; bj < 2; ++bj) { const f32x4 v0 = acc[ai][bj][m][0], v1 = acc[ai][bj][m][1]; u32x4 w; w.x = cvt_pk_bf16(v0[0], v0[1]); w.y = cvt_pk_bf16(v0[2], v0[3]); w.z = cvt_pk_bf16(v1[0], v1[1]); w.w = cvt_pk_bf16(v1[2], v1[3]);
                    *(u32x4*)(rowp + bj * HALF) = w; } } } };
__device__ __forceinline__ void row_rs(const float* part, int row0, int fr, int fq, float (&rs)[2][4]) {
    const int lane = fr + 16 * fq;
#pragma unroll
    for (int ai = 0; ai < 2; ++ai)
#pragma unroll
        for (int m = 0; m < 4; ++m) { const f32x4 p = *(const f32x4*)(part + (size_t)(row0 + ai * HALF + m * 16) * 16 + 4 * fq); float s = (p[0] + p[1]) + (p[2] + p[3]);
            s += shx(s, lane, 16); s += shx(s, lane, 32); rs[ai][m] = rsqrtf(s * (1.f / 1024.f) + EPSF); }
}
struct EpiStoreN { static constexpr bool PERM = true; bf16_t* O; int ldc; const float* part;
    __device__ __forceinline__ void operator()(const f32x4 (&acc)[2][2][4][2], const Unit& u, int wr, int wc, int fr, int fq) const {
        const int row0 = u.pm * BM + wr * 64 + fr, col0 = u.pn * BM + wc * 32 + 8 * fq; float rs[2][4]; row_rs(part, row0, fr, fq, rs);
#pragma unroll
        for (int ai = 0; ai < 2; ++ai)
#pragma unroll
            for (int m = 0; m < 4; ++m) { bf16_t* rowp = O + (size_t)(row0 + ai * HALF + m * 16) * ldc + col0; const float r = rs[ai][m];
#pragma unroll
                for (int bj = 0; bj < 2; ++bj) { const f32x4 v0 = acc[ai][bj][m][0] * r, v1 = acc[ai][bj][m][1] * r; u32x4 w; w.x = cvt_pk_bf16(v0[0], v0[1]); w.y = cvt_pk_bf16(v0[2], v0[3]); w.z = cvt_pk_bf16(v1[0], v1[1]); w.w = cvt_pk_bf16(v1[2], v1[3]);
                    *(u32x4*)(rowp + bj * HALF) = w; } } } };
struct EpiRes { static constexpr bool PERM = true; bf16_t* xb; float* part;
    __device__ __forceinline__ void operator()(const f32x4 (&acc)[2][2][4][2], const Unit& u, int wr, int wc, int fr, int fq) const {
        const int row0 = u.pm * BM + wr * 64 + fr, col0 = u.pn * BM + wc * 32 + 8 * fq, lane = fr + 16 * fq;
        u32x4 rin[2][4][2];
#pragma unroll
        for (int ai = 0; ai < 2; ++ai)
#pragma unroll
            for (int m = 0; m < 4; ++m)
#pragma unroll
                for (int bj = 0; bj < 2; ++bj) rin[ai][m][bj] = *(const u32x4*)(xb + (size_t)(row0 + ai * HALF + m * 16) * 1024 + col0 + bj * HALF);
#pragma unroll
        for (int ai = 0; ai < 2; ++ai)
#pragma unroll
            for (int m = 0; m < 4; ++m) { const int row = row0 + ai * HALF + m * 16; const size_t off = (size_t)row * 1024 + col0; float ss = 0.f;
#pragma unroll
                for (int bj = 0; bj < 2; ++bj) { const u32x4 r = rin[ai][m][bj]; f32x4 v0, v1;
                    v0[0] = __uint_as_float(r.x << 16); v0[1] = __uint_as_float(r.x & 0xffff0000u); v0[2] = __uint_as_float(r.y << 16); v0[3] = __uint_as_float(r.y & 0xffff0000u);
                    v1[0] = __uint_as_float(r.z << 16); v1[1] = __uint_as_float(r.z & 0xffff0000u); v1[2] = __uint_as_float(r.w << 16); v1[3] = __uint_as_float(r.w & 0xffff0000u);
                    v0 += acc[ai][bj][m][0]; v1 += acc[ai][bj][m][1];
                    u32x4 w; w.x = cvt_pk_bf16(v0[0], v0[1]); w.y = cvt_pk_bf16(v0[2], v0[3]); w.z = cvt_pk_bf16(v1[0], v1[1]); w.w = cvt_pk_bf16(v1[2], v1[3]); *(u32x4*)(xb + off + bj * HALF) = w;
                    ss += (v0[0] * v0[0] + v0[1] * v0[1]) + (v0[2] * v0[2] + v0[3] * v0[3]) + (v1[0] * v1[0] + v1[1] * v1[1]) + (v1[2] * v1[2] + v1[3] * v1[3]); }
                ss += shx(ss, lane, 16); ss += shx(ss, lane, 32); if (fq == 0) part[(size_t)row * 16 + 4 * u.pn + wc] = ss; } } };
constexpr int RESC_TAB_OFF = 131072 + 1024;
struct EpiResMix : EpiRes { static constexpr bool RESC = true; const float* pbr;
    __device__ __forceinline__ void operator()(const f32x4 (&acc)[2][2][4][2], const Unit& u, int wr, int wc, int fr, int fq) const {
        const int row0 = u.pm * BM + wr * 64 + fr, col0 = u.pn * BM + wc * 32 + 8 * fq, lane = fr + 16 * fq;
#pragma unroll
        for (int ai = 0; ai < 2; ++ai) { u32x4 rin[4][2];
#pragma unroll
            for (int m = 0; m < 4; ++m)
#pragma unroll
                for (int bj = 0; bj < 2; ++bj) rin[m][bj] = *(const u32x4*)(xb + (size_t)(row0 + ai * HALF + m * 16) * 1024 + col0 + bj * HALF);
#pragma unroll
            for (int m = 0; m < 4; ++m) { const int row = row0 + ai * HALF + m * 16; const size_t off = (size_t)row * 1024 + col0; float ss = 0.f;
#pragma unroll
                for (int bj = 0; bj < 2; ++bj) { const u32x4 r = rin[m][bj]; f32x4 v0, v1;
                    v0[0] = __uint_as_float(r.x << 16); v0[1] = __uint_as_float(r.x & 0xffff0000u); v0[2] = __uint_as_float(r.y << 16); v0[3] = __uint_as_float(r.y & 0xffff0000u);
                    v1[0] = __uint_as_float(r.z << 16); v1[1] = __uint_as_float(r.z & 0xffff0000u); v1[2] = __uint_as_float(r.w << 16); v1[3] = __uint_as_float(r.w & 0xffff0000u);
                    v0 += acc[ai][bj][m][0]; v1 += acc[ai][bj][m][1];
                    u32x4 w; w.x = cvt_pk_bf16(v0[0], v0[1]); w.y = cvt_pk_bf16(v0[2], v0[3]); w.z = cvt_pk_bf16(v1[0], v1[1]); w.w = cvt_pk_bf16(v1[2], v1[3]); *(u32x4*)(xb + off + bj * HALF) = w;
                    ss += (v0[0] * v0[0] + v0[1] * v0[1]) + (v0[2] * v0[2] + v0[3] * v0[3]) + (v1[0] * v1[0] + v1[1] * v1[1]) + (v1[2] * v1[2] + v1[3] * v1[3]); }
                ss += shx(ss, lane, 16); ss += shx(ss, lane, 32); if (fq == 0) part[(size_t)row * 16 + 4 * u.pn + wc] = ss; }
            asm volatile("" ::: "memory"); } }
    __device__ __forceinline__ void build(const Unit& u, LAS unsigned char* lds, int par, int tid) const {
        if (tid < 256) { const float4* p = (const float4*)(pbr + (size_t)(u.pm * BM + tid) * 24); const float4 a = p[0], c0 = p[2], c1 = p[3], b0 = p[4], b1 = p[5];
            const float sa = (a.x + a.y) + (a.z + a.w), sc = ((c0.x + c0.y) + (c0.z + c0.w)) + ((c1.x + c1.y) + (c1.z + c1.w)), sb = ((b0.x + b0.y) + (b0.z + b0.w)) + ((b1.x + b1.y) + (b1.z + b1.w));
            const float r1 = rsqrtf(sa * (1.f / 256.f) + EPSF), r2 = rsqrtf(sb * (1.f / 256.f) + EPSF), r3 = rsqrtf(sc * (1.f / 512.f) + EPSF);
            f32x4 t; t[0] = r1 / r2; t[1] = r2 / r3; t[2] = r3; t[3] = 0.f; *(LAS f32x4*)(lds + RESC_TAB_OFF + par * 4096 + tid * 16) = t; } } };
template <class T, class = void> struct EpiTraits { static constexpr bool RESC = false; };
template <class T> struct EpiTraits<T, decltype(void(T::RESC))> { static constexpr bool RESC = T::RESC; };
__device__ __forceinline__ float silu_mul(float g, float u) { return g * __builtin_amdgcn_rcpf(1.0f + __builtin_amdgcn_exp2f(-1.4426950408889634f * g)) * u; }
struct EpiSwiglu { static constexpr bool PERM = true; bf16_t* O; int ldc; const float* part; const float* rsrow;
    __device__ __forceinline__ void operator()(const f32x4 (&acc)[2][2][4][2], const Unit& u, int wr, int wc, int fr, int fq) const {
        const int row0 = u.pm * BM + wr * 64 + fr, col0 = u.pn * HALF + wc * 32 + 8 * fq; float rs[2][4];
        if (part) row_rs(part, row0, fr, fq, rs);
        else {
#pragma unroll
            for (int ai = 0; ai < 2; ++ai)
#pragma unroll
                for (int m = 0; m < 4; ++m) rs[ai][m] = rsrow[row0 + ai * HALF + m * 16]; }
#pragma unroll
        for (int ai = 0; ai < 2; ++ai)
#pragma unroll
            for (int m = 0; m < 4; ++m) { const float r = rs[ai][m]; const f32x4 g0 = acc[ai][0][m][0] * r, g1 = acc[ai][0][m][1] * r, u0 = acc[ai][1][m][0] * r, u1 = acc[ai][1][m][1] * r; u32x4 w;
                w.x = cvt_pk_bf16(silu_mul(g0[0], u0[0]), silu_mul(g0[1], u0[1])); w.y = cvt_pk_bf16(silu_mul(g0[2], u0[2]), silu_mul(g0[3], u0[3]));
                w.z = cvt_pk_bf16(silu_mul(g1[0], u1[0]), silu_mul(g1[1], u1[1])); w.w = cvt_pk_bf16(silu_mul(g1[2], u1[2]), silu_mul(g1[3], u1[3]));
                *(u32x4*)(O + (size_t)(row0 + ai * HALF + m * 16) * ldc + col0) = w; } } };
template <int NP> __device__ __forceinline__ void row_rs_np(const float* part, float inv_n, int row0, int fr, int fq, float (&rs)[2][4]) {
    const int lane = fr + 16 * fq;
#pragma unroll
    for (int ai = 0; ai < 2; ++ai)
#pragma unroll
        for (int m = 0; m < 4; ++m) { float s = (fq < NP) ? part[(size_t)(row0 + ai * HALF + m * 16) * NP + fq] : 0.f; s += shx(s, lane, 16); s += shx(s, lane, 32); rs[ai][m] = rsqrtf(s * inv_n + EPSF); }
}
struct EpiStoreQ { static constexpr bool PERM = true; bf16_t* O; int ldc; const float* part;
    __device__ __forceinline__ void operator()(const f32x4 (&acc)[2][2][4][2], const Unit& u, int wr, int wc, int fr, int fq) const {
        const int row0 = u.pm * BM + wr * 64 + fr, col0 = u.pn * BM + wc * 32 + 8 * fq; float rs[2][4]; row_rs_np<4>(part, 1.f / 256.f, row0, fr, fq, rs);
#pragma unroll
        for (int ai = 0; ai < 2; ++ai)
#pragma unroll
            for (int m = 0; m < 4; ++m) { bf16_t* rowp = O + (size_t)(row0 + ai * HALF + m * 16) * ldc + col0; const float r = rs[ai][m];
#pragma unroll
                for (int bj = 0; bj < 2; ++bj) { const f32x4 v0 = acc[ai][bj][m][0] * r, v1 = acc[ai][bj][m][1] * r; u32x4 w; w.x = cvt_pk_bf16(v0[0], v0[1]); w.y = cvt_pk_bf16(v0[2], v0[3]); w.z = cvt_pk_bf16(v1[0], v1[1]); w.w = cvt_pk_bf16(v1[2], v1[3]);
                    *(u32x4*)(rowp + bj * HALF) = w; } } } };
struct EpiProj { static constexpr bool PERM = true; bf16_t* O; const float* part; const float *aq, *ak, *bvg, *krg, *bfg; const float2* ropet; float *flog, *pq, *pkv;
    __device__ __forceinline__ void operator()(const f32x4 (&acc)[2][2][4][2], const Unit& u, int wr, int wc, int fr, int fq) const {
        const int row0 = u.pm * BM + wr * 64 + fr, lane = fr + 16 * fq, pn = u.pn; float rs[2][4]; row_rs(part, row0, fr, fq, rs);
        float g[2][8];
#pragma unroll
        for (int bj = 0; bj < 2; ++bj)
#pragma unroll
            for (int i = 0; i < 8; ++i) { const int d = 32 * bj + 8 * fq + i; g[bj][i] = (pn == 0) ? aq[d] * (0.125f * 1.4426950408889634f) : (pn == 1) ? ak[d] : (pn == 4) ? bvg[64 * wc + d] : (pn == 6 && wc == 2 && bj == 0) ? krg[8 * fq + i] : 1.f; }
#pragma unroll
        for (int ai = 0; ai < 2; ++ai)
#pragma unroll
            for (int m = 0; m < 4; ++m) { const int row = row0 + ai * HALF + m * 16; const float r = rs[ai][m]; float v[2][8];
#pragma unroll
                for (int bj = 0; bj < 2; ++bj)
#pragma unroll
                    for (int i = 0; i < 8; ++i) v[bj][i] = acc[ai][bj][m][i >> 2][i & 3] * r;
                if (pn == 3 || pn == 4) {
#pragma unroll
                    for (int bj = 0; bj < 2; ++bj)
#pragma unroll
                        for (int i = 0; i < 8; ++i) v[bj][i] = gelu_erf(v[bj][i]); }
                if (pn <= 1 || pn == 5 || (pn == 6 && wc < 2)) { float ss = 0.f;
#pragma unroll
                    for (int bj = 0; bj < 2; ++bj)
#pragma unroll
                        for (int i = 0; i < 8; ++i) ss += v[bj][i] * v[bj][i];
                    ss += shx(ss, lane, 16); ss += shx(ss, lane, 32);
                    if (pn <= 1) { const float rr = rsqrtf(ss * (1.f / 64.f) + EPSF);
#pragma unroll
                        for (int bj = 0; bj < 2; ++bj)
#pragma unroll
                            for (int i = 0; i < 8; ++i) v[bj][i] *= rr * g[bj][i]; }
                    else if (fq == 0) { if (pn == 5) pq[(size_t)row * 4 + wc] = ss; else pkv[(size_t)row * 2 + wc] = ss; } }
                if (pn == 4) { float s1 = 0.f;
#pragma unroll
                    for (int bj = 0; bj < 2; ++bj)
#pragma unroll
                        for (int i = 0; i < 8; ++i) s1 += v[bj][i];
                    s1 += shx(s1, lane, 16); s1 += shx(s1, lane, 32); const float mu = s1 * (1.f / 64.f); float q2 = 0.f;
#pragma unroll
                    for (int bj = 0; bj < 2; ++bj)
#pragma unroll
                        for (int i = 0; i < 8; ++i) { v[bj][i] -= mu; q2 += v[bj][i] * v[bj][i]; }
                    q2 += shx(q2, lane, 16); q2 += shx(q2, lane, 32); const float rr = rsqrtf(q2 * (1.f / 64.f) + EPSF);
#pragma unroll
                    for (int bj = 0; bj < 2; ++bj)
#pragma unroll
                        for (int i = 0; i < 8; ++i) v[bj][i] *= rr * g[bj][i]; }
                if (pn == 6 && wc == 2) {
                    float ss = 0.f;
#pragma unroll
                    for (int i = 0; i < 8; ++i) ss += v[0][i] * v[0][i];
                    ss += shx(ss, lane, 16); ss += shx(ss, lane, 32); const float rr = rsqrtf(ss * (1.f / 32.f) + EPSF);
                    const float4* tp = (const float4*)(ropet + (size_t)row * 16 + 8 * (fq & 1));
#pragma unroll
                    for (int i = 0; i < 8; i += 2) { const float4 t = tp[i >> 1];
                        const float x0 = v[0][i] * rr * g[0][i], x1 = v[0][i + 1] * rr * g[0][i + 1], p0 = shx(x0, lane, 32), p1 = shx(x1, lane, 32);
                        v[0][i] = (fq < 2) ? (x0 * t.x - p0 * t.y) : (p0 * t.y + x0 * t.x); v[0][i + 1] = (fq < 2) ? (x1 * t.z - p1 * t.w) : (p1 * t.w + x1 * t.z); }
                    if (fq == 0) { f32x4 ls;
#pragma unroll
                        for (int j = 0; j < 4; ++j) ls[j] = logsigmoid(v[1][j] + bfg[j]);
                        *(f32x4*)(flog + (size_t)row * 4) = ls; } }
                bf16_t* rowp = O + (size_t)row * PW + pn * BM + 64 * wc + 8 * fq;
#pragma unroll
                for (int bj = 0; bj < 2; ++bj) { u32x4 w; w.x = cvt_pk_bf16(v[bj][0], v[bj][1]); w.y = cvt_pk_bf16(v[bj][2], v[bj][3]); w.z = cvt_pk_bf16(v[bj][4], v[bj][5]); w.w = cvt_pk_bf16(v[bj][6], v[bj][7]); *(u32x4*)(rowp + 32 * bj) = w; } } } };
struct EpiKV { static constexpr bool PERM = true; bf16_t* O; const float* kg; const float* part;
    __device__ __forceinline__ void operator()(const f32x4 (&acc)[2][2][4][2], const Unit& u, int wr, int wc, int fr, int fq) const {
        const int row0 = u.pm * BM + wr * 64 + fr, lane = fr + 16 * fq; const bool isk = (wc & 1) == 0;
        float rs[2][4]; row_rs_np<2>(part, 1.f / 128.f, row0, fr, fq, rs);
        float g[2][8];
#pragma unroll
        for (int bj = 0; bj < 2; ++bj)
#pragma unroll
            for (int i = 0; i < 8; ++i) g[bj][i] = isk ? kg[32 * bj + 8 * fq + i] : 1.f;
#pragma unroll
        for (int ai = 0; ai < 2; ++ai)
#pragma unroll
            for (int m = 0; m < 4; ++m) { const float r0 = rs[ai][m]; float rr = r0;
                if (isk) { float ss = 0.f;
#pragma unroll
                    for (int bj = 0; bj < 2; ++bj)
#pragma unroll
                        for (int n = 0; n < 2; ++n) { const f32x4 v = acc[ai][bj][m][n] * r0; ss += (v[0] * v[0] + v[1] * v[1]) + (v[2] * v[2] + v[3] * v[3]); }
                    ss += shx(ss, lane, 16); ss += shx(ss, lane, 32); rr = r0 * rsqrtf(ss * (1.f / 64.f) + EPSF); }
                bf16_t* rowp = O + (size_t)(row0 + ai * HALF + m * 16) * 1024 + u.pn * BM + 64 * wc + 8 * fq;
#pragma unroll
                for (int bj = 0; bj < 2; ++bj) { const f32x4 v0 = acc[ai][bj][m][0] * rr, v1 = acc[ai][bj][m][1] * rr; u32x4 w;
                    w.x = cvt_pk_bf16(v0[0] * g[bj][0], v0[1] * g[bj][1]); w.y = cvt_pk_bf16(v0[2] * g[bj][2], v0[3] * g[bj][3]); w.z = cvt_pk_bf16(v1[0] * g[bj][4], v1[1] * g[bj][5]); w.w = cvt_pk_bf16(v1[2] * g[bj][6], v1[3] * g[bj][7]);
                    *(u32x4*)(rowp + 32 * bj) = w; } } } };
template <bool FINAL> struct EpiScatter { static constexpr bool PERM = true; bf16_t* xb; float* out; const int* tok; const float* gate; unsigned* cnt; unsigned target;
    __device__ __forceinline__ void pre() const { if (FINAL && cnt) { unsigned sp = 0;
        while ((unsigned)__builtin_amdgcn_readfirstlane((int)__hip_atomic_load(cnt, __ATOMIC_RELAXED, __HIP_MEMORY_SCOPE_AGENT)) < target) { __builtin_amdgcn_s_sleep(40); if (++sp > (1u << 16)) break; }
        asm volatile("" ::: "memory"); } }
    __device__ __forceinline__ void operator()(const f32x4 (&acc)[2][2][4][2], const Unit& u, int wr, int wc, int fr, int fq) const {
        const int row0 = u.pm * BM + wr * 64 + fr, col0 = u.pn * BM + wc * 32 + 8 * fq;
#pragma unroll
        for (int ai = 0; ai < 2; ++ai) {
            int tk[4]; float gt[4];
#pragma unroll
            for (int m = 0; m < 4; ++m) { const int row = row0 + ai * HALF + m * 16; tk[m] = tok[row]; gt[m] = gate[row]; }
            u32x4 rin[4][2];
#pragma unroll
            for (int m = 0; m < 4; ++m) { const size_t off = (size_t)(tk[m] < 0 ? 0 : tk[m]) * 1024 + col0;
#pragma unroll
                for (int bj = 0; bj < 2; ++bj) rin[m][bj] = *(const u32x4*)(xb + off + bj * HALF); }
#pragma unroll
            for (int m = 0; m < 4; ++m) { const int t = tk[m]; const float g = gt[m];
                if (t >= 0) { const size_t off = (size_t)t * 1024 + col0;
#pragma unroll
                    for (int bj = 0; bj < 2; ++bj) { const u32x4 r = rin[m][bj]; f32x4 v0, v1;
                        v0[0] = __uint_as_float(r.x << 16); v0[1] = __uint_as_float(r.x & 0xffff0000u); v0[2] = __uint_as_float(r.y << 16); v0[3] = __uint_as_float(r.y & 0xffff0000u);
                        v1[0] = __uint_as_float(r.z << 16); v1[1] = __uint_as_float(r.z & 0xffff0000u); v1[2] = __uint_as_float(r.w << 16); v1[3] = __uint_as_float(r.w & 0xffff0000u);
                        v0 += g * acc[ai][bj][m][0]; v1 += g * acc[ai][bj][m][1];
                        if (FINAL) { *(f32x4*)(out + off + bj * HALF) = v0; *(f32x4*)(out + off + bj * HALF + 4) = v1; }
                        else { u32x4 w; w.x = cvt_pk_bf16(v0[0], v0[1]); w.y = cvt_pk_bf16(v0[2], v0[3]); w.z = cvt_pk_bf16(v1[0], v1[1]); w.w = cvt_pk_bf16(v1[2], v1[3]); asm volatile("global_store_dwordx4 %0, %1, off sc1\n\ts_nop 1" :: "v"(xb + off + bj * HALF), "v"(w) : "memory"); } } } }
            asm volatile("" ::: "memory"); } } };

template <class T> __device__ __forceinline__ auto epi_pre(const T& e, int) -> decltype(e.pre(), void()) { e.pre(); }
template <class T> __device__ __forceinline__ void epi_pre(const T&, long) {}
template <class Epi, class Sched, bool ALIGN_EPI, bool SP2>
__device__ __forceinline__ void gemm_phase(LAS unsigned char* lds, const int K, const int lda, const Sched& S, const Epi& E, const int tid_in) {
    const int tid = tid_in, wid = __builtin_amdgcn_readfirstlane(tid >> 6), lane = tid & 63, wr = wid >> 2, wc = wid & 3, fr = lane & 15, fq = lane >> 4;
    int nt = K / BK; asm volatile("" : "+s"(nt));
    unsigned voffA, voffB;
    { int R, C; stage_rc(tid * 16, R, C); const int Rb = Epi::PERM ? ((R & ~31) + perm32(R & 31)) : R; voffA = (unsigned)(R * lda + C) * 2u; voffB = (unsigned)(Rb * K + C) * 2u; }
    const size_t sA = (size_t)64 * lda * 2, sB = (size_t)64 * K * 2;
    const size_t kstep = (size_t)(BK * 2);
    const size_t hA = (size_t)HALF * lda * 2, hB = (size_t)HALF * K * 2;
    const unsigned ldsw = (unsigned)wid * 1024u;
    const int aoff = lds_byte(wr * 64 + fr, fq * 8), boff = lds_byte(wc * 32 + fr, fq * 8);
#define PG8_SA(b, h) (((b) * 2 + (h)) * HTB)
#define PG8_SB(b, h) ((4 + (b) * 2 + (h)) * HTB)
#define PG8_STAGE(bufoff, gbase, voff) do { _Pragma("unroll") for (int _i = 0; _i < 2; ++_i) \
        __builtin_amdgcn_global_load_lds((const unsigned*)((const char*)(gbase) + (size_t)_i * PG8_STEP_##voff + (voff)), (LAS unsigned*)(lds + (bufoff) + ldsw + _i * 8192), 16, 0, 0); } while (0)
#define PG8_STEP_voffA sA
#define PG8_STEP_voffB sB
#define PG8_STAGEA(bufoff, kb, h) do { if constexpr (GATHER) { \
        __builtin_amdgcn_global_load_lds((const unsigned*)((const char*)(kb) + ((h) ? g2 : g0)), (LAS unsigned*)(lds + (bufoff) + ldsw), 16, 0, 0); \
        __builtin_amdgcn_global_load_lds((const unsigned*)((const char*)(kb) + ((h) ? g3 : g1)), (LAS unsigned*)(lds + (bufoff) + ldsw + 8192), 16, 0, 0); } \
      else PG8_STAGE(bufoff, (const char*)(kb) + (h) * hA, voffA); } while (0)
#define PG8_LDA(dst, b, h) do { _Pragma("unroll") for (int m = 0; m < 4; ++m) _Pragma("unroll") for (int k = 0; k < 2; ++k) dst[m][k] = *(const LAS bf16x8*)(lds + PG8_SA(b, h) + aoff + m * 2048 + k * 1024); } while (0)
#define PG8_LDB(dst, b, h) do { _Pragma("unroll") for (int n = 0; n < 2; ++n) _Pragma("unroll") for (int k = 0; k < 2; ++k) dst[n][k] = *(const LAS bf16x8*)(lds + PG8_SB(b, h) + boff + n * 2048 + k * 1024); } while (0)
#define PG8_MMA(ai, bj, At, Bt) do { __builtin_amdgcn_s_setprio(1); _Pragma("unroll") for (int m = 0; m < 4; ++m) _Pragma("unroll") for (int n = 0; n < 2; ++n) _Pragma("unroll") for (int k = 0; k < 2; ++k) \
        acc[ai][bj][m][n] = __builtin_amdgcn_mfma_f32_16x16x32_bf16(Bt[n][k], At[m][k], acc[ai][bj][m][n], 0, 0, 0); __builtin_amdgcn_s_setprio(0); } while (0)
#define PG8_WAIT_V(n) asm volatile("s_waitcnt vmcnt(" #n ")" ::: "memory")
#define PG8_WAIT_L(n) asm volatile("s_waitcnt lgkmcnt(" #n ")" ::: "memory")
#define PG8_BAR __builtin_amdgcn_s_barrier()
#define PG8_SCHED __builtin_amdgcn_sched_barrier(0)
    Unit cur, nxt; int ui = 0;
    if (!S.next(0, cur)) return;
    constexpr bool GATHER = SchedTraits<Sched>::GATHER;
    const int* tokp = sched_tok(S, 0); (void)tokp;
    unsigned g0 = 0u, g1 = 0u, g2 = 0u, g3 = 0u; (void)g0; (void)g1; (void)g2; (void)g3;
    constexpr int GTAB_OFF = 131072 + 1024;
    if constexpr (GATHER) { int R, C; stage_rc(tid * 16, R, C); const int* tp = tokp + cur.pm * BM + R; const int t0 = tp[0], t1 = tp[64], t2 = tp[128], t3 = tp[192];
        g0 = (unsigned)(t0 < 0 ? 0 : t0) * (unsigned)(lda * 2) + C * 2; g1 = (unsigned)(t1 < 0 ? 0 : t1) * (unsigned)(lda * 2) + C * 2; g2 = (unsigned)(t2 < 0 ? 0 : t2) * (unsigned)(lda * 2) + C * 2; g3 = (unsigned)(t3 < 0 ? 0 : t3) * (unsigned)(lda * 2) + C * 2; }
    constexpr bool RESC = EpiTraits<Epi>::RESC;
    if constexpr (RESC) E.build(cur, lds, 0, wid * 64 + hw_lane());
    f32x4 acc[2][2][4][2];
#pragma unroll
    for (int a = 0; a < 2; ++a)
#pragma unroll
        for (int b = 0; b < 2; ++b)
#pragma unroll
            for (int m = 0; m < 4; ++m)
#pragma unroll
                for (int n = 0; n < 2; ++n) acc[a][b][m][n] = (f32x4){0.f, 0.f, 0.f, 0.f};
    bf16x8 At[4][2], B0[2][2], B1[2][2];
    const char* cA = cur.a; const char* cB = cur.b;
    if constexpr (SP2) {
        PG8_STAGE(PG8_SB(0, 0), cB, voffB); PG8_STAGE(PG8_SB(0, 1), cB + hB, voffB); PG8_STAGEA(PG8_SA(0, 0), cA, 0); PG8_STAGEA(PG8_SA(0, 1), cA, 1);
        if (wr == 1) PG8_BAR;
        PG8_WAIT_V(2); PG8_BAR;
        PG8_STAGE(PG8_SB(1, 0), cB + kstep, voffB); PG8_STAGEA(PG8_SA(1, 0), cA + kstep, 0); PG8_STAGE(PG8_SB(1, 1), cB + hB + kstep, voffB);
        PG8_WAIT_V(6); PG8_BAR;
    } else {
        PG8_STAGE(PG8_SB(0, 0), cB, voffB); PG8_STAGE(PG8_SA(0, 0), cA, voffA); PG8_STAGE(PG8_SB(0, 1), cB + hB, voffB); PG8_STAGE(PG8_SA(0, 1), cA + hA, voffA);
        if (wr == 1) PG8_BAR;
        PG8_WAIT_V(4); PG8_BAR;
        PG8_STAGE(PG8_SB(1, 0), cB + kstep, voffB); PG8_STAGE(PG8_SA(1, 0), cA + kstep, voffA); PG8_STAGE(PG8_SB(1, 1), cB + hB + kstep, voffB);
        PG8_WAIT_V(6); PG8_BAR;
    }
    for (;;) {
        const bool has_next = S.next(ui + 1, nxt);
        const char* nA = has_next ? nxt.a : cA; const char* nB = has_next ? nxt.b : cB;
        int ntk = 0; if constexpr (GATHER) { if (has_next) ntk = tokp[nxt.pm * BM + ((wid & 3) * 64 + hw_lane())]; }
        for (int t = 0; t < nt; t += 2) {
            const bool last = (t == nt - 2);
            const char* a1 = cA + (size_t)(t + 1) * kstep;
            const char* a2 = last ? nA : cA + (size_t)(t + 2) * kstep; const char* b2 = last ? nB : cB + (size_t)(t + 2) * kstep;
            const char* a3 = a2 + kstep; const char* b3 = b2 + kstep;
            if constexpr (RESC) { if (t == 4 || t == 8) {
                const int ln = hw_lane(); const LAS float* tb = (const LAS float*)(lds + RESC_TAB_OFF + (ui & 1) * 4096) + (wr * 64 + (ln & 15)) * 4 + (t == 8 ? 1 : 0);
#pragma unroll
                for (int a = 0; a < 2; ++a)
#pragma unroll
                    for (int m = 0; m < 4; ++m) { const float s = tb[(a * HALF + m * 16) * 4];
#pragma unroll
                        for (int b = 0; b < 2; ++b)
#pragma unroll
                            for (int n = 0; n < 2; ++n) acc[a][b][m][n] *= s;
                        PG8_SCHED; } } }
            if constexpr (SP2) {
            PG8_LDB(B0, 0, 0); PG8_LDB(B1, 0, 1); PG8_SCHED; PG8_LDA(At, 0, 0); PG8_STAGEA(PG8_SA(1, 1), a1, 1);
            if constexpr (GATHER) {
                if (t == 2 && wid < 4) ((LAS unsigned*)(lds + GTAB_OFF + ((ui + 1) & 1) * 1024))[wid * 64 + hw_lane()] = (unsigned)(ntk < 0 ? 0 : ntk) * (unsigned)(lda * 2);
                if (last && has_next) { int R, C; stage_rc((wid * 64 + hw_lane()) * 16, R, C); const LAS unsigned* gt = (const LAS unsigned*)(lds + GTAB_OFF + ((ui + 1) & 1) * 1024) + R;
                    g0 = gt[0] + C * 2; g1 = gt[64] + C * 2; g2 = gt[128] + C * 2; g3 = gt[192] + C * 2; } }
            PG8_WAIT_V(8); PG8_WAIT_L(0); PG8_BAR; PG8_MMA(0, 0, At, B0); PG8_MMA(0, 1, At, B1); PG8_BAR; PG8_SCHED;
            PG8_LDA(At, 0, 1); PG8_STAGE(PG8_SB(0, 0), b2, voffB); PG8_STAGE(PG8_SB(0, 1), b2 + hB, voffB); PG8_STAGEA(PG8_SA(0, 0), a2, 0);
            PG8_WAIT_V(8); PG8_WAIT_L(0); PG8_BAR; PG8_MMA(1, 0, At, B0); PG8_MMA(1, 1, At, B1); PG8_BAR; PG8_SCHED;
            PG8_LDB(B0, 1, 0); PG8_LDB(B1, 1, 1); PG8_SCHED; PG8_LDA(At, 1, 0); PG8_STAGEA(PG8_SA(0, 1), a2, 1);
            PG8_WAIT_V(8); PG8_WAIT_L(0); PG8_BAR; PG8_MMA(0, 0, At, B0); PG8_MMA(0, 1, At, B1); PG8_BAR; PG8_SCHED;
            PG8_LDA(At, 1, 1); PG8_STAGE(PG8_SB(1, 0), b3, voffB); PG8_STAGE(PG8_SB(1, 1), b3 + hB, voffB); PG8_STAGEA(PG8_SA(1, 0), a3, 0);
            PG8_WAIT_V(8); PG8_WAIT_L(0); PG8_BAR; PG8_MMA(1, 0, At, B0); PG8_MMA(1, 1, At, B1); PG8_BAR; PG8_SCHED;
            } else {
            PG8_LDB(B0, 0, 0); PG8_SCHED; PG8_LDA(At, 0, 0); PG8_STAGE(PG8_SA(1, 1), a1 + hA, voffA);
            PG8_WAIT_L(8); PG8_BAR; PG8_WAIT_L(0); PG8_MMA(0, 0, At, B0); PG8_BAR; PG8_SCHED;
            PG8_LDB(B1, 0, 1); PG8_STAGE(PG8_SB(0, 0), b2, voffB);
            PG8_BAR; PG8_WAIT_L(0); PG8_MMA(0, 1, At, B1); PG8_BAR;
            PG8_LDA(At, 0, 1); PG8_STAGE(PG8_SA(0, 0), a2, voffA);
            PG8_BAR; PG8_WAIT_L(0); PG8_MMA(1, 0, At, B0); PG8_BAR; PG8_SCHED;
            PG8_STAGE(PG8_SB(0, 1), b2 + hB, voffB);
            PG8_WAIT_V(6); PG8_BAR; PG8_MMA(1, 1, At, B1); PG8_BAR;
            PG8_LDB(B0, 1, 0); PG8_SCHED; PG8_LDA(At, 1, 0); PG8_STAGE(PG8_SA(0, 1), a2 + hA, voffA);
            PG8_WAIT_L(8); PG8_BAR; PG8_WAIT_L(0); PG8_MMA(0, 0, At, B0); PG8_BAR; PG8_SCHED;
            PG8_LDB(B1, 1, 1); PG8_STAGE(PG8_SB(1, 0), b3, voffB);
            PG8_BAR; PG8_WAIT_L(0); PG8_MMA(0, 1, At, B1); PG8_BAR;
            PG8_LDA(At, 1, 1); PG8_STAGE(PG8_SA(1, 0), a3, voffA);
            PG8_BAR; PG8_WAIT_L(0); PG8_MMA(1, 0, At, B0); PG8_BAR; PG8_SCHED;
            PG8_STAGE(PG8_SB(1, 1), b3 + hB, voffB);
            PG8_WAIT_V(6); PG8_BAR; PG8_MMA(1, 1, At, B1); PG8_BAR;
            }
        }
        if constexpr (ALIGN_EPI) { if (wr == 0) PG8_BAR; }
        if constexpr (RESC) { const int ln = hw_lane(); const LAS float* tb = (const LAS float*)(lds + RESC_TAB_OFF + (ui & 1) * 4096) + (wr * 64 + (ln & 15)) * 4 + 2;
#pragma unroll
            for (int a = 0; a < 2; ++a)
#pragma unroll
                for (int m = 0; m < 4; ++m) { const float s = tb[(a * HALF + m * 16) * 4];
#pragma unroll
                    for (int b = 0; b < 2; ++b)
#pragma unroll
                        for (int n = 0; n < 2; ++n) acc[a][b][m][n] *= s;
                    PG8_SCHED; } }
        { const int ln_e = hw_lane(); const int fr_e = ln_e & 15, fq_e = ln_e >> 4;
          if (ui == 0) epi_pre(E, 0);
          E(acc, cur, wr, wc, fr_e, fq_e); }
        if (!has_next) break;
        if constexpr (RESC) { E.build(nxt, lds, (ui + 1) & 1, wid * 64 + hw_lane()); PG8_SCHED; }
#pragma unroll
        for (int a = 0; a < 2; ++a)
#pragma unroll
            for (int b = 0; b < 2; ++b)
#pragma unroll
                for (int m = 0; m < 4; ++m)
#pragma unroll
                    for (int n = 0; n < 2; ++n) acc[a][b][m][n] = (f32x4){0.f, 0.f, 0.f, 0.f};
        cur = nxt; cA = nA; cB = nB; ++ui;
        if constexpr (ALIGN_EPI) { if (wr == 1) PG8_BAR; }
    }
    PG8_WAIT_V(0);
    if constexpr (!ALIGN_EPI) { if (wr == 0) PG8_BAR; }
    PG8_BAR;
#undef PG8_SA
#undef PG8_SB
#undef PG8_STAGE
#undef PG8_STEP_voffA
#undef PG8_STAGEA
#undef PG8_STEP_voffB
#undef PG8_LDA
#undef PG8_LDB
#undef PG8_MMA
#undef PG8_WAIT_V
#undef PG8_WAIT_L
#undef PG8_BAR
#undef PG8_SCHED
}
}

namespace att {
typedef short bf16x8 __attribute__((ext_vector_type(8)));
typedef short s16x4 __attribute__((ext_vector_type(4)));
typedef short v4i16_t __attribute__((ext_vector_type(4)));
typedef float f32x16 __attribute__((ext_vector_type(16)));
typedef float f32x4 __attribute__((ext_vector_type(4)));
typedef unsigned u32x4 __attribute__((ext_vector_type(4)));
typedef float f32x2_t __attribute__((ext_vector_type(2))); typedef __bf16 bf16x2_t __attribute__((ext_vector_type(2)));
__device__ __forceinline__ int crow(int r, int hi) { return (r & 3) + 8 * (r >> 2) + 4 * hi; }
__device__ __forceinline__ void glds16(const void* gsrc, unsigned lds_dst) { unsigned keep;
    asm volatile("s_mov_b32 %0, m0\n\ts_mov_b32 m0, %2\n\ts_nop 0\n\tglobal_load_lds_dwordx4 %1, off\n\ts_mov_b32 m0, %0" : "=&s"(keep) : "v"(gsrc), "s"(lds_dst) : "memory"); }
__device__ __forceinline__ unsigned cvtpk(float lo, float hi) { f32x2_t v = {lo, hi}; bf16x2_t b = __builtin_convertvector(v, bf16x2_t); return __builtin_bit_cast(unsigned, b); }
__device__ __forceinline__ s16x4 vtr(const LAS unsigned char* p) { return __builtin_bit_cast(s16x4, __builtin_amdgcn_ds_read_tr16_b64_v4i16((LAS v4i16_t*)p)); }
__device__ __forceinline__ float half_max(float m) { auto rr = __builtin_amdgcn_permlane32_swap(__float_as_uint(m), __float_as_uint(m), false, false); return fmaxf(__uint_as_float(rr[0]), __uint_as_float(rr[1])); }
__device__ __forceinline__ float half_sum(float m) { auto rr = __builtin_amdgcn_permlane32_swap(__float_as_uint(m), __float_as_uint(m), false, false); return __uint_as_float(rr[0]) + __uint_as_float(rr[1]); }
__device__ __forceinline__ bf16x8 scale8(bf16x8 v, float s) { u32x4 u = __builtin_bit_cast(u32x4, v); u32x4 o;
#pragma unroll
    for (int i = 0; i < 4; ++i) { const float a = __uint_as_float(u[i] << 16) * s, b = __uint_as_float(u[i] & 0xffff0000u) * s; o[i] = cvtpk(a, b); }
    return __builtin_bit_cast(bf16x8, o); }
#define ATT_WAITBAR(N) asm volatile("s_waitcnt vmcnt(%0) lgkmcnt(0)\n\ts_barrier" :: "n"(N) : "memory")

__device__ __forceinline__ float max3f(float a, float b, float c) { return __builtin_fmaxf(__builtin_fmaxf(a, b), c); }
template <int DK, int DV, int MODE, int PROBE = 0>
__device__ __forceinline__ void attn_unit(LAS unsigned char* shm, const bf16* Qw, int ldq, float qscale, const bf16* Kh, int ldk, const bf16* K2, int ldk2, const bf16* Vh, int ldv,
                                          bf16* Ow, int ldo, int q0, int NT, int tid, const float* cumq = nullptr  ) {
    constexpr int ND = DK / 16 + (MODE == 0 ? 1 : 0), NO = DV / 32, PD = (MODE == 2) ? 2 : 4, NSK = PD + 1, NSV = PD + 2;
    constexpr int KSLOT = (MODE == 0 ? 10 : DK / 8) * 1024, VSLOT = DV * 128;
    constexpr int LDS_K = 0, LDS_V = NSK * KSLOT, LDS_WS = LDS_V + NSV * VSLOT;
    constexpr int NPT = (DK > 64 ? 2 : 1) + (DV > 64 ? 2 : 1);
    const int lane = tid & 63, r32 = lane & 31, hi = lane >> 5, wid = __builtin_amdgcn_readfirstlane(tid >> 6), half = wid >> 2;
    const unsigned lds0 = (unsigned)(uintptr_t)shm;
    LAS float* wsf = (LAS float*)(shm + LDS_WS) + wid * 64;
    asm volatile("" ::: "memory");
    const bf16* ksrc = Kh + (size_t)lane * ldk + wid * 8;
    const bf16* k2src = (MODE == 0) ? (K2 + (size_t)lane * 8) : (DK == 96) ? (K2 + (size_t)lane * ldk2 + (wid & 3) * 8) : (Kh + (size_t)lane * ldk + (8 + wid) * 8);
    const size_t k2step = (MODE == 0) ? (size_t)64 * 8 : (DK == 96) ? (size_t)64 * ldk2 : (size_t)64 * ldk;
    const int k2chunk = (MODE == 0) ? 8 : (DK == 96) ? 8 + (wid & 3) : 8 + wid;
    const bool k2do = (MODE == 0) ? (wid == 0) : (DK > 64);
    const bf16* vsrc = Vh + (size_t)(16 * (wid & 3) + (lane >> 2)) * ldv + (wid >> 2) * 32 + (lane & 3) * 8;
#define ATT_DMA(t, ks_, vs_) do { glds16(ksrc + (size_t)(t) * 64 * ldk, (unsigned)__builtin_amdgcn_readfirstlane(lds0 + LDS_K + (ks_) * KSLOT + wid * 1024)); \
        if (k2do) glds16(k2src + (size_t)(t) * k2step, (unsigned)__builtin_amdgcn_readfirstlane(lds0 + LDS_K + (ks_) * KSLOT + k2chunk * 1024)); \
        glds16(vsrc + (size_t)(t) * 64 * ldv, (unsigned)__builtin_amdgcn_readfirstlane(lds0 + LDS_V + (vs_) * VSLOT + wid * 1024)); \
        if (DV > 64) glds16(vsrc + 64 + (size_t)(t) * 64 * ldv, (unsigned)__builtin_amdgcn_readfirstlane(lds0 + LDS_V + (vs_) * VSLOT + (wid + 8) * 1024)); } while (0)
#define ATT_WAITGRP(keep) do { const int k_ = (keep); if (MODE == 0 && wid == 0) { if (k_ <= 0) ATT_WAITBAR(0); else if (k_ == 1) ATT_WAITBAR(NPT + 1); else if (k_ == 2) ATT_WAITBAR(2 * (NPT + 1)); else ATT_WAITBAR(3 * (NPT + 1)); } \
        else { if (k_ <= 0) ATT_WAITBAR(0); else if (k_ == 1) ATT_WAITBAR(NPT); else if (k_ == 2) ATT_WAITBAR(2 * NPT); else ATT_WAITBAR(3 * NPT); } } while (0)
#pragma unroll
    for (int i = 0; i < PD; ++i) if (i < NT) ATT_DMA(i, i, i);
    bf16x8 qr[ND];
    if (MODE == 2) {
        float ss = 0.f;
#pragma unroll
        for (int d0 = 0; d0 < DK / 16; ++d0) { qr[d0] = *(const bf16x8*)(Qw + (size_t)r32 * ldq + d0 * 16 + hi * 8); const u32x4 u = __builtin_bit_cast(u32x4, qr[d0]);
#pragma unroll
            for (int i = 0; i < 4; ++i) { const float a = __uint_as_float(u[i] << 16), b = __uint_as_float(u[i] & 0xffff0000u); ss += a * a + b * b; } }
        const float fac = rsqrtf(half_sum(ss) * (1.f / (float)DK) + EPSF) * qscale;
#pragma unroll
        for (int d0 = 0; d0 < DK / 16; ++d0) qr[d0] = scale8(qr[d0], fac);
    } else {
#pragma unroll
    for (int d0 = 0; d0 < DK / 16; ++d0) qr[d0] = scale8(*(const bf16x8*)(Qw + (size_t)r32 * ldq + d0 * 16 + hi * 8), qscale);
    }
    if (MODE == 0) { const short one = (short)0x3f80; qr[ND - 1] = hi ? (bf16x8){0, 0, 0, 0, 0, 0, 0, 0} : (bf16x8){one, one, one, 0, 0, 0, 0, 0}; }
    if (half == 1) ATT_WAITGRP((NT < PD ? NT : PD) - 1);
    float mhat = 0.f, l_reg = 0.f; f32x16 o[NO]; f32x16 negm = f32x16{};
    if (MODE == 0) {
        mhat = -cumq[(size_t)r32 * 4] * 1.4426950408889634f;
#pragma unroll
        for (int r = 0; r < 16; ++r) negm[r] = -mhat; }
#pragma unroll
    for (int d = 0; d < NO; ++d) o[d] = f32x16{};
    u32x4 pw[4] = {};
    const int qmin = q0 + 32 * wid;
    int ks = 0, ks2 = PD % NSK, vs1 = NSV - 1, vs2 = PD % NSV;
    bool pvis = false;
#define ATT_SCHED() __builtin_amdgcn_sched_barrier(0)
#define ATT_VLOAD(vfr, vslot) do { const LAS unsigned char* vp = shm + LDS_V + (vslot) * VSLOT + ((lane >> 4) & 1) * 32 + (lane & 3) * 8 + (4 * hi + ((lane & 15) >> 2)) * 64; \
        _Pragma("unroll") for (int k4 = 0; k4 < 4; ++k4) _Pragma("unroll") for (int d0 = 0; d0 < NO; ++d0) { const s16x4 lo = vtr(vp + d0 * 4096 + k4 * 1024), hh = vtr(vp + d0 * 4096 + k4 * 1024 + 512); \
            vfr[k4][d0] = (bf16x8){lo[0], lo[1], lo[2], lo[3], hh[0], hh[1], hh[2], hh[3]}; } } while (0)
#define ATT_PVMMA(vfr) do { _Pragma("unroll") for (int k4 = 0; k4 < 4; ++k4) _Pragma("unroll") for (int d0 = 0; d0 < NO; ++d0) \
            o[d0] = __builtin_amdgcn_mfma_f32_32x32x16_bf16(__builtin_bit_cast(bf16x8, pw[k4]), vfr[k4][d0], o[d0], 0, 0, 0); } while (0)
    for (int t = 0; t < NT; ++t) {
        { const int rem = NT - t; ATT_WAITGRP((rem < PD ? rem : PD) - 1); }
        if (t + PD < NT) ATT_DMA(t + PD, ks2, vs2);
        const bool vis0 = (MODE == 2) ? true : (MODE == 1 ? (t <= (qmin >> 6)) : (64 * t <= qmin + 31));
        const bool vis = (PROBE == 1) ? false : vis0;
        f32x16 p0 = f32x16{}, p1 = f32x16{};
        {
            bf16x8 vfr[4][NO]; bf16x8 kf[ND][2];
            ATT_SCHED();
            if (pvis) ATT_VLOAD(vfr, vs1);
            if (DV > 64) { ATT_SCHED(); if (pvis) ATT_PVMMA(vfr); ATT_SCHED(); }
            if (vis) {
                const LAS unsigned char* kb = shm + LDS_K + ks * KSLOT + hi * 1024 + r32 * 16;
#pragma unroll
                for (int d0 = 0; d0 < ND; ++d0) { const LAS unsigned char* kp = (MODE == 0 && d0 == ND - 1) ? (shm + LDS_K + ks * KSLOT + 8 * 1024 + r32 * 16) : (kb + d0 * 2048);
                    kf[d0][0] = *(const LAS bf16x8*)(kp); kf[d0][1] = *(const LAS bf16x8*)(kp + 512); }
            }
            ATT_SCHED();
            if (DV <= 64) { if (pvis) ATT_PVMMA(vfr); }
            if (vis) {
#pragma unroll
                for (int d0 = 0; d0 < ND; ++d0) {
                    if (d0 == 0) { p0 = __builtin_amdgcn_mfma_f32_32x32x16_bf16(kf[0][0], qr[0], negm, 0, 0, 0); p1 = __builtin_amdgcn_mfma_f32_32x32x16_bf16(kf[0][1], qr[0], negm, 0, 0, 0); }
                    else { p0 = __builtin_amdgcn_mfma_f32_32x32x16_bf16(kf[d0][0], qr[d0], p0, 0, 0, 0); p1 = __builtin_amdgcn_mfma_f32_32x32x16_bf16(kf[d0][1], qr[d0], p1, 0, 0, 0); } }
            }
            ATT_SCHED();
        }
        { const int rem = NT - t - 1; ATT_WAITGRP((rem < PD ? rem : PD) - 1); }
        if (vis && PROBE != 2) {
            if (MODE == 0) { if (64 * t + 63 > qmin) { const int q = qmin + r32;
#pragma unroll
                    for (int r = 0; r < 16; ++r) { const int kv = 64 * t + crow(r, hi); if (kv > q) p0[r] = -INFINITY; if (kv + 32 > q) p1[r] = -INFINITY; } } }
            float ma = max3f(p0[0], p0[1], p1[0]), mb = max3f(p0[2], p0[3], p1[1]); ma = max3f(ma, p1[2], p1[3]);
#pragma unroll
            for (int r = 4; r < 16; r += 4) { ma = max3f(ma, p0[r], p0[r + 1]); mb = max3f(mb, p0[r + 2], p0[r + 3]); ma = max3f(ma, p1[r], p1[r + 1]); mb = max3f(mb, p1[r + 2], p1[r + 3]); }
            const float rm = half_max(fmaxf(ma, mb));
            if ((MODE != 0 && t == 0) || __any(rm > 8.0f)) { const float dl = (MODE != 0 && t == 0) ? rm : fmaxf(rm, 0.f); mhat += dl;
#pragma unroll
                for (int r = 0; r < 16; ++r) { p0[r] -= dl; p1[r] -= dl; negm[r] = -mhat; }
                if (MODE == 0 || t > 0) { const float f = __builtin_amdgcn_exp2f(-dl); l_reg *= f;
                    if (hi == 0) wsf[r32] = f;
                    asm volatile("s_waitcnt lgkmcnt(0)" ::: "memory");
#pragma unroll
                    for (int r = 0; r < 16; ++r) { const float fr_ = wsf[crow(r, hi)];
#pragma unroll
                        for (int d = 0; d < NO; ++d) o[d][r] *= fr_; }
                    asm volatile("s_waitcnt lgkmcnt(0)" ::: "memory"); } }
            float sa = 0.f, sb = 0.f;
#pragma unroll
            for (int r = 0; r < 16; ++r) { p0[r] = __builtin_amdgcn_exp2f(p0[r]); p1[r] = __builtin_amdgcn_exp2f(p1[r]); sa += p0[r]; sb += p1[r]; }
            l_reg += sa + sb;
#pragma unroll
            for (int i = 0; i < 4; ++i) { pw[0][i] = cvtpk(p0[2 * i], p0[2 * i + 1]); pw[1][i] = cvtpk(p0[8 + 2 * i], p0[9 + 2 * i]); pw[2][i] = cvtpk(p1[2 * i], p1[2 * i + 1]); pw[3][i] = cvtpk(p1[8 + 2 * i], p1[9 + 2 * i]); }
        }
        pvis = vis;
        ks = (ks == NSK - 1) ? 0 : ks + 1; ks2 = (ks2 == NSK - 1) ? 0 : ks2 + 1; vs1 = (vs1 == NSV - 1) ? 0 : vs1 + 1; vs2 = (vs2 == NSV - 1) ? 0 : vs2 + 1;
    }
    if (pvis) { bf16x8 vfr[4][NO]; ATT_SCHED(); ATT_VLOAD(vfr, vs1); ATT_SCHED(); ATT_PVMMA(vfr); ATT_SCHED(); }
#undef ATT_VLOAD
#undef ATT_PVMMA
#undef ATT_SCHED
#undef ATT_DMA
#undef ATT_WAITGRP
    l_reg = half_sum(l_reg);
    if (half == 0) asm volatile("s_waitcnt lgkmcnt(0)\n\ts_barrier" ::: "memory");
    ATT_WAITBAR(0);
    if (hi == 0) wsf[32 + r32] = l_reg;
    asm volatile("s_waitcnt lgkmcnt(0)" ::: "memory");
    float rli[16];
#pragma unroll
    for (int r = 0; r < 16; ++r) rli[r] = __builtin_amdgcn_rcpf(wsf[32 + crow(r, hi)]);
    LAS bf16* stg = (LAS bf16*)shm + wid * (32 * DV);
#pragma unroll
    for (int r = 0; r < 16; ++r) { const int orow = crow(r, hi);
#pragma unroll
        for (int d0 = 0; d0 < NO; ++d0) stg[orow * DV + d0 * 32 + r32] = f2bf(o[d0][r] * rli[r]); }
    asm volatile("s_waitcnt lgkmcnt(0)" ::: "memory");
    constexpr int CPR = DV / 8;
#pragma unroll
    for (int i = 0; i < (32 * CPR) / 64; ++i) { const int idx = i * 64 + lane, row = idx / CPR, ch = idx % CPR; const u32x4 v = *(const LAS u32x4*)(stg + row * DV + ch * 8); *(u32x4*)(Ow + (size_t)row * ldo + ch * 8) = v; }
    ATT_WAITBAR(0);
}

template <int PRB_M = 0> __device__ __forceinline__ void mla_unit(LAS unsigned char* shm, const bf16* Qw, float qscale, const bf16* Kh, const bf16* K2, const bf16* Vh, bf16* Ow, int q0, int NT, int tid, volatile LAS unsigned* badflag) {
    constexpr int ND = 6, NO = 2, PD = 4, NSK = 4, NSV = 6, KSLOT = 12 * 1024, VSLOT = 8 * 1024, LDS_K = 0, LDS_V = NSK * KSLOT, LDS_WS = LDS_V + NSV * VSLOT;
    constexpr int ldq = 768, ldk = 1024, ldk2 = PW, ldv = 1024, ldo = 1024, NPT = 2;
    const int lane = tid & 63, r32 = lane & 31, hi = lane >> 5, wid = __builtin_amdgcn_readfirstlane(tid >> 6);
    const unsigned lds0 = (unsigned)(uintptr_t)shm;
    bf16x8 qr[ND];
#pragma unroll
    for (int d0 = 0; d0 < ND; ++d0) qr[d0] = scale8(*(const bf16x8*)(Qw + (size_t)r32 * ldq + d0 * 16 + hi * 8), qscale);
    asm volatile("" ::: "memory");
    const int krow = 8 * wid + (lane >> 3);
    const bf16* ksrc = Kh + (size_t)krow * ldk + (((lane & 7) ^ ((krow >> 1) & 7)) * 8);
    const int k2row = 16 * (wid & 3) + (lane >> 2);
    const bf16* k2src = K2 + (size_t)k2row * ldk2 + (((lane & 3) ^ ((k2row >> 2) & 3)) * 8);
    const bool xtra = wid < 4;
    const bf16* vsrc = Vh + (size_t)(16 * (wid & 3) + (lane >> 2)) * ldv + (wid >> 2) * 32 + (lane & 3) * 8;
#define M_DMA(t, ks_, vs_) do { glds16(ksrc + (size_t)(t) * 64 * ldk, (unsigned)__builtin_amdgcn_readfirstlane(lds0 + LDS_K + (ks_) * KSLOT + wid * 1024)); \
        if (xtra) glds16(k2src + (size_t)(t) * 64 * ldk2, (unsigned)__builtin_amdgcn_readfirstlane(lds0 + LDS_K + (ks_) * KSLOT + 8192 + wid * 1024)); \
        glds16(vsrc + (size_t)(t) * 64 * ldv, (unsigned)__builtin_amdgcn_readfirstlane(lds0 + LDS_V + (vs_) * VSLOT + wid * 1024)); } while (0)
#define M_WAITBAR(N) asm volatile("s_waitcnt vmcnt(%0) lgkmcnt(0)\n\ts_barrier" :: "n"(N) : "memory")
#define M_WAITGRP(keep) do { const int k_ = (keep); if (xtra) { if (k_ <= 0) M_WAITBAR(0); else if (k_ == 1) M_WAITBAR(NPT + 1); else if (k_ == 2) M_WAITBAR(2 * (NPT + 1)); else M_WAITBAR(3 * (NPT + 1)); } \
        else { if (k_ <= 0) M_WAITBAR(0); else if (k_ == 1) M_WAITBAR(NPT); else if (k_ == 2) M_WAITBAR(2 * NPT); else M_WAITBAR(3 * NPT); } } while (0)
#define M_SCHED() __builtin_amdgcn_sched_barrier(0)
#define M_KLOADR(kf, kslot, D0, D1) do { int rk = r32, hk = hi; asm volatile("" : "+v"(rk), "+v"(hk)); const LAS unsigned char* kb = shm + LDS_K + (kslot) * KSLOT; \
        _Pragma("unroll") for (int d0 = (D0); d0 < (D1); ++d0) { if (d0 < 4) { const LAS unsigned char* kp = kb + rk * 128 + (((2 * d0 + hk) ^ ((rk >> 1) & 7)) << 4); kf[d0][0] = *(const LAS bf16x8*)(kp); kf[d0][1] = *(const LAS bf16x8*)(kp + 4096); } \
            else { const LAS unsigned char* kp = kb + 8192 + rk * 64 + (((2 * (d0 - 4) + hk) ^ ((rk >> 2) & 3)) << 4); kf[d0][0] = *(const LAS bf16x8*)(kp); kf[d0][1] = *(const LAS bf16x8*)(kp + 2048); } } } while (0)
#define M_KLOAD(kf, kslot) M_KLOADR(kf, kslot, 0, 6)
#define M_VLOAD(vfr, vslot) do { const LAS unsigned char* vp = shm + LDS_V + (vslot) * VSLOT + ((lane >> 4) & 1) * 32 + (lane & 3) * 8 + (4 * hi + ((lane & 15) >> 2)) * 64; \
        _Pragma("unroll") for (int k4 = 0; k4 < 4; ++k4) _Pragma("unroll") for (int d0 = 0; d0 < NO; ++d0) { const s16x4 lo = vtr(vp + d0 * 4096 + k4 * 1024), hh = vtr(vp + d0 * 4096 + k4 * 1024 + 512); \
            vfr[k4][d0] = (bf16x8){lo[0], lo[1], lo[2], lo[3], hh[0], hh[1], hh[2], hh[3]}; } } while (0)
#define M_PVMMA(vfr) do { if (PRB_M != 3) _Pragma("unroll") for (int k4 = 0; k4 < 4; ++k4) { _Pragma("unroll") for (int d0 = 0; d0 < NO; ++d0) \
            o[d0] = __builtin_amdgcn_mfma_f32_32x32x16_bf16(__builtin_bit_cast(bf16x8, pw[k4]), vfr[k4][d0], o[d0], 0, 0, 0); } } while (0)
#define M_QK(P0, P1, kf) do { if (PRB_M != 3) _Pragma("unroll") for (int d0 = 0; d0 < ND; ++d0) { \
            if (d0 == 0) { P0 = __builtin_amdgcn_mfma_f32_32x32x16_bf16(kf[0][0], qr[0], f32x16{}, 0, 0, 0); P1 = __builtin_amdgcn_mfma_f32_32x32x16_bf16(kf[0][1], qr[0], f32x16{}, 0, 0, 0); } \
            else { P0 = __builtin_amdgcn_mfma_f32_32x32x16_bf16(kf[d0][0], qr[d0], P0, 0, 0, 0); P1 = __builtin_amdgcn_mfma_f32_32x32x16_bf16(kf[d0][1], qr[d0], P1, 0, 0, 0); } } } while (0)
#define M_EXP(P0, P1) do { if (PRB_M != 2) _Pragma("unroll") for (int r = 0; r < 16; ++r) { P0[r] = __builtin_amdgcn_exp2f(P0[r]); P1[r] = __builtin_amdgcn_exp2f(P1[r]); } } while (0)
#define M_PACK(P0, P1) do { { float sa_ = 0.f, sb_ = 0.f; _Pragma("unroll") for (int r = 0; r < 16; ++r) { sa_ += P0[r]; sb_ += P1[r]; } l_reg += sa_ + sb_; } if (PRB_M != 2) _Pragma("unroll") for (int i = 0; i < 4; ++i) { pw[0][i] = cvtpk(P0[2 * i], P0[2 * i + 1]); pw[1][i] = cvtpk(P0[8 + 2 * i], P0[9 + 2 * i]); pw[2][i] = cvtpk(P1[2 * i], P1[2 * i + 1]); pw[3][i] = cvtpk(P1[8 + 2 * i], P1[9 + 2 * i]); } } while (0)
#define M_STEP(t) do { \
        { const int rem = NT - 1 - (t); M_WAITGRP((rem < PD - 1 ? rem : PD - 1) - 1); } \
        if ((t) + PD < NT) M_DMA((t) + PD, kslot_t, vslot_n); \
        const bool vis_c = (t) <= tw, vis_n = (t) + 1 <= tw, pvis = (t) >= 1 && (t) - 1 <= tw; \
        bf16x8 kf[ND][2]; bf16x8 vfr[4][NO]; \
        if (pvis && vis_c && vis_n) {        \
            M_SCHED(); M_VLOAD(vfr, vslot_p); M_KLOADR(kf, kslot_n, 0, 3); M_SCHED();                        \
            M_EXP(p0, p1); M_SCHED(); \
            M_PVMMA(vfr); M_KLOADR(kf, kslot_n, 3, 6); M_PACK(p0, p1);                                       \
            _Pragma("unroll") for (int i_ = 0; i_ < 8; ++i_) { __builtin_amdgcn_sched_group_barrier(0x008, 1, 0); __builtin_amdgcn_sched_group_barrier(0x002, 6, 0); } \
            M_SCHED(); \
            M_QK(p0, p1, kf); M_SCHED(); \
        } else { \
            M_SCHED(); if (pvis) M_VLOAD(vfr, vslot_p); if (vis_n) M_KLOAD(kf, kslot_n); M_SCHED(); \
            if (vis_c) M_EXP(p0, p1); \
            if (pvis) M_PVMMA(vfr); \
            if (vis_c) M_PACK(p0, p1); \
            M_SCHED(); \
            if (vis_n) { M_QK(p0, p1, kf); M_SCHED(); } \
        } \
        kslot_t = kslot_n; kslot_n = (kslot_n == NSK - 1) ? 0 : kslot_n + 1; vslot_p = (vslot_p == NSV - 1) ? 0 : vslot_p + 1; vslot_n = (vslot_n == NSV - 1) ? 0 : vslot_n + 1; } while (0)
#pragma unroll
    for (int i = 0; i < PD; ++i) if (i < NT) M_DMA(i, i, i);
    f32x16 o[NO]; float l_reg = 0.f;
#pragma unroll
    for (int d = 0; d < NO; ++d) o[d] = f32x16{};
    u32x4 pw[4] = {};
    const int tw = (PRB_M == 1) ? -1 : ((q0 + 32 * wid) >> 6);
    int kslot_t = 0, kslot_n = 1, vslot_p = NSV - 1, vslot_n = PD % NSV;
    f32x16 p0 = f32x16{}, p1 = f32x16{};
    M_WAITGRP((NT < PD ? NT : PD) - 1);
    { bf16x8 kf[ND][2]; M_SCHED(); M_KLOAD(kf, 0); M_SCHED(); M_QK(p0, p1, kf); M_SCHED(); }
    for (int t = 0; t < NT; ++t) M_STEP(t);
    if (NT - 1 <= tw) { bf16x8 vfr[4][NO]; M_SCHED(); M_VLOAD(vfr, vslot_p); M_SCHED(); M_PVMMA(vfr); M_SCHED(); }
    l_reg = half_sum(l_reg);
    const bool bad = !(l_reg < 3.0e38f) || !(l_reg > 0.f);
    if (__any(bad) && lane == 0) *badflag = 1u;
    M_WAITBAR(0);
    int re = r32, he = hi, le = lane; asm volatile("" : "+v"(re), "+v"(he), "+v"(le));
    LAS float* wsf = (LAS float*)(shm + LDS_WS) + wid * 64;
    if (he == 0) wsf[32 + re] = l_reg;
    asm volatile("s_waitcnt lgkmcnt(0)" ::: "memory");
    float rli[16];
#pragma unroll
    for (int r = 0; r < 16; ++r) rli[r] = __builtin_amdgcn_rcpf(wsf[32 + crow(r, he)]);
    LAS bf16* stg = (LAS bf16*)shm + wid * (32 * 64);
#pragma unroll
    for (int r = 0; r < 16; ++r) { const int orow = crow(r, he);
#pragma unroll
        for (int d0 = 0; d0 < NO; ++d0) stg[orow * 64 + d0 * 32 + re] = f2bf(o[d0][r] * rli[r]); }
    asm volatile("s_waitcnt lgkmcnt(0)" ::: "memory");
#pragma unroll
    for (int i = 0; i < 4; ++i) { const int idx = i * 64 + le, row = idx >> 3, ch = idx & 7; const u32x4 v = *(const LAS u32x4*)(stg + row * 64 + ch * 8); *(u32x4*)(Ow + (size_t)row * ldo + ch * 8) = v; }
    M_WAITBAR(0);
#undef M_DMA
#undef M_WAITBAR
#undef M_WAITGRP
#undef M_SCHED
#undef M_KLOAD
#undef M_KLOADR
#undef M_VLOAD
#undef M_PVMMA
#undef M_QK
#undef M_EXP
#undef M_PACK
#undef M_STEP
}

template <int NU>
__device__ __forceinline__ void sgu_units(LAS unsigned char* shm, const bf16* PROJ, const bf16* Wb  , const float* bS, bf16* OMIX, float* PBR, const int (&win)[NU], const int (&gg)[NU], int tid) {
    const int lane = tid & 63, r32 = lane & 31, hi = lane >> 5, wid = __builtin_amdgcn_readfirstlane(tid >> 6);
    const unsigned lds0 = (unsigned)(uintptr_t)shm;
    const int tb = wid >> 1, db = wid & 1, t = 32 * tb + r32;
    const int ntile = (tb < 2) ? 1 : 2; const int d = 32 * db + r32;
    uint2 wa[2][4][2]; bf16 uu[NU][16]; float bb[16];
    { const int g = gg[0]; const bf16* wrow = Wb + (size_t)g * 16384 + (size_t)t * 128;
#pragma unroll
      for (int tl = 0; tl < 2; ++tl)
#pragma unroll
          for (int ks = 0; ks < 4; ++ks) { if (tl < ntile) { wa[tl][ks][0] = *(const uint2*)(wrow + 64 * tl + 16 * ks + 4 * hi); wa[tl][ks][1] = *(const uint2*)(wrow + 64 * tl + 16 * ks + 8 + 4 * hi); } else { wa[tl][ks][0] = make_uint2(0u, 0u); wa[tl][ks][1] = make_uint2(0u, 0u); } }
#pragma unroll
      for (int r = 0; r < 16; ++r) bb[r] = bS[g * 128 + 32 * tb + crow(r, hi)]; }
#pragma unroll
    for (int u = 0; u < NU; ++u) { const int g = gg[u]; const size_t row0 = (size_t)win[u] * 128;
        const bf16* Vh = PROJ + row0 * PW + C_VB + g * 64;
        const bf16* vsrc = Vh + (size_t)(16 * (wid & 3) + (lane >> 2)) * PW + (wid >> 2) * 32 + (lane & 3) * 8;
        glds16(vsrc, (unsigned)__builtin_amdgcn_readfirstlane(lds0 + u * 16384 + wid * 1024)); glds16(vsrc + (size_t)64 * PW, (unsigned)__builtin_amdgcn_readfirstlane(lds0 + u * 16384 + 8192 + wid * 1024));
#pragma unroll
        for (int r = 0; r < 16; ++r) { const int tt = 32 * tb + crow(r, hi); uu[u][r] = PROJ[(row0 + tt) * PW + C_UB + g * 64 + d]; } }
    ATT_WAITBAR(0);
    const LAS unsigned char* vp = shm + ((lane >> 4) & 1) * 32 + (lane & 3) * 8 + (4 * hi + ((lane & 15) >> 2)) * 64 + db * 4096;
#pragma unroll
    for (int u = 0; u < NU; ++u) { const int g = gg[u]; const size_t row0 = (size_t)win[u] * 128;
        f32x16 o = f32x16{};
#pragma unroll
        for (int tl = 0; tl < 2; ++tl) { if (tl < ntile) {
#pragma unroll
            for (int ks = 0; ks < 4; ++ks) { const s16x4 lo = vtr(vp + u * 16384 + tl * 8192 + ks * 1024), hh = vtr(vp + u * 16384 + tl * 8192 + ks * 1024 + 512);
                const bf16x8 vf = (bf16x8){lo[0], lo[1], lo[2], lo[3], hh[0], hh[1], hh[2], hh[3]};
                const u32x4 au = {wa[tl][ks][0].x, wa[tl][ks][0].y, wa[tl][ks][1].x, wa[tl][ks][1].y};
                o = __builtin_amdgcn_mfma_f32_32x32x16_bf16(__builtin_bit_cast(bf16x8, au), vf, o, 0, 0, 0); } } }
        float sq[16];
#pragma unroll
        for (int r = 0; r < 16; ++r) { const int tt = 32 * tb + crow(r, hi); const bf16 ob = f2bf(bf2f(uu[u][r]) * (o[r] + bb[r])); OMIX[(row0 + tt) * 1024 + 256 + g * 64 + d] = ob; const float of = bf2f(ob); sq[r] = of * of; }
        { float w8[8], w4[4], w2[2];
#pragma unroll
          for (int i = 0; i < 8; ++i) { const bool up = (r32 & 16) != 0; const float send = up ? sq[i] : sq[i + 8], keep = up ? sq[i + 8] : sq[i]; w8[i] = keep + shx(send, lane, 16); }
#pragma unroll
          for (int i = 0; i < 4; ++i) { const bool up = (r32 & 8) != 0; const float send = up ? w8[i] : w8[i + 4], keep = up ? w8[i + 4] : w8[i]; w4[i] = keep + shx(send, lane, 8); }
#pragma unroll
          for (int i = 0; i < 2; ++i) { const bool up = (r32 & 4) != 0; const float send = up ? w4[i] : w4[i + 2], keep = up ? w4[i + 2] : w4[i]; w2[i] = keep + shx(send, lane, 4); }
          const bool up2 = (r32 & 2) != 0; float w1 = (up2 ? w2[1] : w2[0]) + shx(up2 ? w2[0] : w2[1], lane, 2); w1 += shx(w1, lane, 1);
          if ((r32 & 1) == 0) PBR[(row0 + 32 * tb + crow(r32 >> 1, hi)) * 24 + 16 + 2 * g + db] = w1; } }
    asm volatile("s_waitcnt lgkmcnt(0)\n\ts_barrier" ::: "memory");
}
#undef ATT_WAITBAR
}

#include <hip/hip_bf16.h>
#include <cmath>
namespace tfx {
using bf16=__hip_bfloat16;
using bf16x8=__attribute__((ext_vector_type(8)))short;
using s16x4=__attribute__((ext_vector_type(4)))short;
using f32x16=__attribute__((ext_vector_type(16)))float;
using u32x4=__attribute__((ext_vector_type(4)))unsigned;
constexpr int SEQ=4096,D=64,DM=2816  ,DMO=1024  ;
constexpr int NW=8,QBLK=32,QB=QBLK*NW,KVBLK=64,NQB=SEQ/QB;
constexpr int ATTN_UNIT_ROWS=QB;
__device__ __forceinline__ int crow(int r,int hi){return (r&3)+8*(r>>2)+4*hi;}
#define SBAR() __builtin_amdgcn_sched_barrier(0)
__device__ __forceinline__ void cmask(f32x16&p0,f32x16&p1,int jb,int qrel,int hi){
  const float NEG=-INFINITY; int kb=64*jb+4*hi;
  #pragma unroll
  for(int r=0;r<16;++r){int kv=kb+(r&3)+8*(r>>2); if(kv>qrel)p0[r]=NEG; if(kv+32>qrel)p1[r]=NEG;}
}

constexpr int NSLOT=3, SLOTB=8192;
constexpr int LDS_K=0, LDS_V=NSLOT*SLOTB, LDS_WS=2*NSLOT*SLOTB, LDS_OST=LDS_WS+NW*64*4, LDS_BYTES=LDS_OST+NW*4096;
constexpr float C2=0.125f*1.4426950408889634f;
__device__ __forceinline__ void glds16(const void*gsrc,unsigned lds_dst){unsigned keep;
  asm volatile("s_mov_b32 %0, m0\n\ts_mov_b32 m0, %2\n\ts_nop 0\n\tglobal_load_lds_dwordx4 %1, off\n\ts_mov_b32 m0, %0":"=&s"(keep):"v"(gsrc),"s"(lds_dst):"memory");}
__device__ __forceinline__ float max3f(float a,float b,float c){float r;asm("v_max3_f32 %0, %1, %2, %3":"=v"(r):"v"(a),"v"(b),"v"(c));return r;}
__device__ __forceinline__ float max2f(float a,float b){float r;asm("v_max_f32_e32 %0, %1, %2":"=v"(r):"v"(a),"v"(b));return r;}
__device__ __forceinline__ float fadd_s(float a,float b){float r;asm("v_add_f32_e32 %0, %1, %2":"=v"(r):"v"(a),"v"(b));return r;}
__device__ __forceinline__ float fsub_s(float a,float b){float r;asm("v_sub_f32_e32 %0, %1, %2":"=v"(r):"v"(a),"v"(b));return r;}
typedef float f32x2_t __attribute__((ext_vector_type(2))); typedef __bf16 bf16x2_t __attribute__((ext_vector_type(2)));
__device__ __forceinline__ unsigned cvtpk_s(float lo,float hi){f32x2_t v={lo,hi};bf16x2_t b=__builtin_convertvector(v,bf16x2_t);return __builtin_bit_cast(unsigned,b);}
#define WAIT_BAR(N) asm volatile("s_waitcnt vmcnt(" #N ") lgkmcnt(0)\n\ts_barrier":::"memory")

__device__ __forceinline__ void qkt(f32x16&p0,f32x16&p1,const char*Kslot,const bf16x8*qr,const f32x16&negm,int r32,int hi){
  const char*kb=Kslot+hi*1024+r32*16;
  #pragma unroll
  for(int d0=0;d0<4;++d0){
    const bf16x8 b0=*reinterpret_cast<const bf16x8*>(kb+d0*2048);
    const bf16x8 b1=*reinterpret_cast<const bf16x8*>(kb+d0*2048+512);
    if(d0==0){p0=__builtin_amdgcn_mfma_f32_32x32x16_bf16(b0,qr[0],negm,0,0,0);p1=__builtin_amdgcn_mfma_f32_32x32x16_bf16(b1,qr[0],negm,0,0,0);}
    else{p0=__builtin_amdgcn_mfma_f32_32x32x16_bf16(b0,qr[d0],p0,0,0,0);p1=__builtin_amdgcn_mfma_f32_32x32x16_bf16(b1,qr[d0],p1,0,0,0);}}
}
typedef __attribute__((address_space(3))) const char* lds_cptr;
typedef short v4i16_t __attribute__((ext_vector_type(4)));
__device__ __forceinline__ void kload8(bf16x8*kf,lds_cptr kp){
  kf[0]=*(const __attribute__((address_space(3))) bf16x8*)(kp);      kf[1]=*(const __attribute__((address_space(3))) bf16x8*)(kp+512);
  kf[2]=*(const __attribute__((address_space(3))) bf16x8*)(kp+2048); kf[3]=*(const __attribute__((address_space(3))) bf16x8*)(kp+2560);
  kf[4]=*(const __attribute__((address_space(3))) bf16x8*)(kp+4096); kf[5]=*(const __attribute__((address_space(3))) bf16x8*)(kp+4608);
  kf[6]=*(const __attribute__((address_space(3))) bf16x8*)(kp+6144); kf[7]=*(const __attribute__((address_space(3))) bf16x8*)(kp+6656);
}
__device__ __forceinline__ void kload2(bf16x8*kf,lds_cptr kp,int j){ kf[2*j]=*(const __attribute__((address_space(3))) bf16x8*)(kp+j*2048); kf[2*j+1]=*(const __attribute__((address_space(3))) bf16x8*)(kp+j*2048+512); }
__device__ __forceinline__ s16x4 vtr(lds_cptr p){ return __builtin_bit_cast(s16x4,__builtin_amdgcn_ds_read_tr16_b64_v4i16((__attribute__((address_space(3))) v4i16_t*)p)); }
__device__ __forceinline__ float rowmax(const f32x16&p0,const f32x16&p1){
  float a=max3f(p0[0],p0[1],p1[0]),b=max3f(p0[2],p0[3],p1[1]);a=max3f(a,p1[2],p1[3]);
  #pragma unroll
  for(int r=4;r<16;r+=4){a=max3f(a,p0[r],p0[r+1]);b=max3f(b,p0[r+2],p0[r+3]);a=max3f(a,p1[r],p1[r+1]);b=max3f(b,p1[r+2],p1[r+3]);}
  const float m=max2f(a,b);
  auto rr=__builtin_amdgcn_permlane32_swap(__float_as_uint(m),__float_as_uint(m),false,false);
  return max2f(__uint_as_float(rr[0]),__uint_as_float(rr[1]));
}
__device__ __forceinline__ void pv(f32x16*o,int vb,bf16x8 pa0,bf16x8 pa1,bf16x8 pa2,bf16x8 pa3){
  #pragma unroll
  for(int d0=0;d0<2;++d0){s16x4 lo[4],hi[4];
    #pragma unroll
    for(int ks=0;ks<4;++ks){
      asm volatile("ds_read_b64_tr_b16 %0,%1 offset:%c2":"=&v"(lo[ks]):"v"(vb),"i"(d0*4096+ks*1024):"memory");
      asm volatile("ds_read_b64_tr_b16 %0,%1 offset:%c2":"=&v"(hi[ks]):"v"(vb),"i"(d0*4096+ks*1024+512):"memory");}
    asm volatile("s_waitcnt lgkmcnt(0)":::"memory");SBAR();
    #define PK(k) (bf16x8){lo[k][0],lo[k][1],lo[k][2],lo[k][3],hi[k][0],hi[k][1],hi[k][2],hi[k][3]}
    o[d0]=__builtin_amdgcn_mfma_f32_32x32x16_bf16(pa0,PK(0),o[d0],0,0,0);
    o[d0]=__builtin_amdgcn_mfma_f32_32x32x16_bf16(pa1,PK(1),o[d0],0,0,0);
    o[d0]=__builtin_amdgcn_mfma_f32_32x32x16_bf16(pa2,PK(2),o[d0],0,0,0);
    o[d0]=__builtin_amdgcn_mfma_f32_32x32x16_bf16(pa3,PK(3),o[d0],0,0,0);
    #undef PK
  }
}

#ifndef ATTN_STORE16
#define ATTN_STORE16(p,v) (*(u32x4*)(p)=(v))
#endif
typedef __attribute__((address_space(3))) const float* lds_fptr; typedef float f32x4_t __attribute__((ext_vector_type(4)));
#define FBIAS(P0,P1,t) do{ const lds_fptr fp_=fbk+64*(t)+4*hi; _Pragma("unroll") for(int g_=0;g_<4;++g_){ const f32x4_t f0_=*(const __attribute__((address_space(3))) f32x4_t*)(fp_+8*g_), f1_=*(const __attribute__((address_space(3))) f32x4_t*)(fp_+32+8*g_); \
    _Pragma("unroll") for(int j_=0;j_<4;++j_){P0[4*g_+j_]+=f0_[j_];P1[4*g_+j_]+=f1_[j_];} } }while(0)
template<int THRL,int MODE> __device__ __forceinline__ void attn_unit(int b,int qb,const bf16*Q,const bf16*__restrict__ K,const bf16*__restrict__ V,const bf16*__restrict__ R,bf16*O,char*shm,const float*cumh,int tid_in,const float*qng=nullptr,const float*qrg=nullptr,const float*ropet=nullptr,float*PS=nullptr,float mshift=0.f,float skipthr=0.f){
  constexpr int DMQ=MODE?768:DM, DMK=MODE?1024:DM, DMV=DMK, DMR=DM, NQ=MODE?6:4, LDS_R=LDS_BYTES;
  int tid=tid_in; asm volatile("":"+v"(tid));
  const int lane=tid&63,r32=lane&31,hi=lane>>5; const int wid=__builtin_amdgcn_readfirstlane(tid>>6);
  const long rowbase=(long)b*SEQ; const int q0=qb*QB;
  const bf16*Qw=Q+(rowbase+q0+wid*QBLK)*DMQ;
  const bf16*Kh=K+rowbase*DMK,*Vh=V+rowbase*DMV;
  int t0=0;
  if(MODE==0&&skipthr>0.f){ const int NTf=(q0+QB)/KVBLK; const float cq=cumh[(long)q0*4]; bool sk=false; if(lane<NTf-4){ const float ck=cumh[(long)(64*lane+63)*4]; sk=((cq-ck)*1.4426950408889634f<-skipthr); }
    const unsigned long long m_=__ballot(sk); int z=(~m_==0ull)?64:__builtin_ctzll(~m_); if(z>NTf-4)z=NTf-4; t0=__builtin_amdgcn_readfirstlane(z&~1); Kh+=(long)t0*KVBLK*DMK; Vh+=(long)t0*KVBLK*DMV; }
  const unsigned lds0=(unsigned)(uintptr_t)shm;
  float*wsf=(float*)(shm+LDS_WS)+wid*64;
  if(MODE==0){ float*fbw=(float*)(shm+LDS_BYTES); for(int i=64*t0+tid;i<q0+QB;i+=NW*64)fbw[i]=-cumh[(long)i*4]*1.4426950408889634f; }
  const lds_fptr fb3=(lds_fptr)(shm+LDS_BYTES); const lds_fptr fbk=fb3+64*t0;
  const bf16*ksrc=Kh+(long)lane*DMK+wid*8;
  const bf16*vsrc=Vh+(long)(16*(wid&3)+(lane>>2))*DMV+(wid>>2)*32+(lane&3)*8;
  const bf16*rsrc=MODE?(R+rowbase*DMR+(long)lane*DMR+(wid&3)*8):nullptr;
  const bool xw=(MODE==1)&&(wid<4); const unsigned rdst=lds0+LDS_R+(wid&3)*1024;
  const unsigned kdst=lds0+LDS_K+wid*1024, vdst=lds0+LDS_V+wid*1024;
  #define DMA_K(t,slot) do{ glds16(ksrc+(long)(t)*KVBLK*DMK,(unsigned)__builtin_amdgcn_readfirstlane(kdst+(slot))); if(xw) glds16(rsrc+(long)(t)*KVBLK*DMR,(unsigned)__builtin_amdgcn_readfirstlane(rdst+((t)&3)*4096)); }while(0)
  #define DMA_V(t,slot) glds16(vsrc+(long)(t)*KVBLK*DMV,(unsigned)__builtin_amdgcn_readfirstlane(vdst+(slot)))
  #define WAITX(N,NX) do{ if(xw){WAIT_BAR(NX);}else{WAIT_BAR(N);} }while(0)
  const int vb0=(int)(lds0+LDS_V)+((lane>>4)&1)*32+(lane&3)*8+(4*hi+((lane&15)>>2))*64;
  const char*Kbase=shm+LDS_K; bf16x8 kf[8];
  const lds_cptr shm3=(lds_cptr)shm; const lds_cptr kp0=shm3+LDS_K+hi*1024+r32*16; const lds_cptr vp0=shm3+LDS_V+((lane>>4)&1)*32+(lane&3)*8+(4*hi+((lane&15)>>2))*64;
  const int NT=(q0+QB)/KVBLK-t0;
  DMA_K(0,0);DMA_V(0,0);DMA_K(1,SLOTB);
  bf16x8 qr[NQ];
  #pragma unroll
  for(int d0=0;d0<NQ;++d0)qr[d0]=*reinterpret_cast<const bf16x8*>(&Qw[(long)r32*DMQ+d0*16+hi*8]);
  if(MODE==1){
    const float C2m=0.10206207261596575f*1.4426950408889634f;
    float xn[4][8]; float ss=0.f;
    #pragma unroll
    for(int d0=0;d0<4;++d0){ const u32x4 u=__builtin_bit_cast(u32x4,qr[d0]);
      #pragma unroll
      for(int i=0;i<4;++i){ xn[d0][2*i]=__uint_as_float(u[i]<<16); xn[d0][2*i+1]=__uint_as_float(u[i]&0xffff0000u); ss+=xn[d0][2*i]*xn[d0][2*i]+xn[d0][2*i+1]*xn[d0][2*i+1]; } }
    { auto rr=__builtin_amdgcn_permlane32_swap(__float_as_uint(ss),__float_as_uint(ss),false,false); ss=__uint_as_float(rr[0])+__uint_as_float(rr[1]); }
    const float rn=__builtin_amdgcn_rsqf(ss*(1.f/64.f)+1e-6f)*C2m;
    #pragma unroll
    for(int d0=0;d0<4;++d0){ u32x4 w;
      #pragma unroll
      for(int i=0;i<4;++i) w[i]=cvtpk_s(xn[d0][2*i]*rn*qng[d0*16+hi*8+2*i], xn[d0][2*i+1]*rn*qng[d0*16+hi*8+2*i+1]);
      qr[d0]=__builtin_bit_cast(bf16x8,w); }
    float x1[8],x2[8]; float s2=0.f;
    { const u32x4 u1=__builtin_bit_cast(u32x4,qr[4]),u2=__builtin_bit_cast(u32x4,qr[5]);
      #pragma unroll
      for(int i=0;i<4;++i){ x1[2*i]=__uint_as_float(u1[i]<<16); x1[2*i+1]=__uint_as_float(u1[i]&0xffff0000u); x2[2*i]=__uint_as_float(u2[i]<<16); x2[2*i+1]=__uint_as_float(u2[i]&0xffff0000u); } }
    #pragma unroll
    for(int j=0;j<8;++j)s2+=x1[j]*x1[j]+x2[j]*x2[j];
    { auto rr=__builtin_amdgcn_permlane32_swap(__float_as_uint(s2),__float_as_uint(s2),false,false); s2=__uint_as_float(rr[0])+__uint_as_float(rr[1]); }
    const float rq=__builtin_amdgcn_rsqf(s2*(1.f/32.f)+1e-6f);
    const float4*tp=reinterpret_cast<const float4*>(ropet+((rowbase+q0+wid*QBLK+r32)*16+8*hi)*2);
    u32x4 w1,w2;
    #pragma unroll
    for(int i=0;i<4;++i){ const float4 t=tp[i]; const int j0=2*i,j1=2*i+1;
      const float a0=x1[j0]*rq*qrg[8*hi+j0],b0=x2[j0]*rq*qrg[16+8*hi+j0],a1=x1[j1]*rq*qrg[8*hi+j1],b1=x2[j1]*rq*qrg[16+8*hi+j1];
      w1[i]=cvtpk_s((a0*t.x-b0*t.y)*C2m,(a1*t.z-b1*t.w)*C2m); w2[i]=cvtpk_s((a0*t.y+b0*t.x)*C2m,(a1*t.w+b1*t.z)*C2m); }
    qr[4]=__builtin_bit_cast(bf16x8,w1); qr[5]=__builtin_bit_cast(bf16x8,w2);
  }
  const lds_cptr rp0=(lds_cptr)shm+LDS_R+hi*1024+r32*16;
  #define ROPE(C0_,C1_,t,ACC) do{ if(MODE==1){ const lds_cptr rp_=rp0+((t)&3)*4096; \
      const bf16x8 r0_=*(const __attribute__((address_space(3))) bf16x8*)(rp_), r1_=*(const __attribute__((address_space(3))) bf16x8*)(rp_+512), r2_=*(const __attribute__((address_space(3))) bf16x8*)(rp_+2048), r3_=*(const __attribute__((address_space(3))) bf16x8*)(rp_+2560); \
      C0_=__builtin_amdgcn_mfma_f32_32x32x16_bf16(r0_,qr[NQ-2],ACC?C0_:negm,0,0,0); C1_=__builtin_amdgcn_mfma_f32_32x32x16_bf16(r1_,qr[NQ-2],ACC?C1_:negm,0,0,0); \
      C0_=__builtin_amdgcn_mfma_f32_32x32x16_bf16(r2_,qr[NQ-1],C0_,0,0,0); C1_=__builtin_amdgcn_mfma_f32_32x32x16_bf16(r3_,qr[NQ-1],C1_,0,0,0); } }while(0)
  float mhat=0.f,l_reg=0.f;f32x16 o[2];o[0]=f32x16{};o[1]=f32x16{};f32x16 negm=f32x16{};asm volatile("":"+v"(negm));
  const int qrel=wid*QBLK+r32;
  #define CMASK(P0,P1,t) do{int jb_=(t)-(NT-4); if(jb_>=0){ if(MODE==0)cmask(P0,P1,jb_,qrel,hi); else if(jb_>(wid>>1)){ _Pragma("unroll") for(int r_=0;r_<16;++r_){P0[r_]=-INFINITY;P1[r_]=-INFINITY;} } } }while(0)
  bool resc=false;
  #define START(P0,P1) do{ resc=false; \
    { const float dl=((MODE==0)?fb3[q0+qrel]:0.f)+mshift; mhat=fadd_s(mhat,dl); \
      _Pragma("unroll") for(int r=0;r<16;++r){P0[r]=fsub_s(P0[r],dl);P1[r]=fsub_s(P1[r],dl);} \
      _Pragma("unroll") for(int r=0;r<16;++r)negm[r]=-mhat; asm volatile("":"+v"(negm)); } \
    _Pragma("unroll") for(int r=0;r<16;++r)P0[r]=__builtin_amdgcn_exp2f(P0[r]); }while(0)
  #define RESC() do{}while(0)
  f32x16 pA0,pA1,pB0,pB1;
  int sl_prev=0,sl_cur=0,sl_next=SLOTB;
  #define ROT() do{sl_prev=sl_cur;sl_cur=sl_next;sl_next=(sl_next==(NSLOT-1)*SLOTB)?0:sl_next+SLOTB;}while(0)
  DMA_K(2,2*SLOTB);
  WAITX(3,5);
  qkt(pA0,pA1,Kbase,qr,negm,r32,hi);ROPE(pA0,pA1,0,true);asm volatile("s_nop 15\n\ts_nop 7":"+v"(pA0),"+v"(pA1));if(MODE==0)FBIAS(pA0,pA1,0);CMASK(pA0,pA1,0);
  START(pA0,pA1);
  _Pragma("unroll") for(int r=0;r<16;++r)pA1[r]=__builtin_amdgcn_exp2f(pA1[r]);
  WAIT_BAR(0);
  DMA_K(3,0);DMA_V(1,SLOTB);
  ROT();
  kload8(kf,kp0+sl_cur);
  WAITX(2,3);
  s16x4 vlo[8],vhi[8]; u32x4 pw0,pw1,pw2,pw3;
  #define PKW(P,B) cvtpk_s(P[B],P[B+1])
  #define PAF(k) __builtin_bit_cast(bf16x8,pw##k)
  #define VFR(i) (bf16x8){vlo[i][0],vlo[i][1],vlo[i][2],vlo[i][3],vhi[i][0],vhi[i][1],vhi[i][2],vhi[i][3]}
  #define PIN(x) asm volatile("":"+v"(x))
  #define MX3(a,b,c) __builtin_fmaxf(__builtin_fmaxf((a),(b)),(c))
  #define GAPA(MF,A0,A1,A2,A3,W0,W1,PW) do{ MF; sacc+=A0; sacc+=A1; sacc+=A2; sacc+=A3; PIN(sacc); W0; W1; PIN(PW); SBAR(); }while(0)
  #define EX(v) __builtin_amdgcn_exp2f(v)
  #define GAPB(MF,X,B) do{ MF; X[B]=EX(X[B]); X[B+1]=EX(X[B+1]); X[B+2]=EX(X[B+2]); X[B+3]=EX(X[B+3]); PIN(X); SBAR(); }while(0)
  #define VRD(i) do{ vlo[i]=vtr(vp_+(((i)>>2)*4096+((i)&3)*1024)); vhi[i]=vtr(vp_+(((i)>>2)*4096+((i)&3)*1024+512)); }while(0)
  #define KRD(G,j) do{ if(G){ kload2(kf,kp0+sl_next,j); SBAR(); } }while(0)
  #define STEP(C0,C1,P0,P1,t,GK,GV,GL) do{ SBAR(); \
    const lds_cptr vp_=vp0+sl_prev; \
    ROPE(C0,C1,t,false); SBAR(); \
    VRD(0); SBAR(); float sacc=(P0[0]+P0[1]); \
    GAPA(C0=__builtin_amdgcn_mfma_f32_32x32x16_bf16(kf[0],qr[0],MODE==1?C0:negm,0,0,0), P0[2],P0[3],P0[4],P0[5],     pw0[0]=PKW(P0,0), pw0[1]=PKW(P0,2), pw0); \
    VRD(4); SBAR(); GAPA(C1=__builtin_amdgcn_mfma_f32_32x32x16_bf16(kf[1],qr[0],MODE==1?C1:negm,0,0,0), P0[6],P0[7],P0[8],P0[9],     pw0[2]=PKW(P0,4), pw0[3]=PKW(P0,6), pw0); \
    VRD(1); SBAR(); GAPA(C0=__builtin_amdgcn_mfma_f32_32x32x16_bf16(kf[2],qr[1],C0,0,0,0),   P0[10],P0[11],P0[12],P0[13], pw1[0]=PKW(P0,8), pw1[1]=PKW(P0,10), pw1); \
    VRD(5); SBAR(); GAPA(C1=__builtin_amdgcn_mfma_f32_32x32x16_bf16(kf[3],qr[1],C1,0,0,0),   P0[14],P0[15],P1[0],P1[1],   pw1[2]=PKW(P0,12),pw1[3]=PKW(P0,14), pw1); \
    VRD(2); SBAR(); GAPA(C0=__builtin_amdgcn_mfma_f32_32x32x16_bf16(kf[4],qr[2],C0,0,0,0),   P1[2],P1[3],P1[4],P1[5],     pw2[0]=PKW(P1,0), pw2[1]=PKW(P1,2), pw2); \
    VRD(6); SBAR(); GAPA(C1=__builtin_amdgcn_mfma_f32_32x32x16_bf16(kf[5],qr[2],C1,0,0,0),   P1[6],P1[7],P1[8],P1[9],     pw2[2]=PKW(P1,4), pw2[3]=PKW(P1,6), pw2); \
    VRD(3); SBAR(); GAPA(C0=__builtin_amdgcn_mfma_f32_32x32x16_bf16(kf[6],qr[3],C0,0,0,0),   P1[10],P1[11],P1[12],P1[13], pw3[0]=PKW(P1,8), pw3[1]=PKW(P1,10), pw3); \
    VRD(7); SBAR(); GAPA(C1=__builtin_amdgcn_mfma_f32_32x32x16_bf16(kf[7],qr[3],C1,0,0,0),   P1[14],P1[15],0.f,0.f,       pw3[2]=PKW(P1,12),pw3[3]=PKW(P1,14), pw3); \
    l_reg+=sacc; \
    if(GK){DMA_K((t)+3,sl_cur);} if(GV){DMA_V((t)+1,sl_next);} \
    if(MODE==0)FBIAS(C0,C1,t); CMASK(C0,C1,t); \
    SBAR(); \
    GAPB(o[0]=__builtin_amdgcn_mfma_f32_32x32x16_bf16(PAF(0),VFR(0),o[0],0,0,0), C0,0); \
    GAPB(o[1]=__builtin_amdgcn_mfma_f32_32x32x16_bf16(PAF(0),VFR(4),o[1],0,0,0), C0,4); \
    KRD(GL,0); GAPB(o[0]=__builtin_amdgcn_mfma_f32_32x32x16_bf16(PAF(1),VFR(1),o[0],0,0,0), C0,8); \
    KRD(GL,1); GAPB(o[1]=__builtin_amdgcn_mfma_f32_32x32x16_bf16(PAF(1),VFR(5),o[1],0,0,0), C0,12); \
    KRD(GL,2); GAPB(o[0]=__builtin_amdgcn_mfma_f32_32x32x16_bf16(PAF(2),VFR(2),o[0],0,0,0), C1,0); \
    KRD(GL,3); GAPB(o[1]=__builtin_amdgcn_mfma_f32_32x32x16_bf16(PAF(2),VFR(6),o[1],0,0,0), C1,4); \
    GAPB(o[0]=__builtin_amdgcn_mfma_f32_32x32x16_bf16(PAF(3),VFR(3),o[0],0,0,0), C1,8); \
    GAPB(o[1]=__builtin_amdgcn_mfma_f32_32x32x16_bf16(PAF(3),VFR(7),o[1],0,0,0), C1,12); \
    }while(0)
  int t=1;
  #undef CMASK
  #define CMASK(P0,P1,t) do{}while(0)
  for(;t+5<NT;t+=2){
    STEP(pB0,pB1,pA0,pA1,t,true,true,true);     WAITX(2,3); RESC(); ROT();
    STEP(pA0,pA1,pB0,pB1,t+1,true,true,true);   WAITX(2,3); RESC(); ROT();
  }
  #undef CMASK
  #define CMASK(P0,P1,t) do{int jb_=(t)-(NT-4); if(jb_>=0){ if(MODE==0)cmask(P0,P1,jb_,qrel,hi); else if(jb_>(wid>>1)){ _Pragma("unroll") for(int r_=0;r_<16;++r_){P0[r_]=-INFINITY;P1[r_]=-INFINITY;} } } }while(0)
  #define ENDW(tt) do{ if((tt)+3<NT){WAITX(2,3);} else if((tt)+2<NT){WAIT_BAR(1);} else {WAIT_BAR(0);} }while(0)
  for(;t+1<NT;t+=2){
    STEP(pB0,pB1,pA0,pA1,t,(t+3<NT),(t+1<NT),(t+1<NT));       ENDW(t);   RESC(); ROT();
    STEP(pA0,pA1,pB0,pB1,t+1,(t+4<NT),(t+2<NT),(t+2<NT));     ENDW(t+1); RESC(); ROT();
  }
  STEP(pB0,pB1,pA0,pA1,NT-1,false,false,false); RESC();
  { float sacc=pB0[0]+pB0[1]; _Pragma("unroll") for(int r=2;r<16;++r)sacc+=pB0[r]; _Pragma("unroll") for(int r=0;r<16;++r)sacc+=pB1[r]; l_reg+=sacc;
    pw0=(u32x4){PKW(pB0,0),PKW(pB0,2),PKW(pB0,4),PKW(pB0,6)};pw1=(u32x4){PKW(pB0,8),PKW(pB0,10),PKW(pB0,12),PKW(pB0,14)};pw2=(u32x4){PKW(pB1,0),PKW(pB1,2),PKW(pB1,4),PKW(pB1,6)};pw3=(u32x4){PKW(pB1,8),PKW(pB1,10),PKW(pB1,12),PKW(pB1,14)};
    SBAR(); pv(o,vb0+sl_cur,PAF(0),PAF(1),PAF(2),PAF(3)); }
  #undef PKW
  #undef PAF
  #undef VFR
  #undef PIN
  #undef MX3
  #undef GAPA
  #undef GAPB
  #undef EX
  #undef VRD
  #undef KRD
  #undef STEP
  #undef ENDW
  int lane_e=lane; asm volatile("":"+v"(lane_e)); const int r32e=lane_e&31,hie=lane_e>>5;
  {auto rr=__builtin_amdgcn_permlane32_swap(__float_as_uint(l_reg),__float_as_uint(l_reg),false,false);l_reg=__uint_as_float(rr[0])+__uint_as_float(rr[1]);}
  if(hie==0)wsf[32+r32e]=l_reg;asm volatile("s_waitcnt lgkmcnt(0)":::"memory");
  float rli[16];
  #pragma unroll
  for(int r=0;r<16;++r)rli[r]=__builtin_amdgcn_rcpf(wsf[32+crow(r,hie)]);
  bf16*Ow=O+(rowbase+q0+wid*QBLK)*DMO;
  { bf16*stg=(bf16*)(shm+LDS_OST)+wid*2048;
    #pragma unroll
    for(int r=0;r<16;++r){const int orow=crow(r,hie);
      #pragma unroll
      for(int d0=0;d0<2;++d0)stg[orow*64+d0*32+r32e]=__float2bfloat16(o[d0][r]*rli[r]);}
    asm volatile("s_waitcnt lgkmcnt(0)":::"memory");
    #pragma unroll
    for(int i=0;i<4;++i){const int row=i*8+(lane_e>>3),ch=lane_e&7; const u32x4 v=*(const u32x4*)(stg+row*64+ch*8); ATTN_STORE16(Ow+(long)row*DMO+ch*8,v);
      float ss=0.f;
      {const unsigned w4[4]={v.x,v.y,v.z,v.w};
       #pragma unroll
       for(int e=0;e<4;++e){const float a0=__uint_as_float(w4[e]<<16),a1=__uint_as_float(w4[e]&0xffff0000u);ss+=a0*a0+a1*a1;}}
      ss+=::shx(ss,lane_e,1);ss+=::shx(ss,lane_e,2);ss+=::shx(ss,lane_e,4);
      if(ch==0)PS[(rowbase+q0+wid*QBLK+row)*24]=ss;} }
  asm volatile("s_waitcnt lgkmcnt(0)\n\ts_barrier":::"memory");
  #undef DMA_K
  #undef WAITX
  #undef ROPE
  #undef DMA_V
  #undef CMASK
  #undef START
  #undef RESC
  #undef ROT
}
constexpr int ATTN_LDS_BYTES=LDS_BYTES+16384;
#undef FBIAS
#undef SBAR
#undef WAIT_BAR
}

#define XB_TMO      128
#define XB_XCNT(j)  (256  + 64 * (j))
#define XB_XSUB(j)  (1280 + 64 * (j))
#define XB_XGEN(j)  (2304 + 64 * (j))
#define XB_TOP      3328
#define XB_TOPGEN   3392
#define XCD_BAR_WORDS 3456
#define XB_SPIN_CAP (1u << 18)
__device__ __forceinline__ unsigned xb_ld(unsigned* p)              { return __hip_atomic_load(p, __ATOMIC_RELAXED, __HIP_MEMORY_SCOPE_AGENT); }
__device__ __forceinline__ unsigned xb_add(unsigned* p, unsigned v) { return __hip_atomic_fetch_add(p, v, __ATOMIC_RELAXED, __HIP_MEMORY_SCOPE_AGENT); }
__device__ __forceinline__ unsigned xb_xcc_id() { return (unsigned)__builtin_amdgcn_s_getreg((3 << 11) | 20) & 0xFu; }
#define XB_SPIN(cond, bar) do { unsigned _sp = 0; while (cond) { __builtin_amdgcn_s_sleep(1); \
    if ((++_sp & 255u) == 0u) { if (xb_ld(&(bar)[XB_TMO])) break; if (_sp > XB_SPIN_CAP) { atomicAdd(&(bar)[XB_TMO], 1u); break; } } } } while (0)
struct XcdBarrier { unsigned* bar; unsigned x; volatile LAS unsigned* st; };
__device__ __forceinline__ XcdBarrier xcd_barrier_post(unsigned* bar, volatile LAS unsigned* st) {
    XcdBarrier b; b.bar = bar; b.x = xb_xcc_id(); b.st = st;
    if (threadIdx.x == 0) { const unsigned rank = xb_add(&bar[XB_XCNT(b.x)], 1u); st[2] = rank; st[3] = b.x; }
    return b;
}
__device__ __forceinline__ void xcd_barrier_complete(unsigned* bar, unsigned x, unsigned& nloc, unsigned& nx) {
    const unsigned G = gridDim.x * gridDim.y * gridDim.z;
    unsigned sum, cnt, mine, sp = 0u;
    for (;;) {
        sum = 0u; cnt = 0u; mine = 0u;
#pragma unroll
        for (unsigned j = 0; j < 16; ++j) { const unsigned c = xb_ld(&bar[XB_XCNT(j)]); sum += c; cnt += (c > 0u) ? 1u : 0u; mine = (j == x) ? c : mine; }
        if (sum == G) break;
        __builtin_amdgcn_s_sleep(1);
        if ((++sp & 255u) == 0u) { if (xb_ld(&bar[XB_TMO])) break; if (sp > XB_SPIN_CAP) { atomicAdd(&bar[XB_TMO], 1u); break; } }
    }
    nloc = mine > 0u ? mine : 1u; nx = cnt > 0u ? cnt : 1u;
}
__device__ __forceinline__ void xcd_barrier(const XcdBarrier& b, int tid_) {
    asm volatile("s_waitcnt vmcnt(0)" ::: "memory");
    __syncthreads();
    if (tid_ == 0) {
        unsigned* bar = b.bar;
        __builtin_amdgcn_s_waitcnt(0);
        unsigned nloc = b.st[0], nx = b.st[1];
        unsigned bx_ = b.x; asm volatile("" : "+s"(bx_));
        if (nloc == 0u) { xcd_barrier_complete(bar, bx_, nloc, nx); b.st[0] = nloc; b.st[1] = nx; }
        const unsigned old = xb_add(&bar[XB_XSUB(bx_)], 1u);
        const unsigned gen = old / nloc;
        if (old + 1u == (gen + 1u) * nloc) {
            __builtin_amdgcn_fence(__ATOMIC_RELEASE, "agent");
            asm volatile("s_waitcnt vmcnt(0)" ::: "memory");
            const unsigned og = xb_add(&bar[XB_TOP], 1u);
            const unsigned tg = og / nx;
            if (og + 1u == (tg + 1u) * nx) xb_add(&bar[XB_TOPGEN], 1u);
            else XB_SPIN(xb_ld(&bar[XB_TOPGEN]) == tg, bar);
            __builtin_amdgcn_fence(__ATOMIC_ACQUIRE, "agent");
            xb_add(&bar[XB_XGEN(bx_)], 1u);
            asm volatile("s_waitcnt vmcnt(0)" ::: "memory");
        } else {
            XB_SPIN(xb_ld(&bar[XB_XGEN(bx_)]) == gen, bar);
            __builtin_amdgcn_fence(__ATOMIC_ACQUIRE, "agent");
            asm volatile("s_waitcnt vmcnt(0)" ::: "memory");
        }
    }
    __syncthreads();
}

#define XL_SUB(j) (8192 + 64 * (j))
#define XL_GEN(j) (9216 + 64 * (j))
__device__ __forceinline__ void xcc_local_barrier(unsigned* ctl, unsigned* bar, unsigned x, unsigned nloc, int tid_) {
    asm volatile("s_waitcnt vmcnt(0)" ::: "memory");
    __syncthreads();
    if (tid_ == 0) {
        unsigned xx = x; asm volatile("" : "+s"(xx));
        const unsigned old = xb_add(&ctl[XL_SUB(xx)], 1u), gen = old / nloc;
        if (old + 1u == (gen + 1u) * nloc) xb_add(&ctl[XL_GEN(xx)], 1u);
        else XB_SPIN(xb_ld(&ctl[XL_GEN(xx)]) == gen, bar);
        __builtin_amdgcn_fence(__ATOMIC_ACQUIRE, "agent");
        asm volatile("s_waitcnt vmcnt(0)" ::: "memory");
    }
    __syncthreads();
}

constexpr int NWAVES = 8;
constexpr int RING_BYTES = 131072, LDSCTL_OFF = RING_BYTES, MISC_OFF = LDSCTL_OFF + 320, LDS_BYTES = 147456;
constexpr int CW_BAR = 4096;
constexpr size_t L_WIN = 0, L_WUQ = 3670016, L_WUKV = 4063232, L_WOUT = 4587520, L_WMQ = 6684672, L_WMKV = 7733248, L_WMO = 9830400, LW_STRIDE = 11 * MiB;
constexpr size_t W_FGU = 22 * MiB, W_FD = 33 * MiB, W_MGU = 39 * MiB, W_MD = 83 * MiB, MGU_STRIDE = (size_t)DFE * 2 * 1024 * 2, MD_STRIDE = (size_t)1024 * DFE * 2;
constexpr size_t W_SGU = 106 * MiB;
constexpr size_t WS_HMP = WS_QC;

struct Job { const float* src; const float* src2; const float* ksc; const float* kscb; const float* kscc; int ldw, Ksrc, Kpad, Nphys, map, nlog; bf16* dst; };
__device__ __forceinline__ Job get_job(const Args& a, int j) {
    Job J; J.src2 = nullptr; J.ksc = nullptr; J.kscb = nullptr; J.kscc = nullptr; J.map = 0; unsigned char* wb = a.ws + WS_WB;
    if (j < 14) { const int l = j / 7, t = j % 7; unsigned char* lb = wb + (size_t)l * LW_STRIDE;
        switch (t) {
        case 0: J.src = a.in[4] + (size_t)l * 1024 * IN_W; J.ldw = IN_W; J.Ksrc = 1024; J.Kpad = 1024; J.Nphys = 1792; J.map = 4; J.nlog = IN_W; J.dst = (bf16*)(lb + L_WIN); J.ksc = a.in[3] + l * 1024; break;
        case 1: J.src = a.in[12] + (size_t)l * 256 * 768; J.ldw = 768; J.Ksrc = 256; J.Kpad = 256; J.Nphys = 768; J.nlog = 768; J.dst = (bf16*)(lb + L_WUQ); J.ksc = a.in[11] + l * 256; break;
        case 2: J.src = a.in[14] + (size_t)l * 128 * 1024; J.ldw = 1024; J.Ksrc = 128; J.Kpad = 128; J.Nphys = 1024; J.nlog = 1024; J.map = 3; J.dst = (bf16*)(lb + L_WUKV); J.ksc = a.in[13] + l * 128; break;
        case 3: J.src = a.in[22] + (size_t)l * 1024 * 1024; J.ldw = 1024; J.Ksrc = 1024; J.Kpad = 1024; J.Nphys = 1024; J.nlog = 1024; J.dst = (bf16*)(lb + L_WOUT); J.ksc = a.in[19] + l * 256; J.kscb = a.in[20] + l * 256; J.kscc = a.in[21] + l * 512; break;
        case 4: J.src = a.in[25] + (size_t)l * 1024 * 512; J.ldw = 512; J.Ksrc = 1024; J.Kpad = 1024; J.Nphys = 512; J.nlog = 512; J.dst = (bf16*)(lb + L_WMQ); J.ksc = a.in[23] + l * 1024; break;
        case 5: J.src = a.in[26] + (size_t)l * 1024 * 1024; J.ldw = 1024; J.Ksrc = 1024; J.Kpad = 1024; J.Nphys = 1024; J.nlog = 1024; J.dst = (bf16*)(lb + L_WMKV); break;
        default: J.src = a.in[29] + (size_t)l * 512 * 1024; J.ldw = 1024; J.Ksrc = 512; J.Kpad = 512; J.Nphys = 1024; J.nlog = 1024; J.dst = (bf16*)(lb + L_WMO); break;
        }
    } else if (j == 14) { J.src = a.in[31]; J.src2 = a.in[32]; J.ldw = DFF; J.Ksrc = 1024; J.Kpad = 1024; J.Nphys = 2 * DFFP; J.map = 2; J.nlog = DFF; J.dst = (bf16*)(wb + W_FGU); J.ksc = a.in[30]; }
    else if (j == 15) { J.src = a.in[33]; J.ldw = 1024; J.Ksrc = DFF; J.Kpad = DFFP; J.Nphys = 1024; J.nlog = 1024; J.dst = (bf16*)(wb + W_FD); }
    else if (j < 24) { const int e = j - 16; J.src = a.in[36] + (size_t)e * 1024 * DFE; J.src2 = a.in[37] + (size_t)e * 1024 * DFE; J.ldw = DFE; J.Ksrc = 1024; J.Kpad = 1024; J.Nphys = 2 * DFE; J.map = 2; J.nlog = DFE; J.dst = (bf16*)(wb + W_MGU + (size_t)e * MGU_STRIDE); J.ksc = a.in[30] + 1024; }
    else { const int e = j - 24; J.src = a.in[38] + (size_t)e * DFE * 1024; J.ldw = 1024; J.Ksrc = DFE; J.Kpad = DFE; J.Nphys = 1024; J.nlog = 1024; J.dst = (bf16*)(wb + W_MD + (size_t)e * MD_STRIDE); }
    return J;
}
__device__ __forceinline__ int job_items(const Job& J) { return (J.Kpad / 32) * (J.Nphys / 64); }
__device__ __forceinline__ void transpose_item(const Job& J, int item, LAS float* scr, int lane) {
    const int nblk = J.Nphys / 64, kb = item / nblk, nb = item % nblk, k0 = 32 * kb, n0 = 64 * nb;
    const int p = n0 + 4 * (lane & 15); int col = -1; const float* src = J.src;
    if (J.map == 0) col = p < J.nlog ? p : -1;
    else if (J.map == 1) col = p < 768 ? p : (p < 1696 ? p + 4 : (p < 1700 ? 768 + (p - 1696) : -1));
    else if (J.map == 3 || J.map == 4) { col = (p & ~255) + 64 * ((p >> 5) & 3) + 32 * ((p >> 7) & 1) + (p & 31); if (J.map == 4) col = col < 768 ? col : (col < 1696 ? col + 4 : (col < 1700 ? 768 + (col - 1696) : -1)); }
    else { const int jt = p >> 8, w = p & 255; col = 128 * jt + (w & 127); if (w >> 7) src = J.src2; if (col >= J.nlog) col = -1; }
    float4 v[8];
#pragma unroll
    for (int i = 0; i < 8; ++i) { const int kk = 4 * i + (lane >> 4); v[i] = make_float4(0.f, 0.f, 0.f, 0.f);
        if (col >= 0 && k0 + kk < J.Ksrc) { v[i] = *(const float4*)(src + (size_t)(k0 + kk) * J.ldw + col); if (J.ksc) { const int kr = k0 + kk; const float s = !J.kscb ? J.ksc[kr] : (kr < 256 ? J.ksc[kr] : (kr < 512 ? J.kscb[kr - 256] : J.kscc[kr - 512])); v[i].x *= s; v[i].y *= s; v[i].z *= s; v[i].w *= s; } } }
#pragma unroll
    for (int i = 0; i < 8; ++i) { const int kk = 4 * i + (lane >> 4); LAS float* d = scr + kk * 65 + 4 * (lane & 15); d[0] = v[i].x; d[1] = v[i].y; d[2] = v[i].z; d[3] = v[i].w; }
    asm volatile("s_waitcnt lgkmcnt(0)" ::: "memory");
    const int c = lane & 3;
#pragma unroll
    for (int j = 0; j < 4; ++j) { const int n = (lane >> 2) + 16 * j; const LAS float* s = scr + (8 * c) * 65 + n;
        uint4 o; o.x = pack2(s[0 * 65], s[1 * 65]); o.y = pack2(s[2 * 65], s[3 * 65]); o.z = pack2(s[4 * 65], s[5 * 65]); o.w = pack2(s[6 * 65], s[7 * 65]);
        *(uint4*)(J.dst + (size_t)(n0 + n) * J.Kpad + k0 + 8 * c) = o; }
    asm volatile("s_waitcnt lgkmcnt(0)" ::: "memory");
}

enum { GP_PRO = 0, GP_KVM = 1, GP_L0 = 2, GP_LSTRIDE = 20, GP_END = 42 };
enum { LP_N1 = 0, LP_G1, LP_POSTPROJ, LP_UP, LP_POSTUP, LP_ATTN, LP_MIXNORM, LP_G4, LP_N2, LP_G5, LP_MEMNQ, LP_ATTM, LP_G7, LP_N3, LP_F1, LP_F2, LP_F3, LP_F4 };

typedef pg8::DenseOrder ChainOrder;
struct MArgs { const float* in[39]; float* out; unsigned char* ws; int ph_lo, ph_hi, li, pad; };
typedef const __attribute__((address_space(4))) MArgs* KArgP;
#define PHASE_ENV() KArgP kp_ = kp; asm volatile("" : "+s"(kp_)); const int lane = hw_lane(), wave = wave_s, tid = wave_s * 64 + lane; int l_ = l; asm volatile("" : "+s"(l_)); int cg = cg_g; asm volatile("" : "+s"(cg)); (void)cg; \
    const int gw = bx * NWAVES + wave, ngw = G * NWAVES; (void)lane; (void)gw; (void)ngw; (void)tid; \
    Args a; _Pragma("unroll") for (int i_ = 0; i_ < 39; ++i_) a.in[i_] = kp_->in[i_]; a.out = kp_->out; a.ws = kp_->ws; a.l = 0; a.phase = 0; \
    const Ctx c = make_ctx(a, l_); unsigned char* wb = a.ws + WS_WB; unsigned char* lb = wb + (size_t)l_ * LW_STRIDE; (void)lb; (void)c; \
    bf16* HMP = (bf16*)(a.ws + WS_HMP); bf16* KVM2 = (bf16*)(a.ws + WS_KVM); bf16* KVMl = KVM2 + (size_t)l_ * 4096 * 1024; (void)HMP; (void)KVMl; \
      \
    const int rbase_x = xl_ok ? hw_xcc * (MTOK / 8) : 0, nrows_x = xl_ok ? MTOK / 8 : MTOK, gw_x = xl_ok ? hw_rank * NWAVES + wave : gw, ngw_x = xl_ok ? 32 * NWAVES : ngw; (void)rbase_x; (void)nrows_x; (void)gw_x; (void)ngw_x;
__global__ void __launch_bounds__(NWAVES * 64, 2) mega(MArgs margs) {
    extern __shared__ __attribute__((aligned(16))) unsigned char lds_raw[];
    LAS unsigned char* lds = (LAS unsigned char*)lds_raw;
    volatile LAS unsigned* MISC = (volatile LAS unsigned*)(lds + MISC_OFF);
    const int G = gridDim.x, bx = blockIdx.x;
    for (int u = threadIdx.x; u < (LDS_BYTES - LDSCTL_OFF) / 4; u += NWAVES * 64) ((LAS unsigned*)(lds + LDSCTL_OFF))[u] = 0u;
    __syncthreads();
    const KArgP kp = (KArgP)__builtin_amdgcn_kernarg_segment_ptr();
    const int wave_s = __builtin_amdgcn_readfirstlane(threadIdx.x >> 6);
    const XcdBarrier bar = xcd_barrier_post((unsigned*)(margs.ws + WS_CTL) + CW_BAR + margs.li * XCD_BAR_WORDS, MISC + 8);
    const int lo = margs.ph_lo, hi = margs.ph_hi;
    __syncthreads();
    const int hw_rank = __builtin_amdgcn_readfirstlane((int)MISC[10]), hw_xcc = __builtin_amdgcn_readfirstlane((int)MISC[11]);
    int xl_ok = 0;
    int cg_g = bx;
    int vcu_g = (G % 8 == 0) ? (bx % 8) * (G / 8) + bx / 8 : bx;
#define TS_WORD 16384
#define SPLIT_WORD 12288
#ifndef SPLITB
#define SPLITB 1
#endif
#define STAMP() do { if (TPA >= 0 || TPB >= 0) { if (bx == 0 && wave_s == 0 && hw_lane() == 0) ((unsigned long long*)((unsigned*)(margs.ws + WS_CTL) + TS_WORD))[n_stamp] = __builtin_amdgcn_s_memrealtime(); ++n_stamp; } } while (0)
    int n_stamp = 0; STAMP();
#define IN(k) (lo <= (k) && (k) < hi)
#define SEAM(k) do { if (IN(k) && IN((k) + 1)) { xcd_barrier(bar, wave_s * 64 + hw_lane()); STAMP(); } } while (0)
#define LSEAM(k) do { if (CHAIN && xl_ok) { if (IN(k) && IN((k) + 1)) xcc_local_barrier((unsigned*)(margs.ws + WS_CTL), bar.bar, (unsigned)hw_xcc, 32u, wave_s * 64 + hw_lane()); } else SEAM(k); } while (0)
    { const int l = 0;
    for (int pr_ = 0; pr_ < (PRB == 5 ? 2 : 1); ++pr_) {
    for (int rp_ = 0; rp_ < REP_PRO; ++rp_) if (IN(GP_PRO)) { PHASE_ENV();
        LAS float* scr = (LAS float*)(lds + wave * 16384);
        int base = 0;
        const int njobs = (G > 128) ? 24 : 32;
        for (int j = 0; j < njobs; ++j) { const Job J = get_job(a, j); const int n = job_items(J);
            int first = gw - (base % ngw); if (first < 0) first += ngw;
            for (int it = first; it < n; it += ngw) transpose_item(J, it, scr, lane);
            base += n; }
        { bf16* wsg = (bf16*)(wb + W_SGU); for (int i = gw * 64 + lane; i < 2 * 65536; i += ngw * 64) wsg[i] = f2bf(a.in[9][i]); }
        if (G <= 128) { float2* rt = (float2*)(a.ws + WS_ROPE); const int* posi = (const int*)a.in[2];
          for (int e = gw * 64 + lane; e < MTOK * 16; e += ngw * 64) { const float ang = (float)posi[e >> 4] * rope_inv(e & 15); rt[e] = make_float2(cosf(ang), sinf(ang)); } }
        pass_xb(a.in[0], (bf16*)(a.ws + WS_H), c.PART, MTOK, gw, ngw, lane);
        for (int l2 = 0; l2 < 2; ++l2) pass_norm(a.in[1], a.in[24] + l2 * 1024, HMP + (size_t)l2 * 4096 * 1024, BATCH * MEML, gw, ngw, lane);
    }
    SEAM(GP_PRO);
    if (IN(GP_PRO) && IN(GP_PRO + 1) && G % 8 == 0) {
        bool ok = true; for (int j = 0; j < 8; ++j) ok = ok && (xb_ld(&bar.bar[XB_XCNT(j)]) == (unsigned)(G / 8));
        const int okk = __builtin_amdgcn_readfirstlane((int)(ok && hw_xcc < 8 && hw_rank < G / 8));
        if (okk) { vcu_g = hw_xcc * (G / 8) + hw_rank; cg_g = hw_rank * 8 + hw_xcc; xl_ok = (G == 256); } }
    if (IN(GP_KVM)) { PHASE_ENV();
        if (G > 128 && bx >= 128) {
            LAS float* scr = (LAS float*)(lds + wave * 16384); const int gw2 = (bx - 128) * NWAVES + wave, ngw2 = (G - 128) * NWAVES; int base = 0;
            for (int j = 24; j < 32; ++j) { const Job J = get_job(a, j); const int n = job_items(J);
                int first = gw2 - (base % ngw2); if (first < 0) first += ngw2;
                for (int it = first; it < n; it += ngw2) transpose_item(J, it, scr, lane);
                base += n; }
            float2* rt = (float2*)(a.ws + WS_ROPE); const int* posi = (const int*)a.in[2];
            for (int e = gw2 * 64 + lane; e < MTOK * 16; e += ngw2 * 64) { const float ang = (float)posi[e >> 4] * rope_inv(e & 15); rt[e] = make_float2(cosf(ang), sinf(ang)); }
        }
        pg8::KvmOrder S; S.c = bx; S.A = (const char*)HMP; S.B = (const char*)(wb + L_WMKV); S.bstride = LW_STRIDE;
        pg8::EpiStore E{KVM2, 1024};
        pg8::gemm_phase<pg8::EpiStore, pg8::KvmOrder, false, true>(lds, 1024, 1024, S, E, tid);
    }
    SEAM(GP_KVM);
    }
    if (PRB == 5) for (int i_ = 0; i_ < 20; ++i_) xcd_barrier(bar, wave_s * 64 + hw_lane());
    }
    for (int l = 0; l < 2; ++l) {
        const int B = GP_L0 + GP_LSTRIDE * l;
        for (int pr_ = 0; pr_ < (PRB == 1 ? 2 : 1); ++pr_) {
        for (int rep_ = 0; rep_ < REP_G1; ++rep_) if (IN(B + LP_G1)) { PHASE_ENV(); pg8::DenseOrder S; S.init(MTOK / 256, PNC / 256, G, cg, c.H, 1024, lb + L_WIN, 1024); pg8::EpiProj E{c.PROJ, c.PART, c.aq, c.ak, c.bv, c.krg, c.b_forget, c.ROPET, c.FLOG, c.PQ, c.PKV};
            pg8::gemm_phase<pg8::EpiProj, pg8::DenseOrder, true, true>(lds, 1024, 1024, S, E, tid); }
        LSEAM(B + LP_G1);
        }
        for (int pr_ = 0; pr_ < ((PRB == 1 || PRB == 2) ? 2 : 1); ++pr_) {
        if (IN(B + LP_UP)) {
            { PHASE_ENV(); pass_memnorm(KVMl + (size_t)(xl_ok ? hw_xcc * 2 * MEML : 0) * 1024, 1024, c.mkg, c.mqg, xl_ok ? 2 * MEML : BATCH * MEML, gw_x, ngw_x, lane); }
            { PHASE_ENV(); if (xl_ok) { if (hw_rank < 2) cumsum_batch(c, 2 * hw_xcc + hw_rank, (LAS float*)lds, tid); } else for (int b = bx; b < BATCH; b += G) cumsum_batch(c, b, (LAS float*)lds, tid); }
            { PHASE_ENV(); pg8::DenseOrder S; S.init(MTOK / 256, 3, G, cg, c.PROJ + C_CQ, PW, lb + L_WUQ, 256); pg8::EpiStoreQ E{c.QC, 768, c.PQ};
              pg8::gemm_phase<pg8::EpiStoreQ, pg8::DenseOrder, true, true>(lds, 256, PW, S, E, tid); }
            { PHASE_ENV(); pg8::DenseOrder S; S.init(MTOK / 256, 4, G, cg, c.PROJ + C_CKV, PW, lb + L_WUKV, 128); pg8::EpiKV E{c.KVC, c.kng, c.PKV};
              pg8::gemm_phase<pg8::EpiKV, pg8::DenseOrder, true, true>(lds, 128, PW, S, E, tid); }
        }
        LSEAM(B + LP_UP);
        if (PRB == 2 && pr_ == 0) continue;
        }
        for (int pr_ = 0; pr_ < (PRB == 1 ? 2 : 1); ++pr_) {
        for (int rep_ = 0; rep_ < REP_ATTN; ++rep_) {
          for (int r2_ = 0; r2_ < REP_FOX; ++r2_) if (IN(B + LP_ATTN) && BUILD_STEP >= 2) { PHASE_ENV(); const int vcu = vcu_g;
            const float Bf = 64.f * 0.125f * 1.4426950408889634f * wmaxabs(c.aq, 64, lane) * wmaxabs(c.ak, 64, lane);
            float msf, skf; { const float a_ = fmaxf(Bf - 32.f, 0.f), b_ = 2.f * Bf + 80.f; int as_, bs_; asm volatile("v_readfirstlane_b32 %0, %2\n\tv_readfirstlane_b32 %1, %3" : "=&s"(as_), "=&s"(bs_) : "v"(a_), "v"(b_)); msf = __int_as_float(as_); skf = __int_as_float(bs_); }
            for (int U = vcu; U < 1024; U += G) { const int i = U >> 8, v = U & 255, xq = v >> 5, j = v & 31, h = i, b = 2 * xq + ((i + (j >> 4)) & 1), uu = (i & 2) ? (((j & 15) + 8) & 15) : (j & 15), qb = (i & 1) ? 15 - uu : uu;
                const size_t rb = (size_t)b * SEQ, rw = rb + qb * 256 + 32 * wave;
                tfx::attn_unit<8, 0>(b, qb, (const tfx::bf16*)(c.PROJ + C_QA + h * 64), (const tfx::bf16*)(c.PROJ + C_KA + h * 64), (const tfx::bf16*)(c.PROJ + C_VA + h * 64), nullptr, (tfx::bf16*)(c.OMIX + h * 64), (char*)lds_raw, c.CUM + rb * 4 + h, tid, nullptr, nullptr, nullptr, c.PBR + h, msf, skf); }
          }
          for (int r2_ = 0; r2_ < REP_MLA; ++r2_) if (IN(B + LP_ATTN) && BUILD_STEP >= 2) { PHASE_ENV(); const int vcu = vcu_g;
            const float msm = fmaxf(0.10206207261596575f * 1.4426950408889634f * (64.f * wmaxabs(c.qng, 64, lane) * wmaxabs(c.kng, 64, lane) + 32.f * wmaxabs(c.qrg, 32, lane) * wmaxabs(c.krg, 32, lane)) - 32.f, 0.f);
            for (int U = vcu; U < 2048; U += G) { const int i = U >> 8, v = U & 255, xq = v >> 5, j = v & 31, bh = 16 * xq + 2 * i + (j >> 4), qb = (i & 1) ? 15 - (j & 15) : (j & 15), b = bh >> 3, h = bh & 7;
                const size_t rb = (size_t)b * SEQ, rw = rb + qb * 256 + 32 * wave;
                tfx::attn_unit<8, 1>(b, qb, (const tfx::bf16*)(c.QC + h * 96), (const tfx::bf16*)(c.KVC + h * 128), (const tfx::bf16*)(c.KVC + h * 128 + 64), (const tfx::bf16*)(c.PROJ + C_KR), (tfx::bf16*)(c.OMIX + 512 + h * 64), (char*)lds_raw, nullptr, tid, c.qng, c.qrg, (const float*)c.ROPET, c.PBR + 8 + h, msm); }
          }
          for (int r2_ = 0; r2_ < REP_SGU; ++r2_) if (IN(B + LP_ATTN) && BUILD_STEP >= 2) { PHASE_ENV(); const int vcu = vcu_g;
            for (int U = vcu; U < 2048; U += 2 * G) { const int Ua = xl_ok ? (256 * hw_xcc + hw_rank + 32 * (U / G)) : U, Ub = xl_ok ? Ua + 32 : U + G;
                if (U + G < 2048 && ((Ua ^ Ub) & 3) == 0) { const int wn[2] = {Ua >> 2, Ub >> 2}, gn[2] = {Ua & 3, Ub & 3}; att::sgu_units<2>(lds, c.PROJ, (const bf16*)(wb + W_SGU) + (size_t)l_ * 65536, c.bsb, c.OMIX, c.PBR, wn, gn, tid); }
                else for (int k = 0; k < 2; ++k) if (U + k * G < 2048) { const int Uk = k ? Ub : Ua; const int wn[1] = {Uk >> 2}, gn[1] = {Uk & 3}; att::sgu_units<1>(lds, c.PROJ, (const bf16*)(wb + W_SGU) + (size_t)l_ * 65536, c.bsb, c.OMIX, c.PBR, wn, gn, tid); } }
          }
        }
        LSEAM(B + LP_ATTN);
        }
        if (PRB == 3 && IN(B + LP_G4)) { PHASE_ENV(); pg8::DenseOrder S; S.init(MTOK / 256, 4, G, cg, c.OMIX, 1024, lb + L_WOUT, 1024); pg8::EpiStore E{c.KVC, 1024};
            pg8::gemm_phase<pg8::EpiStore, pg8::DenseOrder, true, true>(lds, 1024, 1024, S, E, tid); xcd_barrier(bar, wave_s * 64 + hw_lane()); }
        if (IN(B + LP_G4)) { PHASE_ENV(); ChainOrder S; S.init(MTOK / 256, 4, G, cg, c.OMIX, 1024, lb + L_WOUT, 1024); pg8::EpiResMix E{{c.H, c.PART}, c.PBR};
            pg8::gemm_phase<pg8::EpiResMix, ChainOrder, true, true>(lds, 1024, 1024, S, E, tid); }
        LSEAM(B + LP_G4);
        for (int pr_ = 0; pr_ < ((PRB == 1 || PRB == 2) ? 2 : 1); ++pr_) {
        if (IN(B + LP_G5)) { PHASE_ENV(); ChainOrder S; S.init(MTOK / 256, 2, G, cg, c.H, 1024, lb + L_WMQ, 1024); pg8::EpiStoreN E{c.QM, 768, c.PART};
            pg8::gemm_phase<pg8::EpiStoreN, ChainOrder, true, true>(lds, 1024, 1024, S, E, tid); }
        LSEAM(B + LP_G5);
        }
        for (int rep_ = 0; rep_ < REP_ATTM; ++rep_) if (IN(B + LP_ATTM) && BUILD_STEP >= 2) { PHASE_ENV(); const int vcu = vcu_g;
            for (int U = vcu; U < 1024; U += G) { const int Uc = (CHAIN && xl_ok) ? (128 * hw_xcc + hw_rank + 32 * (U / G)) : U;
                const int qblk = Uc >> 2, h = Uc & 3; const size_t rw = (size_t)qblk * 256 + 32 * wave; const int b = (qblk * 256) / SEQ; const bf16* kvb = KVMl + (size_t)b * MEML * 1024 + h * 128;
                att::attn_unit<128, 128, 2>(lds, c.QM + rw * 768 + h * 128, 768, 0.08838834764831845f * 1.4426950408889634f, kvb, 1024, nullptr, 0, kvb + 512, 1024, c.OM + rw * 1024 + h * 128, 1024, 0, 4, tid); }
        }
        LSEAM(B + LP_ATTM);
        if (PRB == 3 && IN(B + LP_G7)) { PHASE_ENV(); pg8::DenseOrder S; S.init(MTOK / 256, 4, G, cg, c.OM, 512, lb + L_WMO, 512); pg8::EpiStore E{c.OMIX, 1024};
            pg8::gemm_phase<pg8::EpiStore, pg8::DenseOrder, true, true>(lds, 512, 512, S, E, tid); xcd_barrier(bar, wave_s * 64 + hw_lane()); }
        if (IN(B + LP_G7)) { PHASE_ENV(); ChainOrder S; S.init(MTOK / 256, 4, G, cg, c.OM, 1024, lb + L_WMO, 512); pg8::EpiRes E{c.H, c.PART};
            pg8::gemm_phase<pg8::EpiRes, ChainOrder, true, true>(lds, 512, 1024, S, E, tid); }
        if (l == 0) LSEAM(B + LP_G7); else SEAM(B + LP_G7);
        if (l == 0) {
            for (int rep_ = 0; rep_ < REP_F1; ++rep_) if (IN(B + LP_F1)) { PHASE_ENV(); ChainOrder S; S.init(MTOK / 256, 22, G, cg, c.H, 1024, wb + W_FGU, 1024); pg8::EpiSwiglu E{c.HID, DFFP, c.PART, nullptr};
                pg8::gemm_phase<pg8::EpiSwiglu, ChainOrder, true, true>(lds, 1024, 1024, S, E, tid); }
            LSEAM(B + LP_F1);
            if (PRB == 3 && IN(B + LP_F2)) { PHASE_ENV(); pg8::DenseOrder S; S.init(MTOK / 256, 4, G, cg, c.HID, DFFP, wb + W_FD, DFFP); pg8::EpiStore E{c.OMIX, 1024};
                pg8::gemm_phase<pg8::EpiStore, pg8::DenseOrder, true, true>(lds, DFFP, DFFP, S, E, tid); xcd_barrier(bar, wave_s * 64 + hw_lane()); }
            if (IN(B + LP_F2)) { PHASE_ENV(); ChainOrder S; S.init(MTOK / 256, 4, G, cg, c.HID, DFFP, wb + W_FD, DFFP); pg8::EpiRes E{c.H, c.PART};
                pg8::gemm_phase<pg8::EpiRes, ChainOrder, true, true>(lds, DFFP, DFFP, S, E, tid); }
            if (IN(B + LP_F2) && IN(B + GP_LSTRIDE)) { if (CHAIN && xl_ok) xcc_local_barrier((unsigned*)(margs.ws + WS_CTL), bar.bar, (unsigned)hw_xcc, 32u, wave_s * 64 + hw_lane()); else { xcd_barrier(bar, wave_s * 64 + hw_lane()); STAMP(); } }
        } else {
            for (int pr_ = 0; pr_ < (PRB == 4 ? 2 : 1); ++pr_) {
            if (IN(B + LP_N3)) { PHASE_ENV(); for (int ch = bx; ch < 256; ch += G) route1_chunk(c, ch, (LAS int*)lds, tid); }
            SEAM(B + LP_N3);
            if (IN(B + LP_F1)) { PHASE_ENV(); for (int ch = bx; ch < 256; ch += G) route2_chunk(c, ch, (LAS int*)lds, tid); }
            SEAM(B + LP_F1);
            if (IN(B + LP_F2)) { PHASE_ENV(); const int nt = c.TAB[1000]; pg8::EpiSwiglu E{c.HIDM, DFE, nullptr, c.SLOT_R};
#if GATHER_A
                pg8::GatherOrder S; S.init(nt, 11, G, cg, c.H, 1024, wb + W_MGU, 1024); S.tab = c.TAB; S.estride = MGU_STRIDE; S.tok = c.SLOT_TOK; pg8::gemm_phase<pg8::EpiSwiglu, pg8::GatherOrder, true, true>(lds, 1024, 1024, S, E, tid);
#else
                pg8::GroupOrder S; S.init(nt, 11, G, cg, c.HS, 1024, wb + W_MGU, 1024); S.tab = c.TAB; S.estride = MGU_STRIDE; pg8::gemm_phase<pg8::EpiSwiglu, pg8::GroupOrder, true, true>(lds, 1024, 1024, S, E, tid);
#endif
            }
            SEAM(B + LP_F2);
            }
            if (PRB == 3 && IN(B + LP_F3)) { PHASE_ENV(); const int nt = c.TAB[1000]; pg8::GroupOrder S; S.init(nt, 4, G, cg, c.HIDM, DFE, wb + W_MD, DFE); S.tab = c.TAB; S.estride = MD_STRIDE; pg8::EpiStore E{c.HS, 1024};
                pg8::gemm_phase<pg8::EpiStore, pg8::GroupOrder, true, true>(lds, DFE, DFE, S, E, tid); xcd_barrier(bar, wave_s * 64 + hw_lane()); }
            if (IN(B + LP_F3)) { PHASE_ENV(); const int t0 = c.TAB[1001]; pg8::GroupOrder S; S.init(t0, 4, G, cg, c.HIDM, DFE, wb + W_MD, DFE); S.tab = c.TAB; S.estride = MD_STRIDE; pg8::EpiScatter<false> E{c.H, c.X, c.SLOT_TOK, c.SLOT_GATE, nullptr, 0u};
                pg8::gemm_phase<pg8::EpiScatter<false>, pg8::GroupOrder, true, true>(lds, DFE, DFE, S, E, tid); }
            if (SPLITB) { if (IN(B + LP_F3) && IN(B + LP_F4)) { asm volatile("s_waitcnt vmcnt(0)" ::: "memory"); __syncthreads();
                if (wave_s * 64 + hw_lane() == 0) xb_add((unsigned*)(margs.ws + WS_CTL) + SPLIT_WORD, 1u); } }
            else SEAM(B + LP_F3);
            if (IN(B + LP_F4)) { PHASE_ENV(); const int nt = c.TAB[1000], t0 = c.TAB[1001]; pg8::GroupOrder S; S.init(nt - t0, 4, G, SPLITB ? G - 1 - cg : cg, c.HIDM, DFE, wb + W_MD, DFE); S.pm0 = t0; S.tab = c.TAB; S.estride = MD_STRIDE;
                pg8::EpiScatter<true> E{c.H, c.X, c.SLOT_TOK, c.SLOT_GATE, (SPLITB && IN(B + LP_F3)) ? (unsigned*)(margs.ws + WS_CTL) + SPLIT_WORD : nullptr, (unsigned)G};
                pg8::gemm_phase<pg8::EpiScatter<true>, pg8::GroupOrder, true, true>(lds, DFE, DFE, S, E, tid); }
        }
    }
    if (TPA >= 0 || TPB >= 0) { xcd_barrier(bar, wave_s * 64 + hw_lane()); STAMP();
        if (bx == 0) { const unsigned long long* TS = (const unsigned long long*)((unsigned*)(margs.ws + WS_CTL) + TS_WORD); const int tid_ = wave_s * 64 + hw_lane();
            const float usA = (TPA >= 0) ? (float)(__hip_atomic_load(TS + TPA + 1, __ATOMIC_RELAXED, __HIP_MEMORY_SCOPE_AGENT) - __hip_atomic_load(TS + TPA, __ATOMIC_RELAXED, __HIP_MEMORY_SCOPE_AGENT)) * 0.01f : 0.f;
            const float usB = (TPB >= 0) ? (float)(__hip_atomic_load(TS + TPB + 1, __ATOMIC_RELAXED, __HIP_MEMORY_SCOPE_AGENT) - __hip_atomic_load(TS + TPB, __ATOMIC_RELAXED, __HIP_MEMORY_SCOPE_AGENT)) * 0.01f : 0.f;
            if (TPA >= 0 && tid_ == 0) margs.out[0] += usA;
            if (TPB >= 0) { const int M = (int)(usB * 1000.f); for (int i = tid_; i < M; i += 512) margs.out[1024 + i] += 8.0f; } } }
#undef IN
#undef SEAM
#undef LSEAM
}

extern "C" void kernel_launch(void* const* d_in, const int* in_sizes, int n_in, void* d_out, int out_size, void* d_ws, size_t ws_size, hipStream_t stream) {
    static int grid = 0;
    if (grid == 0) {
        if (n_in != 39 || out_size != MTOK * DM || ws_size < WS_END) { fprintf(stderr, "kernel_launch: unexpected problem (n_in %d out %d ws %zu)\n", n_in, out_size, ws_size); grid = -1; return; }
        int dev = 0, cus = 0, per_cu = 0;
        if (hipGetDevice(&dev) != hipSuccess || hipDeviceGetAttribute(&cus, hipDeviceAttributeMultiprocessorCount, dev) != hipSuccess) { grid = -1; return; }
        if (hipFuncSetAttribute((const void*)mega, hipFuncAttributeMaxDynamicSharedMemorySize, LDS_BYTES) != hipSuccess) { fprintf(stderr, "kernel_launch: hipFuncSetAttribute failed\n"); grid = -1; return; }
        if (hipOccupancyMaxActiveBlocksPerMultiprocessor(&per_cu, (const void*)mega, NWAVES * 64, LDS_BYTES) != hipSuccess || per_cu < 1) fprintf(stderr, "kernel_launch: occupancy query says %d\n", per_cu);
        (void)hipGetLastError();
        grid = cus;
    }
    if (grid < 0) return;
    hipMemsetAsync((char*)d_ws + WS_CTL, 0, 1 * MiB, stream);
    Args a{}; for (int i = 0; i < 39; ++i) a.in[i] = (const float*)d_in[i]; a.out = (float*)d_out; a.ws = (unsigned char*)d_ws;
    MArgs m{}; for (int i = 0; i < 39; ++i) m.in[i] = (const float*)d_in[i]; m.out = (float*)d_out; m.ws = (unsigned char*)d_ws;
    int li = 0;
#define MEGA(lo_, hi_) do { m.ph_lo = (lo_); m.ph_hi = (hi_); m.li = li++; hipLaunchKernelGGL(mega, dim3(grid), dim3(NWAVES * 64), LDS_BYTES, stream, m); } while (0)
#if BUILD_STEP >= 2
    MEGA(GP_PRO, GP_END);
}
#else
    const int B0 = GP_L0, B1 = GP_L0 + GP_LSTRIDE;
    int cur = GP_PRO;
    for (int l = 0; l < 2; ++l) {
        a.l = l; const Ctx c = make_ctx(a, l); const int B = l ? B1 : B0;
        MEGA(cur, B + LP_ATTN);
        hipLaunchKernelGGL((nv_attn<64, 64, 0>), dim3(MTOK / 64, 4, 1), dim3(64), 0, stream, c.PROJ + C_QA, PW, 64, c.PROJ + C_KA, PW, 64, nullptr, 0, c.PROJ + C_VA, PW, 64, c.OMIX, 1024, 64, c.CUM, 0.125f);
        hipLaunchKernelGGL(nv_sgu, dim3(MTOK / 128, 4), dim3(256), 0, stream, c.PROJ, c.bsw, c.bsb, c.OMIX);
        hipLaunchKernelGGL((nv_attn<96, 64, 1>), dim3(MTOK / 64, 8, 1), dim3(64), 0, stream, c.QC, 768, 96, c.KVC, 1024, 128, c.PROJ + C_KR, PW, c.KVC + 64, 1024, 128, c.OMIX + 512, 1024, 64, nullptr, 0.10206207261596575f);
        MEGA(B + LP_MIXNORM, B + LP_ATTM);
        hipLaunchKernelGGL((nv_attn<128, 128, 2>), dim3(MTOK / 64, 4, 2), dim3(64), 0, stream, c.QM, 512, 128, c.KVM + (size_t)l * 4096 * 1024, 1024, 128, nullptr, 0, c.KVM + (size_t)l * 4096 * 1024 + 512, 1024, 128, c.OM, 512, 128, nullptr, 0.08838834764831845f);
        cur = B + LP_G7;
    }
    MEGA(cur, GP_END);
}
#endif
```
